# Optimizing an MI355X kernel written in HIP

```python
import math
import jax, jax.numpy as jnp
from jax import lax
import numpy as np


D_MODEL = 1024
BATCH = 4
SEQ = 4096
DEPTH = 1

HEAD_DIM = 64
N_HEADS_DSA = 8
N_HEADS_MOBA = 8
N_IDX_HEADS = 4
IDX_DIM = 64
DSA_TOPK = 256
MOBA_BLOCK = 256
MOBA_TOPK = 3
N_BUCKETS = 32
MAX_DISTANCE = 128
D_FF = 2816
Q_BLOCK = 128
MOBA_Q_CHUNK = 32
EPS = 1e-6

W_DSA = N_HEADS_DSA * HEAD_DIM
W_MOBA = N_HEADS_MOBA * HEAD_DIM
W_IDX_Q = N_IDX_HEADS * IDX_DIM
SPLIT_SIZES = (W_DSA, W_DSA, W_DSA, W_MOBA, W_MOBA, W_MOBA, W_IDX_Q, IDX_DIM, N_IDX_HEADS, 2 * D_MODEL)
SPLIT_POINTS = tuple(int(v) for v in np.cumsum(SPLIT_SIZES)[:-1])
D_IN = int(sum(SPLIT_SIZES))

kernel_name = 'hybrid_dsa_moba_gated_macaron'


def rmsnorm(x, g):
    xf = x.astype(jnp.float32)
    y = xf * lax.rsqrt(jnp.mean(xf * xf, axis=-1, keepdims=True) + EPS)
    return (y * g.astype(jnp.float32)).astype(x.dtype)


def swiglu(x, w_gu, w_down):
    gate, up = jnp.split(x @ w_gu, 2, axis=-1)
    return (jax.nn.silu(gate) * up) @ w_down


def t5_bucket(dist):
    max_exact = N_BUCKETS // 2
    d = jnp.maximum(dist, 0)
    df = jnp.maximum(d, 1).astype(jnp.float32)
    large = max_exact + (jnp.log(df / max_exact) / math.log(MAX_DISTANCE / max_exact)
                         * (N_BUCKETS - max_exact)).astype(jnp.int32)
    large = jnp.minimum(large, N_BUCKETS - 1)
    return jnp.where(d < max_exact, d, large)


def dsa_attention(q, k, v, q_idx, k_idx, w_idx, bias_tab):
    B, S, H, Dh = q.shape
    topk = min(DSA_TOPK, S // 4)
    scale = Dh ** -0.5
    key_pos = jnp.arange(S)
    b_ix = jnp.arange(B)[:, None, None]
    k_idx_f = k_idx.astype(jnp.float32)

    def block(i):
        t0 = i * Q_BLOCK
        qb = lax.dynamic_slice_in_dim(q, t0, Q_BLOCK, axis=1)
        qib = lax.dynamic_slice_in_dim(q_idx, t0, Q_BLOCK, axis=1).astype(jnp.float32)
        wib = lax.dynamic_slice_in_dim(w_idx, t0, Q_BLOCK, axis=1).astype(jnp.float32)
        q_pos = t0 + jnp.arange(Q_BLOCK)
        dots = jnp.einsum('bqhd,bsd->bqhs', qib, k_idx_f) * (IDX_DIM ** -0.5)
        scores = jnp.einsum('bqh,bqhs->bqs', wib, jax.nn.relu(dots))
        causal = key_pos[None, :] <= q_pos[:, None]
        scores = jnp.where(causal[None], scores, -jnp.inf)
        _, idx = lax.top_k(scores, topk)
        k_sel = k[b_ix, idx]
        v_sel = v[b_ix, idx]
        logits = jnp.einsum('bqhd,bqkhd->bqhk', qb, k_sel).astype(jnp.float32) * scale
        dist = q_pos[None, :, None] - idx
        bias = bias_tab[t5_bucket(dist)].astype(jnp.float32)
        logits = logits + jnp.transpose(bias, (0, 1, 3, 2))
        logits = jnp.where((dist >= 0)[:, :, None, :], logits, -jnp.inf)
        p = jax.nn.softmax(logits, axis=-1)
        return jnp.einsum('bqhk,bqkhd->bqhd', p.astype(v.dtype), v_sel)

    outs = lax.map(block, jnp.arange(S // Q_BLOCK))
    return jnp.transpose(outs, (1, 0, 2, 3, 4)).reshape(B, S, H * Dh)


def moba_attention(q, k, v, bias_tab):
    B, S, H, Dh = q.shape
    scale = Dh ** -0.5
    nb = -(-S // MOBA_BLOCK)
    pad = nb * MOBA_BLOCK - S
    kp = jnp.pad(k, ((0, 0), (0, pad), (0, 0), (0, 0))).reshape(B, nb, MOBA_BLOCK, H, Dh)
    vp = jnp.pad(v, ((0, 0), (0, pad), (0, 0), (0, 0))).reshape(B, nb, MOBA_BLOCK, H, Dh)
    counts = jnp.minimum(S - jnp.arange(nb) * MOBA_BLOCK, MOBA_BLOCK).astype(jnp.float32)
    k_mean = kp.astype(jnp.float32).sum(axis=2) / counts[None, :, None, None]
    kbT = jnp.transpose(kp, (0, 3, 1, 2, 4))
    vbT = jnp.transpose(vp, (0, 3, 1, 2, 4))
    n_sel = min(MOBA_TOPK, nb - 1)
    C = MOBA_Q_CHUNK
    b_ix = jnp.arange(B)[:, None, None, None]
    h_ix = jnp.arange(H)[None, None, :, None]
    h_ix5 = jnp.arange(H)[None, None, :, None, None]
    blk_ids = jnp.arange(nb)
    offs = jnp.arange(MOBA_BLOCK)

    def chunk(i):
        t0 = i * C
        qc = lax.dynamic_slice_in_dim(q, t0, C, axis=1)
        q_pos = t0 + jnp.arange(C)
        own = q_pos // MOBA_BLOCK
        own_b = jnp.broadcast_to(own[None, :, None, None], (B, C, H, 1))
        if n_sel > 0:
            gate = jnp.einsum('bqhd,bnhd->bqhn', qc.astype(jnp.float32), k_mean)
            past = blk_ids[None, :] < own[:, None]
            gate = jnp.where(past[None, :, None, :], gate, -jnp.inf)
            _, sel = lax.top_k(gate, n_sel)
            blocks = jnp.concatenate([sel, own_b], axis=-1)
            blk_valid = jnp.concatenate([sel < own[None, :, None, None],
                                         jnp.ones((B, C, H, 1), bool)], axis=-1)
        else:
            blocks = own_b
            blk_valid = jnp.ones((B, C, H, 1), bool)
        k_g = kbT[b_ix, h_ix, blocks]
        v_g = vbT[b_ix, h_ix, blocks]
        logits = jnp.einsum('bqhd,bqhjld->bqhjl', qc, k_g).astype(jnp.float32) * scale
        key_pos = blocks[..., None] * MOBA_BLOCK + offs
        dist = q_pos[None, :, None, None, None] - key_pos
        logits = logits + bias_tab[t5_bucket(dist), h_ix5].astype(jnp.float32)
        valid = (dist >= 0) & blk_valid[..., None]
        logits = jnp.where(valid, logits, -jnp.inf)
        J = blocks.shape[-1]
        p = jax.nn.softmax(logits.reshape(B, C, H, J * MOBA_BLOCK), axis=-1)
        p = p.reshape(B, C, H, J, MOBA_BLOCK).astype(v.dtype)
        return jnp.einsum('bqhjl,bqhjld->bqhd', p, v_g)

    outs = lax.map(chunk, jnp.arange(S // C))
    return jnp.transpose(outs, (1, 0, 2, 3, 4)).reshape(B, S, H * Dh)


def setup_inputs(seed: int = 0) -> dict:
    key = jax.random.key(seed)
    ks = jax.random.split(key, 20)
    f32 = jnp.float32
    L = DEPTH

    def dense(k, shape):
        return jax.random.normal(k, shape, f32) * (shape[-2] ** -0.5)

    def gain(k, shape):
        return 1.0 + 0.02 * jax.random.normal(k, shape, f32)

    return {
        'x': jax.random.normal(ks[0], (BATCH, SEQ, D_MODEL), f32),
        'ffn1_norm': gain(ks[1], (L, D_MODEL)),
        'ffn1_w_gu': dense(ks[2], (L, D_MODEL, 2 * D_FF)),
        'ffn1_w_down': dense(ks[3], (L, D_FF, D_MODEL)),
        'mix_norm': gain(ks[4], (L, D_MODEL)),
        'w_in': dense(ks[5], (L, D_MODEL, D_IN)),
        'b_gate': 0.1 * jax.random.normal(ks[6], (L, 2 * D_MODEL), f32),
        'q_norm_dsa': gain(ks[7], (L, HEAD_DIM)),
        'k_norm_dsa': gain(ks[8], (L, HEAD_DIM)),
        'q_norm_moba': gain(ks[9], (L, HEAD_DIM)),
        'k_norm_moba': gain(ks[10], (L, HEAD_DIM)),
        'w_branch_dsa': dense(ks[11], (L, W_DSA, D_MODEL)),
        'w_branch_moba': dense(ks[12], (L, W_MOBA, D_MODEL)),
        'w_out': dense(ks[13], (L, D_MODEL, D_MODEL)),
        'ffn2_norm': gain(ks[14], (L, D_MODEL)),
        'ffn2_w_gu': dense(ks[15], (L, D_MODEL, 2 * D_FF)),
        'ffn2_w_down': dense(ks[16], (L, D_FF, D_MODEL)),
        'rel_bias': 0.1 * jax.random.normal(ks[17], (N_BUCKETS, N_HEADS_DSA + N_HEADS_MOBA), f32),
    }


def reference(x, ffn1_norm, ffn1_w_gu, ffn1_w_down, mix_norm, w_in, b_gate,
              q_norm_dsa, k_norm_dsa, q_norm_moba, k_norm_moba,
              w_branch_dsa, w_branch_moba, w_out,
              ffn2_norm, ffn2_w_gu, ffn2_w_down, rel_bias):
    B, S, _ = x.shape
    bias_dsa = rel_bias[:, :N_HEADS_DSA]
    bias_moba = rel_bias[:, N_HEADS_DSA:]
    h = x
    for l in range(DEPTH):
        h = h + 0.5 * swiglu(rmsnorm(h, ffn1_norm[l]), ffn1_w_gu[l], ffn1_w_down[l])
        u = rmsnorm(h, mix_norm[l])
        qa, ka, va, qb, kb, vb, qi, ki, wi, g = jnp.split(u @ w_in[l], SPLIT_POINTS, axis=-1)
        qa = rmsnorm(qa.reshape(B, S, N_HEADS_DSA, HEAD_DIM), q_norm_dsa[l])
        ka = rmsnorm(ka.reshape(B, S, N_HEADS_DSA, HEAD_DIM), k_norm_dsa[l])
        va = va.reshape(B, S, N_HEADS_DSA, HEAD_DIM)
        qb = rmsnorm(qb.reshape(B, S, N_HEADS_MOBA, HEAD_DIM), q_norm_moba[l])
        kb = rmsnorm(kb.reshape(B, S, N_HEADS_MOBA, HEAD_DIM), k_norm_moba[l])
        vb = vb.reshape(B, S, N_HEADS_MOBA, HEAD_DIM)
        qi = qi.reshape(B, S, N_IDX_HEADS, IDX_DIM)
        wi = wi * (N_IDX_HEADS ** -0.5)
        out_a = dsa_attention(qa, ka, va, qi, ki, wi, bias_dsa)
        out_b = moba_attention(qb, kb, vb, bias_moba)
        gates = jax.nn.sigmoid((g + b_gate[l]).astype(jnp.float32)).astype(h.dtype)
        g_a, g_b = jnp.split(gates, 2, axis=-1)
        mixed = g_a * (out_a @ w_branch_dsa[l]) + g_b * (out_b @ w_branch_moba[l])
        h = h + mixed @ w_out[l]
        h = h + 0.5 * swiglu(rmsnorm(h, ffn2_norm[l]), ffn2_w_gu[l], ffn2_w_down[l])
    return h
```

```cpp
#include <hip/hip_runtime.h>
#include <hip/hip_bf16.h>
#include <cstdint>
#include <cstdio>
#include <cmath>

namespace K {
constexpr int B = 4, S = 4096, M = B * S, D = 1024, DFF = 2816, H = 8, HD = 64, NIH = 4, IDIM = 64, TOPK = 256, MBLK = 256, NBLK = 16;
constexpr int DIN = 5444;
constexpr float EPS = 1e-6f;
constexpr float LOG2E = 1.4426950408889634f;
constexpr float C2 = 0.125f * LOG2E;
}
typedef unsigned short bf16_t;
typedef unsigned long long u64;

__device__ __forceinline__ bf16_t f2bf(float f) { unsigned u = __float_as_uint(f); return (bf16_t)((u + 0x7fffu + ((u >> 16) & 1u)) >> 16); }
__device__ __forceinline__ int t5_bucket(int d) {
    if (d < 16) return d;
    int large = 16 + (int)(logf((float)d / 16.0f) / 2.0794415416798357f * 16.0f);
    return large < 31 ? large : 31;
}
namespace pg8 {
#define PG8_LAS __attribute__((address_space(3)))
typedef short bf16x8 __attribute__((ext_vector_type(8)));
typedef float f32x4 __attribute__((ext_vector_type(4)));
typedef unsigned u32x4 __attribute__((ext_vector_type(4)));
constexpr int BM = 256, BK = 64, HALF = 128, HTB = HALF * BK * 2  , STAGE_BYTES = 8 * HTB, NXCD = 8, WGM = 8;

__host__ __device__ __forceinline__ int lds_byte(int r, int c) { const int st = (r >> 4) * 2 + (c >> 5), rr = r & 15, cc = c & 31, ob = rr * 64 + cc * 2; return st * 1024 + (ob ^ (((ob >> 9) & 1) << 5)); }
__host__ __device__ __forceinline__ void stage_rc(int b, int& R, int& C) { const int st = b / 1024, sb = b % 1024, swz = sb ^ (((sb >> 9) & 1) << 5); R = (st >> 1) * 16 + swz / 64; C = (st & 1) * 32 + (swz % 64) / 2; }
__host__ __device__ __forceinline__ int perm32(int rho) { const int n = rho >> 4, i = rho & 15; return 8 * (i >> 2) + 4 * n + (i & 3); }

__host__ __device__ __forceinline__ size_t tiled_b_off(int nrow, int k, int nkt) {
    const int ht = nrow >> 7, rb = nrow & 127, c = rb & 31, rho = ((c >> 2) & 1) * 16 + ((c >> 3) << 2) + (c & 3), R = (rb & ~31) + rho;
    return ((size_t)ht * nkt + (k >> 6)) * (size_t)(HALF * BK * 2) + (size_t)lds_byte(R, k & 63);
}
struct Unit { int pm, pn; };
struct Gemm { const bf16_t* A; const bf16_t* Bt; int M, N, K, lda, asplit_pn, asplit_off; };

struct StaticOrder {
    int nM, nN, nwg, G, c;
    __host__ __device__ void init(int M, int N, int G_, int c_) { nM = M / BM; nN = N / BM; nwg = nM * nN; G = G_; c = c_; }
    __host__ __device__ bool next(int i, Unit& u) const {
        const long L = (long)i * G + c; if (L >= nwg) return false;
        int wgid = (int)L; { const int q = nwg / NXCD, r = nwg % NXCD, xcd = wgid % NXCD, off = wgid / NXCD; wgid = (xcd < r ? xcd * (q + 1) : r * (q + 1) + (xcd - r) * q) + off; }
        const int nig = WGM * nN, gid = wgid / nig, fm = gid * WGM, gsz = (nM - fm) < WGM ? (nM - fm) : WGM;
        u.pm = fm + ((wgid % nig) % gsz); u.pn = (wgid % nig) / gsz; return true;
    }
    __device__ __forceinline__ void a_ready(const Unit&) const {}
    __device__ __forceinline__ void done(const Unit&) const {}
};


typedef float f32x2_t __attribute__((ext_vector_type(2))); typedef __bf16 bf16x2_t __attribute__((ext_vector_type(2)));
__device__ __forceinline__ unsigned cvt_pk_bf16(float lo, float hi) { f32x2_t v = {lo, hi}; bf16x2_t b = __builtin_convertvector(v, bf16x2_t); return __builtin_bit_cast(unsigned, b); }
__device__ __forceinline__ float row_rstd(const float* __restrict__ ssq, int row) {
    const f32x4* p = (const f32x4*)(ssq + (size_t)row * 16);
    const f32x4 a = p[0], b = p[1], c = p[2], d = p[3];
    const float s = (((a[0] + a[1]) + (a[2] + a[3])) + ((b[0] + b[1]) + (b[2] + b[3]))) + (((c[0] + c[1]) + (c[2] + c[3])) + ((d[0] + d[1]) + (d[2] + d[3])));
    return 1.0f / sqrtf(s * (1.0f / 1024.0f) + 1e-6f);
}
__device__ __forceinline__ void rstd_stage(const float* __restrict__ ssq, PG8_LAS float* tab, int pm, int wr, int fr, int fq) {
    const int l = fq * 16 + fr;
    tab[l] = row_rstd(ssq, pm * BM + wr * 64 + l);
    tab[64 + l] = row_rstd(ssq, pm * BM + HALF + wr * 64 + l);
    asm volatile("s_waitcnt lgkmcnt(0)" ::: "memory");
}
__device__ __forceinline__ float xrow_sum4(float v) {
    { auto r = __builtin_amdgcn_permlane16_swap(__float_as_uint(v), __float_as_uint(v), false, false); v = __uint_as_float(r[0]) + __uint_as_float(r[1]); }
    { auto r = __builtin_amdgcn_permlane32_swap(__float_as_uint(v), __float_as_uint(v), false, false); v = __uint_as_float(r[0]) + __uint_as_float(r[1]); }
    return v;
}
__device__ __forceinline__ float silu_f(float g) { return g * __builtin_amdgcn_rcpf(1.0f + __builtin_amdgcn_exp2f(-1.4426950408889634f * g)); }
__device__ __forceinline__ float sigmoid_f(float g) { return __builtin_amdgcn_rcpf(1.0f + __builtin_amdgcn_exp2f(-1.4426950408889634f * g)); }

struct EpiGu {
    static constexpr bool PERM = true, AFTER_DRAIN = false, HAS_MID = false;
    bf16_t* act; const float* ssq; PG8_LAS float* rtab;
    __device__ __forceinline__ void operator()(const f32x4 (&acc)[2][2][4][2], const Unit& u, int wr, int wc, int fr, int fq) const {
        asm volatile("" : "+v"(fr), "+v"(fq));
        const int row0 = u.pm * BM + wr * 64 + fr, col0 = u.pn * 128 + wc * 32 + 8 * fq;
        PG8_LAS float* tab = rtab + (wr * 4 + wc) * 128; rstd_stage(ssq, tab, u.pm, wr, fr, fq);
#pragma unroll
        for (int ai = 0; ai < 2; ++ai)
#pragma unroll
            for (int m = 0; m < 4; ++m) {
                const int row = row0 + ai * HALF + m * 16; const float rs = tab[64 * ai + 16 * m + fr];
                float o[8];
#pragma unroll
                for (int n = 0; n < 2; ++n)
#pragma unroll
                    for (int i = 0; i < 4; ++i) o[n * 4 + i] = silu_f(acc[ai][0][m][n][i] * rs) * (acc[ai][1][m][n][i] * rs);
                u32x4 w; w.x = cvt_pk_bf16(o[0], o[1]); w.y = cvt_pk_bf16(o[2], o[3]); w.z = cvt_pk_bf16(o[4], o[5]); w.w = cvt_pk_bf16(o[6], o[7]);
                *(u32x4*)(act + (size_t)row * 2816 + col0) = w;
            }
    }
};
template <bool RIN32, bool OUT32, bool STATS> struct EpiRes {
    static constexpr bool PERM = true, AFTER_DRAIN = false, HAS_MID = false;
    const float* hin32; const bf16_t* hin16; float* hout; bf16_t* hb; float* ssq; float scale;
    __device__ __forceinline__ void operator()(const f32x4 (&acc)[2][2][4][2], const Unit& u, int wr, int wc, int fr, int fq) const {
        asm volatile("" : "+v"(fr), "+v"(fq));
        const int row0 = u.pm * BM + wr * 64 + fr, col0 = u.pn * BM + wc * 32 + 8 * fq;
#pragma unroll
        for (int ai = 0; ai < 2; ++ai)
#pragma unroll
            for (int m = 0; m < 4; ++m) {
                const int row = row0 + ai * HALF + m * 16; float ss = 0.f;
#pragma unroll
                for (int bj = 0; bj < 2; ++bj) {
                    const size_t off = (size_t)row * 1024 + col0 + bj * HALF;
                    f32x4 r0, r1;
                    if (RIN32) { r0 = *(const f32x4*)(hin32 + off); r1 = *(const f32x4*)(hin32 + off + 4); }
                    else { const u32x4 rw = *(const u32x4*)(hin16 + off);
                        r0 = (f32x4){__uint_as_float(rw.x << 16), __uint_as_float(rw.x & 0xffff0000u), __uint_as_float(rw.y << 16), __uint_as_float(rw.y & 0xffff0000u)};
                        r1 = (f32x4){__uint_as_float(rw.z << 16), __uint_as_float(rw.z & 0xffff0000u), __uint_as_float(rw.w << 16), __uint_as_float(rw.w & 0xffff0000u)}; }
                    const f32x4 v0 = r0 + acc[ai][bj][m][0] * scale, v1 = r1 + acc[ai][bj][m][1] * scale;
                    if (OUT32) { *(f32x4*)(hout + off) = v0; *(f32x4*)(hout + off + 4) = v1; }
                    if (STATS) {
                        u32x4 w; w.x = cvt_pk_bf16(v0[0], v0[1]); w.y = cvt_pk_bf16(v0[2], v0[3]); w.z = cvt_pk_bf16(v1[0], v1[1]); w.w = cvt_pk_bf16(v1[2], v1[3]);
                        *(u32x4*)(hb + off) = w;
                        ss += (v0[0] * v0[0] + v0[1] * v0[1]) + (v0[2] * v0[2] + v0[3] * v0[3]) + (v1[0] * v1[0] + v1[1] * v1[1]) + (v1[2] * v1[2] + v1[3] * v1[3]);
                    }
                }
                if (STATS) { ss = xrow_sum4(ss); if (fq == 0) ssq[(size_t)row * 16 + u.pn * 4 + wc] = ss; }
            }
    }
};
struct EpiIn {
    static constexpr bool PERM = true, AFTER_DRAIN = false, HAS_MID = false;
    bf16_t *QO, *KB, *VB, *GATES, *QI, *KI; float* WI; float* KMEAN; const float* ssq; const float* bgate; const float *qn_a, *kn_a, *qn_b, *kn_b; PG8_LAS float* rtab;
    template <int KIND, bool MOBA> __device__ __forceinline__ void qkv(const f32x4 (&acc)[2][2][4][2], const Unit& u, int wr, int wc, int fr, int fq, PG8_LAS float* tab, bf16_t* base, const float* gn) const {
        const int row0 = u.pm * BM + wr * 64 + fr, head = 4 * (u.pn & 1) + wc;
        bf16_t* dst = base + (MOBA ? 512 : 0) + head * 64 + 8 * fq;
        f32x4 gv[2][2];
#pragma unroll
        for (int bj = 0; bj < 2; ++bj)
#pragma unroll
            for (int n = 0; n < 2; ++n) gv[bj][n] = (KIND < 2) ? *(const f32x4*)(gn + 32 * bj + 8 * fq + 4 * n) : (f32x4){1.f, 1.f, 1.f, 1.f};
        constexpr bool km = (KIND == 1) && MOBA;
        f32x4 ks[2][2];
#pragma unroll
        for (int bj = 0; bj < 2; ++bj)
#pragma unroll
            for (int n = 0; n < 2; ++n) ks[bj][n] = (f32x4){0.f, 0.f, 0.f, 0.f};
#pragma unroll
        for (int ai = 0; ai < 2; ++ai)
#pragma unroll
            for (int m = 0; m < 4; ++m) {
                const int row = row0 + ai * HALF + m * 16; const float rs = tab[64 * ai + 16 * m + fr];
                f32x4 v[2][2]; float ss = 0.f;
#pragma unroll
                for (int bj = 0; bj < 2; ++bj)
#pragma unroll
                    for (int n = 0; n < 2; ++n) { v[bj][n] = acc[ai][bj][m][n] * rs; ss += (v[bj][n][0] * v[bj][n][0] + v[bj][n][1] * v[bj][n][1]) + (v[bj][n][2] * v[bj][n][2] + v[bj][n][3] * v[bj][n][3]); }
                if (KIND < 2) {
                    ss = xrow_sum4(ss);
                    float r = 1.0f / sqrtf(ss * (1.0f / 64.0f) + 1e-6f); if (KIND == 0) r *= K::C2;
#pragma unroll
                    for (int bj = 0; bj < 2; ++bj)
#pragma unroll
                        for (int n = 0; n < 2; ++n) v[bj][n] = v[bj][n] * gv[bj][n] * r;
                }
#pragma unroll
                for (int bj = 0; bj < 2; ++bj) {
                    u32x4 w; w.x = cvt_pk_bf16(v[bj][0][0], v[bj][0][1]); w.y = cvt_pk_bf16(v[bj][0][2], v[bj][0][3]); w.z = cvt_pk_bf16(v[bj][1][0], v[bj][1][1]); w.w = cvt_pk_bf16(v[bj][1][2], v[bj][1][3]);
                    *(u32x4*)(dst + (size_t)row * 1024 + 32 * bj) = w;
                    if (km) { ks[bj][0] += v[bj][0]; ks[bj][1] += v[bj][1]; }
                }
                if (km) asm volatile("" : "+v"(ks[0][0]), "+v"(ks[0][1]), "+v"(ks[1][0]), "+v"(ks[1][1]));
                asm volatile("" ::: "memory");
            }
        if (km) {
            float* kd = KMEAN + ((size_t)u.pm * 8 + head) * 64 + 8 * fq;
#pragma unroll
            for (int bj = 0; bj < 2; ++bj)
#pragma unroll
                for (int n = 0; n < 2; ++n)
#pragma unroll
                    for (int i = 0; i < 4; ++i) { float s = ks[bj][n][i]; s += __shfl_xor(s, 1); s += __shfl_xor(s, 2); s += __shfl_xor(s, 4); s += __shfl_xor(s, 8);
                        if (fr == 0) atomicAdd(kd + 32 * bj + 4 * n + i, s); }
        }
    }
    __device__ __forceinline__ void operator()(const f32x4 (&acc)[2][2][4][2], const Unit& u, int wr, int wc, int fr, int fq) const {
        asm volatile("" : "+v"(fr), "+v"(fq));
        const int pn = u.pn, row0 = u.pm * BM + wr * 64 + fr;
        PG8_LAS float* tab = rtab + (wr * 4 + wc) * 128; rstd_stage(ssq, tab, u.pm, wr, fr, fq);
        if (pn < 2) qkv<0, false>(acc, u, wr, wc, fr, fq, tab, QO, qn_a);
        else if (pn < 4) qkv<1, false>(acc, u, wr, wc, fr, fq, tab, KB, kn_a);
        else if (pn < 6) qkv<2, false>(acc, u, wr, wc, fr, fq, tab, VB, nullptr);
        else if (pn < 8) qkv<0, true>(acc, u, wr, wc, fr, fq, tab, QO, qn_b);
        else if (pn < 10) qkv<1, true>(acc, u, wr, wc, fr, fq, tab, KB, kn_b);
        else if (pn < 12) qkv<2, true>(acc, u, wr, wc, fr, fq, tab, VB, nullptr);
        else if (pn == 12) {
#pragma unroll
            for (int ai = 0; ai < 2; ++ai)
#pragma unroll
                for (int m = 0; m < 4; ++m) { const int row = row0 + ai * HALF + m * 16; const float rs = tab[64 * ai + 16 * m + fr];
#pragma unroll
                    for (int bj = 0; bj < 2; ++bj) { const f32x4 a = acc[ai][bj][m][0] * rs, b = acc[ai][bj][m][1] * rs;
                        u32x4 w; w.x = cvt_pk_bf16(a[0], a[1]); w.y = cvt_pk_bf16(a[2], a[3]); w.z = cvt_pk_bf16(b[0], b[1]); w.w = cvt_pk_bf16(b[2], b[3]);
                        *(u32x4*)(QI + (size_t)row * 256 + 128 * bj + 32 * wc + 8 * fq) = w; } }
        } else if (pn == 13) {
#pragma unroll
            for (int ai = 0; ai < 2; ++ai)
#pragma unroll
                for (int m = 0; m < 4; ++m) { const int row = row0 + ai * HALF + m * 16; const float rs = tab[64 * ai + 16 * m + fr];
                    const f32x4 a = acc[ai][0][m][0] * rs, b = acc[ai][0][m][1] * rs;
                    if (wc < 2) { u32x4 w; w.x = cvt_pk_bf16(a[0], a[1]); w.y = cvt_pk_bf16(a[2], a[3]); w.z = cvt_pk_bf16(b[0], b[1]); w.w = cvt_pk_bf16(b[2], b[3]);
                        *(u32x4*)(KI + (size_t)row * 64 + 32 * wc + 8 * fq) = w; }
                    else if (wc == 2 && fq == 0) *(f32x4*)(WI + (size_t)row * 4) = a * 0.5f; }
        } else {
            const int cg0 = 256 * (pn - 14) + 32 * wc + 8 * fq;
            f32x4 bv[2][2];
#pragma unroll
            for (int bj = 0; bj < 2; ++bj)
#pragma unroll
                for (int n = 0; n < 2; ++n) bv[bj][n] = *(const f32x4*)(bgate + cg0 + 128 * bj + 4 * n);
#pragma unroll
            for (int ai = 0; ai < 2; ++ai)
#pragma unroll
                for (int m = 0; m < 4; ++m) { const int row = row0 + ai * HALF + m * 16; const float rs = tab[64 * ai + 16 * m + fr];
#pragma unroll
                    for (int bj = 0; bj < 2; ++bj) { const f32x4 a = acc[ai][bj][m][0] * rs + bv[bj][0], b = acc[ai][bj][m][1] * rs + bv[bj][1];
                        u32x4 w; w.x = cvt_pk_bf16(sigmoid_f(a[0]), sigmoid_f(a[1])); w.y = cvt_pk_bf16(sigmoid_f(a[2]), sigmoid_f(a[3])); w.z = cvt_pk_bf16(sigmoid_f(b[0]), sigmoid_f(b[1])); w.w = cvt_pk_bf16(sigmoid_f(b[2]), sigmoid_f(b[3]));
                        *(u32x4*)(GATES + (size_t)row * 2048 + cg0 + 128 * bj) = w; } }
        }
    }
};
struct EpiBranch2 {
    static constexpr bool PERM = true, AFTER_DRAIN = false, HAS_MID = true;
    const bf16_t* gates; bf16_t* mx;
    __device__ __forceinline__ void mid(f32x4 (&acc)[2][2][4][2], const Unit& u, int wr, int wc, int fr, int fq) const {
        asm volatile("" : "+v"(fr), "+v"(fq));
        const int row0 = u.pm * BM + wr * 64 + fr, col0 = u.pn * BM + wc * 32 + 8 * fq;
#pragma unroll
        for (int ai = 0; ai < 2; ++ai)
#pragma unroll
            for (int m = 0; m < 4; ++m) {
                const int row = row0 + ai * HALF + m * 16;
#pragma unroll
                for (int bj = 0; bj < 2; ++bj) {
                    const size_t off = (size_t)row * 2048 + col0 + bj * HALF;
                    const u32x4 ga = *(const u32x4*)(gates + off), gb = *(const u32x4*)(gates + off + 1024);
                    float r[8];
#pragma unroll
                    for (int x = 0; x < 4; ++x) {
                        r[2 * x] = __uint_as_float(ga[x] << 16) * __builtin_amdgcn_rcpf(__builtin_fmaxf(__uint_as_float(gb[x] << 16), 1e-30f));
                        r[2 * x + 1] = __uint_as_float(ga[x] & 0xffff0000u) * __builtin_amdgcn_rcpf(__builtin_fmaxf(__uint_as_float(gb[x] & 0xffff0000u), 1e-30f)); }
                    acc[ai][bj][m][0] = acc[ai][bj][m][0] * (f32x4){r[0], r[1], r[2], r[3]};
                    acc[ai][bj][m][1] = acc[ai][bj][m][1] * (f32x4){r[4], r[5], r[6], r[7]};
                }
                asm volatile("" ::: "memory");
            }
    }
    __device__ __forceinline__ void operator()(const f32x4 (&acc)[2][2][4][2], const Unit& u, int wr, int wc, int fr, int fq) const {
        asm volatile("" : "+v"(fr), "+v"(fq));
        const int row0 = u.pm * BM + wr * 64 + fr, col0 = u.pn * BM + wc * 32 + 8 * fq;
#pragma unroll
        for (int ai = 0; ai < 2; ++ai)
#pragma unroll
            for (int m = 0; m < 4; ++m) {
                const int row = row0 + ai * HALF + m * 16;
#pragma unroll
                for (int bj = 0; bj < 2; ++bj) {
                    const u32x4 gw = *(const u32x4*)(gates + (size_t)row * 2048 + 1024 + col0 + bj * HALF);
                    const f32x4 a = acc[ai][bj][m][0], b = acc[ai][bj][m][1];
                    u32x4 w;
                    w.x = cvt_pk_bf16(a[0] * __builtin_fmaxf(__uint_as_float(gw.x << 16), 1e-30f), a[1] * __builtin_fmaxf(__uint_as_float(gw.x & 0xffff0000u), 1e-30f));
                    w.y = cvt_pk_bf16(a[2] * __builtin_fmaxf(__uint_as_float(gw.y << 16), 1e-30f), a[3] * __builtin_fmaxf(__uint_as_float(gw.y & 0xffff0000u), 1e-30f));
                    w.z = cvt_pk_bf16(b[0] * __builtin_fmaxf(__uint_as_float(gw.z << 16), 1e-30f), b[1] * __builtin_fmaxf(__uint_as_float(gw.z & 0xffff0000u), 1e-30f));
                    w.w = cvt_pk_bf16(b[2] * __builtin_fmaxf(__uint_as_float(gw.w << 16), 1e-30f), b[3] * __builtin_fmaxf(__uint_as_float(gw.w & 0xffff0000u), 1e-30f));
                    *(u32x4*)(mx + (size_t)row * 1024 + col0 + bj * HALF) = w;
                }
                asm volatile("" ::: "memory");
            }
    }
};
template <class Epi, class Sched, bool ALIGN_EPI = false, bool SP2 = false>
__device__ __forceinline__ void gemm_phase(PG8_LAS unsigned char* lds, const Gemm g, const Sched& S, const Epi& E) {
    const int tid = threadIdx.x, wid = __builtin_amdgcn_readfirstlane(tid >> 6), lane = tid & 63, wr = wid >> 2, wc = wid & 3, fr = lane & 15, fq = lane >> 4;
    const int K = g.K, nt = K / BK;
    unsigned voffA[2], voffB[2];
#pragma unroll
    for (int i = 0; i < 2; ++i) { int R, C; stage_rc(tid * 16 + i * 8192, R, C); const int Rb = Epi::PERM ? ((R & ~31) + perm32(R & 31)) : R;
        voffA[i] = (unsigned)(R * g.lda + C) * 2u; voffB[i] = (unsigned)(tid * 16 + i * 8192); (void)Rb; }
    const size_t kstep = (size_t)(BK * 2), kstepB = (size_t)HTB;
    const size_t hstepA = (size_t)HALF * g.lda * 2, hstepB = (size_t)nt * kstepB;
    const size_t tstepA = 2 * hstepA, tstepB = 2 * hstepB;
#define PG8_ABASE(u_) ((const char*)g.A + (size_t)(u_).pm * tstepA + (((u_).pn >= g.asplit_pn) ? (size_t)g.asplit_off : (size_t)0))
    const unsigned ldsw = (unsigned)wid * 1024u;
    const int aoff = lds_byte(wr * 64 + fr, fq * 8), boff = lds_byte(wc * 32 + fr, fq * 8);
#define PG8_SA(b, h) (((b) * 2 + (h)) * HTB)
#define PG8_SB(b, h) ((4 + (b) * 2 + (h)) * HTB)
#define PG8_STAGE(bufoff, gbase, voff) do { _Pragma("unroll") for (int _i = 0; _i < 2; ++_i) \
        __builtin_amdgcn_global_load_lds((const unsigned*)((const char*)(gbase) + (voff)[_i]), (PG8_LAS unsigned*)(lds + (bufoff) + ldsw + _i * 8192), 16, 0, 0); } while (0)
#define PG8_LDA(dst, b, h) do { _Pragma("unroll") for (int m = 0; m < 4; ++m) _Pragma("unroll") for (int k = 0; k < 2; ++k) dst[m][k] = *(const PG8_LAS bf16x8*)(lds + PG8_SA(b, h) + aoff + m * 2048 + k * 1024); } while (0)
#define PG8_LDB(dst, b, h) do { _Pragma("unroll") for (int n = 0; n < 2; ++n) _Pragma("unroll") for (int k = 0; k < 2; ++k) dst[n][k] = *(const PG8_LAS bf16x8*)(lds + PG8_SB(b, h) + boff + n * 2048 + k * 1024); } while (0)
#define PG8_MMA(ai, bj, At, Bt) do { __builtin_amdgcn_s_setprio(1); _Pragma("unroll") for (int m = 0; m < 4; ++m) _Pragma("unroll") for (int n = 0; n < 2; ++n) _Pragma("unroll") for (int k = 0; k < 2; ++k) \
        acc[ai][bj][m][n] = __builtin_amdgcn_mfma_f32_16x16x32_bf16(Bt[n][k], At[m][k], acc[ai][bj][m][n], 0, 0, 0); __builtin_amdgcn_s_setprio(0); } while (0)
#define PG8_WAIT_V(n) asm volatile("s_waitcnt vmcnt(" #n ")" ::: "memory")
#define PG8_WAIT_L(n) asm volatile("s_waitcnt lgkmcnt(" #n ")" ::: "memory")
#define PG8_BAR __builtin_amdgcn_s_barrier()
#define PG8_SCHED __builtin_amdgcn_sched_barrier(0)
    Unit cur, nxt; int ui = 0;
    if (!S.next(0, cur)) return;
    f32x4 acc[2][2][4][2];
#pragma unroll
    for (int a = 0; a < 2; ++a)
#pragma unroll
        for (int b = 0; b < 2; ++b)
#pragma unroll
            for (int m = 0; m < 4; ++m)
#pragma unroll
                for (int n = 0; n < 2; ++n) acc[a][b][m][n] = (f32x4){0.f, 0.f, 0.f, 0.f};
    bf16x8 At[4][2], B0[2][2], B1[2][2];
    const char* cA = PG8_ABASE(cur); const char* cB = (const char*)g.Bt + (size_t)cur.pn * tstepB;
    S.a_ready(cur);
    if constexpr (SP2) {
        PG8_STAGE(PG8_SB(0, 0), cB, voffB); PG8_STAGE(PG8_SB(0, 1), cB + hstepB, voffB); PG8_STAGE(PG8_SA(0, 0), cA, voffA); PG8_STAGE(PG8_SA(0, 1), cA + hstepA, voffA);
        PG8_STAGE(PG8_SB(1, 0), cB + kstepB, voffB); PG8_STAGE(PG8_SA(1, 0), cA + kstep, voffA); PG8_STAGE(PG8_SB(1, 1), cB + hstepB + kstepB, voffB);
        if (wr == 1) PG8_BAR;
        PG8_WAIT_V(8); PG8_BAR;
        PG8_WAIT_V(6); PG8_BAR;
    } else {
        PG8_STAGE(PG8_SB(0, 0), cB, voffB); PG8_STAGE(PG8_SA(0, 0), cA, voffA); PG8_STAGE(PG8_SB(0, 1), cB + hstepB, voffB); PG8_STAGE(PG8_SA(0, 1), cA + hstepA, voffA);
        if (wr == 1) PG8_BAR;
        PG8_WAIT_V(4); PG8_BAR;
        PG8_STAGE(PG8_SB(1, 0), cB + kstepB, voffB); PG8_STAGE(PG8_SA(1, 0), cA + kstep, voffA); PG8_STAGE(PG8_SB(1, 1), cB + hstepB + kstepB, voffB);
        PG8_WAIT_V(6); PG8_BAR;
    }
    for (;;) {
        const bool has_next = S.next(ui + 1, nxt);
        const char* nA = has_next ? PG8_ABASE(nxt) : cA; const char* nB = has_next ? (const char*)g.Bt + (size_t)nxt.pn * tstepB : cB;
        for (int t = 0; t < nt; t += 2) {
            const bool last = (t == nt - 2);
            const char* a1 = cA + (size_t)(t + 1) * kstep;
            const char* a2 = last ? nA : cA + (size_t)(t + 2) * kstep; const char* b2 = last ? nB : cB + (size_t)(t + 2) * kstepB;
            const char* a3 = a2 + kstep; const char* b3 = b2 + kstepB;
            if (last && has_next) S.a_ready(nxt);
            if constexpr (SP2) {
            PG8_LDB(B0, 0, 0); PG8_LDB(B1, 0, 1); PG8_SCHED; PG8_LDA(At, 0, 0); PG8_STAGE(PG8_SA(1, 1), a1 + hstepA, voffA);
            PG8_WAIT_V(8); PG8_WAIT_L(0); PG8_BAR; PG8_MMA(0, 0, At, B0); PG8_MMA(0, 1, At, B1); PG8_BAR; PG8_SCHED;
            PG8_LDA(At, 0, 1); PG8_STAGE(PG8_SB(0, 0), b2, voffB); PG8_STAGE(PG8_SB(0, 1), b2 + hstepB, voffB); PG8_STAGE(PG8_SA(0, 0), a2, voffA);
            PG8_WAIT_V(8); PG8_WAIT_L(0); PG8_BAR; PG8_MMA(1, 0, At, B0); PG8_MMA(1, 1, At, B1); PG8_BAR; PG8_SCHED;
            PG8_LDB(B0, 1, 0); PG8_LDB(B1, 1, 1); PG8_SCHED; PG8_LDA(At, 1, 0); PG8_STAGE(PG8_SA(0, 1), a2 + hstepA, voffA);
            PG8_WAIT_V(8); PG8_WAIT_L(0); PG8_BAR; PG8_MMA(0, 0, At, B0); PG8_MMA(0, 1, At, B1); PG8_BAR; PG8_SCHED;
            PG8_LDA(At, 1, 1); PG8_STAGE(PG8_SB(1, 0), b3, voffB); PG8_STAGE(PG8_SB(1, 1), b3 + hstepB, voffB); PG8_STAGE(PG8_SA(1, 0), a3, voffA);
            PG8_WAIT_V(8); PG8_WAIT_L(0); PG8_BAR; PG8_MMA(1, 0, At, B0); PG8_MMA(1, 1, At, B1); PG8_BAR; PG8_SCHED;
            } else {
            PG8_LDB(B0, 0, 0); PG8_SCHED; PG8_LDA(At, 0, 0); PG8_STAGE(PG8_SA(1, 1), a1 + hstepA, voffA);
            PG8_WAIT_L(8); PG8_BAR; PG8_WAIT_L(0); PG8_MMA(0, 0, At, B0); PG8_BAR; PG8_SCHED;
            PG8_LDB(B1, 0, 1); PG8_STAGE(PG8_SB(0, 0), b2, voffB);
            PG8_BAR; PG8_WAIT_L(0); PG8_MMA(0, 1, At, B1); PG8_BAR;
            PG8_LDA(At, 0, 1); PG8_STAGE(PG8_SA(0, 0), a2, voffA);
            PG8_BAR; PG8_WAIT_L(0); PG8_MMA(1, 0, At, B0); PG8_BAR; PG8_SCHED;
            PG8_STAGE(PG8_SB(0, 1), b2 + hstepB, voffB);
            PG8_WAIT_V(6); PG8_BAR; PG8_MMA(1, 1, At, B1); PG8_BAR;
            PG8_LDB(B0, 1, 0); PG8_SCHED; PG8_LDA(At, 1, 0); PG8_STAGE(PG8_SA(0, 1), a2 + hstepA, voffA);
            PG8_WAIT_L(8); PG8_BAR; PG8_WAIT_L(0); PG8_MMA(0, 0, At, B0); PG8_BAR; PG8_SCHED;
            PG8_LDB(B1, 1, 1); PG8_STAGE(PG8_SB(1, 0), b3, voffB);
            PG8_BAR; PG8_WAIT_L(0); PG8_MMA(0, 1, At, B1); PG8_BAR;
            PG8_LDA(At, 1, 1); PG8_STAGE(PG8_SA(1, 0), a3, voffA);
            PG8_BAR; PG8_WAIT_L(0); PG8_MMA(1, 0, At, B0); PG8_BAR; PG8_SCHED;
            PG8_STAGE(PG8_SB(1, 1), b3 + hstepB, voffB);
            PG8_WAIT_V(6); PG8_BAR; PG8_MMA(1, 1, At, B1); PG8_BAR;
            }
            if constexpr (Epi::HAS_MID) { if (t + 2 == nt / 2) E.mid(acc, cur, wr, wc, fr, fq); }
        }
        if constexpr (ALIGN_EPI) { if (wr == 0) PG8_BAR; }
        if constexpr (!Epi::AFTER_DRAIN) { E(acc, cur, wr, wc, fr, fq); S.done(cur); }
        if (!has_next) break;
#pragma unroll
        for (int a = 0; a < 2; ++a)
#pragma unroll
            for (int b = 0; b < 2; ++b)
#pragma unroll
                for (int m = 0; m < 4; ++m)
#pragma unroll
                    for (int n = 0; n < 2; ++n) acc[a][b][m][n] = (f32x4){0.f, 0.f, 0.f, 0.f};
        cur = nxt; cA = nA; cB = nB; ++ui;
        if constexpr (ALIGN_EPI) { if (wr == 1) PG8_BAR; }
    }
    PG8_WAIT_V(0);
    if constexpr (!ALIGN_EPI) { if (wr == 0) PG8_BAR; }
    PG8_BAR;
    if constexpr (Epi::AFTER_DRAIN) { E.fused(acc, cur, wr, wc, fr, fq, lds, wid, lane); S.done(cur); }
#undef PG8_ABASE
#undef PG8_SA
#undef PG8_SB
#undef PG8_STAGE
#undef PG8_LDA
#undef PG8_LDB
#undef PG8_MMA
#undef PG8_WAIT_V
#undef PG8_WAIT_L
#undef PG8_BAR
#undef PG8_SCHED
}
}

constexpr int NWAVES = 8;
namespace WS {
constexpr size_t MiB = 1u << 20;
constexpr size_t CTL = 0, CTL_ZERO_BYTES = 1 * MiB;
constexpr size_t KMEAN = 512 * 1024;
constexpr size_t SSQ = 1 * MiB;
constexpr size_t GU1 = 2 * MiB, DN1 = 13 * MiB, WIN = 19 * MiB, WB = 30 * MiB, WO = 32 * MiB, GU2 = 36 * MiB, DN2 = 47 * MiB;
constexpr size_t XB = 53 * MiB;
constexpr size_t QO = 85 * MiB, KB = 117 * MiB, VB = 149 * MiB;
constexpr size_t GATES = 181 * MiB;
constexpr size_t QI = 245 * MiB, KI = 253 * MiB, WI = 255 * MiB, BMASK = 255 * MiB + 256 * 1024;
constexpr size_t ACT = 85 * MiB;
constexpr size_t GM = 117 * MiB;
constexpr size_t END = 256 * MiB;
}
constexpr int CW_BAR = 4096;
constexpr int RING_OFF = 0, RING_BYTES = 131072;
constexpr int LDSCTL_OFF = RING_BYTES, MISC_OFF = LDSCTL_OFF + 320;
constexpr int RTAB_OFF = LDSCTL_OFF + 1024;
constexpr int LDS_BYTES = 147456;

#define GAS __attribute__((address_space(1)))
#define LAS __attribute__((address_space(3)))
typedef unsigned v4u __attribute__((ext_vector_type(4)));
typedef float f32x4 __attribute__((ext_vector_type(4)));
typedef GAS unsigned gu32;
#define LDS_WAIT() asm volatile("s_waitcnt lgkmcnt(0)" ::: "memory")
#define VM_WAIT() asm volatile("s_waitcnt vmcnt(0)" ::: "memory")
__device__ __forceinline__ unsigned pk2(float lo, float hi) { return (unsigned)f2bf(lo) | ((unsigned)f2bf(hi) << 16); }
#define XB_TMO      128
#define XB_XCNT(j)  (256  + 64 * (j))
#define XB_XSUB(j)  (1280 + 64 * (j))
#define XB_XGEN(j)  (2304 + 64 * (j))
#define XB_TOP      3328
#define XB_TOPGEN   3392
#define XCD_BAR_WORDS 3456
#define XB_SPIN_CAP (1u << 18)

__device__ __forceinline__ unsigned xb_ld(unsigned* p)              { return __hip_atomic_load(p, __ATOMIC_RELAXED, __HIP_MEMORY_SCOPE_AGENT); }
__device__ __forceinline__ unsigned xb_add(unsigned* p, unsigned v) { return __hip_atomic_fetch_add(p, v, __ATOMIC_RELAXED, __HIP_MEMORY_SCOPE_AGENT); }
__device__ __forceinline__ unsigned xb_xcc_id() { return (unsigned)__builtin_amdgcn_s_getreg((3 << 11) | 20) & 0xFu; }
#define XB_SPIN(cond, bar) do { unsigned _sp = 0; while (cond) { __builtin_amdgcn_s_sleep(1); \
    if ((++_sp & 255u) == 0u) { if (xb_ld(&(bar)[XB_TMO])) break; if (_sp > XB_SPIN_CAP) { atomicAdd(&(bar)[XB_TMO], 1u); break; } } } } while (0)

struct XcdBarrier {
    unsigned* bar; unsigned x;
    volatile LAS unsigned* st;
};

__device__ __forceinline__ XcdBarrier xcd_barrier_post(unsigned* bar, volatile LAS unsigned* st) {
    XcdBarrier b; b.bar = bar; b.x = xb_xcc_id(); b.st = st;
    if (threadIdx.x == 0) (void)xb_add(&bar[XB_XCNT(b.x)], 1u);
    return b;
}
__device__ __forceinline__ void xcd_barrier_complete(unsigned* bar, unsigned x, unsigned& nloc, unsigned& nx) {
    const unsigned G = gridDim.x * gridDim.y * gridDim.z;
    unsigned sum, cnt, mine, sp = 0u;
    for (;;) {
        sum = 0u; cnt = 0u; mine = 0u;
#pragma unroll
        for (unsigned j = 0; j < 16; ++j) { const unsigned c = xb_ld(&bar[XB_XCNT(j)]); sum += c; cnt += (c > 0u) ? 1u : 0u; mine = (j == x) ? c : mine; }
        if (sum == G) break;
        __builtin_amdgcn_s_sleep(1);
        if ((++sp & 255u) == 0u) { if (xb_ld(&bar[XB_TMO])) break; if (sp > XB_SPIN_CAP) { atomicAdd(&bar[XB_TMO], 1u); break; } }
    }
    nloc = mine > 0u ? mine : 1u; nx = cnt > 0u ? cnt : 1u;
}

__device__ __forceinline__ void xcd_barrier(const XcdBarrier& b) {
    asm volatile("s_waitcnt vmcnt(0)" ::: "memory");
    __syncthreads();
    if (threadIdx.x == 0) {
        unsigned* bar = b.bar;
        __builtin_amdgcn_s_waitcnt(0);
        unsigned nloc = b.st[0], nx = b.st[1];
        if (nloc == 0u) { xcd_barrier_complete(bar, b.x, nloc, nx); b.st[0] = nloc; b.st[1] = nx; }
        const unsigned old = xb_add(&bar[XB_XSUB(b.x)], 1u);
        const unsigned gen = old / nloc;
        if (old + 1u == (gen + 1u) * nloc) {
            __builtin_amdgcn_fence(__ATOMIC_RELEASE, "agent");
            asm volatile("s_waitcnt vmcnt(0)" ::: "memory");
            const unsigned og = xb_add(&bar[XB_TOP], 1u);
            const unsigned tg = og / nx;
            if (og + 1u == (tg + 1u) * nx) xb_add(&bar[XB_TOPGEN], 1u);
            else XB_SPIN(xb_ld(&bar[XB_TOPGEN]) == tg, bar);
            __builtin_amdgcn_fence(__ATOMIC_ACQUIRE, "agent");
            xb_add(&bar[XB_XGEN(b.x)], 1u);
            asm volatile("s_waitcnt vmcnt(0)" ::: "memory");
        } else {
            XB_SPIN(xb_ld(&bar[XB_XGEN(b.x)]) == gen, bar);
            __builtin_amdgcn_fence(__ATOMIC_ACQUIRE, "agent");
            asm volatile("s_waitcnt vmcnt(0)" ::: "memory");
        }
    }
    __syncthreads();
}

namespace tk {
typedef short bf16x8 __attribute__((ext_vector_type(8)));
typedef float f32x4 __attribute__((ext_vector_type(4)));
constexpr int HIST_OFF = 0, HSTR = 1025;
constexpr int TCNT_OFF = 65664;
constexpr int MSTG_OFF = TCNT_OFF + 16384;
constexpr int TBASE_OFF = MSTG_OFF + 8192;
constexpr int RES_OFF = TBASE_OFF + 8192;
#define TK_BAR() do { asm volatile("s_waitcnt lgkmcnt(0)" ::: "memory"); __builtin_amdgcn_s_barrier(); asm volatile("" ::: "memory"); } while (0)

__device__ __forceinline__ unsigned wave_prefix_incl(unsigned x) {
    x += (unsigned)__builtin_amdgcn_update_dpp(0, (int)x, 0x111, 0xf, 0xf, true);
    x += (unsigned)__builtin_amdgcn_update_dpp(0, (int)x, 0x112, 0xf, 0xf, true);
    x += (unsigned)__builtin_amdgcn_update_dpp(0, (int)x, 0x114, 0xf, 0xf, true);
    x += (unsigned)__builtin_amdgcn_update_dpp(0, (int)x, 0x118, 0xf, 0xf, true);
    x += (unsigned)__builtin_amdgcn_update_dpp(0, (int)x, 0x142, 0xa, 0xf, false);
    x += (unsigned)__builtin_amdgcn_update_dpp(0, (int)x, 0x143, 0xc, 0xf, false);
    return x;
}
template <int NW>
__device__ __forceinline__ void scan_query(const LAS unsigned* hq, LAS unsigned* res, int qq, unsigned r, int lane) {
    unsigned w[NW]; unsigned tot = 0; const int wbase = (63 - lane) * NW;
#pragma unroll
    for (int x = 0; x < NW; ++x) { w[x] = hq[wbase + x]; tot += (w[x] & 0xffffu) + (w[x] >> 16); }
    const unsigned incl = wave_prefix_incl(tot);
    const unsigned above = incl - tot;
    if (above < r && incl >= r) {
        unsigned c = above, bin = 0, cnt = 0, cb = 0; bool found = false;
#pragma unroll
        for (int x = NW - 1; x >= 0; --x) {
            const unsigned hi = w[x] >> 16, lo = w[x] & 0xffffu;
            if (!found && c + hi >= r) { found = true; bin = (unsigned)(wbase + x) * 2u + 1u; cnt = hi; cb = c; }
            c += hi;
            if (!found && c + lo >= r) { found = true; bin = (unsigned)(wbase + x) * 2u; cnt = lo; cb = c; }
            c += lo;
        }
        res[qq] = bin; res[16 + qq] = r - cb; res[32 + qq] = cnt;
    }
}

__device__ __forceinline__ void topk_group(LAS unsigned char* L, const bf16_t* __restrict__ QI, const bf16_t* __restrict__ KI, const float* __restrict__ WI, u64* __restrict__ MASK,
                                           int b, int tq0, int tid, int lane, int wave) {
    using namespace K;
    const int q = lane & 15, g = lane >> 4;
    const int row0 = b * S + tq0, jmax = tq0 >> 4;
    LAS unsigned* hist = (LAS unsigned*)(L + HIST_OFF); LAS unsigned* tcnt = (LAS unsigned*)(L + TCNT_OFF);
    LAS unsigned short* mstg = (LAS unsigned short*)(L + MSTG_OFF); LAS unsigned short* tbase = (LAS unsigned short*)(L + TBASE_OFF); LAS unsigned* res = (LAS unsigned*)(L + RES_OFF);
    for (int i = tid; i < (16384 + 8192) / 4; i += NWAVES * 64) tcnt[i] = 0u;
    LAS unsigned* const tc_q = tcnt + q * 256 + wave; LAS unsigned short* const tb_q = tbase + q * 256 + wave;
    LAS unsigned* const ms32_q = (LAS unsigned*)mstg + ((q * 256 + wave) >> 1); const unsigned sh_q = 16u * (wave & 1) + 4u * g;
    if (tq0 < TOPK) {
        TK_BAR();
        for (int idx = tid; idx < 16 * (jmax + 1); idx += NWAVES * 64) { const int qq = idx & 15, j = idx >> 4; mstg[qq * 256 + j] = (unsigned short)((j < jmax) ? 0xffffu : ((2u << qq) - 1u)); }
    } else {
        bf16x8 qf[4][2];
#pragma unroll
        for (int h = 0; h < 4; ++h)
#pragma unroll
            for (int ks = 0; ks < 2; ++ks) qf[h][ks] = *(const bf16x8*)(QI + (size_t)(row0 + q) * 256 + h * 64 + ks * 32 + g * 8);
        const f32x4 wv = *(const f32x4*)(WI + (size_t)(row0 + q) * 4);
        unsigned key[32][4];
        for (int i = tid; i < 16 * HSTR / 4; i += NWAVES * 64) ((LAS v4u*)hist)[i] = (v4u){0u, 0u, 0u, 0u};
        TK_BAR();
#pragma unroll
        for (int c = 0; c < 4; ++c) {
            if (64 * c <= jmax) {
                bf16x8 kk[8][2];
#pragma unroll
                for (int s = 0; s < 8; ++s) {
                    const int j = wave + 8 * (8 * c + s), jc = j < jmax ? j : jmax;
                    const bf16_t* kp = KI + (size_t)(b * S + jc * 16 + q) * 64 + g * 8;
                    kk[s][0] = *(const bf16x8*)kp; kk[s][1] = *(const bf16x8*)(kp + 32);
                }
#pragma unroll
                for (int s = 0; s < 8; ++s) {
                    const int i = 8 * c + s, j = wave + 8 * i;
                    f32x4 sc = {0.f, 0.f, 0.f, 0.f};
#pragma unroll
                    for (int h = 0; h < 4; ++h) {
                        f32x4 d = __builtin_amdgcn_mfma_f32_16x16x32_bf16(kk[s][0], qf[h][0], (f32x4){0.f, 0.f, 0.f, 0.f}, 0, 0, 0);
                        d = __builtin_amdgcn_mfma_f32_16x16x32_bf16(kk[s][1], qf[h][1], d, 0, 0, 0);
#pragma unroll
                        for (int r = 0; r < 4; ++r) { const int di = __float_as_int(d[r]); sc[r] = __builtin_fmaf(wv[h], __int_as_float(di > 0 ? di : 0), sc[r]); }
                    }
#pragma unroll
                    for (int r = 0; r < 4; ++r) {
                        const unsigned u = __float_as_uint(sc[r]);
                        unsigned k = u ^ ((unsigned)((int)u >> 31) | 0x80000000u);
                        if (j > jmax || (j == jmax && 4 * g + r > q)) k = 0u;
                        key[i][r] = k;
                        if (k != 0u) { const unsigned bin = k >> 21; __hip_atomic_fetch_add(hist + q * HSTR + (bin >> 1), 1u << (16 * (bin & 1u)), __ATOMIC_RELAXED, __HIP_MEMORY_SCOPE_WORKGROUP); }
                    }
                }
            } else {
#pragma unroll
                for (int s = 0; s < 8; ++s)
#pragma unroll
                    for (int r = 0; r < 4; ++r) key[8 * c + s][r] = 0u;
            }
        }
        unsigned prefix = 0u, rnk = (unsigned)TOPK, cnt_eq = 0u;
#pragma unroll
        for (int pass = 0; pass < 3; ++pass) {
            const int shift = (pass == 0) ? 21 : (pass == 1 ? 10 : 0), pshift = (pass == 1) ? 21 : 10; const unsigned bmask = (pass == 2) ? 1023u : 2047u;
            if (pass != 0) {
            TK_BAR();
            for (int i = tid; i < 16 * HSTR / 4; i += NWAVES * 64) ((LAS v4u*)hist)[i] = (v4u){0u, 0u, 0u, 0u};
            TK_BAR();
#pragma unroll
            for (int i = 0; i < 32; ++i) {
                if (wave + 8 * i <= jmax) {
#pragma unroll
                    for (int r = 0; r < 4; ++r) {
                        const unsigned k = key[i][r];
                        const bool m = (pass == 0) ? (k != 0u) : ((k >> pshift) == prefix);
                        if (m) { const unsigned bin = (k >> shift) & bmask; __hip_atomic_fetch_add(hist + q * HSTR + (bin >> 1), 1u << (16 * (bin & 1u)), __ATOMIC_RELAXED, __HIP_MEMORY_SCOPE_WORKGROUP); }
                    }
                }
            }
            }
            TK_BAR();
            { const unsigned r0 = (unsigned)__builtin_amdgcn_readlane((int)rnk, 2 * wave), r1 = (unsigned)__builtin_amdgcn_readlane((int)rnk, 2 * wave + 1);
              if (pass < 2) { scan_query<16>(hist + (2 * wave) * HSTR, res, 2 * wave, r0, lane); scan_query<16>(hist + (2 * wave + 1) * HSTR, res, 2 * wave + 1, r1, lane); }
              else { scan_query<8>(hist + (2 * wave) * HSTR, res, 2 * wave, r0, lane); scan_query<8>(hist + (2 * wave + 1) * HSTR, res, 2 * wave + 1, r1, lane); } }
            TK_BAR();
            prefix = (prefix << ((pass == 2) ? 10 : 11)) | res[q]; rnk = res[16 + q]; cnt_eq = res[32 + q];
        }
        const unsigned T = prefix, need = rnk;
        const bool slow = __any(need != cnt_eq);
        if (slow) {
#pragma unroll
            for (int i = 0; i < 32; ++i) {
                if (wave + 8 * i <= jmax) {
                    unsigned c = 0;
#pragma unroll
                    for (int r = 0; r < 4; ++r) c += (key[i][r] == T) ? 1u : 0u;
                    if (c) __hip_atomic_fetch_add(tc_q + 8 * i, c << (8 * g), __ATOMIC_RELAXED, __HIP_MEMORY_SCOPE_WORKGROUP);
                }
            }
            TK_BAR();
#pragma unroll
            for (int s = 0; s < 2; ++s) {
                const int qq = 2 * wave + s; unsigned tt[4], tot = 0;
#pragma unroll
                for (int x = 0; x < 4; ++x) { const unsigned e = tcnt[qq * 256 + lane * 4 + x]; tt[x] = (e & 255u) + ((e >> 8) & 255u) + ((e >> 16) & 255u) + (e >> 24); tot += tt[x]; }
                const unsigned incl = wave_prefix_incl(tot);
                unsigned base = incl - tot;
#pragma unroll
                for (int x = 0; x < 4; ++x) { tbase[qq * 256 + lane * 4 + x] = (unsigned short)base; base += tt[x]; }
            }
            TK_BAR();
        }
#pragma unroll
        for (int i = 0; i < 32; ++i) {
            const int j = wave + 8 * i;
            if (j <= jmax) {
                unsigned nib = 0;
                if (!slow) {
#pragma unroll
                    for (int r = 0; r < 4; ++r) nib |= (key[i][r] >= T && key[i][r] != 0u) ? (1u << r) : 0u;
                } else {
                    const unsigned e = tc_q[8 * i]; unsigned rank = tb_q[8 * i];
                    if (g > 0) rank += e & 255u; if (g > 1) rank += (e >> 8) & 255u; if (g > 2) rank += (e >> 16) & 255u;
#pragma unroll
                    for (int r = 0; r < 4; ++r) { const unsigned k = key[i][r];
                        if (k > T) nib |= 1u << r; else if (k == T && k != 0u) { if (rank < need) nib |= 1u << r; ++rank; } }
                }
                if (nib) __hip_atomic_fetch_or(ms32_q + 4 * i, nib << sh_q, __ATOMIC_RELAXED, __HIP_MEMORY_SCOPE_WORKGROUP);
            }
        }
    }
    TK_BAR();
    for (int idx = tid; idx < 1024; idx += NWAVES * 64) {
        const int qq = idx & 15, t64 = idx >> 4;
        const u64 wd = *(const LAS u64*)(mstg + qq * 256 + t64 * 4);
        MASK[((size_t)b * 64 + t64) * S + tq0 + qq] = wd;
    }
    TK_BAR();
}

__device__ __forceinline__ void gating_block(LAS unsigned char* L, const bf16_t* __restrict__ QO, const float* __restrict__ KMEAN, unsigned* __restrict__ BMASK, int blk64, int tid) {
    using namespace K;
    const int row0 = 64 * blk64, b = row0 / S;
    LAS float* km = (LAS float*)L;
    const int r = tid >> 3, h = tid & 7, row = row0 + r, t = row % S, own = t / MBLK;
    uint4 qraw[8];
#pragma unroll
    for (int x = 0; x < 8; ++x) qraw[x] = *(const uint4*)(QO + (size_t)row * 1024 + 512 + h * 64 + 8 * x);
    for (int i = tid; i < 16 * 8 * 64; i += NWAVES * 64) { const int n = i >> 9, hh = (i >> 6) & 7, d = i & 63; km[(n * 8 + hh) * 68 + d] = KMEAN[((size_t)(b * 16 + n) * 8 + hh) * 64 + d]; }
    TK_BAR();
    float qv[64];
#pragma unroll
    for (int x = 0; x < 8; ++x) { const uint4 u = qraw[x];
        qv[8 * x + 0] = __uint_as_float(u.x << 16); qv[8 * x + 1] = __uint_as_float(u.x & 0xffff0000u); qv[8 * x + 2] = __uint_as_float(u.y << 16); qv[8 * x + 3] = __uint_as_float(u.y & 0xffff0000u);
        qv[8 * x + 4] = __uint_as_float(u.z << 16); qv[8 * x + 5] = __uint_as_float(u.z & 0xffff0000u); qv[8 * x + 6] = __uint_as_float(u.w << 16); qv[8 * x + 7] = __uint_as_float(u.w & 0xffff0000u); }
    float b0 = -INFINITY, b1 = -INFINITY, b2 = -INFINITY; int i0 = -1, i1 = -1, i2 = -1;
    for (int n = 0; n < own; ++n) {
        const LAS f32x4* kp = (const LAS f32x4*)(km + (n * 8 + h) * 68); float gs = 0.f;
#pragma unroll
        for (int d4 = 0; d4 < 16; ++d4) { const f32x4 kv = kp[d4]; gs = __builtin_fmaf(qv[4 * d4], kv[0], gs); gs = __builtin_fmaf(qv[4 * d4 + 1], kv[1], gs); gs = __builtin_fmaf(qv[4 * d4 + 2], kv[2], gs); gs = __builtin_fmaf(qv[4 * d4 + 3], kv[3], gs); }
        if (gs > b0) { b2 = b1; i2 = i1; b1 = b0; i1 = i0; b0 = gs; i0 = n; }
        else if (gs > b1) { b2 = b1; i2 = i1; b1 = gs; i1 = n; }
        else if (gs > b2) { b2 = gs; i2 = n; }
    }
    unsigned bm = 1u << own;
    if (i0 >= 0) bm |= 1u << i0; if (i1 >= 0) bm |= 1u << i1; if (i2 >= 0) bm |= 1u << i2;
    BMASK[(size_t)row * 8 + h] = bm;
    TK_BAR();
}
#undef TK_BAR
}
namespace attn_body {
using bf16=__hip_bfloat16;
using bf16x8=__attribute__((ext_vector_type(8)))short;
using s16x4=__attribute__((ext_vector_type(4)))short;
using f32x16=__attribute__((ext_vector_type(16)))float;
using u32x4=__attribute__((ext_vector_type(4)))unsigned;
constexpr int BATCH=4,NHEAD=16,SEQ=4096,D=64,DM=NHEAD*D;
constexpr int NW=8,QBLK=32,QB=QBLK*NW,KVBLK=64,NQB=SEQ/QB;
constexpr int ATTN_PITCH=DM, ATTN_UNIT_ROWS=QB;
__device__ __forceinline__ int crow(int r,int hi){return (r&3)+8*(r>>2)+4*hi;}
#define SBAR() __builtin_amdgcn_sched_barrier(0)
typedef __attribute__((address_space(3))) const float* lds_fptr;
__device__ __forceinline__ void addbias(f32x16&p0,f32x16&p1,int jb6,int qrel,int hi,lds_fptr bt){
  const lds_fptr b=bt+(qrel+128-64*jb6-4*hi+197);
  #pragma unroll
  for(int r=0;r<16;++r){const int c=(r&3)+8*(r>>2); p0[r]+=b[59-c]; p1[r]+=b[27-c];}
}

constexpr int BT_N=640;
constexpr int NSLOT=3, SLOTB=8192;
#define EXM(p,w) do{ if(MOBA) asm volatile("v_sub_f32 %0, %0, %2\n\tv_exp_f32 %0, %0\n\tv_add_co_u32 %1, vcc, %1, %1\n\tv_cndmask_b32 %0, 0, %0, vcc":"+v"(p),"+v"(w):"v"(mhat):"vcc"); \
  else asm volatile("v_exp_f32 %0, %0\n\tv_add_co_u32 %1, vcc, %1, %1\n\tv_cndmask_b32 %0, 0, %0, vcc":"+v"(p),"+v"(w)::"vcc"); }while(0)
#define EXS(p,mh) asm volatile("v_sub_f32 %0, %0, %1\n\tv_exp_f32 %0, %0\n\ts_nop 0":"+v"(p):"v"(mh))
#define EXM16(P,w) do{ EXM(P[15],w);EXM(P[14],w);EXM(P[13],w);EXM(P[12],w); w<<=4; EXM(P[11],w);EXM(P[10],w);EXM(P[9],w);EXM(P[8],w); w<<=4; EXM(P[7],w);EXM(P[6],w);EXM(P[5],w);EXM(P[4],w); w<<=4; EXM(P[3],w);EXM(P[2],w);EXM(P[1],w);EXM(P[0],w); }while(0)
__device__ __forceinline__ int cbit(int r){return (r&3)+8*(r>>2);}
constexpr int LDS_K=0, LDS_V=NSLOT*SLOTB, LDS_WS=2*NSLOT*SLOTB, LDS_OST=LDS_WS+NW*64*4, LDS_BT=LDS_OST+NW*4096, LDS_BYTES=LDS_BT+BT_N*4;
constexpr float C2=0.125f*1.4426950408889634f;
__device__ __forceinline__ void glds16(const void*gsrc,unsigned lds_dst){unsigned keep;
  asm volatile("s_mov_b32 %0, m0\n\ts_mov_b32 m0, %2\n\ts_nop 0\n\tglobal_load_lds_dwordx4 %1, off\n\ts_mov_b32 m0, %0":"=&s"(keep):"v"(gsrc),"s"(lds_dst):"memory");}
__device__ __forceinline__ float max3f(float a,float b,float c){float r;asm("v_max3_f32 %0, %1, %2, %3":"=v"(r):"v"(a),"v"(b),"v"(c));return r;}
__device__ __forceinline__ float max2f(float a,float b){float r;asm("v_max_f32_e32 %0, %1, %2":"=v"(r):"v"(a),"v"(b));return r;}
__device__ __forceinline__ float fadd_s(float a,float b){float r;asm("v_add_f32_e32 %0, %1, %2":"=v"(r):"v"(a),"v"(b));return r;}
__device__ __forceinline__ float fsub_s(float a,float b){float r;asm("v_sub_f32_e32 %0, %1, %2":"=v"(r):"v"(a),"v"(b));return r;}
typedef float f32x2_t __attribute__((ext_vector_type(2))); typedef __bf16 bf16x2_t __attribute__((ext_vector_type(2)));
__device__ __forceinline__ unsigned cvtpk_s(float lo,float hi){f32x2_t v={lo,hi};bf16x2_t b=__builtin_convertvector(v,bf16x2_t);return __builtin_bit_cast(unsigned,b);}
#define WAIT_BAR(N) asm volatile("s_waitcnt vmcnt(" #N ") lgkmcnt(0)\n\ts_barrier":::"memory")

__device__ __forceinline__ void qkt(f32x16&p0,f32x16&p1,const char*Kslot,const bf16x8*qr,const f32x16&c0,int r32,int hi){
  const char*kb=Kslot+hi*1024+r32*16;
  #pragma unroll
  for(int d0=0;d0<4;++d0){
    const bf16x8 b0=*reinterpret_cast<const bf16x8*>(kb+d0*2048);
    const bf16x8 b1=*reinterpret_cast<const bf16x8*>(kb+d0*2048+512);
    if(d0==0){p0=__builtin_amdgcn_mfma_f32_32x32x16_bf16(b0,qr[0],c0,0,0,0);p1=__builtin_amdgcn_mfma_f32_32x32x16_bf16(b1,qr[0],c0,0,0,0);}
    else{p0=__builtin_amdgcn_mfma_f32_32x32x16_bf16(b0,qr[d0],p0,0,0,0);p1=__builtin_amdgcn_mfma_f32_32x32x16_bf16(b1,qr[d0],p1,0,0,0);}}
}
typedef __attribute__((address_space(3))) const char* lds_cptr;
typedef short v4i16_t __attribute__((ext_vector_type(4)));
__device__ __forceinline__ void kload8(bf16x8*kf,lds_cptr kp){
  kf[0]=*(const __attribute__((address_space(3))) bf16x8*)(kp);      kf[1]=*(const __attribute__((address_space(3))) bf16x8*)(kp+512);
  kf[2]=*(const __attribute__((address_space(3))) bf16x8*)(kp+2048); kf[3]=*(const __attribute__((address_space(3))) bf16x8*)(kp+2560);
  kf[4]=*(const __attribute__((address_space(3))) bf16x8*)(kp+4096); kf[5]=*(const __attribute__((address_space(3))) bf16x8*)(kp+4608);
  kf[6]=*(const __attribute__((address_space(3))) bf16x8*)(kp+6144); kf[7]=*(const __attribute__((address_space(3))) bf16x8*)(kp+6656);
}
__device__ __forceinline__ void kload2(bf16x8*kf,lds_cptr kp,int j){ kf[2*j]=*(const __attribute__((address_space(3))) bf16x8*)(kp+j*2048); kf[2*j+1]=*(const __attribute__((address_space(3))) bf16x8*)(kp+j*2048+512); }
__device__ __forceinline__ s16x4 vtr(lds_cptr p){ return __builtin_bit_cast(s16x4,__builtin_amdgcn_ds_read_tr16_b64_v4i16((__attribute__((address_space(3))) v4i16_t*)p)); }
__device__ __forceinline__ float rowmax(const f32x16&p0,const f32x16&p1){
  float a=max3f(p0[0],p0[1],p1[0]),b=max3f(p0[2],p0[3],p1[1]);a=max3f(a,p1[2],p1[3]);
  #pragma unroll
  for(int r=4;r<16;r+=4){a=max3f(a,p0[r],p0[r+1]);b=max3f(b,p0[r+2],p0[r+3]);a=max3f(a,p1[r],p1[r+1]);b=max3f(b,p1[r+2],p1[r+3]);}
  const float m=max2f(a,b);
  auto rr=__builtin_amdgcn_permlane32_swap(__float_as_uint(m),__float_as_uint(m),false,false);
  return max2f(__uint_as_float(rr[0]),__uint_as_float(rr[1]));
}
__device__ __forceinline__ void pv(f32x16*o,int vb,bf16x8 pa0,bf16x8 pa1,bf16x8 pa2,bf16x8 pa3){
  #pragma unroll
  for(int d0=0;d0<2;++d0){s16x4 lo[4],hi[4];
    #pragma unroll
    for(int ks=0;ks<4;++ks){
      asm volatile("ds_read_b64_tr_b16 %0,%1 offset:%c2":"=&v"(lo[ks]):"v"(vb),"i"(d0*4096+ks*1024):"memory");
      asm volatile("ds_read_b64_tr_b16 %0,%1 offset:%c2":"=&v"(hi[ks]):"v"(vb),"i"(d0*4096+ks*1024+512):"memory");}
    asm volatile("s_waitcnt lgkmcnt(0)":::"memory");SBAR();
    #define PK(k) (bf16x8){lo[k][0],lo[k][1],lo[k][2],lo[k][3],hi[k][0],hi[k][1],hi[k][2],hi[k][3]}
    o[d0]=__builtin_amdgcn_mfma_f32_32x32x16_bf16(pa0,PK(0),o[d0],0,0,0);
    o[d0]=__builtin_amdgcn_mfma_f32_32x32x16_bf16(pa1,PK(1),o[d0],0,0,0);
    o[d0]=__builtin_amdgcn_mfma_f32_32x32x16_bf16(pa2,PK(2),o[d0],0,0,0);
    o[d0]=__builtin_amdgcn_mfma_f32_32x32x16_bf16(pa3,PK(3),o[d0],0,0,0);
    #undef PK
  }
}

#ifndef ATTN_STORE16
#define ATTN_STORE16(p,v) (*(u32x4*)(p)=(v))
#endif
template<int THRL,bool MOBA> __device__ __forceinline__ void attn_unit(int b,int h,int qb,const bf16*Q,const bf16*__restrict__ K,const bf16*__restrict__ V,bf16*O,const unsigned long long*__restrict__ MASKW,const unsigned*__restrict__ BMASK,const float*__restrict__ relb,char*shm){
  const int tid=threadIdx.x,lane=tid&63,r32=lane&31,hi=lane>>5; const int wid=__builtin_amdgcn_readfirstlane(tid>>6);
  const long rowbase=(long)b*SEQ; const int q0=qb*QB;
  const bf16*Qw=Q+(rowbase+q0+wid*QBLK)*DM+h*D;
  const bf16*Kh=K+rowbase*DM+h*D,*Vh=V+rowbase*DM+h*D;
  const unsigned lds0=(unsigned)(uintptr_t)shm;
  float*wsf=(float*)(shm+LDS_WS)+wid*64;
  const bf16*ksrc=Kh+(long)lane*DM+wid*8;
  const bf16*vsrc=Vh+(long)(16*(wid&3)+(lane>>2))*DM+(wid>>2)*32+(lane&3)*8;
  const unsigned kdst=lds0+LDS_K+wid*1024, vdst=lds0+LDS_V+wid*1024;
  #define DMA_K(t,slot) glds16(ksrc+(long)(t)*KVBLK*DM,(unsigned)__builtin_amdgcn_readfirstlane(kdst+(slot)))
  #define DMA_V(t,slot) glds16(vsrc+(long)(t)*KVBLK*DM,(unsigned)__builtin_amdgcn_readfirstlane(vdst+(slot)))
  const int vb0=(int)(lds0+LDS_V)+((lane>>4)&1)*32+(lane&3)*8+(4*hi+((lane&15)>>2))*64;
  const char*Kbase=shm+LDS_K; bf16x8 kf[8];
  const lds_cptr shm3=(lds_cptr)shm; const lds_cptr kp0=shm3+LDS_K+hi*1024+r32*16; const lds_cptr vp0=shm3+LDS_V+((lane>>4)&1)*32+(lane&3)*8+(4*hi+((lane&15)>>2))*64;
  const int NT=(q0+QB)/KVBLK;
  const int qrel=wid*QBLK+r32; constexpr bool moba=MOBA;
  const lds_fptr bt=(lds_fptr)(shm3+LDS_BT);
  unsigned bm=0u;
  const unsigned mvoff=(unsigned)(q0+qrel)*8u; unsigned long long mraw=0ull; unsigned mlo=0u,mhi=0u;
  #define MLOAD(tt) do{ if(!moba&&(tt)<NT){ const unsigned long long*mb_=MASKW+((size_t)(b*64+(tt)))*SEQ; \
      asm volatile("s_nop 4\n\tglobal_load_dwordx2 %0, %1, %2":"=v"(mraw):"v"(mvoff),"s"(mb_):"memory"); } }while(0)
  #define MSET(tt) do{ if(!moba){ asm volatile("":"+v"(mraw)); mlo=(unsigned)mraw<<(4-4*hi); mhi=(unsigned)(mraw>>32)<<(4-4*hi); } \
      else{ unsigned wl=((bm>>((tt)>>2))&1u)?0xffffffffu:0u, wh=wl; const int jb_=(tt)-(NT-4); \
        if(jb_>=0){ const int n=qrel-64*jb_, n2=n-32; wl&=(n<0)?0u:((n>=31)?0xffffffffu:((2u<<n)-1u)); wh&=(n2<0)?0u:((n2>=31)?0xffffffffu:((2u<<n2)-1u)); } \
        mlo=wl<<(4-4*hi); mhi=wh<<(4-4*hi); } }while(0)
  MLOAD(0);
  DMA_K(0,0);DMA_V(0,0);DMA_K(1,SLOTB);
  bf16x8 qr[4];
  #pragma unroll
  for(int d0=0;d0<4;++d0)qr[d0]=*reinterpret_cast<const bf16x8*>(&Qw[(long)r32*DM+d0*16+hi*8]);
  if(moba)bm=BMASK[(size_t)(rowbase+q0+qrel)*8+(h-8)];
  { __attribute__((address_space(3))) float*btw=(__attribute__((address_space(3))) float*)(shm3+LDS_BT); const float b31=relb[31*16+h];
    for(int i=tid;i<BT_N;i+=NW*64){ const int d=i-256; btw[i]=(d>=0&&d<=112)?(relb[t5_bucket(d)*16+h]-b31)*1.4426950408889634f:0.f; } }
  float mhat=0.f,l_reg=0.f;f32x16 o[2];o[0]=f32x16{};o[1]=f32x16{}; f32x16 negm=f32x16{}; if(!MOBA)asm volatile("":"+v"(negm));
  #define CMASK(P0,P1,t) do{int jb_=(t)-(NT-6); if(jb_>=0)addbias(P0,P1,jb_,qrel,hi,bt);}while(0)
  bool resc=false;
  #define START(P0,P1) do{ const float rm=rowmax(P0,P1); resc=false; mhat=rm; \
    if(!MOBA){ _Pragma("unroll") for(int r=0;r<16;++r){P0[r]-=rm;P1[r]-=rm;} _Pragma("unroll") for(int r=0;r<16;++r)negm[r]=-mhat; asm volatile("":"+v"(negm)); } \
    EXM16(P0,mlo); }while(0)
  #define RESC() do{ if(resc){ asm volatile("s_waitcnt lgkmcnt(0)":::"memory"); \
      _Pragma("unroll") for(int d_=0;d_<2;++d_) _Pragma("unroll") for(int r=0;r<16;++r)o[d_][r]*=wsf[crow(r,hi)]; } }while(0)
  f32x16 pA0,pA1,pB0,pB1;
  int sl_prev=0,sl_cur=0,sl_next=SLOTB;
  #define ROT() do{sl_prev=sl_cur;sl_cur=sl_next;sl_next=(sl_next==(NSLOT-1)*SLOTB)?0:sl_next+SLOTB;}while(0)
  DMA_K(2,2*SLOTB);
  WAIT_BAR(3);
  MSET(0); MLOAD(1);
  qkt(pA0,pA1,Kbase,qr,f32x16{},r32,hi);asm volatile("s_nop 15\n\ts_nop 7":"+v"(pA0),"+v"(pA1));CMASK(pA0,pA1,0);
  START(pA0,pA1);
  EXM16(pA1,mhi);
  WAIT_BAR(0);
  MSET(1);
  DMA_K(3,0);DMA_V(1,SLOTB);
  ROT();
  kload8(kf,kp0+sl_cur);
  WAIT_BAR(2);
  s16x4 vlo[8],vhi[8]; u32x4 pw0,pw1,pw2,pw3;
  #define PKW(P,B) cvtpk_s(P[B],P[B+1])
  #define PAF(k) __builtin_bit_cast(bf16x8,pw##k)
  #define VFR(i) (bf16x8){vlo[i][0],vlo[i][1],vlo[i][2],vlo[i][3],vhi[i][0],vhi[i][1],vhi[i][2],vhi[i][3]}
  #define PIN(x) asm volatile("":"+v"(x))
  #define MX3(a,b,c) __builtin_fmaxf(__builtin_fmaxf((a),(b)),(c))
  #define GAPA(MF,A0,A1,A2,A3,W0,W1,PW) do{ MF; sacc+=A0; sacc+=A1; sacc+=A2; sacc+=A3; PIN(sacc); W0; W1; PIN(PW); SBAR(); }while(0)
  #define EX(v) __builtin_amdgcn_exp2f(v)
  #define GAPB(MF,X,B,MW,CH) do{ MF; if(CH){ EXS(X[B+3],mh_); EXS(X[B+2],mh_); EXS(X[B+1],mh_); EXS(X[B],mh_); } else { EXM(X[B+3],MW); EXM(X[B+2],MW); EXM(X[B+1],MW); EXM(X[B],MW); if((B)>0)MW<<=4; } PIN(X); SBAR(); }while(0)
  #define VRD(i) do{ vlo[i]=vtr(vp_+(((i)>>2)*4096+((i)&3)*1024)); vhi[i]=vtr(vp_+(((i)>>2)*4096+((i)&3)*1024+512)); }while(0)
  #define KRD(G,j) do{ if(G){ kload2(kf,kp0+sl_next,j); SBAR(); } }while(0)
  #define STEP(C0,C1,P0,P1,t,GK,GV,GL,CH) do{ SBAR(); \
    const lds_cptr vp_=vp0+sl_prev; \
    VRD(0); SBAR(); float sacc=(P0[0]+P0[1]); \
    GAPA(C0=__builtin_amdgcn_mfma_f32_32x32x16_bf16(kf[0],qr[0],(MOBA?f32x16{}:negm),0,0,0), P0[2],P0[3],P0[4],P0[5],     pw0[0]=PKW(P0,0), pw0[1]=PKW(P0,2), pw0); \
    VRD(4); SBAR(); GAPA(C1=__builtin_amdgcn_mfma_f32_32x32x16_bf16(kf[1],qr[0],(MOBA?f32x16{}:negm),0,0,0), P0[6],P0[7],P0[8],P0[9],     pw0[2]=PKW(P0,4), pw0[3]=PKW(P0,6), pw0); \
    VRD(1); SBAR(); GAPA(C0=__builtin_amdgcn_mfma_f32_32x32x16_bf16(kf[2],qr[1],C0,0,0,0),   P0[10],P0[11],P0[12],P0[13], pw1[0]=PKW(P0,8), pw1[1]=PKW(P0,10), pw1); \
    VRD(5); SBAR(); GAPA(C1=__builtin_amdgcn_mfma_f32_32x32x16_bf16(kf[3],qr[1],C1,0,0,0),   P0[14],P0[15],P1[0],P1[1],   pw1[2]=PKW(P0,12),pw1[3]=PKW(P0,14), pw1); \
    VRD(2); SBAR(); GAPA(C0=__builtin_amdgcn_mfma_f32_32x32x16_bf16(kf[4],qr[2],C0,0,0,0),   P1[2],P1[3],P1[4],P1[5],     pw2[0]=PKW(P1,0), pw2[1]=PKW(P1,2), pw2); \
    VRD(6); SBAR(); GAPA(C1=__builtin_amdgcn_mfma_f32_32x32x16_bf16(kf[5],qr[2],C1,0,0,0),   P1[6],P1[7],P1[8],P1[9],     pw2[2]=PKW(P1,4), pw2[3]=PKW(P1,6), pw2); \
    VRD(3); SBAR(); GAPA(C0=__builtin_amdgcn_mfma_f32_32x32x16_bf16(kf[6],qr[3],C0,0,0,0),   P1[10],P1[11],P1[12],P1[13], pw3[0]=PKW(P1,8), pw3[1]=PKW(P1,10), pw3); \
    VRD(7); SBAR(); GAPA(C1=__builtin_amdgcn_mfma_f32_32x32x16_bf16(kf[7],qr[3],C1,0,0,0),   P1[14],P1[15],0.f,0.f,       pw3[2]=PKW(P1,12),pw3[3]=PKW(P1,14), pw3); \
    l_reg+=sacc; \
    if(GK){DMA_K((t)+3,sl_cur);} if(GV){DMA_V((t)+1,sl_next);} \
    CMASK(C0,C1,t); \
    { float a=MX3(C0[0],C0[1],C1[0]),b=MX3(C0[2],C0[3],C1[1]); a=MX3(a,C1[2],C1[3]); \
      _Pragma("unroll") for(int r=4;r<16;r+=4){a=MX3(a,C0[r],C0[r+1]);b=MX3(b,C0[r+2],C0[r+3]);a=MX3(a,C1[r],C1[r+1]);b=MX3(b,C1[r+2],C1[r+3]);} \
      float rm=__builtin_fmaxf(a,b); { auto rr=__builtin_amdgcn_permlane32_swap(__float_as_uint(rm),__float_as_uint(rm),false,false); rm=__builtin_fmaxf(__uint_as_float(rr[0]),__uint_as_float(rr[1])); } \
      resc=false; \
      if(MOBA)rm-=mhat; \
      if(__builtin_expect(__any(rm>(float)THRL),0)){ const float dl=__builtin_fmaxf(rm,0.f); mhat+=dl; \
        if(!MOBA){ _Pragma("unroll") for(int r=0;r<16;++r){C0[r]-=dl;C1[r]-=dl;} _Pragma("unroll") for(int r=0;r<16;++r)negm[r]=-mhat; asm volatile("":"+v"(negm)); } \
        const float f=__builtin_amdgcn_exp2f(-dl); l_reg*=f; if(hi==0)wsf[r32]=f; resc=true; } } \
    const float mh_=(CH)?((mlo!=0u)?mhat:__builtin_inff()):0.f; (void)mh_; \
    SBAR(); \
    GAPB(o[0]=__builtin_amdgcn_mfma_f32_32x32x16_bf16(PAF(0),VFR(0),o[0],0,0,0), C0,12,mlo,CH); \
    GAPB(o[1]=__builtin_amdgcn_mfma_f32_32x32x16_bf16(PAF(0),VFR(4),o[1],0,0,0), C0,8,mlo,CH); \
    KRD(GL,0); GAPB(o[0]=__builtin_amdgcn_mfma_f32_32x32x16_bf16(PAF(1),VFR(1),o[0],0,0,0), C0,4,mlo,CH); \
    KRD(GL,1); GAPB(o[1]=__builtin_amdgcn_mfma_f32_32x32x16_bf16(PAF(1),VFR(5),o[1],0,0,0), C0,0,mlo,CH); \
    KRD(GL,2); GAPB(o[0]=__builtin_amdgcn_mfma_f32_32x32x16_bf16(PAF(2),VFR(2),o[0],0,0,0), C1,12,mhi,CH); \
    KRD(GL,3); GAPB(o[1]=__builtin_amdgcn_mfma_f32_32x32x16_bf16(PAF(2),VFR(6),o[1],0,0,0), C1,8,mhi,CH); \
    GAPB(o[0]=__builtin_amdgcn_mfma_f32_32x32x16_bf16(PAF(3),VFR(3),o[0],0,0,0), C1,4,mhi,CH); \
    GAPB(o[1]=__builtin_amdgcn_mfma_f32_32x32x16_bf16(PAF(3),VFR(7),o[1],0,0,0), C1,0,mhi,CH); \
    }while(0)
  int t=1;
  #undef CMASK
  #define CMASK(P0,P1,t) do{}while(0)
  for(;t+7<NT;t+=2){
    MLOAD(t+1); STEP(pB0,pB1,pA0,pA1,t,true,true,true,MOBA);     WAIT_BAR(2); RESC(); ROT(); MSET(t+1);
    MLOAD(t+2); STEP(pA0,pA1,pB0,pB1,t+1,true,true,true,MOBA);   WAIT_BAR(2); RESC(); ROT(); MSET(t+2);
  }
  #undef CMASK
  #define CMASK(P0,P1,t) do{int jb_=(t)-(NT-6); if(jb_>=0)addbias(P0,P1,jb_,qrel,hi,bt);}while(0)
  #define ENDW(tt) do{ if((tt)+3<NT){WAIT_BAR(2);} else if((tt)+2<NT){WAIT_BAR(1);} else {WAIT_BAR(0);} }while(0)
  for(;t+1<NT;t+=2){
    MLOAD(t+1); STEP(pB0,pB1,pA0,pA1,t,(t+3<NT),(t+1<NT),(t+1<NT),0);       ENDW(t);   RESC(); ROT(); MSET(t+1);
    MLOAD(t+2); STEP(pA0,pA1,pB0,pB1,t+1,(t+4<NT),(t+2<NT),(t+2<NT),0);     ENDW(t+1); RESC(); ROT(); MSET(t+2);
  }
  STEP(pB0,pB1,pA0,pA1,NT-1,false,false,false,0); RESC();
  { float sacc=pB0[0]+pB0[1]; _Pragma("unroll") for(int r=2;r<16;++r)sacc+=pB0[r]; _Pragma("unroll") for(int r=0;r<16;++r)sacc+=pB1[r]; l_reg+=sacc;
    pw0=(u32x4){PKW(pB0,0),PKW(pB0,2),PKW(pB0,4),PKW(pB0,6)};pw1=(u32x4){PKW(pB0,8),PKW(pB0,10),PKW(pB0,12),PKW(pB0,14)};pw2=(u32x4){PKW(pB1,0),PKW(pB1,2),PKW(pB1,4),PKW(pB1,6)};pw3=(u32x4){PKW(pB1,8),PKW(pB1,10),PKW(pB1,12),PKW(pB1,14)};
    SBAR(); pv(o,vb0+sl_cur,PAF(0),PAF(1),PAF(2),PAF(3)); }
  #undef PKW
  #undef PAF
  #undef VFR
  #undef PIN
  #undef MX3
  #undef GAPA
  #undef GAPB
  #undef EX
  #undef VRD
  #undef KRD
  #undef STEP
  #undef ENDW
  {auto rr=__builtin_amdgcn_permlane32_swap(__float_as_uint(l_reg),__float_as_uint(l_reg),false,false);l_reg=__uint_as_float(rr[0])+__uint_as_float(rr[1]);}
  if(hi==0)wsf[32+r32]=l_reg;asm volatile("s_waitcnt lgkmcnt(0)":::"memory");
  float rli[16];
  #pragma unroll
  for(int r=0;r<16;++r)rli[r]=__builtin_amdgcn_rcpf(wsf[32+crow(r,hi)]);
  bf16*Ow=O+(rowbase+q0+wid*QBLK)*DM+h*D;
  { bf16*stg=(bf16*)(shm+LDS_OST)+wid*2048;
    #pragma unroll
    for(int r=0;r<16;++r){const int orow=crow(r,hi);
      #pragma unroll
      for(int d0=0;d0<2;++d0)stg[orow*64+d0*32+r32]=__float2bfloat16(o[d0][r]*rli[r]);}
    asm volatile("s_waitcnt lgkmcnt(0)":::"memory");
    #pragma unroll
    for(int i=0;i<4;++i){const int row=i*8+(lane>>3),ch=lane&7; const u32x4 v=*(const u32x4*)(stg+row*64+ch*8); ATTN_STORE16(Ow+(long)row*DM+ch*8,v);} }
  asm volatile("s_waitcnt lgkmcnt(0)\n\ts_barrier":::"memory");
  #undef MLOAD
  #undef MSET
  #undef DMA_K
  #undef DMA_V
  #undef CMASK
  #undef START
  #undef RESC
  #undef ROT
}
constexpr int ATTN_LDS_BYTES=LDS_BYTES;
#undef SBAR
#undef WAIT_BAR
}

__device__ __forceinline__ float wave_sum_fast(float v) {
#define WS_DPP_(ctrl, rm, bc) v += __int_as_float(__builtin_amdgcn_update_dpp(0, __float_as_int(v), ctrl, rm, 0xf, bc))
    WS_DPP_(0x111, 0xf, true); WS_DPP_(0x112, 0xf, true); WS_DPP_(0x114, 0xf, true); WS_DPP_(0x118, 0xf, true); WS_DPP_(0x142, 0xa, false); WS_DPP_(0x143, 0xc, false);
#undef WS_DPP_
    return __int_as_float(__builtin_amdgcn_readlane(__float_as_int(v), 63));
}
__device__ __forceinline__ int rowmap(int map, int n) {
    if (map == 1) { const int up = n >= 2816; const int j = up ? n - 2816 : n; return 256 * (j >> 7) + (up ? 128 : 0) + (j & 127); }
    if (map == 2) {
        if (n < 3072) { const int part = n >> 9, cc = n & 511, tl = cc >> 8, wc = (cc & 255) >> 6, d = cc & 63; return 256 * (2 * part + tl) + 128 * (d >> 5) + 32 * wc + (d & 31); }
        if (n < 3328) return 256 * 12 + (n - 3072);
        if (n < 3396) return 256 * 13 + (n - 3328);
        if (n < 5444) return 256 * 14 + (n - 3396);
        return 256 * 13 + 68 + (n - 5444);
    }
    if (map == 3) return 1024 + n;
    return n;
}
__device__ __forceinline__ void conv_item(const float* __restrict__ W, int ldw, int N, int Nw, const float* __restrict__ gain, bf16_t* WT, int ldk, int map, int koff, LAS float* scr, int item, int lane) {
    const int nblk = (Nw + 31) >> 5, kb = item / nblk, nb = item % nblk, k0 = 64 * kb, n0 = 32 * nb;
    const int rr = lane >> 3, c4 = (lane & 7) * 4; const bool inb = (n0 + c4) < N;
    f32x4 v[8];
#pragma unroll
    for (int i = 0; i < 8; ++i) v[i] = inb ? *(const GAS f32x4*)(W + (size_t)(k0 + 8 * i + rr) * ldw + n0 + c4) : (f32x4){0.f, 0.f, 0.f, 0.f};
#pragma unroll
    for (int i = 0; i < 8; ++i) { const int kk = 8 * i + rr; const float gk = gain ? gain[k0 + kk] : 1.0f; LAS float* s = scr + kk * 33 + c4;
        s[0] = v[i][0] * gk; s[1] = v[i][1] * gk; s[2] = v[i][2] * gk; s[3] = v[i][3] * gk; }
    LDS_WAIT(); asm volatile("" ::: "memory");
    const int c = lane & 7;
#pragma unroll
    for (int j = 0; j < 4; ++j) { const int n = (lane >> 3) + 8 * j; const LAS float* s = scr + (8 * c) * 33 + n;
        if (n0 + n < Nw) {
            v4u o; o.x = pk2(s[0 * 33], s[1 * 33]); o.y = pk2(s[2 * 33], s[3 * 33]); o.z = pk2(s[4 * 33], s[5 * 33]); o.w = pk2(s[6 * 33], s[7 * 33]);
            *(GAS v4u*)((unsigned char*)WT + pg8::tiled_b_off(rowmap(map, n0 + n), koff + k0 + 8 * c, ldk >> 6)) = o; } }
    LDS_WAIT(); asm volatile("" ::: "memory");
}

struct Args { const float* in[18]; float* out; unsigned char* ws; int ph_lo, ph_hi, li, pad; };
enum { I_X = 0, I_N1, I_GU1, I_DN1, I_NM, I_WIN, I_BG, I_QNA, I_KNA, I_QNB, I_KNB, I_WBA, I_WBB, I_WO, I_N2, I_GU2, I_DN2, I_RB };

__device__ __forceinline__ void p0_prologue(const Args& args, LAS unsigned char* L, int gw, int NGW, int lane, int gtid, int ngt) {
    using namespace K;
    unsigned char* ws = args.ws;
    LAS float* scr = (LAS float*)(L + RING_OFF + (gw & 7) * 16384);
    constexpr int I0 = 16 * 176, I1 = 44 * 32, I2 = 16 * 176, I3 = 8 * 32, I4 = 8 * 32, I5 = 16 * 32;
    constexpr int NITEMS = 2 * I0 + 2 * I1 + I2 + I3 + I4 + I5;
    for (int it = gw; it < NITEMS; it += NGW) {
        int r = it;
        if (r < I0) { conv_item(args.in[I_GU1], 2 * DFF, 2 * DFF, 2 * DFF, args.in[I_N1], (bf16_t*)(ws + WS::GU1), D, 1, 0, scr, r, lane); continue; } r -= I0;
        if (r < I0) { conv_item(args.in[I_GU2], 2 * DFF, 2 * DFF, 2 * DFF, args.in[I_N2], (bf16_t*)(ws + WS::GU2), D, 1, 0, scr, r, lane); continue; } r -= I0;
        if (r < I1) { conv_item(args.in[I_DN1], D, D, D, nullptr, (bf16_t*)(ws + WS::DN1), DFF, 0, 0, scr, r, lane); continue; } r -= I1;
        if (r < I1) { conv_item(args.in[I_DN2], D, D, D, nullptr, (bf16_t*)(ws + WS::DN2), DFF, 0, 0, scr, r, lane); continue; } r -= I1;
        if (r < I2) { conv_item(args.in[I_WIN], DIN, DIN, 5632, args.in[I_NM], (bf16_t*)(ws + WS::WIN), D, 2, 0, scr, r, lane); continue; } r -= I2;
        if (r < I3) { conv_item(args.in[I_WBA], D, D, D, nullptr, (bf16_t*)(ws + WS::WB), D, 0, 0, scr, r, lane); continue; } r -= I3;
        if (r < I4) { conv_item(args.in[I_WBB], D, D, D, nullptr, (bf16_t*)(ws + WS::WB), D, 0, 512, scr, r, lane); continue; } r -= I4;
        conv_item(args.in[I_WO], D, D, D, nullptr, (bf16_t*)(ws + WS::WO), D, 0, 0, scr, r, lane);
    }
    const float* x = args.in[I_X];
    for (int m0 = 2 * gw; m0 < M; m0 += 2 * NGW) {
        f32x4 v[2][4]; float s[2] = {0.f, 0.f};
#pragma unroll
        for (int rr = 0; rr < 2; ++rr) { const GAS f32x4* xr = (const GAS f32x4*)(x + (size_t)(m0 + rr) * D) + lane;
#pragma unroll
            for (int j = 0; j < 4; ++j) v[rr][j] = xr[64 * j]; }
#pragma unroll
        for (int rr = 0; rr < 2; ++rr) {
#pragma unroll
            for (int j = 0; j < 4; ++j) s[rr] += (v[rr][j][0] * v[rr][j][0] + v[rr][j][1] * v[rr][j][1]) + (v[rr][j][2] * v[rr][j][2] + v[rr][j][3] * v[rr][j][3]);
            s[rr] = wave_sum_fast(s[rr]);
            GAS unsigned long long* o8 = (GAS unsigned long long*)(ws + WS::XB + (size_t)(m0 + rr) * D * 2) + lane;
#pragma unroll
            for (int j = 0; j < 4; ++j) o8[64 * j] = (unsigned long long)pk2(v[rr][j][0], v[rr][j][1]) | ((unsigned long long)pk2(v[rr][j][2], v[rr][j][3]) << 32);
            if (lane < 4) { f32x4 q = {lane == 0 ? s[rr] : 0.f, 0.f, 0.f, 0.f}; *((GAS f32x4*)(ws + WS::SSQ + (size_t)(m0 + rr) * 64) + lane) = q; }
        }
    }
}

__global__ void __launch_bounds__(NWAVES * 64, 2) mega(Args args) {
    extern __shared__ __attribute__((aligned(16))) unsigned char lds[];
    using namespace K;
    LAS unsigned char* L = (LAS unsigned char*)lds;
    volatile LAS unsigned* MISC = (volatile LAS unsigned*)(L + MISC_OFF);
    const int tid = threadIdx.x, lane = tid & 63, wave = __builtin_amdgcn_readfirstlane(tid >> 6);
    const int G = gridDim.x, bx = blockIdx.x; const int vcu = (G % 8 == 0) ? (bx % 8) * (G / 8) + bx / 8 : bx;
    unsigned char* ws = args.ws;
    for (int u = tid; u < (LDS_BYTES - LDSCTL_OFF) / 4; u += NWAVES * 64) ((LAS unsigned*)(L + LDSCTL_OFF))[u] = 0u;
    __syncthreads();
    XcdBarrier bar = xcd_barrier_post((unsigned*)(ws + WS::CTL) + CW_BAR + args.li * XCD_BAR_WORDS, MISC + 8);
    const int lo = args.ph_lo, hi = args.ph_hi;
#define IN(k) (lo <= (k) && (k) < hi)
#define SEAM(k) do { if (IN(k) && IN((k) + 1)) xcd_barrier(bar); } while (0)
    bf16_t* XB = (bf16_t*)(ws + WS::XB); bf16_t* ACT = (bf16_t*)(ws + WS::ACT); float* SSQ = (float*)(ws + WS::SSQ);

    if (IN(0)) { p0_prologue(args, L, vcu * NWAVES + wave, G * NWAVES, lane, bx * (NWAVES * 64) + tid, G * NWAVES * 64); SEAM(0); }
    if (IN(1)) {
        pg8::Gemm g{XB, (const bf16_t*)(ws + WS::GU1), M, 2 * DFF, D, D, 1 << 30, 0}; pg8::StaticOrder S; S.init(M, 2 * DFF, G, bx);
        pg8::EpiGu E{ACT, SSQ, (LAS float*)(L + RTAB_OFF)};
        pg8::gemm_phase<pg8::EpiGu, pg8::StaticOrder, true, true>(L + RING_OFF, g, S, E);
        SEAM(1);
    }
    if (IN(2)) {
        pg8::Gemm g{ACT, (const bf16_t*)(ws + WS::DN1), M, D, DFF, DFF, 1 << 30, 0}; pg8::StaticOrder S; S.init(M, D, G, bx);
        pg8::EpiRes<true, false, true> E{args.in[I_X], nullptr, nullptr, XB, SSQ, 0.5f};
        pg8::gemm_phase<pg8::EpiRes<true, false, true>, pg8::StaticOrder, false, true>(L + RING_OFF, g, S, E);
        SEAM(2);
    }
    if (IN(3)) {
        pg8::Gemm g{XB, (const bf16_t*)(ws + WS::WIN), M, 5632, D, D, 1 << 30, 0}; pg8::StaticOrder S; S.init(M, 5632, G, bx);
        pg8::EpiIn E{(bf16_t*)(ws + WS::QO), (bf16_t*)(ws + WS::KB), (bf16_t*)(ws + WS::VB), (bf16_t*)(ws + WS::GATES), (bf16_t*)(ws + WS::QI), (bf16_t*)(ws + WS::KI), (float*)(ws + WS::WI), (float*)(ws + WS::KMEAN), SSQ,
                     args.in[I_BG], args.in[I_QNA], args.in[I_KNA], args.in[I_QNB], args.in[I_KNB], (LAS float*)(L + RTAB_OFF)};
        pg8::gemm_phase<pg8::EpiIn, pg8::StaticOrder, true, true>(L + RING_OFF, g, S, E);
        SEAM(3);
    }
    if (IN(4)) {
        for (int blk = vcu; blk < M / 64; blk += G) tk::gating_block(L, (const bf16_t*)(ws + WS::QO), (const float*)(ws + WS::KMEAN), (unsigned*)(ws + WS::BMASK), blk, tid);
        for (int it = vcu; it < 1024; it += G) {
            const int bb = it >> 8, v = it & 255, vv = (v + 128 * (bb >> 1)) & 255, pos = (bb & 1) ? 255 - vv : vv;
            tk::topk_group(L, (const bf16_t*)(ws + WS::QI), (const bf16_t*)(ws + WS::KI), (const float*)(ws + WS::WI), (u64*)args.out, bb, pos * 16, tid, lane, wave);
        }
        SEAM(4);
    }
    if (IN(5)) {
        static_assert(attn_body::ATTN_LDS_BYTES <= RING_BYTES, "attention LDS vs frame");
        const attn_body::bf16* Qp = (const attn_body::bf16*)(ws + WS::QO); const attn_body::bf16* Kp = (const attn_body::bf16*)(ws + WS::KB); const attn_body::bf16* Vp = (const attn_body::bf16*)(ws + WS::VB);
        for (int p = vcu; p < 512; p += G) {
            const int s = p & 7, bh = (p < 256) ? (p >> 3) : (32 + (((p - 256) >> 3) ^ 8));
            if ((bh & 15) >= 8) { for (int k = 0; k < 2; ++k)
                attn_body::attn_unit<8, true>(bh >> 4, bh & 15, k ? s : 15 - s, Qp, Kp, Vp, (attn_body::bf16*)(ws + WS::QO), (const unsigned long long*)args.out, (const unsigned*)(ws + WS::BMASK), args.in[I_RB], (char*)lds); }
            else { for (int k = 0; k < 2; ++k)
                attn_body::attn_unit<8, false>(bh >> 4, bh & 15, k ? s : 15 - s, Qp, Kp, Vp, (attn_body::bf16*)(ws + WS::QO), (const unsigned long long*)args.out, (const unsigned*)(ws + WS::BMASK), args.in[I_RB], (char*)lds); }
        }
        SEAM(5);
    }
    if (IN(6)) {
        pg8::Gemm g{(const bf16_t*)(ws + WS::QO), (const bf16_t*)(ws + WS::WB), M, D, D, D, 1 << 30, 0}; pg8::StaticOrder S; S.init(M, D, G, bx);
        pg8::EpiBranch2 E{(const bf16_t*)(ws + WS::GATES), (bf16_t*)(ws + WS::GM)};
        pg8::gemm_phase<pg8::EpiBranch2, pg8::StaticOrder, false, true>(L + RING_OFF, g, S, E);
        SEAM(6);
    }
    if (IN(7)) {
        pg8::Gemm g{(const bf16_t*)(ws + WS::GM), (const bf16_t*)(ws + WS::WO), M, D, D, D, 1 << 30, 0}; pg8::StaticOrder S; S.init(M, D, G, bx);
        pg8::EpiRes<false, false, true> E{nullptr, XB, nullptr, XB, SSQ, 1.0f};
        pg8::gemm_phase<pg8::EpiRes<false, false, true>, pg8::StaticOrder, false, true>(L + RING_OFF, g, S, E);
        SEAM(7);
    }
    if (IN(8)) {
        pg8::Gemm g{XB, (const bf16_t*)(ws + WS::GU2), M, 2 * DFF, D, D, 1 << 30, 0}; pg8::StaticOrder S; S.init(M, 2 * DFF, G, bx);
        pg8::EpiGu E{ACT, SSQ, (LAS float*)(L + RTAB_OFF)};
        pg8::gemm_phase<pg8::EpiGu, pg8::StaticOrder, true, true>(L + RING_OFF, g, S, E);
        SEAM(8);
    }
    if (IN(9)) {
        pg8::Gemm g{ACT, (const bf16_t*)(ws + WS::DN2), M, D, DFF, DFF, 1 << 30, 0}; pg8::StaticOrder S; S.init(M, D, G, bx);
        pg8::EpiRes<false, true, false> E{nullptr, XB, args.out, nullptr, nullptr, 0.5f};
        pg8::gemm_phase<pg8::EpiRes<false, true, false>, pg8::StaticOrder, false, true>(L + RING_OFF, g, S, E);
    }
#undef IN
#undef SEAM
}

extern "C" void kernel_launch(void* const* d_in, const int* in_sizes, int n_in, void* d_out, int out_size, void* d_ws, size_t ws_size, hipStream_t stream) {
    using namespace K;
    static int grid = 0;
    if (grid == 0) {
        if (n_in != 18 || in_sizes[0] != M * D || out_size != M * D || ws_size < WS::END) { fprintf(stderr, "kernel_launch: unexpected shapes (n_in %d, in0 %d, out %d, ws %zu)\n", n_in, n_in > 0 ? in_sizes[0] : -1, out_size, ws_size); grid = -1; return; }
        int dev = 0, cus = 0, per_cu = 0;
        if (hipGetDevice(&dev) != hipSuccess || hipDeviceGetAttribute(&cus, hipDeviceAttributeMultiprocessorCount, dev) != hipSuccess) { grid = -1; return; }
        if (hipFuncSetAttribute((const void*)mega, hipFuncAttributeMaxDynamicSharedMemorySize, LDS_BYTES) != hipSuccess) { fprintf(stderr, "kernel_launch: hipFuncSetAttribute failed\n"); grid = -1; return; }
        if (hipOccupancyMaxActiveBlocksPerMultiprocessor(&per_cu, (const void*)mega, NWAVES * 64, LDS_BYTES) != hipSuccess || per_cu < 1) { fprintf(stderr, "kernel_launch: occupancy query says %d blocks/CU\n", per_cu); (void)hipGetLastError(); grid = -1; return; }
        grid = cus;
    }
    if (grid < 0) return;
    const float* const* in = (const float* const*)d_in;
    float* out = (float*)d_out; char* ws = (char*)d_ws;
    (void)hipMemsetAsync(ws + WS::CTL, 0, WS::CTL_ZERO_BYTES, stream);
    Args a{};
    for (int i = 0; i < 18; ++i) a.in[i] = in[i];
    a.out = out; a.ws = (unsigned char*)d_ws; a.pad = 0;
    a.ph_lo = 0; a.ph_hi = 10; a.li = 0;
    hipLaunchKernelGGL(mega, dim3(grid), dim3(NWAVES * 64), LDS_BYTES, stream, a);

}
```

```cpp
#include <hip/hip_runtime.h>
#include <hip/hip_bf16.h>
#include <cstdint>
#include <cstdio>
#include <cmath>

namespace K {
constexpr int B = 4, S = 4096, M = B * S, D = 1024, DFF = 2816, H = 8, HD = 64, NIH = 4, IDIM = 64, TOPK = 256, MBLK = 256, NBLK = 16;
constexpr int DIN = 5444;
constexpr float EPS = 1e-6f;
constexpr float LOG2E = 1.4426950408889634f;
constexpr float C2 = 0.125f * LOG2E;
}
typedef unsigned short bf16_t;
typedef unsigned long long u64;

__device__ __forceinline__ bf16_t f2bf(float f) { unsigned u = __float_as_uint(f); return (bf16_t)((u + 0x7fffu + ((u >> 16) & 1u)) >> 16); }
__device__ __forceinline__ int t5_bucket(int d) {
    if (d < 16) return d;
    int large = 16 + (int)(logf((float)d / 16.0f) / 2.0794415416798357f * 16.0f);
    return large < 31 ? large : 31;
}
namespace pg8 {
#define PG8_LAS __attribute__((address_space(3)))
typedef short bf16x8 __attribute__((ext_vector_type(8)));
typedef float f32x4 __attribute__((ext_vector_type(4)));
typedef unsigned u32x4 __attribute__((ext_vector_type(4)));
constexpr int BM = 256, BK = 64, HALF = 128, HTB = HALF * BK * 2  , STAGE_BYTES = 8 * HTB, NXCD = 8, WGM = 8;

__host__ __device__ __forceinline__ int lds_byte(int r, int c) { const int st = (r >> 4) * 2 + (c >> 5), rr = r & 15, cc = c & 31, ob = rr * 64 + cc * 2; return st * 1024 + (ob ^ (((ob >> 9) & 1) << 5)); }
__host__ __device__ __forceinline__ void stage_rc(int b, int& R, int& C) { const int st = b / 1024, sb = b % 1024, swz = sb ^ (((sb >> 9) & 1) << 5); R = (st >> 1) * 16 + swz / 64; C = (st & 1) * 32 + (swz % 64) / 2; }
__host__ __device__ __forceinline__ int perm32(int rho) { const int n = rho >> 4, i = rho & 15; return 8 * (i >> 2) + 4 * n + (i & 3); }

__host__ __device__ __forceinline__ size_t tiled_b_off(int nrow, int k, int nkt) {
    const int ht = nrow >> 7, rb = nrow & 127, c = rb & 31, rho = ((c >> 2) & 1) * 16 + ((c >> 3) << 2) + (c & 3), R = (rb & ~31) + rho;
    return ((size_t)ht * nkt + (k >> 6)) * (size_t)(HALF * BK * 2) + (size_t)lds_byte(R, k & 63);
}
struct Unit { int pm, pn; };
struct Gemm { const bf16_t* A; const bf16_t* Bt; int M, N, K, lda, asplit_pn, asplit_off; };

struct StaticOrder {
    int nM, nN, nwg, G, c;
    __host__ __device__ void init(int M, int N, int G_, int c_) { nM = M / BM; nN = N / BM; nwg = nM * nN; G = G_; c = c_; }
    __host__ __device__ bool next(int i, Unit& u) const {
        const long L = (long)i * G + c; if (L >= nwg) return false;
        int wgid = (int)L; { const int q = nwg / NXCD, r = nwg % NXCD, xcd = wgid % NXCD, off = wgid / NXCD; wgid = (xcd < r ? xcd * (q + 1) : r * (q + 1) + (xcd - r) * q) + off; }
        const int nig = WGM * nN, gid = wgid / nig, fm = gid * WGM, gsz = (nM - fm) < WGM ? (nM - fm) : WGM;
        u.pm = fm + ((wgid % nig) % gsz); u.pn = (wgid % nig) / gsz; return true;
    }
    __device__ __forceinline__ void a_ready(const Unit&) const {}
    __device__ __forceinline__ void done(const Unit&) const {}
};


typedef float f32x2_t __attribute__((ext_vector_type(2))); typedef __bf16 bf16x2_t __attribute__((ext_vector_type(2)));
__device__ __forceinline__ unsigned cvt_pk_bf16(float lo, float hi) { f32x2_t v = {lo, hi}; bf16x2_t b = __builtin_convertvector(v, bf16x2_t); return __builtin_bit_cast(unsigned, b); }
__device__ __forceinline__ float row_rstd(const float* __restrict__ ssq, int row) {
    const f32x4* p = (const f32x4*)(ssq + (size_t)row * 16);
    const f32x4 a = p[0], b = p[1], c = p[2], d = p[3];
    const float s = (((a[0] + a[1]) + (a[2] + a[3])) + ((b[0] + b[1]) + (b[2] + b[3]))) + (((c[0] + c[1]) + (c[2] + c[3])) + ((d[0] + d[1]) + (d[2] + d[3])));
    return 1.0f / sqrtf(s * (1.0f / 1024.0f) + 1e-6f);
}
__device__ __forceinline__ void rstd_stage(const float* __restrict__ ssq, PG8_LAS float* tab, int pm, int wr, int fr, int fq) {
    const int l = fq * 16 + fr;
    tab[l] = row_rstd(ssq, pm * BM + wr * 64 + l);
    tab[64 + l] = row_rstd(ssq, pm * BM + HALF + wr * 64 + l);
    asm volatile("s_waitcnt lgkmcnt(0)" ::: "memory");
}
__device__ __forceinline__ float xrow_sum4(float v) {
    { auto r = __builtin_amdgcn_permlane16_swap(__float_as_uint(v), __float_as_uint(v), false, false); v = __uint_as_float(r[0]) + __uint_as_float(r[1]); }
    { auto r = __builtin_amdgcn_permlane32_swap(__float_as_uint(v), __float_as_uint(v), false, false); v = __uint_as_float(r[0]) + __uint_as_float(r[1]); }
    return v;
}
__device__ __forceinline__ float silu_f(float g) { return g * __builtin_amdgcn_rcpf(1.0f + __builtin_amdgcn_exp2f(-1.4426950408889634f * g)); }
__device__ __forceinline__ float sigmoid_f(float g) { return __builtin_amdgcn_rcpf(1.0f + __builtin_amdgcn_exp2f(-1.4426950408889634f * g)); }

struct EpiGu {
    static constexpr bool PERM = true, AFTER_DRAIN = false, HAS_MID = false;
    bf16_t* act; const float* ssq; PG8_LAS float* rtab;
    __device__ __forceinline__ void operator()(const f32x4 (&acc)[2][2][4][2], const Unit& u, int wr, int wc, int fr, int fq) const {
        asm volatile("" : "+v"(fr), "+v"(fq));
        const int row0 = u.pm * BM + wr * 64 + fr, col0 = u.pn * 128 + wc * 32 + 8 * fq;
        PG8_LAS float* tab = rtab + (wr * 4 + wc) * 128; rstd_stage(ssq, tab, u.pm, wr, fr, fq);
#pragma unroll
        for (int ai = 0; ai < 2; ++ai)
#pragma unroll
            for (int m = 0; m < 4; ++m) {
                const int row = row0 + ai * HALF + m * 16; const float rs = tab[64 * ai + 16 * m + fr];
                float o[8];
#pragma unroll
                for (int n = 0; n < 2; ++n)
#pragma unroll
                    for (int i = 0; i < 4; ++i) o[n * 4 + i] = silu_f(acc[ai][0][m][n][i] * rs) * (acc[ai][1][m][n][i] * rs);
                u32x4 w; w.x = cvt_pk_bf16(o[0], o[1]); w.y = cvt_pk_bf16(o[2], o[3]); w.z = cvt_pk_bf16(o[4], o[5]); w.w = cvt_pk_bf16(o[6], o[7]);
                *(u32x4*)(act + (size_t)row * 2816 + col0) = w;
            }
    }
};
template <bool RIN32, bool OUT32, bool STATS> struct EpiRes {
    static constexpr bool PERM = true, AFTER_DRAIN = false, HAS_MID = false;
    const float* hin32; const bf16_t* hin16; float* hout; bf16_t* hb; float* ssq; float scale;
    __device__ __forceinline__ void operator()(const f32x4 (&acc)[2][2][4][2], const Unit& u, int wr, int wc, int fr, int fq) const {
        asm volatile("" : "+v"(fr), "+v"(fq));
        const int row0 = u.pm * BM + wr * 64 + fr, col0 = u.pn * BM + wc * 32 + 8 * fq;
#pragma unroll
        for (int ai = 0; ai < 2; ++ai)
#pragma unroll
            for (int m = 0; m < 4; ++m) {
                const int row = row0 + ai * HALF + m * 16; float ss = 0.f;
#pragma unroll
                for (int bj = 0; bj < 2; ++bj) {
                    const size_t off = (size_t)row * 1024 + col0 + bj * HALF;
                    f32x4 r0, r1;
                    if (RIN32) { r0 = *(const f32x4*)(hin32 + off); r1 = *(const f32x4*)(hin32 + off + 4); }
                    else { const u32x4 rw = *(const u32x4*)(hin16 + off);
                        r0 = (f32x4){__uint_as_float(rw.x << 16), __uint_as_float(rw.x & 0xffff0000u), __uint_as_float(rw.y << 16), __uint_as_float(rw.y & 0xffff0000u)};
                        r1 = (f32x4){__uint_as_float(rw.z << 16), __uint_as_float(rw.z & 0xffff0000u), __uint_as_float(rw.w << 16), __uint_as_float(rw.w & 0xffff0000u)}; }
                    const f32x4 v0 = r0 + acc[ai][bj][m][0] * scale, v1 = r1 + acc[ai][bj][m][1] * scale;
                    if (OUT32) { *(f32x4*)(hout + off) = v0; *(f32x4*)(hout + off + 4) = v1; }
                    if (STATS) {
                        u32x4 w; w.x = cvt_pk_bf16(v0[0], v0[1]); w.y = cvt_pk_bf16(v0[2], v0[3]); w.z = cvt_pk_bf16(v1[0], v1[1]); w.w = cvt_pk_bf16(v1[2], v1[3]);
                        *(u32x4*)(hb + off) = w;
                        ss += (v0[0] * v0[0] + v0[1] * v0[1]) + (v0[2] * v0[2] + v0[3] * v0[3]) + (v1[0] * v1[0] + v1[1] * v1[1]) + (v1[2] * v1[2] + v1[3] * v1[3]);
                    }
                }
                if (STATS) { ss = xrow_sum4(ss); if (fq == 0) ssq[(size_t)row * 16 + u.pn * 4 + wc] = ss; }
            }
    }
};
struct EpiIn {
    static constexpr bool PERM = true, AFTER_DRAIN = false, HAS_MID = false;
    bf16_t *QO, *KB, *VB, *GATES, *QI, *KI; float* WI; float* KMEAN; const float* ssq; const float* bgate; const float *qn_a, *kn_a, *qn_b, *kn_b; PG8_LAS float* rtab;
    template <int KIND, bool MOBA> __device__ __forceinline__ void qkv(const f32x4 (&acc)[2][2][4][2], const Unit& u, int wr, int wc, int fr, int fq, PG8_LAS float* tab, bf16_t* base, const float* gn) const {
        const int row0 = u.pm * BM + wr * 64 + fr, head = 4 * (u.pn & 1) + wc;
        bf16_t* dst = base + (MOBA ? 512 : 0) + head * 64 + 8 * fq;
        f32x4 gv[2][2];
#pragma unroll
        for (int bj = 0; bj < 2; ++bj)
#pragma unroll
            for (int n = 0; n < 2; ++n) gv[bj][n] = (KIND < 2) ? *(const f32x4*)(gn + 32 * bj + 8 * fq + 4 * n) : (f32x4){1.f, 1.f, 1.f, 1.f};
        constexpr bool km = (KIND == 1) && MOBA;
        f32x4 ks[2][2];
#pragma unroll
        for (int bj = 0; bj < 2; ++bj)
#pragma unroll
            for (int n = 0; n < 2; ++n) ks[bj][n] = (f32x4){0.f, 0.f, 0.f, 0.f};
#pragma unroll
        for (int ai = 0; ai < 2; ++ai)
#pragma unroll
            for (int m = 0; m < 4; ++m) {
                const int row = row0 + ai * HALF + m * 16; const float rs = tab[64 * ai + 16 * m + fr];
                f32x4 v[2][2]; float ss = 0.f;
#pragma unroll
                for (int bj = 0; bj < 2; ++bj)
#pragma unroll
                    for (int n = 0; n < 2; ++n) { v[bj][n] = acc[ai][bj][m][n] * rs; ss += (v[bj][n][0] * v[bj][n][0] + v[bj][n][1] * v[bj][n][1]) + (v[bj][n][2] * v[bj][n][2] + v[bj][n][3] * v[bj][n][3]); }
                if (KIND < 2) {
                    ss = xrow_sum4(ss);
                    float r = 1.0f / sqrtf(ss * (1.0f / 64.0f) + 1e-6f); if (KIND == 0) r *= K::C2;
#pragma unroll
                    for (int bj = 0; bj < 2; ++bj)
#pragma unroll
                        for (int n = 0; n < 2; ++n) v[bj][n] = v[bj][n] * gv[bj][n] * r;
                }
#pragma unroll
                for (int bj = 0; bj < 2; ++bj) {
                    u32x4 w; w.x = cvt_pk_bf16(v[bj][0][0], v[bj][0][1]); w.y = cvt_pk_bf16(v[bj][0][2], v[bj][0][3]); w.z = cvt_pk_bf16(v[bj][1][0], v[bj][1][1]); w.w = cvt_pk_bf16(v[bj][1][2], v[bj][1][3]);
                    *(u32x4*)(dst + (size_t)row * 1024 + 32 * bj) = w;
                    if (km) { ks[bj][0] += v[bj][0]; ks[bj][1] += v[bj][1]; }
                }
                if (km) asm volatile("" : "+v"(ks[0][0]), "+v"(ks[0][1]), "+v"(ks[1][0]), "+v"(ks[1][1]));
                asm volatile("" ::: "memory");
            }
        if (km) {
            float* kd = KMEAN + ((size_t)u.pm * 8 + head) * 64 + 8 * fq;
#pragma unroll
            for (int bj = 0; bj < 2; ++bj)
#pragma unroll
                for (int n = 0; n < 2; ++n)
#pragma unroll
                    for (int i = 0; i < 4; ++i) { float s = ks[bj][n][i]; s += __shfl_xor(s, 1); s += __shfl_xor(s, 2); s += __shfl_xor(s, 4); s += __shfl_xor(s, 8);
                        if (fr == 0) atomicAdd(kd + 32 * bj + 4 * n + i, s); }
        }
    }
    __device__ __forceinline__ void operator()(const f32x4 (&acc)[2][2][4][2], const Unit& u, int wr, int wc, int fr, int fq) const {
        asm volatile("" : "+v"(fr), "+v"(fq));
        const int pn = u.pn, row0 = u.pm * BM + wr * 64 + fr;
        PG8_LAS float* tab = rtab + (wr * 4 + wc) * 128; rstd_stage(ssq, tab, u.pm, wr, fr, fq);
        if (pn < 2) qkv<0, false>(acc, u, wr, wc, fr, fq, tab, QO, qn_a);
        else if (pn < 4) qkv<1, false>(acc, u, wr, wc, fr, fq, tab, KB, kn_a);
        else if (pn < 6) qkv<2, false>(acc, u, wr, wc, fr, fq, tab, VB, nullptr);
        else if (pn < 8) qkv<0, true>(acc, u, wr, wc, fr, fq, tab, QO, qn_b);
        else if (pn < 10) qkv<1, true>(acc, u, wr, wc, fr, fq, tab, KB, kn_b);
        else if (pn < 12) qkv<2, true>(acc, u, wr, wc, fr, fq, tab, VB, nullptr);
        else if (pn == 12) {
#pragma unroll
            for (int ai = 0; ai < 2; ++ai)
#pragma unroll
                for (int m = 0; m < 4; ++m) { const int row = row0 + ai * HALF + m * 16; const float rs = tab[64 * ai + 16 * m + fr];
#pragma unroll
                    for (int bj = 0; bj < 2; ++bj) { const f32x4 a = acc[ai][bj][m][0] * rs, b = acc[ai][bj][m][1] * rs;
                        u32x4 w; w.x = cvt_pk_bf16(a[0], a[1]); w.y = cvt_pk_bf16(a[2], a[3]); w.z = cvt_pk_bf16(b[0], b[1]); w.w = cvt_pk_bf16(b[2], b[3]);
                        *(u32x4*)(QI + (size_t)row * 256 + 128 * bj + 32 * wc + 8 * fq) = w; } }
        } else if (pn == 13) {
#pragma unroll
            for (int ai = 0; ai < 2; ++ai)
#pragma unroll
                for (int m = 0; m < 4; ++m) { const int row = row0 + ai * HALF + m * 16; const float rs = tab[64 * ai + 16 * m + fr];
                    const f32x4 a = acc[ai][0][m][0] * rs, b = acc[ai][0][m][1] * rs;
                    if (wc < 2) { u32x4 w; w.x = cvt_pk_bf16(a[0], a[1]); w.y = cvt_pk_bf16(a[2], a[3]); w.z = cvt_pk_bf16(b[0], b[1]); w.w = cvt_pk_bf16(b[2], b[3]);
                        *(u32x4*)(KI + (size_t)row * 64 + 32 * wc + 8 * fq) = w; }
                    else if (wc == 2 && fq == 0) *(f32x4*)(WI + (size_t)row * 4) = a * 0.5f; }
        } else {
            const int cg0 = 256 * (pn - 14) + 32 * wc + 8 * fq;
            f32x4 bv[2][2];
#pragma unroll
            for (int bj = 0; bj < 2; ++bj)
#pragma unroll
                for (int n = 0; n < 2; ++n) bv[bj][n] = *(const f32x4*)(bgate + cg0 + 128 * bj + 4 * n);
#pragma unroll
            for (int ai = 0; ai < 2; ++ai)
#pragma unroll
                for (int m = 0; m < 4; ++m) { const int row = row0 + ai * HALF + m * 16; const float rs = tab[64 * ai + 16 * m + fr];
#pragma unroll
                    for (int bj = 0; bj < 2; ++bj) { const f32x4 a = acc[ai][bj][m][0] * rs + bv[bj][0], b = acc[ai][bj][m][1] * rs + bv[bj][1];
                        u32x4 w; w.x = cvt_pk_bf16(sigmoid_f(a[0]), sigmoid_f(a[1])); w.y = cvt_pk_bf16(sigmoid_f(a[2]), sigmoid_f(a[3])); w.z = cvt_pk_bf16(sigmoid_f(b[0]), sigmoid_f(b[1])); w.w = cvt_pk_bf16(sigmoid_f(b[2]), sigmoid_f(b[3]));
                        *(u32x4*)(GATES + (size_t)row * 2048 + cg0 + 128 * bj) = w; } }
        }
    }
};
struct EpiBranch2 {
    static constexpr bool PERM = true, AFTER_DRAIN = false, HAS_MID = true;
    const bf16_t* gates; bf16_t* mx;
    __device__ __forceinline__ void mid(f32x4 (&acc)[2][2][4][2], const Unit& u, int wr, int wc, int fr, int fq) const {
        asm volatile("" : "+v"(fr), "+v"(fq));
        const int row0 = u.pm * BM + wr * 64 + fr, col0 = u.pn * BM + wc * 32 + 8 * fq;
#pragma unroll
        for (int ai = 0; ai < 2; ++ai)
#pragma unroll
            for (int m = 0; m < 4; ++m) {
                const int row = row0 + ai * HALF + m * 16;
#pragma unroll
                for (int bj = 0; bj < 2; ++bj) {
                    const size_t off = (size_t)row * 2048 + col0 + bj * HALF;
                    const u32x4 ga = *(const u32x4*)(gates + off), gb = *(const u32x4*)(gates + off + 1024);
                    float r[8];
#pragma unroll
                    for (int x = 0; x < 4; ++x) {
                        r[2 * x] = __uint_as_float(ga[x] << 16) * __builtin_amdgcn_rcpf(__builtin_fmaxf(__uint_as_float(gb[x] << 16), 1e-30f));
                        r[2 * x + 1] = __uint_as_float(ga[x] & 0xffff0000u) * __builtin_amdgcn_rcpf(__builtin_fmaxf(__uint_as_float(gb[x] & 0xffff0000u), 1e-30f)); }
                    acc[ai][bj][m][0] = acc[ai][bj][m][0] * (f32x4){r[0], r[1], r[2], r[3]};
                    acc[ai][bj][m][1] = acc[ai][bj][m][1] * (f32x4){r[4], r[5], r[6], r[7]};
                }
                asm volatile("" ::: "memory");
            }
    }
    __device__ __forceinline__ void operator()(const f32x4 (&acc)[2][2][4][2], const Unit& u, int wr, int wc, int fr, int fq) const {
        asm volatile("" : "+v"(fr), "+v"(fq));
        const int row0 = u.pm * BM + wr * 64 + fr, col0 = u.pn * BM + wc * 32 + 8 * fq;
#pragma unroll
        for (int ai = 0; ai < 2; ++ai)
#pragma unroll
            for (int m = 0; m < 4; ++m) {
                const int row = row0 + ai * HALF + m * 16;
#pragma unroll
                for (int bj = 0; bj < 2; ++bj) {
                    const u32x4 gw = *(const u32x4*)(gates + (size_t)row * 2048 + 1024 + col0 + bj * HALF);
                    const f32x4 a = acc[ai][bj][m][0], b = acc[ai][bj][m][1];
                    u32x4 w;
                    w.x = cvt_pk_bf16(a[0] * __builtin_fmaxf(__uint_as_float(gw.x << 16), 1e-30f), a[1] * __builtin_fmaxf(__uint_as_float(gw.x & 0xffff0000u), 1e-30f));
                    w.y = cvt_pk_bf16(a[2] * __builtin_fmaxf(__uint_as_float(gw.y << 16), 1e-30f), a[3] * __builtin_fmaxf(__uint_as_float(gw.y & 0xffff0000u), 1e-30f));
                    w.z = cvt_pk_bf16(b[0] * __builtin_fmaxf(__uint_as_float(gw.z << 16), 1e-30f), b[1] * __builtin_fmaxf(__uint_as_float(gw.z & 0xffff0000u), 1e-30f));
                    w.w = cvt_pk_bf16(b[2] * __builtin_fmaxf(__uint_as_float(gw.w << 16), 1e-30f), b[3] * __builtin_fmaxf(__uint_as_float(gw.w & 0xffff0000u), 1e-30f));
                    *(u32x4*)(mx + (size_t)row * 1024 + col0 + bj * HALF) = w;
                }
                asm volatile("" ::: "memory");
            }
    }
};
template <class Epi, class Sched, bool ALIGN_EPI = false, bool SP2 = false>
__device__ __forceinline__ void gemm_phase(PG8_LAS unsigned char* lds, const Gemm g, const Sched& S, const Epi& E) {
    const int tid = threadIdx.x, wid = __builtin_amdgcn_readfirstlane(tid >> 6), lane = tid & 63, wr = wid >> 2, wc = wid & 3, fr = lane & 15, fq = lane >> 4;
    const int K = g.K, nt = K / BK;
    unsigned voffA[2], voffB[2];
#pragma unroll
    for (int i = 0; i < 2; ++i) { int R, C; stage_rc(tid * 16 + i * 8192, R, C); const int Rb = Epi::PERM ? ((R & ~31) + perm32(R & 31)) : R;
        voffA[i] = (unsigned)(R * g.lda + C) * 2u; voffB[i] = (unsigned)(tid * 16 + i * 8192); (void)Rb; }
    const size_t kstep = (size_t)(BK * 2), kstepB = (size_t)HTB;
    const size_t hstepA = (size_t)HALF * g.lda * 2, hstepB = (size_t)nt * kstepB;
    const size_t tstepA = 2 * hstepA, tstepB = 2 * hstepB;
#define PG8_ABASE(u_) ((const char*)g.A + (size_t)(u_).pm * tstepA + (((u_).pn >= g.asplit_pn) ? (size_t)g.asplit_off : (size_t)0))
    const unsigned ldsw = (unsigned)wid * 1024u;
    const int aoff = lds_byte(wr * 64 + fr, fq * 8), boff = lds_byte(wc * 32 + fr, fq * 8);
#define PG8_SA(b, h) (((b) * 2 + (h)) * HTB)
#define PG8_SB(b, h) ((4 + (b) * 2 + (h)) * HTB)
#define PG8_STAGE(bufoff, gbase, voff) do { _Pragma("unroll") for (int _i = 0; _i < 2; ++_i) \
        __builtin_amdgcn_global_load_lds((const unsigned*)((const char*)(gbase) + (voff)[_i]), (PG8_LAS unsigned*)(lds + (bufoff) + ldsw + _i * 8192), 16, 0, 0); } while (0)
#define PG8_LDA(dst, b, h) do { _Pragma("unroll") for (int m = 0; m < 4; ++m) _Pragma("unroll") for (int k = 0; k < 2; ++k) dst[m][k] = *(const PG8_LAS bf16x8*)(lds + PG8_SA(b, h) + aoff + m * 2048 + k * 1024); } while (0)
#define PG8_LDB(dst, b, h) do { _Pragma("unroll") for (int n = 0; n < 2; ++n) _Pragma("unroll") for (int k = 0; k < 2; ++k) dst[n][k] = *(const PG8_LAS bf16x8*)(lds + PG8_SB(b, h) + boff + n * 2048 + k * 1024); } while (0)
#define PG8_MMA(ai, bj, At, Bt) do { __builtin_amdgcn_s_setprio(1); _Pragma("unroll") for (int m = 0; m < 4; ++m) _Pragma("unroll") for (int n = 0; n < 2; ++n) _Pragma("unroll") for (int k = 0; k < 2; ++k) \
        acc[ai][bj][m][n] = __builtin_amdgcn_mfma_f32_16x16x32_bf16(Bt[n][k], At[m][k], acc[ai][bj][m][n], 0, 0, 0); __builtin_amdgcn_s_setprio(0); } while (0)
#define PG8_WAIT_V(n) asm volatile("s_waitcnt vmcnt(" #n ")" ::: "memory")
#define PG8_WAIT_L(n) asm volatile("s_waitcnt lgkmcnt(" #n ")" ::: "memory")
#define PG8_BAR __builtin_amdgcn_s_barrier()
#define PG8_SCHED __builtin_amdgcn_sched_barrier(0)
    Unit cur, nxt; int ui = 0;
    if (!S.next(0, cur)) return;
    f32x4 acc[2][2][4][2];
#pragma unroll
    for (int a = 0; a < 2; ++a)
#pragma unroll
        for (int b = 0; b < 2; ++b)
#pragma unroll
            for (int m = 0; m < 4; ++m)
#pragma unroll
                for (int n = 0; n < 2; ++n) acc[a][b][m][n] = (f32x4){0.f, 0.f, 0.f, 0.f};
    bf16x8 At[4][2], B0[2][2], B1[2][2];
    const char* cA = PG8_ABASE(cur); const char* cB = (const char*)g.Bt + (size_t)cur.pn * tstepB;
    S.a_ready(cur);
    if constexpr (SP2) {
        PG8_STAGE(PG8_SB(0, 0), cB, voffB); PG8_STAGE(PG8_SB(0, 1), cB + hstepB, voffB); PG8_STAGE(PG8_SA(0, 0), cA, voffA); PG8_STAGE(PG8_SA(0, 1), cA + hstepA, voffA);
        PG8_STAGE(PG8_SB(1, 0), cB + kstepB, voffB); PG8_STAGE(PG8_SA(1, 0), cA + kstep, voffA); PG8_STAGE(PG8_SB(1, 1), cB + hstepB + kstepB, voffB);
        if (wr == 1) PG8_BAR;
        PG8_WAIT_V(8); PG8_BAR;
        PG8_WAIT_V(6); PG8_BAR;
    } else {
        PG8_STAGE(PG8_SB(0, 0), cB, voffB); PG8_STAGE(PG8_SA(0, 0), cA, voffA); PG8_STAGE(PG8_SB(0, 1), cB + hstepB, voffB); PG8_STAGE(PG8_SA(0, 1), cA + hstepA, voffA);
        if (wr == 1) PG8_BAR;
        PG8_WAIT_V(4); PG8_BAR;
        PG8_STAGE(PG8_SB(1, 0), cB + kstepB, voffB); PG8_STAGE(PG8_SA(1, 0), cA + kstep, voffA); PG8_STAGE(PG8_SB(1, 1), cB + hstepB + kstepB, voffB);
        PG8_WAIT_V(6); PG8_BAR;
    }
    for (;;) {
        const bool has_next = S.next(ui + 1, nxt);
        const char* nA = has_next ? PG8_ABASE(nxt) : cA; const char* nB = has_next ? (const char*)g.Bt + (size_t)nxt.pn * tstepB : cB;
        for (int t = 0; t < nt; t += 2) {
            const bool last = (t == nt - 2);
            const char* a1 = cA + (size_t)(t + 1) * kstep;
            const char* a2 = last ? nA : cA + (size_t)(t + 2) * kstep; const char* b2 = last ? nB : cB + (size_t)(t + 2) * kstepB;
            const char* a3 = a2 + kstep; const char* b3 = b2 + kstepB;
            if (last && has_next) S.a_ready(nxt);
            if constexpr (SP2) {
            PG8_LDB(B0, 0, 0); PG8_LDB(B1, 0, 1); PG8_SCHED; PG8_LDA(At, 0, 0); PG8_STAGE(PG8_SA(1, 1), a1 + hstepA, voffA);
            PG8_WAIT_V(8); PG8_WAIT_L(0); PG8_BAR; PG8_MMA(0, 0, At, B0); PG8_MMA(0, 1, At, B1); PG8_BAR; PG8_SCHED;
            PG8_LDA(At, 0, 1); PG8_STAGE(PG8_SB(0, 0), b2, voffB); PG8_STAGE(PG8_SB(0, 1), b2 + hstepB, voffB); PG8_STAGE(PG8_SA(0, 0), a2, voffA);
            PG8_WAIT_V(8); PG8_WAIT_L(0); PG8_BAR; PG8_MMA(1, 0, At, B0); PG8_MMA(1, 1, At, B1); PG8_BAR; PG8_SCHED;
            PG8_LDB(B0, 1, 0); PG8_LDB(B1, 1, 1); PG8_SCHED; PG8_LDA(At, 1, 0); PG8_STAGE(PG8_SA(0, 1), a2 + hstepA, voffA);
            PG8_WAIT_V(8); PG8_WAIT_L(0); PG8_BAR; PG8_MMA(0, 0, At, B0); PG8_MMA(0, 1, At, B1); PG8_BAR; PG8_SCHED;
            PG8_LDA(At, 1, 1); PG8_STAGE(PG8_SB(1, 0), b3, voffB); PG8_STAGE(PG8_SB(1, 1), b3 + hstepB, voffB); PG8_STAGE(PG8_SA(1, 0), a3, voffA);
            PG8_WAIT_V(8); PG8_WAIT_L(0); PG8_BAR; PG8_MMA(1, 0, At, B0); PG8_MMA(1, 1, At, B1); PG8_BAR; PG8_SCHED;
            } else {
            PG8_LDB(B0, 0, 0); PG8_SCHED; PG8_LDA(At, 0, 0); PG8_STAGE(PG8_SA(1, 1), a1 + hstepA, voffA);
            PG8_WAIT_L(8); PG8_BAR; PG8_WAIT_L(0); PG8_MMA(0, 0, At, B0); PG8_BAR; PG8_SCHED;
            PG8_LDB(B1, 0, 1); PG8_STAGE(PG8_SB(0, 0), b2, voffB);
            PG8_BAR; PG8_WAIT_L(0); PG8_MMA(0, 1, At, B1); PG8_BAR;
            PG8_LDA(At, 0, 1); PG8_STAGE(PG8_SA(0, 0), a2, voffA);
            PG8_BAR; PG8_WAIT_L(0); PG8_MMA(1, 0, At, B0); PG8_BAR; PG8_SCHED;
            PG8_STAGE(PG8_SB(0, 1), b2 + hstepB, voffB);
            PG8_WAIT_V(6); PG8_BAR; PG8_MMA(1, 1, At, B1); PG8_BAR;
            PG8_LDB(B0, 1, 0); PG8_SCHED; PG8_LDA(At, 1, 0); PG8_STAGE(PG8_SA(0, 1), a2 + hstepA, voffA);
            PG8_WAIT_L(8); PG8_BAR; PG8_WAIT_L(0); PG8_MMA(0, 0, At, B0); PG8_BAR; PG8_SCHED;
            PG8_LDB(B1, 1, 1); PG8_STAGE(PG8_SB(1, 0), b3, voffB);
            PG8_BAR; PG8_WAIT_L(0); PG8_MMA(0, 1, At, B1); PG8_BAR;
            PG8_LDA(At, 1, 1); PG8_STAGE(PG8_SA(1, 0), a3, voffA);
            PG8_BAR; PG8_WAIT_L(0); PG8_MMA(1, 0, At, B0); PG8_BAR; PG8_SCHED;
            PG8_STAGE(PG8_SB(1, 1), b3 + hstepB, voffB);
            PG8_WAIT_V(6); PG8_BAR; PG8_MMA(1, 1, At, B1); PG8_BAR;
            }
            if constexpr (Epi::HAS_MID) { if (t + 2 == nt / 2) E.mid(acc, cur, wr, wc, fr, fq); }
        }
        if constexpr (ALIGN_EPI) { if (wr == 0) PG8_BAR; }
        if constexpr (!Epi::AFTER_DRAIN) { E(acc, cur, wr, wc, fr, fq); S.done(cur); }
        if (!has_next) break;
#pragma unroll
        for (int a = 0; a < 2; ++a)
#pragma unroll
            for (int b = 0; b < 2; ++b)
#pragma unroll
                for (int m = 0; m < 4; ++m)
#pragma unroll
                    for (int n = 0; n < 2; ++n) acc[a][b][m][n] = (f32x4){0.f, 0.f, 0.f, 0.f};
        cur = nxt; cA = nA; cB = nB; ++ui;
        if constexpr (ALIGN_EPI) { if (wr == 1) PG8_BAR; }
    }
    PG8_WAIT_V(0);
    if constexpr (!ALIGN_EPI) { if (wr == 0) PG8_BAR; }
    PG8_BAR;
    if constexpr (Epi::AFTER_DRAIN) { E.fused(acc, cur, wr, wc, fr, fq, lds, wid, lane); S.done(cur); }
#undef PG8_ABASE
#undef PG8_SA
#undef PG8_SB
#undef PG8_STAGE
#undef PG8_LDA
#undef PG8_LDB
#undef PG8_MMA
#undef PG8_WAIT_V
#undef PG8_WAIT_L
#undef PG8_BAR
#undef PG8_SCHED
}
}

constexpr int NWAVES = 8;
namespace WS {
constexpr size_t MiB = 1u << 20;
constexpr size_t CTL = 0, CTL_ZERO_BYTES = 1 * MiB;
constexpr size_t KMEAN = 512 * 1024;
constexpr size_t SSQ = 1 * MiB;
constexpr size_t GU1 = 2 * MiB, DN1 = 13 * MiB, WIN = 19 * MiB, WB = 30 * MiB, WO = 32 * MiB, GU2 = 36 * MiB, DN2 = 47 * MiB;
constexpr size_t XB = 53 * MiB;
constexpr size_t QO = 85 * MiB, KB = 117 * MiB, VB = 149 * MiB;
constexpr size_t GATES = 181 * MiB;
constexpr size_t QI = 245 * MiB, KI = 253 * MiB, WI = 255 * MiB, BMASK = 255 * MiB + 256 * 1024;
constexpr size_t ACT = 85 * MiB;
constexpr size_t GM = 117 * MiB;
constexpr size_t END = 256 * MiB;
}
constexpr int CW_BAR = 4096;
constexpr int RING_OFF = 0, RING_BYTES = 131072;
constexpr int LDSCTL_OFF = RING_BYTES, MISC_OFF = LDSCTL_OFF + 320;
constexpr int RTAB_OFF = LDSCTL_OFF + 1024;
constexpr int LDS_BYTES = 147456;

#define GAS __attribute__((address_space(1)))
#define LAS __attribute__((address_space(3)))
typedef unsigned v4u __attribute__((ext_vector_type(4)));
typedef float f32x4 __attribute__((ext_vector_type(4)));
typedef GAS unsigned gu32;
#define LDS_WAIT() asm volatile("s_waitcnt lgkmcnt(0)" ::: "memory")
#define VM_WAIT() asm volatile("s_waitcnt vmcnt(0)" ::: "memory")
__device__ __forceinline__ unsigned pk2(float lo, float hi) { return (unsigned)f2bf(lo) | ((unsigned)f2bf(hi) << 16); }
#define XB_TMO      128
#define XB_XCNT(j)  (256  + 64 * (j))
#define XB_XSUB(j)  (1280 + 64 * (j))
#define XB_XGEN(j)  (2304 + 64 * (j))
#define XB_TOP      3328
#define XB_TOPGEN   3392
#define XCD_BAR_WORDS 3456
#define XB_SPIN_CAP (1u << 18)

__device__ __forceinline__ unsigned xb_ld(unsigned* p)              { return __hip_atomic_load(p, __ATOMIC_RELAXED, __HIP_MEMORY_SCOPE_AGENT); }
__device__ __forceinline__ unsigned xb_add(unsigned* p, unsigned v) { return __hip_atomic_fetch_add(p, v, __ATOMIC_RELAXED, __HIP_MEMORY_SCOPE_AGENT); }
__device__ __forceinline__ unsigned xb_xcc_id() { return (unsigned)__builtin_amdgcn_s_getreg((3 << 11) | 20) & 0xFu; }
#define XB_SPIN(cond, bar) do { unsigned _sp = 0; while (cond) { __builtin_amdgcn_s_sleep(1); \
    if ((++_sp & 255u) == 0u) { if (xb_ld(&(bar)[XB_TMO])) break; if (_sp > XB_SPIN_CAP) { atomicAdd(&(bar)[XB_TMO], 1u); break; } } } } while (0)

struct XcdBarrier {
    unsigned* bar; unsigned x;
    volatile LAS unsigned* st;
};

__device__ __forceinline__ XcdBarrier xcd_barrier_post(unsigned* bar, volatile LAS unsigned* st) {
    XcdBarrier b; b.bar = bar; b.x = xb_xcc_id(); b.st = st;
    if (threadIdx.x == 0) (void)xb_add(&bar[XB_XCNT(b.x)], 1u);
    return b;
}
__device__ __forceinline__ void xcd_barrier_complete(unsigned* bar, unsigned x, unsigned& nloc, unsigned& nx) {
    const unsigned G = gridDim.x * gridDim.y * gridDim.z;
    unsigned sum, cnt, mine, sp = 0u;
    for (;;) {
        sum = 0u; cnt = 0u; mine = 0u;
#pragma unroll
        for (unsigned j = 0; j < 16; ++j) { const unsigned c = xb_ld(&bar[XB_XCNT(j)]); sum += c; cnt += (c > 0u) ? 1u : 0u; mine = (j == x) ? c : mine; }
        if (sum == G) break;
        __builtin_amdgcn_s_sleep(1);
        if ((++sp & 255u) == 0u) { if (xb_ld(&bar[XB_TMO])) break; if (sp > XB_SPIN_CAP) { atomicAdd(&bar[XB_TMO], 1u); break; } }
    }
    nloc = mine > 0u ? mine : 1u; nx = cnt > 0u ? cnt : 1u;
}

__device__ __forceinline__ void xcd_barrier(const XcdBarrier& b) {
    asm volatile("s_waitcnt vmcnt(0)" ::: "memory");
    __syncthreads();
    if (threadIdx.x == 0) {
        unsigned* bar = b.bar;
        __builtin_amdgcn_s_waitcnt(0);
        unsigned nloc = b.st[0], nx = b.st[1];
        if (nloc == 0u) { xcd_barrier_complete(bar, b.x, nloc, nx); b.st[0] = nloc; b.st[1] = nx; }
        const unsigned old = xb_add(&bar[XB_XSUB(b.x)], 1u);
        const unsigned gen = old / nloc;
        if (old + 1u == (gen + 1u) * nloc) {
            __builtin_amdgcn_fence(__ATOMIC_RELEASE, "agent");
            asm volatile("s_waitcnt vmcnt(0)" ::: "memory");
            const unsigned og = xb_add(&bar[XB_TOP], 1u);
            const unsigned tg = og / nx;
            if (og + 1u == (tg + 1u) * nx) xb_add(&bar[XB_TOPGEN], 1u);
            else XB_SPIN(xb_ld(&bar[XB_TOPGEN]) == tg, bar);
            __builtin_amdgcn_fence(__ATOMIC_ACQUIRE, "agent");
            xb_add(&bar[XB_XGEN(b.x)], 1u);
            asm volatile("s_waitcnt vmcnt(0)" ::: "memory");
        } else {
            XB_SPIN(xb_ld(&bar[XB_XGEN(b.x)]) == gen, bar);
            __builtin_amdgcn_fence(__ATOMIC_ACQUIRE, "agent");
            asm volatile("s_waitcnt vmcnt(0)" ::: "memory");
        }
    }
    __syncthreads();
}

namespace tk {
typedef short bf16x8 __attribute__((ext_vector_type(8)));
typedef float f32x4 __attribute__((ext_vector_type(4)));
constexpr int HIST_OFF = 0, HSTR = 1025;
constexpr int TCNT_OFF = 65664;
constexpr int MSTG_OFF = TCNT_OFF + 16384;
constexpr int TBASE_OFF = MSTG_OFF + 8192;
constexpr int RES_OFF = TBASE_OFF + 8192;
constexpr int QST_OFF = 102400;
#define TK_BAR() do { asm volatile("s_waitcnt lgkmcnt(0)" ::: "memory"); __builtin_amdgcn_s_barrier(); asm volatile("" ::: "memory"); } while (0)

__device__ __forceinline__ unsigned wave_prefix_incl(unsigned x) {
    x += (unsigned)__builtin_amdgcn_update_dpp(0, (int)x, 0x111, 0xf, 0xf, true);
    x += (unsigned)__builtin_amdgcn_update_dpp(0, (int)x, 0x112, 0xf, 0xf, true);
    x += (unsigned)__builtin_amdgcn_update_dpp(0, (int)x, 0x114, 0xf, 0xf, true);
    x += (unsigned)__builtin_amdgcn_update_dpp(0, (int)x, 0x118, 0xf, 0xf, true);
    x += (unsigned)__builtin_amdgcn_update_dpp(0, (int)x, 0x142, 0xa, 0xf, false);
    x += (unsigned)__builtin_amdgcn_update_dpp(0, (int)x, 0x143, 0xc, 0xf, false);
    return x;
}
template <int NW>
__device__ __forceinline__ void scan_query(const LAS unsigned* hq, LAS unsigned* res, int qq, unsigned r, int lane) {
    unsigned w[NW]; unsigned tot = 0; const int wbase = (63 - lane) * NW;
#pragma unroll
    for (int x = 0; x < NW; ++x) { w[x] = hq[wbase + x]; tot += (w[x] & 0xffffu) + (w[x] >> 16); }
    const unsigned incl = wave_prefix_incl(tot);
    const unsigned above = incl - tot;
    if (above < r && incl >= r) {
        unsigned c = above, bin = 0, cnt = 0, cb = 0; bool found = false;
#pragma unroll
        for (int x = NW - 1; x >= 0; --x) {
            const unsigned hi = w[x] >> 16, lo = w[x] & 0xffffu;
            if (!found && c + hi >= r) { found = true; bin = (unsigned)(wbase + x) * 2u + 1u; cnt = hi; cb = c; }
            c += hi;
            if (!found && c + lo >= r) { found = true; bin = (unsigned)(wbase + x) * 2u; cnt = lo; cb = c; }
            c += lo;
        }
        res[qq] = bin; res[16 + qq] = r - cb; res[32 + qq] = cnt;
    }
}

__device__ __forceinline__ void tk_prefetch_q(LAS unsigned char* L, const bf16_t* __restrict__ QI, const float* __restrict__ WI, int b, int tq0, int lane) {
    const size_t row = (size_t)b * K::S + tq0 + (lane & 15);
#pragma unroll
    for (int f = 0; f < 8; ++f) __builtin_amdgcn_global_load_lds((const unsigned*)(QI + row * 256 + (f >> 1) * 64 + (f & 1) * 32 + (lane >> 4) * 8), (LAS unsigned*)(L + QST_OFF + f * 1024), 16, 0, 0);
    __builtin_amdgcn_global_load_lds((const unsigned*)(WI + row * 4), (LAS unsigned*)(L + QST_OFF + 8192), 16, 0, 0);
}
__device__ __forceinline__ void topk_group(LAS unsigned char* L, const bf16_t* __restrict__ QI, const bf16_t* __restrict__ KI, const float* __restrict__ WI, u64* __restrict__ MASK,
                                           int b, int tq0, int nb, int ntq0, int tid, int lane, int wave) {
    using namespace K;
    const int q = lane & 15, g = lane >> 4;
    const int row0 = b * S + tq0, jmax = tq0 >> 4;
    LAS unsigned* hist = (LAS unsigned*)(L + HIST_OFF); LAS unsigned* tcnt = (LAS unsigned*)(L + TCNT_OFF);
    LAS unsigned short* mstg = (LAS unsigned short*)(L + MSTG_OFF); LAS unsigned short* tbase = (LAS unsigned short*)(L + TBASE_OFF); LAS unsigned* res = (LAS unsigned*)(L + RES_OFF);
    for (int i = tid; i < (16384 + 8192) / 4; i += NWAVES * 64) tcnt[i] = 0u;
    LAS unsigned* const tc_q = tcnt + q * 256 + wave; LAS unsigned short* const tb_q = tbase + q * 256 + wave;
    LAS unsigned* const ms32_q = (LAS unsigned*)mstg + ((q * 256 + wave) >> 1); const unsigned sh_q = 16u * (wave & 1) + 4u * g;
    if (tq0 < TOPK) {
        if (wave == 0 && ntq0 >= TOPK) tk_prefetch_q(L, QI, WI, nb, ntq0, lane);
        TK_BAR();
        for (int idx = tid; idx < 16 * (jmax + 1); idx += NWAVES * 64) { const int qq = idx & 15, j = idx >> 4; mstg[qq * 256 + j] = (unsigned short)((j < jmax) ? 0xffffu : ((2u << qq) - 1u)); }
    } else {
        unsigned key[32][4];
        for (int i = tid; i < 16 * HSTR / 4; i += NWAVES * 64) ((LAS v4u*)hist)[i] = (v4u){0u, 0u, 0u, 0u};
        if (wave == 0) asm volatile("s_waitcnt vmcnt(0)" ::: "memory");
        TK_BAR();
        bf16x8 qf[4][2];
#pragma unroll
        for (int h = 0; h < 4; ++h)
#pragma unroll
            for (int ks = 0; ks < 2; ++ks) qf[h][ks] = *(const LAS bf16x8*)(L + QST_OFF + (h * 2 + ks) * 1024 + lane * 16);
        const f32x4 wv = *(const LAS f32x4*)(L + QST_OFF + 8192 + lane * 16);
        bf16x8 kk[3][2][2];
#define TK_LOADK(c_) do { _Pragma("unroll") for (int s_ = 0; s_ < 2; ++s_) { const int j_ = wave + 8 * (2 * (c_) + s_), jc_ = j_ < jmax ? j_ : jmax; \
            const bf16_t* kp_ = KI + (size_t)(b * S + jc_ * 16 + q) * 64 + g * 8; kk[(c_) % 3][s_][0] = *(const bf16x8*)kp_; kk[(c_) % 3][s_][1] = *(const bf16x8*)(kp_ + 32); } } while (0)
        TK_LOADK(0); if (16 <= jmax) TK_LOADK(1);
#pragma unroll
        for (int c = 0; c < 16; ++c) {
            if (16 * c <= jmax) {
                if (c < 14 && 16 * (c + 2) <= jmax) TK_LOADK(c + 2);
#pragma unroll
                for (int s = 0; s < 2; ++s) {
                    const int i = 2 * c + s, j = wave + 8 * i;
                    f32x4 sc = {0.f, 0.f, 0.f, 0.f};
#pragma unroll
                    for (int h = 0; h < 4; ++h) {
                        f32x4 d = __builtin_amdgcn_mfma_f32_16x16x32_bf16(kk[c % 3][s][0], qf[h][0], (f32x4){0.f, 0.f, 0.f, 0.f}, 0, 0, 0);
                        d = __builtin_amdgcn_mfma_f32_16x16x32_bf16(kk[c % 3][s][1], qf[h][1], d, 0, 0, 0);
#pragma unroll
                        for (int r = 0; r < 4; ++r) { const int di = __float_as_int(d[r]); sc[r] = __builtin_fmaf(wv[h], __int_as_float(di > 0 ? di : 0), sc[r]); }
                    }
#pragma unroll
                    for (int r = 0; r < 4; ++r) {
                        const unsigned u = __float_as_uint(sc[r]);
                        unsigned k = u ^ ((unsigned)((int)u >> 31) | 0x80000000u);
                        if (j > jmax || (j == jmax && 4 * g + r > q)) k = 0u;
                        key[i][r] = k;
                        if (k != 0u) { const unsigned bin = k >> 21; __hip_atomic_fetch_add(hist + q * HSTR + (bin >> 1), 1u << (16 * (bin & 1u)), __ATOMIC_RELAXED, __HIP_MEMORY_SCOPE_WORKGROUP); }
                    }
                }
            } else {
#pragma unroll
                for (int s = 0; s < 2; ++s)
#pragma unroll
                    for (int r = 0; r < 4; ++r) key[2 * c + s][r] = 0u;
            }
        }
#undef TK_LOADK
        unsigned prefix = 0u, rnk = (unsigned)TOPK, cnt_eq = 0u;
#pragma unroll
        for (int pass = 0; pass < 3; ++pass) {
            const int shift = (pass == 0) ? 21 : (pass == 1 ? 10 : 0), pshift = (pass == 1) ? 21 : 10; const unsigned bmask = (pass == 2) ? 1023u : 2047u;
            if (pass != 0) {
            TK_BAR();
            if (pass == 1 && wave == 0 && ntq0 >= TOPK) tk_prefetch_q(L, QI, WI, nb, ntq0, lane);
            for (int i = tid; i < 16 * HSTR / 4; i += NWAVES * 64) ((LAS v4u*)hist)[i] = (v4u){0u, 0u, 0u, 0u};
            TK_BAR();
#pragma unroll
            for (int i = 0; i < 32; ++i) {
                if (wave + 8 * i <= jmax) {
#pragma unroll
                    for (int r = 0; r < 4; ++r) {
                        const unsigned k = key[i][r];
                        const bool m = (pass == 0) ? (k != 0u) : ((k >> pshift) == prefix);
                        if (m) { const unsigned bin = (k >> shift) & bmask; __hip_atomic_fetch_add(hist + q * HSTR + (bin >> 1), 1u << (16 * (bin & 1u)), __ATOMIC_RELAXED, __HIP_MEMORY_SCOPE_WORKGROUP); }
                    }
                }
            }
            }
            TK_BAR();
            { const unsigned r0 = (unsigned)__builtin_amdgcn_readlane((int)rnk, 2 * wave), r1 = (unsigned)__builtin_amdgcn_readlane((int)rnk, 2 * wave + 1);
              if (pass < 2) { scan_query<16>(hist + (2 * wave) * HSTR, res, 2 * wave, r0, lane); scan_query<16>(hist + (2 * wave + 1) * HSTR, res, 2 * wave + 1, r1, lane); }
              else { scan_query<8>(hist + (2 * wave) * HSTR, res, 2 * wave, r0, lane); scan_query<8>(hist + (2 * wave + 1) * HSTR, res, 2 * wave + 1, r1, lane); } }
            TK_BAR();
            prefix = (prefix << ((pass == 2) ? 10 : 11)) | res[q]; rnk = res[16 + q]; cnt_eq = res[32 + q];
        }
        const unsigned T = prefix, need = rnk;
        const bool slow = __any(need != cnt_eq);
        if (slow) {
#pragma unroll
            for (int i = 0; i < 32; ++i) {
                if (wave + 8 * i <= jmax) {
                    unsigned c = 0;
#pragma unroll
                    for (int r = 0; r < 4; ++r) c += (key[i][r] == T) ? 1u : 0u;
                    if (c) __hip_atomic_fetch_add(tc_q + 8 * i, c << (8 * g), __ATOMIC_RELAXED, __HIP_MEMORY_SCOPE_WORKGROUP);
                }
            }
            TK_BAR();
#pragma unroll
            for (int s = 0; s < 2; ++s) {
                const int qq = 2 * wave + s; unsigned tt[4], tot = 0;
#pragma unroll
                for (int x = 0; x < 4; ++x) { const unsigned e = tcnt[qq * 256 + lane * 4 + x]; tt[x] = (e & 255u) + ((e >> 8) & 255u) + ((e >> 16) & 255u) + (e >> 24); tot += tt[x]; }
                const unsigned incl = wave_prefix_incl(tot);
                unsigned base = incl - tot;
#pragma unroll
                for (int x = 0; x < 4; ++x) { tbase[qq * 256 + lane * 4 + x] = (unsigned short)base; base += tt[x]; }
            }
            TK_BAR();
        }
#pragma unroll
        for (int i = 0; i < 32; ++i) {
            const int j = wave + 8 * i;
            if (j <= jmax) {
                unsigned nib = 0;
                if (!slow) {
#pragma unroll
                    for (int r = 0; r < 4; ++r) nib |= (key[i][r] >= T && key[i][r] != 0u) ? (1u << r) : 0u;
                } else {
                    const unsigned e = tc_q[8 * i]; unsigned rank = tb_q[8 * i];
                    if (g > 0) rank += e & 255u; if (g > 1) rank += (e >> 8) & 255u; if (g > 2) rank += (e >> 16) & 255u;
#pragma unroll
                    for (int r = 0; r < 4; ++r) { const unsigned k = key[i][r];
                        if (k > T) nib |= 1u << r; else if (k == T && k != 0u) { if (rank < need) nib |= 1u << r; ++rank; } }
                }
                if (nib) __hip_atomic_fetch_or(ms32_q + 4 * i, nib << sh_q, __ATOMIC_RELAXED, __HIP_MEMORY_SCOPE_WORKGROUP);
            }
        }
    }
    TK_BAR();
    for (int idx = tid; idx < 1024; idx += NWAVES * 64) {
        const int qq = idx & 15, t64 = idx >> 4;
        const u64 wd = *(const LAS u64*)(mstg + qq * 256 + t64 * 4);
        MASK[((size_t)b * 64 + t64) * S + tq0 + qq] = wd;
    }
    TK_BAR();
}

__device__ __forceinline__ void gating_block(LAS unsigned char* L, const bf16_t* __restrict__ QO, const float* __restrict__ KMEAN, unsigned* __restrict__ BMASK, int blk64, int tid) {
    using namespace K;
    const int row0 = 64 * blk64, b = row0 / S;
    LAS float* km = (LAS float*)L;
    const int r = tid >> 3, h = tid & 7, row = row0 + r, t = row % S, own = t / MBLK;
    uint4 qraw[8];
#pragma unroll
    for (int x = 0; x < 8; ++x) qraw[x] = *(const uint4*)(QO + (size_t)row * 1024 + 512 + h * 64 + 8 * x);
    for (int i = tid; i < 16 * 8 * 64; i += NWAVES * 64) { const int n = i >> 9, hh = (i >> 6) & 7, d = i & 63; km[(n * 8 + hh) * 68 + d] = KMEAN[((size_t)(b * 16 + n) * 8 + hh) * 64 + d]; }
    TK_BAR();
    float qv[64];
#pragma unroll
    for (int x = 0; x < 8; ++x) { const uint4 u = qraw[x];
        qv[8 * x + 0] = __uint_as_float(u.x << 16); qv[8 * x + 1] = __uint_as_float(u.x & 0xffff0000u); qv[8 * x + 2] = __uint_as_float(u.y << 16); qv[8 * x + 3] = __uint_as_float(u.y & 0xffff0000u);
        qv[8 * x + 4] = __uint_as_float(u.z << 16); qv[8 * x + 5] = __uint_as_float(u.z & 0xffff0000u); qv[8 * x + 6] = __uint_as_float(u.w << 16); qv[8 * x + 7] = __uint_as_float(u.w & 0xffff0000u); }
    float b0 = -INFINITY, b1 = -INFINITY, b2 = -INFINITY; int i0 = -1, i1 = -1, i2 = -1;
    for (int n = 0; n < own; ++n) {
        const LAS f32x4* kp = (const LAS f32x4*)(km + (n * 8 + h) * 68); float gs = 0.f;
#pragma unroll
        for (int d4 = 0; d4 < 16; ++d4) { const f32x4 kv = kp[d4]; gs = __builtin_fmaf(qv[4 * d4], kv[0], gs); gs = __builtin_fmaf(qv[4 * d4 + 1], kv[1], gs); gs = __builtin_fmaf(qv[4 * d4 + 2], kv[2], gs); gs = __builtin_fmaf(qv[4 * d4 + 3], kv[3], gs); }
        if (gs > b0) { b2 = b1; i2 = i1; b1 = b0; i1 = i0; b0 = gs; i0 = n; }
        else if (gs > b1) { b2 = b1; i2 = i1; b1 = gs; i1 = n; }
        else if (gs > b2) { b2 = gs; i2 = n; }
    }
    unsigned bm = 1u << own;
    if (i0 >= 0) bm |= 1u << i0; if (i1 >= 0) bm |= 1u << i1; if (i2 >= 0) bm |= 1u << i2;
    BMASK[(size_t)row * 8 + h] = bm;
    TK_BAR();
}
#undef TK_BAR
}
namespace attn_body {
using bf16=__hip_bfloat16;
using bf16x8=__attribute__((ext_vector_type(8)))short;
using s16x4=__attribute__((ext_vector_type(4)))short;
using f32x16=__attribute__((ext_vector_type(16)))float;
using u32x4=__attribute__((ext_vector_type(4)))unsigned;
constexpr int BATCH=4,NHEAD=16,SEQ=4096,D=64,DM=NHEAD*D;
constexpr int NW=8,QBLK=32,QB=QBLK*NW,KVBLK=64,NQB=SEQ/QB;
constexpr int ATTN_PITCH=DM, ATTN_UNIT_ROWS=QB;
__device__ __forceinline__ int crow(int r,int hi){return (r&3)+8*(r>>2)+4*hi;}
#define SBAR() __builtin_amdgcn_sched_barrier(0)
typedef __attribute__((address_space(3))) const float* lds_fptr;
__device__ __forceinline__ void addbias(f32x16&p0,f32x16&p1,int jb6,int qrel,int hi,lds_fptr bt){
  const lds_fptr b=bt+(qrel+128-64*jb6-4*hi+197);
  #pragma unroll
  for(int r=0;r<16;++r){const int c=(r&3)+8*(r>>2); p0[r]+=b[59-c]; p1[r]+=b[27-c];}
}

constexpr int BT_N=640;
constexpr int NSLOT=3, SLOTB=8192;
#define EXM(p,w) do{ if(MOBA) asm volatile("v_sub_f32 %0, %0, %2\n\tv_exp_f32 %0, %0\n\tv_add_co_u32 %1, vcc, %1, %1\n\tv_cndmask_b32 %0, 0, %0, vcc":"+v"(p),"+v"(w):"v"(mhat):"vcc"); \
  else asm volatile("v_exp_f32 %0, %0\n\tv_add_co_u32 %1, vcc, %1, %1\n\tv_cndmask_b32 %0, 0, %0, vcc":"+v"(p),"+v"(w)::"vcc"); }while(0)
#define EXS(p,mh) asm volatile("v_sub_f32 %0, %0, %1\n\tv_exp_f32 %0, %0\n\ts_nop 0":"+v"(p):"v"(mh))
#define EXM16(P,w) do{ EXM(P[15],w);EXM(P[14],w);EXM(P[13],w);EXM(P[12],w); w<<=4; EXM(P[11],w);EXM(P[10],w);EXM(P[9],w);EXM(P[8],w); w<<=4; EXM(P[7],w);EXM(P[6],w);EXM(P[5],w);EXM(P[4],w); w<<=4; EXM(P[3],w);EXM(P[2],w);EXM(P[1],w);EXM(P[0],w); }while(0)
__device__ __forceinline__ int cbit(int r){return (r&3)+8*(r>>2);}
constexpr int LDS_K=0, LDS_V=NSLOT*SLOTB, LDS_WS=2*NSLOT*SLOTB, LDS_OST=LDS_WS+NW*64*4, LDS_BT=LDS_OST+NW*4096, LDS_BYTES=LDS_BT+BT_N*4;
constexpr float C2=0.125f*1.4426950408889634f;
__device__ __forceinline__ void glds16(const void*gsrc,unsigned lds_dst){unsigned keep;
  asm volatile("s_mov_b32 %0, m0\n\ts_mov_b32 m0, %2\n\ts_nop 0\n\tglobal_load_lds_dwordx4 %1, off\n\ts_mov_b32 m0, %0":"=&s"(keep):"v"(gsrc),"s"(lds_dst):"memory");}
__device__ __forceinline__ float max3f(float a,float b,float c){float r;asm("v_max3_f32 %0, %1, %2, %3":"=v"(r):"v"(a),"v"(b),"v"(c));return r;}
__device__ __forceinline__ float max2f(float a,float b){float r;asm("v_max_f32_e32 %0, %1, %2":"=v"(r):"v"(a),"v"(b));return r;}
__device__ __forceinline__ float fadd_s(float a,float b){float r;asm("v_add_f32_e32 %0, %1, %2":"=v"(r):"v"(a),"v"(b));return r;}
__device__ __forceinline__ float fsub_s(float a,float b){float r;asm("v_sub_f32_e32 %0, %1, %2":"=v"(r):"v"(a),"v"(b));return r;}
typedef float f32x2_t __attribute__((ext_vector_type(2))); typedef __bf16 bf16x2_t __attribute__((ext_vector_type(2)));
__device__ __forceinline__ unsigned cvtpk_s(float lo,float hi){f32x2_t v={lo,hi};bf16x2_t b=__builtin_convertvector(v,bf16x2_t);return __builtin_bit_cast(unsigned,b);}
#define WAIT_BAR(N) asm volatile("s_waitcnt vmcnt(" #N ") lgkmcnt(0)\n\ts_barrier":::"memory")

__device__ __forceinline__ void qkt(f32x16&p0,f32x16&p1,const char*Kslot,const bf16x8*qr,const f32x16&c0,int r32,int hi){
  const char*kb=Kslot+hi*1024+r32*16;
  #pragma unroll
  for(int d0=0;d0<4;++d0){
    const bf16x8 b0=*reinterpret_cast<const bf16x8*>(kb+d0*2048);
    const bf16x8 b1=*reinterpret_cast<const bf16x8*>(kb+d0*2048+512);
    if(d0==0){p0=__builtin_amdgcn_mfma_f32_32x32x16_bf16(b0,qr[0],c0,0,0,0);p1=__builtin_amdgcn_mfma_f32_32x32x16_bf16(b1,qr[0],c0,0,0,0);}
    else{p0=__builtin_amdgcn_mfma_f32_32x32x16_bf16(b0,qr[d0],p0,0,0,0);p1=__builtin_amdgcn_mfma_f32_32x32x16_bf16(b1,qr[d0],p1,0,0,0);}}
}
typedef __attribute__((address_space(3))) const char* lds_cptr;
typedef short v4i16_t __attribute__((ext_vector_type(4)));
__device__ __forceinline__ void kload8(bf16x8*kf,lds_cptr kp){
  kf[0]=*(const __attribute__((address_space(3))) bf16x8*)(kp);      kf[1]=*(const __attribute__((address_space(3))) bf16x8*)(kp+512);
  kf[2]=*(const __attribute__((address_space(3))) bf16x8*)(kp+2048); kf[3]=*(const __attribute__((address_space(3))) bf16x8*)(kp+2560);
  kf[4]=*(const __attribute__((address_space(3))) bf16x8*)(kp+4096); kf[5]=*(const __attribute__((address_space(3))) bf16x8*)(kp+4608);
  kf[6]=*(const __attribute__((address_space(3))) bf16x8*)(kp+6144); kf[7]=*(const __attribute__((address_space(3))) bf16x8*)(kp+6656);
}
__device__ __forceinline__ void kload2(bf16x8*kf,lds_cptr kp,int j){ kf[2*j]=*(const __attribute__((address_space(3))) bf16x8*)(kp+j*2048); kf[2*j+1]=*(const __attribute__((address_space(3))) bf16x8*)(kp+j*2048+512); }
__device__ __forceinline__ s16x4 vtr(lds_cptr p){ return __builtin_bit_cast(s16x4,__builtin_amdgcn_ds_read_tr16_b64_v4i16((__attribute__((address_space(3))) v4i16_t*)p)); }
__device__ __forceinline__ float rowmax(const f32x16&p0,const f32x16&p1){
  float a=max3f(p0[0],p0[1],p1[0]),b=max3f(p0[2],p0[3],p1[1]);a=max3f(a,p1[2],p1[3]);
  #pragma unroll
  for(int r=4;r<16;r+=4){a=max3f(a,p0[r],p0[r+1]);b=max3f(b,p0[r+2],p0[r+3]);a=max3f(a,p1[r],p1[r+1]);b=max3f(b,p1[r+2],p1[r+3]);}
  const float m=max2f(a,b);
  auto rr=__builtin_amdgcn_permlane32_swap(__float_as_uint(m),__float_as_uint(m),false,false);
  return max2f(__uint_as_float(rr[0]),__uint_as_float(rr[1]));
}
__device__ __forceinline__ void pv(f32x16*o,int vb,bf16x8 pa0,bf16x8 pa1,bf16x8 pa2,bf16x8 pa3){
  #pragma unroll
  for(int d0=0;d0<2;++d0){s16x4 lo[4],hi[4];
    #pragma unroll
    for(int ks=0;ks<4;++ks){
      asm volatile("ds_read_b64_tr_b16 %0,%1 offset:%c2":"=&v"(lo[ks]):"v"(vb),"i"(d0*4096+ks*1024):"memory");
      asm volatile("ds_read_b64_tr_b16 %0,%1 offset:%c2":"=&v"(hi[ks]):"v"(vb),"i"(d0*4096+ks*1024+512):"memory");}
    asm volatile("s_waitcnt lgkmcnt(0)":::"memory");SBAR();
    #define PK(k) (bf16x8){lo[k][0],lo[k][1],lo[k][2],lo[k][3],hi[k][0],hi[k][1],hi[k][2],hi[k][3]}
    o[d0]=__builtin_amdgcn_mfma_f32_32x32x16_bf16(pa0,PK(0),o[d0],0,0,0);
    o[d0]=__builtin_amdgcn_mfma_f32_32x32x16_bf16(pa1,PK(1),o[d0],0,0,0);
    o[d0]=__builtin_amdgcn_mfma_f32_32x32x16_bf16(pa2,PK(2),o[d0],0,0,0);
    o[d0]=__builtin_amdgcn_mfma_f32_32x32x16_bf16(pa3,PK(3),o[d0],0,0,0);
    #undef PK
  }
}

#ifndef ATTN_STORE16
#define ATTN_STORE16(p,v) (*(u32x4*)(p)=(v))
#endif
template<int THRL,bool MOBA> __device__ __forceinline__ void attn_unit(int b,int h,int qb,const bf16*Q,const bf16*__restrict__ K,const bf16*__restrict__ V,bf16*O,const unsigned long long*__restrict__ MASKW,const unsigned*__restrict__ BMASK,const float*__restrict__ relb,char*shm){
  const int tid=threadIdx.x,lane=tid&63,r32=lane&31,hi=lane>>5; const int wid=__builtin_amdgcn_readfirstlane(tid>>6);
  const long rowbase=(long)b*SEQ; const int q0=qb*QB;
  const bf16*Qw=Q+(rowbase+q0+wid*QBLK)*DM+h*D;
  const bf16*Kh=K+rowbase*DM+h*D,*Vh=V+rowbase*DM+h*D;
  const unsigned lds0=(unsigned)(uintptr_t)shm;
  float*wsf=(float*)(shm+LDS_WS)+wid*64;
  const bf16*ksrc=Kh+(long)lane*DM+wid*8;
  const bf16*vsrc=Vh+(long)(16*(wid&3)+(lane>>2))*DM+(wid>>2)*32+(lane&3)*8;
  const unsigned kdst=lds0+LDS_K+wid*1024, vdst=lds0+LDS_V+wid*1024;
  #define DMA_K(t,slot) glds16(ksrc+(long)(t)*KVBLK*DM,(unsigned)__builtin_amdgcn_readfirstlane(kdst+(slot)))
  #define DMA_V(t,slot) glds16(vsrc+(long)(t)*KVBLK*DM,(unsigned)__builtin_amdgcn_readfirstlane(vdst+(slot)))
  const int vb0=(int)(lds0+LDS_V)+((lane>>4)&1)*32+(lane&3)*8+(4*hi+((lane&15)>>2))*64;
  const char*Kbase=shm+LDS_K; bf16x8 kf[8];
  const lds_cptr shm3=(lds_cptr)shm; const lds_cptr kp0=shm3+LDS_K+hi*1024+r32*16; const lds_cptr vp0=shm3+LDS_V+((lane>>4)&1)*32+(lane&3)*8+(4*hi+((lane&15)>>2))*64;
  const int NT=(q0+QB)/KVBLK;
  const int qrel=wid*QBLK+r32; constexpr bool moba=MOBA;
  const lds_fptr bt=(lds_fptr)(shm3+LDS_BT);
  unsigned bm=0u;
  const unsigned mvoff=(unsigned)(q0+qrel)*8u; unsigned long long mraw=0ull; unsigned mlo=0u,mhi=0u;
  #define MLOAD(tt) do{ if(!moba&&(tt)<NT){ const unsigned long long*mb_=MASKW+((size_t)(b*64+(tt)))*SEQ; \
      asm volatile("s_nop 4\n\tglobal_load_dwordx2 %0, %1, %2":"=v"(mraw):"v"(mvoff),"s"(mb_):"memory"); } }while(0)
  #define MSET(tt) do{ if(!moba){ asm volatile("":"+v"(mraw)); mlo=(unsigned)mraw<<(4-4*hi); mhi=(unsigned)(mraw>>32)<<(4-4*hi); } \
      else{ unsigned wl=((bm>>((tt)>>2))&1u)?0xffffffffu:0u, wh=wl; const int jb_=(tt)-(NT-4); \
        if(jb_>=0){ const int n=qrel-64*jb_, n2=n-32; wl&=(n<0)?0u:((n>=31)?0xffffffffu:((2u<<n)-1u)); wh&=(n2<0)?0u:((n2>=31)?0xffffffffu:((2u<<n2)-1u)); } \
        mlo=wl<<(4-4*hi); mhi=wh<<(4-4*hi); } }while(0)
  MLOAD(0);
  DMA_K(0,0);DMA_V(0,0);DMA_K(1,SLOTB);
  bf16x8 qr[4];
  #pragma unroll
  for(int d0=0;d0<4;++d0)qr[d0]=*reinterpret_cast<const bf16x8*>(&Qw[(long)r32*DM+d0*16+hi*8]);
  if(moba)bm=BMASK[(size_t)(rowbase+q0+qrel)*8+(h-8)];
  { __attribute__((address_space(3))) float*btw=(__attribute__((address_space(3))) float*)(shm3+LDS_BT); const float b31=relb[31*16+h];
    for(int i=tid;i<BT_N;i+=NW*64){ const int d=i-256; btw[i]=(d>=0&&d<=112)?(relb[t5_bucket(d)*16+h]-b31)*1.4426950408889634f:0.f; } }
  float mhat=0.f,l_reg=0.f;f32x16 o[2];o[0]=f32x16{};o[1]=f32x16{}; f32x16 negm=f32x16{}; if(!MOBA)asm volatile("":"+v"(negm));
  #define CMASK(P0,P1,t) do{int jb_=(t)-(NT-6); if(jb_>=0)addbias(P0,P1,jb_,qrel,hi,bt);}while(0)
  bool resc=false;
  #define START(P0,P1) do{ const float rm=rowmax(P0,P1); resc=false; mhat=rm; \
    if(!MOBA){ _Pragma("unroll") for(int r=0;r<16;++r){P0[r]-=rm;P1[r]-=rm;} _Pragma("unroll") for(int r=0;r<16;++r)negm[r]=-mhat; asm volatile("":"+v"(negm)); } \
    EXM16(P0,mlo); }while(0)
  #define RESC() do{ if(resc){ asm volatile("s_waitcnt lgkmcnt(0)":::"memory"); \
      _Pragma("unroll") for(int d_=0;d_<2;++d_) _Pragma("unroll") for(int r=0;r<16;++r)o[d_][r]*=wsf[crow(r,hi)]; } }while(0)
  f32x16 pA0,pA1,pB0,pB1;
  int sl_prev=0,sl_cur=0,sl_next=SLOTB;
  #define ROT() do{sl_prev=sl_cur;sl_cur=sl_next;sl_next=(sl_next==(NSLOT-1)*SLOTB)?0:sl_next+SLOTB;}while(0)
  DMA_K(2,2*SLOTB);
  WAIT_BAR(3);
  MSET(0); MLOAD(1);
  qkt(pA0,pA1,Kbase,qr,f32x16{},r32,hi);asm volatile("s_nop 15\n\ts_nop 7":"+v"(pA0),"+v"(pA1));CMASK(pA0,pA1,0);
  START(pA0,pA1);
  EXM16(pA1,mhi);
  WAIT_BAR(0);
  MSET(1);
  DMA_K(3,0);DMA_V(1,SLOTB);
  ROT();
  kload8(kf,kp0+sl_cur);
  WAIT_BAR(2);
  s16x4 vlo[8],vhi[8]; u32x4 pw0,pw1,pw2,pw3;
  #define PKW(P,B) cvtpk_s(P[B],P[B+1])
  #define PAF(k) __builtin_bit_cast(bf16x8,pw##k)
  #define VFR(i) (bf16x8){vlo[i][0],vlo[i][1],vlo[i][2],vlo[i][3],vhi[i][0],vhi[i][1],vhi[i][2],vhi[i][3]}
  #define PIN(x) asm volatile("":"+v"(x))
  #define MX3(a,b,c) __builtin_fmaxf(__builtin_fmaxf((a),(b)),(c))
  #define GAPA(MF,A0,A1,A2,A3,W0,W1,PW) do{ MF; sacc+=A0; sacc+=A1; sacc+=A2; sacc+=A3; PIN(sacc); W0; W1; PIN(PW); SBAR(); }while(0)
  #define EX(v) __builtin_amdgcn_exp2f(v)
  #define GAPB(MF,X,B,MW,CH) do{ MF; if(CH){ EXS(X[B+3],mh_); EXS(X[B+2],mh_); EXS(X[B+1],mh_); EXS(X[B],mh_); } else { EXM(X[B+3],MW); EXM(X[B+2],MW); EXM(X[B+1],MW); EXM(X[B],MW); if((B)>0)MW<<=4; } PIN(X); SBAR(); }while(0)
  #define VRD(i) do{ vlo[i]=vtr(vp_+(((i)>>2)*4096+((i)&3)*1024)); vhi[i]=vtr(vp_+(((i)>>2)*4096+((i)&3)*1024+512)); }while(0)
  #define KRD(G,j) do{ if(G){ kload2(kf,kp0+sl_next,j); SBAR(); } }while(0)
  #define STEP(C0,C1,P0,P1,t,GK,GV,GL,CH) do{ SBAR(); \
    const lds_cptr vp_=vp0+sl_prev; \
    VRD(0); SBAR(); float sacc=(P0[0]+P0[1]); \
    GAPA(C0=__builtin_amdgcn_mfma_f32_32x32x16_bf16(kf[0],qr[0],(MOBA?f32x16{}:negm),0,0,0), P0[2],P0[3],P0[4],P0[5],     pw0[0]=PKW(P0,0), pw0[1]=PKW(P0,2), pw0); \
    VRD(4); SBAR(); GAPA(C1=__builtin_amdgcn_mfma_f32_32x32x16_bf16(kf[1],qr[0],(MOBA?f32x16{}:negm),0,0,0), P0[6],P0[7],P0[8],P0[9],     pw0[2]=PKW(P0,4), pw0[3]=PKW(P0,6), pw0); \
    VRD(1); SBAR(); GAPA(C0=__builtin_amdgcn_mfma_f32_32x32x16_bf16(kf[2],qr[1],C0,0,0,0),   P0[10],P0[11],P0[12],P0[13], pw1[0]=PKW(P0,8), pw1[1]=PKW(P0,10), pw1); \
    VRD(5); SBAR(); GAPA(C1=__builtin_amdgcn_mfma_f32_32x32x16_bf16(kf[3],qr[1],C1,0,0,0),   P0[14],P0[15],P1[0],P1[1],   pw1[2]=PKW(P0,12),pw1[3]=PKW(P0,14), pw1); \
    VRD(2); SBAR(); GAPA(C0=__builtin_amdgcn_mfma_f32_32x32x16_bf16(kf[4],qr[2],C0,0,0,0),   P1[2],P1[3],P1[4],P1[5],     pw2[0]=PKW(P1,0), pw2[1]=PKW(P1,2), pw2); \
    VRD(6); SBAR(); GAPA(C1=__builtin_amdgcn_mfma_f32_32x32x16_bf16(kf[5],qr[2],C1,0,0,0),   P1[6],P1[7],P1[8],P1[9],     pw2[2]=PKW(P1,4), pw2[3]=PKW(P1,6), pw2); \
    VRD(3); SBAR(); GAPA(C0=__builtin_amdgcn_mfma_f32_32x32x16_bf16(kf[6],qr[3],C0,0,0,0),   P1[10],P1[11],P1[12],P1[13], pw3[0]=PKW(P1,8), pw3[1]=PKW(P1,10), pw3); \
    VRD(7); SBAR(); GAPA(C1=__builtin_amdgcn_mfma_f32_32x32x16_bf16(kf[7],qr[3],C1,0,0,0),   P1[14],P1[15],0.f,0.f,       pw3[2]=PKW(P1,12),pw3[3]=PKW(P1,14), pw3); \
    l_reg+=sacc; \
    if(GK){DMA_K((t)+3,sl_cur);} if(GV){DMA_V((t)+1,sl_next);} \
    CMASK(C0,C1,t); \
    { float a=MX3(C0[0],C0[1],C1[0]),b=MX3(C0[2],C0[3],C1[1]); a=MX3(a,C1[2],C1[3]); \
      _Pragma("unroll") for(int r=4;r<16;r+=4){a=MX3(a,C0[r],C0[r+1]);b=MX3(b,C0[r+2],C0[r+3]);a=MX3(a,C1[r],C1[r+1]);b=MX3(b,C1[r+2],C1[r+3]);} \
      float rm=__builtin_fmaxf(a,b); { auto rr=__builtin_amdgcn_permlane32_swap(__float_as_uint(rm),__float_as_uint(rm),false,false); rm=__builtin_fmaxf(__uint_as_float(rr[0]),__uint_as_float(rr[1])); } \
      resc=false; \
      if(MOBA)rm-=mhat; \
      if(__builtin_expect(__any(rm>(float)THRL),0)){ const float dl=__builtin_fmaxf(rm,0.f); mhat+=dl; \
        if(!MOBA){ _Pragma("unroll") for(int r=0;r<16;++r){C0[r]-=dl;C1[r]-=dl;} _Pragma("unroll") for(int r=0;r<16;++r)negm[r]=-mhat; asm volatile("":"+v"(negm)); } \
        const float f=__builtin_amdgcn_exp2f(-dl); l_reg*=f; if(hi==0)wsf[r32]=f; resc=true; } } \
    const float mh_=(CH)?((mlo!=0u)?mhat:__builtin_inff()):0.f; (void)mh_; \
    SBAR(); \
    GAPB(o[0]=__builtin_amdgcn_mfma_f32_32x32x16_bf16(PAF(0),VFR(0),o[0],0,0,0), C0,12,mlo,CH); \
    GAPB(o[1]=__builtin_amdgcn_mfma_f32_32x32x16_bf16(PAF(0),VFR(4),o[1],0,0,0), C0,8,mlo,CH); \
    KRD(GL,0); GAPB(o[0]=__builtin_amdgcn_mfma_f32_32x32x16_bf16(PAF(1),VFR(1),o[0],0,0,0), C0,4,mlo,CH); \
    KRD(GL,1); GAPB(o[1]=__builtin_amdgcn_mfma_f32_32x32x16_bf16(PAF(1),VFR(5),o[1],0,0,0), C0,0,mlo,CH); \
    KRD(GL,2); GAPB(o[0]=__builtin_amdgcn_mfma_f32_32x32x16_bf16(PAF(2),VFR(2),o[0],0,0,0), C1,12,mhi,CH); \
    KRD(GL,3); GAPB(o[1]=__builtin_amdgcn_mfma_f32_32x32x16_bf16(PAF(2),VFR(6),o[1],0,0,0), C1,8,mhi,CH); \
    GAPB(o[0]=__builtin_amdgcn_mfma_f32_32x32x16_bf16(PAF(3),VFR(3),o[0],0,0,0), C1,4,mhi,CH); \
    GAPB(o[1]=__builtin_amdgcn_mfma_f32_32x32x16_bf16(PAF(3),VFR(7),o[1],0,0,0), C1,0,mhi,CH); \
    }while(0)
  int t=1;
  #undef CMASK
  #define CMASK(P0,P1,t) do{}while(0)
  for(;t+7<NT;t+=2){
    MLOAD(t+1); STEP(pB0,pB1,pA0,pA1,t,true,true,true,MOBA);     WAIT_BAR(2); RESC(); ROT(); MSET(t+1);
    MLOAD(t+2); STEP(pA0,pA1,pB0,pB1,t+1,true,true,true,MOBA);   WAIT_BAR(2); RESC(); ROT(); MSET(t+2);
  }
  #undef CMASK
  #define CMASK(P0,P1,t) do{int jb_=(t)-(NT-6); if(jb_>=0)addbias(P0,P1,jb_,qrel,hi,bt);}while(0)
  #define ENDW(tt) do{ if((tt)+3<NT){WAIT_BAR(2);} else if((tt)+2<NT){WAIT_BAR(1);} else {WAIT_BAR(0);} }while(0)
  for(;t+1<NT;t+=2){
    MLOAD(t+1); STEP(pB0,pB1,pA0,pA1,t,(t+3<NT),(t+1<NT),(t+1<NT),0);       ENDW(t);   RESC(); ROT(); MSET(t+1);
    MLOAD(t+2); STEP(pA0,pA1,pB0,pB1,t+1,(t+4<NT),(t+2<NT),(t+2<NT),0);     ENDW(t+1); RESC(); ROT(); MSET(t+2);
  }
  STEP(pB0,pB1,pA0,pA1,NT-1,false,false,false,0); RESC();
  { float sacc=pB0[0]+pB0[1]; _Pragma("unroll") for(int r=2;r<16;++r)sacc+=pB0[r]; _Pragma("unroll") for(int r=0;r<16;++r)sacc+=pB1[r]; l_reg+=sacc;
    pw0=(u32x4){PKW(pB0,0),PKW(pB0,2),PKW(pB0,4),PKW(pB0,6)};pw1=(u32x4){PKW(pB0,8),PKW(pB0,10),PKW(pB0,12),PKW(pB0,14)};pw2=(u32x4){PKW(pB1,0),PKW(pB1,2),PKW(pB1,4),PKW(pB1,6)};pw3=(u32x4){PKW(pB1,8),PKW(pB1,10),PKW(pB1,12),PKW(pB1,14)};
    SBAR(); pv(o,vb0+sl_cur,PAF(0),PAF(1),PAF(2),PAF(3)); }
  #undef PKW
  #undef PAF
  #undef VFR
  #undef PIN
  #undef MX3
  #undef GAPA
  #undef GAPB
  #undef EX
  #undef VRD
  #undef KRD
  #undef STEP
  #undef ENDW
  {auto rr=__builtin_amdgcn_permlane32_swap(__float_as_uint(l_reg),__float_as_uint(l_reg),false,false);l_reg=__uint_as_float(rr[0])+__uint_as_float(rr[1]);}
  if(hi==0)wsf[32+r32]=l_reg;asm volatile("s_waitcnt lgkmcnt(0)":::"memory");
  float rli[16];
  #pragma unroll
  for(int r=0;r<16;++r)rli[r]=__builtin_amdgcn_rcpf(wsf[32+crow(r,hi)]);
  bf16*Ow=O+(rowbase+q0+wid*QBLK)*DM+h*D;
  { bf16*stg=(bf16*)(shm+LDS_OST)+wid*2048;
    #pragma unroll
    for(int r=0;r<16;++r){const int orow=crow(r,hi);
      #pragma unroll
      for(int d0=0;d0<2;++d0)stg[orow*64+d0*32+r32]=__float2bfloat16(o[d0][r]*rli[r]);}
    asm volatile("s_waitcnt lgkmcnt(0)":::"memory");
    #pragma unroll
    for(int i=0;i<4;++i){const int row=i*8+(lane>>3),ch=lane&7; const u32x4 v=*(const u32x4*)(stg+row*64+ch*8); ATTN_STORE16(Ow+(long)row*DM+ch*8,v);} }
  asm volatile("s_waitcnt lgkmcnt(0)\n\ts_barrier":::"memory");
  #undef MLOAD
  #undef MSET
  #undef DMA_K
  #undef DMA_V
  #undef CMASK
  #undef START
  #undef RESC
  #undef ROT
}
constexpr int ATTN_LDS_BYTES=LDS_BYTES;
#undef SBAR
#undef WAIT_BAR
}

__device__ __forceinline__ float wave_sum_fast(float v) {
#define WS_DPP_(ctrl, rm, bc) v += __int_as_float(__builtin_amdgcn_update_dpp(0, __float_as_int(v), ctrl, rm, 0xf, bc))
    WS_DPP_(0x111, 0xf, true); WS_DPP_(0x112, 0xf, true); WS_DPP_(0x114, 0xf, true); WS_DPP_(0x118, 0xf, true); WS_DPP_(0x142, 0xa, false); WS_DPP_(0x143, 0xc, false);
#undef WS_DPP_
    return __int_as_float(__builtin_amdgcn_readlane(__float_as_int(v), 63));
}
__device__ __forceinline__ int rowmap(int map, int n) {
    if (map == 1) { const int up = n >= 2816; const int j = up ? n - 2816 : n; return 256 * (j >> 7) + (up ? 128 : 0) + (j & 127); }
    if (map == 2) {
        if (n < 3072) { const int part = n >> 9, cc = n & 511, tl = cc >> 8, wc = (cc & 255) >> 6, d = cc & 63; return 256 * (2 * part + tl) + 128 * (d >> 5) + 32 * wc + (d & 31); }
        if (n < 3328) return 256 * 12 + (n - 3072);
        if (n < 3396) return 256 * 13 + (n - 3328);
        if (n < 5444) return 256 * 14 + (n - 3396);
        return 256 * 13 + 68 + (n - 5444);
    }
    if (map == 3) return 1024 + n;
    return n;
}
__device__ __forceinline__ void conv_item(const float* __restrict__ W, int ldw, int N, int Nw, const float* __restrict__ gain, bf16_t* WT, int ldk, int map, int koff, LAS float* scr, int item, int lane) {
    const int nblk = (Nw + 31) >> 5, kb = item / nblk, nb = item % nblk, k0 = 64 * kb, n0 = 32 * nb;
    const int rr = lane >> 3, c4 = (lane & 7) * 4; const bool inb = (n0 + c4) < N;
    f32x4 v[8];
#pragma unroll
    for (int i = 0; i < 8; ++i) v[i] = inb ? *(const GAS f32x4*)(W + (size_t)(k0 + 8 * i + rr) * ldw + n0 + c4) : (f32x4){0.f, 0.f, 0.f, 0.f};
#pragma unroll
    for (int i = 0; i < 8; ++i) { const int kk = 8 * i + rr; const float gk = gain ? gain[k0 + kk] : 1.0f; LAS float* s = scr + kk * 33 + c4;
        s[0] = v[i][0] * gk; s[1] = v[i][1] * gk; s[2] = v[i][2] * gk; s[3] = v[i][3] * gk; }
    LDS_WAIT(); asm volatile("" ::: "memory");
    const int c = lane & 7;
#pragma unroll
    for (int j = 0; j < 4; ++j) { const int n = (lane >> 3) + 8 * j; const LAS float* s = scr + (8 * c) * 33 + n;
        if (n0 + n < Nw) {
            v4u o; o.x = pk2(s[0 * 33], s[1 * 33]); o.y = pk2(s[2 * 33], s[3 * 33]); o.z = pk2(s[4 * 33], s[5 * 33]); o.w = pk2(s[6 * 33], s[7 * 33]);
            *(GAS v4u*)((unsigned char*)WT + pg8::tiled_b_off(rowmap(map, n0 + n), koff + k0 + 8 * c, ldk >> 6)) = o; } }
    LDS_WAIT(); asm volatile("" ::: "memory");
}

struct Args { const float* in[18]; float* out; unsigned char* ws; int ph_lo, ph_hi, li, pad; };
enum { I_X = 0, I_N1, I_GU1, I_DN1, I_NM, I_WIN, I_BG, I_QNA, I_KNA, I_QNB, I_KNB, I_WBA, I_WBB, I_WO, I_N2, I_GU2, I_DN2, I_RB };

__device__ __forceinline__ void p0_prologue(const Args& args, LAS unsigned char* L, int gw, int NGW, int lane, int gtid, int ngt) {
    using namespace K;
    unsigned char* ws = args.ws;
    LAS float* scr = (LAS float*)(L + RING_OFF + (gw & 7) * 16384);
    constexpr int I0 = 16 * 176, I1 = 44 * 32, I2 = 16 * 176, I3 = 8 * 32, I4 = 8 * 32, I5 = 16 * 32;
    constexpr int NITEMS = 2 * I0 + 2 * I1 + I2 + I3 + I4 + I5;
    for (int it = gw; it < NITEMS; it += NGW) {
        int r = it;
        if (r < I0) { conv_item(args.in[I_GU1], 2 * DFF, 2 * DFF, 2 * DFF, args.in[I_N1], (bf16_t*)(ws + WS::GU1), D, 1, 0, scr, r, lane); continue; } r -= I0;
        if (r < I0) { conv_item(args.in[I_GU2], 2 * DFF, 2 * DFF, 2 * DFF, args.in[I_N2], (bf16_t*)(ws + WS::GU2), D, 1, 0, scr, r, lane); continue; } r -= I0;
        if (r < I1) { conv_item(args.in[I_DN1], D, D, D, nullptr, (bf16_t*)(ws + WS::DN1), DFF, 0, 0, scr, r, lane); continue; } r -= I1;
        if (r < I1) { conv_item(args.in[I_DN2], D, D, D, nullptr, (bf16_t*)(ws + WS::DN2), DFF, 0, 0, scr, r, lane); continue; } r -= I1;
        if (r < I2) { conv_item(args.in[I_WIN], DIN, DIN, 5632, args.in[I_NM], (bf16_t*)(ws + WS::WIN), D, 2, 0, scr, r, lane); continue; } r -= I2;
        if (r < I3) { conv_item(args.in[I_WBA], D, D, D, nullptr, (bf16_t*)(ws + WS::WB), D, 0, 0, scr, r, lane); continue; } r -= I3;
        if (r < I4) { conv_item(args.in[I_WBB], D, D, D, nullptr, (bf16_t*)(ws + WS::WB), D, 0, 512, scr, r, lane); continue; } r -= I4;
        conv_item(args.in[I_WO], D, D, D, nullptr, (bf16_t*)(ws + WS::WO), D, 0, 0, scr, r, lane);
    }
    const float* x = args.in[I_X];
    for (int m0 = 2 * gw; m0 < M; m0 += 2 * NGW) {
        f32x4 v[2][4]; float s[2] = {0.f, 0.f};
#pragma unroll
        for (int rr = 0; rr < 2; ++rr) { const GAS f32x4* xr = (const GAS f32x4*)(x + (size_t)(m0 + rr) * D) + lane;
#pragma unroll
            for (int j = 0; j < 4; ++j) v[rr][j] = xr[64 * j]; }
#pragma unroll
        for (int rr = 0; rr < 2; ++rr) {
#pragma unroll
            for (int j = 0; j < 4; ++j) s[rr] += (v[rr][j][0] * v[rr][j][0] + v[rr][j][1] * v[rr][j][1]) + (v[rr][j][2] * v[rr][j][2] + v[rr][j][3] * v[rr][j][3]);
            s[rr] = wave_sum_fast(s[rr]);
            GAS unsigned long long* o8 = (GAS unsigned long long*)(ws + WS::XB + (size_t)(m0 + rr) * D * 2) + lane;
#pragma unroll
            for (int j = 0; j < 4; ++j) o8[64 * j] = (unsigned long long)pk2(v[rr][j][0], v[rr][j][1]) | ((unsigned long long)pk2(v[rr][j][2], v[rr][j][3]) << 32);
            if (lane < 4) { f32x4 q = {lane == 0 ? s[rr] : 0.f, 0.f, 0.f, 0.f}; *((GAS f32x4*)(ws + WS::SSQ + (size_t)(m0 + rr) * 64) + lane) = q; }
        }
    }
}

__global__ void __launch_bounds__(NWAVES * 64, 2) mega(Args args) {
    extern __shared__ __attribute__((aligned(16))) unsigned char lds[];
    using namespace K;
    LAS unsigned char* L = (LAS unsigned char*)lds;
    volatile LAS unsigned* MISC = (volatile LAS unsigned*)(L + MISC_OFF);
    const int tid = threadIdx.x, lane = tid & 63, wave = __builtin_amdgcn_readfirstlane(tid >> 6);
    const int G = gridDim.x, bx = blockIdx.x; const int vcu = (G % 8 == 0) ? (bx % 8) * (G / 8) + bx / 8 : bx;
    unsigned char* ws = args.ws;
    for (int u = tid; u < (LDS_BYTES - LDSCTL_OFF) / 4; u += NWAVES * 64) ((LAS unsigned*)(L + LDSCTL_OFF))[u] = 0u;
    __syncthreads();
    XcdBarrier bar = xcd_barrier_post((unsigned*)(ws + WS::CTL) + CW_BAR + args.li * XCD_BAR_WORDS, MISC + 8);
    const int lo = args.ph_lo, hi = args.ph_hi;
#define IN(k) (lo <= (k) && (k) < hi)
#define SEAM(k) do { if (IN(k) && IN((k) + 1)) xcd_barrier(bar); } while (0)
    bf16_t* XB = (bf16_t*)(ws + WS::XB); bf16_t* ACT = (bf16_t*)(ws + WS::ACT); float* SSQ = (float*)(ws + WS::SSQ);

    if (IN(0)) { p0_prologue(args, L, vcu * NWAVES + wave, G * NWAVES, lane, bx * (NWAVES * 64) + tid, G * NWAVES * 64); SEAM(0); }
    if (IN(1)) {
        pg8::Gemm g{XB, (const bf16_t*)(ws + WS::GU1), M, 2 * DFF, D, D, 1 << 30, 0}; pg8::StaticOrder S; S.init(M, 2 * DFF, G, bx);
        pg8::EpiGu E{ACT, SSQ, (LAS float*)(L + RTAB_OFF)};
        pg8::gemm_phase<pg8::EpiGu, pg8::StaticOrder, true, true>(L + RING_OFF, g, S, E);
        SEAM(1);
    }
    if (IN(2)) {
        pg8::Gemm g{ACT, (const bf16_t*)(ws + WS::DN1), M, D, DFF, DFF, 1 << 30, 0}; pg8::StaticOrder S; S.init(M, D, G, bx);
        pg8::EpiRes<true, false, true> E{args.in[I_X], nullptr, nullptr, XB, SSQ, 0.5f};
        pg8::gemm_phase<pg8::EpiRes<true, false, true>, pg8::StaticOrder, false, true>(L + RING_OFF, g, S, E);
        SEAM(2);
    }
    if (IN(3)) {
        pg8::Gemm g{XB, (const bf16_t*)(ws + WS::WIN), M, 5632, D, D, 1 << 30, 0}; pg8::StaticOrder S; S.init(M, 5632, G, bx);
        pg8::EpiIn E{(bf16_t*)(ws + WS::QO), (bf16_t*)(ws + WS::KB), (bf16_t*)(ws + WS::VB), (bf16_t*)(ws + WS::GATES), (bf16_t*)(ws + WS::QI), (bf16_t*)(ws + WS::KI), (float*)(ws + WS::WI), (float*)(ws + WS::KMEAN), SSQ,
                     args.in[I_BG], args.in[I_QNA], args.in[I_KNA], args.in[I_QNB], args.in[I_KNB], (LAS float*)(L + RTAB_OFF)};
        pg8::gemm_phase<pg8::EpiIn, pg8::StaticOrder, true, true>(L + RING_OFF, g, S, E);
        SEAM(3);
    }
    if (IN(4)) {
        {
#define TK_POS(it_, bb_, tq_) do { bb_ = (it_) >> 8; const int v_ = (it_) & 255, vv_ = (v_ + 128 * (bb_ >> 1)) & 255; tq_ = 16 * ((bb_ & 1) ? 255 - vv_ : vv_); } while (0)
            int bb = 0, tq = -1;
            if (vcu < 1024) { TK_POS(vcu, bb, tq); if (wave == 0 && tq >= TOPK) tk::tk_prefetch_q(L, (const bf16_t*)(ws + WS::QI), (const float*)(ws + WS::WI), bb, tq, lane); }
            for (int blk = vcu; blk < M / 64; blk += G) tk::gating_block(L, (const bf16_t*)(ws + WS::QO), (const float*)(ws + WS::KMEAN), (unsigned*)(ws + WS::BMASK), blk, tid);
            for (int it = vcu; it < 1024; it += G) {
                int nb = 0, ntq = -1; if (it + G < 1024) TK_POS(it + G, nb, ntq);
                tk::topk_group(L, (const bf16_t*)(ws + WS::QI), (const bf16_t*)(ws + WS::KI), (const float*)(ws + WS::WI), (u64*)args.out, bb, tq, nb, ntq, tid, lane, wave);
                bb = nb; tq = ntq;
            }
#undef TK_POS
        }
        SEAM(4);
    }
    if (IN(5)) {
        static_assert(attn_body::ATTN_LDS_BYTES <= RING_BYTES, "attention LDS vs frame");
        const attn_body::bf16* Qp = (const attn_body::bf16*)(ws + WS::QO); const attn_body::bf16* Kp = (const attn_body::bf16*)(ws + WS::KB); const attn_body::bf16* Vp = (const attn_body::bf16*)(ws + WS::VB);
        for (int p = vcu; p < 512; p += G) {
            const int s = p & 7, bh = (p < 256) ? (p >> 3) : (32 + (((p - 256) >> 3) ^ 8));
            if ((bh & 15) >= 8) { for (int k = 0; k < 2; ++k)
                attn_body::attn_unit<8, true>(bh >> 4, bh & 15, k ? s : 15 - s, Qp, Kp, Vp, (attn_body::bf16*)(ws + WS::QO), (const unsigned long long*)args.out, (const unsigned*)(ws + WS::BMASK), args.in[I_RB], (char*)lds); }
            else { for (int k = 0; k < 2; ++k)
                attn_body::attn_unit<8, false>(bh >> 4, bh & 15, k ? s : 15 - s, Qp, Kp, Vp, (attn_body::bf16*)(ws + WS::QO), (const unsigned long long*)args.out, (const unsigned*)(ws + WS::BMASK), args.in[I_RB], (char*)lds); }
        }
        SEAM(5);
    }
    if (IN(6)) {
        pg8::Gemm g{(const bf16_t*)(ws + WS::QO), (const bf16_t*)(ws + WS::WB), M, D, D, D, 1 << 30, 0}; pg8::StaticOrder S; S.init(M, D, G, bx);
        pg8::EpiBranch2 E{(const bf16_t*)(ws + WS::GATES), (bf16_t*)(ws + WS::GM)};
        pg8::gemm_phase<pg8::EpiBranch2, pg8::StaticOrder, false, true>(L + RING_OFF, g, S, E);
        SEAM(6);
    }
    if (IN(7)) {
        pg8::Gemm g{(const bf16_t*)(ws + WS::GM), (const bf16_t*)(ws + WS::WO), M, D, D, D, 1 << 30, 0}; pg8::StaticOrder S; S.init(M, D, G, bx);
        pg8::EpiRes<false, false, true> E{nullptr, XB, nullptr, XB, SSQ, 1.0f};
        pg8::gemm_phase<pg8::EpiRes<false, false, true>, pg8::StaticOrder, false, true>(L + RING_OFF, g, S, E);
        SEAM(7);
    }
    if (IN(8)) {
        pg8::Gemm g{XB, (const bf16_t*)(ws + WS::GU2), M, 2 * DFF, D, D, 1 << 30, 0}; pg8::StaticOrder S; S.init(M, 2 * DFF, G, bx);
        pg8::EpiGu E{ACT, SSQ, (LAS float*)(L + RTAB_OFF)};
        pg8::gemm_phase<pg8::EpiGu, pg8::StaticOrder, true, true>(L + RING_OFF, g, S, E);
        SEAM(8);
    }
    if (IN(9)) {
        pg8::Gemm g{ACT, (const bf16_t*)(ws + WS::DN2), M, D, DFF, DFF, 1 << 30, 0}; pg8::StaticOrder S; S.init(M, D, G, bx);
        pg8::EpiRes<false, true, false> E{nullptr, XB, args.out, nullptr, nullptr, 0.5f};
        pg8::gemm_phase<pg8::EpiRes<false, true, false>, pg8::StaticOrder, false, true>(L + RING_OFF, g, S, E);
    }
#undef IN
#undef SEAM
}

extern "C" void kernel_launch(void* const* d_in, const int* in_sizes, int n_in, void* d_out, int out_size, void* d_ws, size_t ws_size, hipStream_t stream) {
    using namespace K;
    static int grid = 0;
    if (grid == 0) {
        if (n_in != 18 || in_sizes[0] != M * D || out_size != M * D || ws_size < WS::END) { fprintf(stderr, "kernel_launch: unexpected shapes (n_in %d, in0 %d, out %d, ws %zu)\n", n_in, n_in > 0 ? in_sizes[0] : -1, out_size, ws_size); grid = -1; return; }
        int dev = 0, cus = 0, per_cu = 0;
        if (hipGetDevice(&dev) != hipSuccess || hipDeviceGetAttribute(&cus, hipDeviceAttributeMultiprocessorCount, dev) != hipSuccess) { grid = -1; return; }
        if (hipFuncSetAttribute((const void*)mega, hipFuncAttributeMaxDynamicSharedMemorySize, LDS_BYTES) != hipSuccess) { fprintf(stderr, "kernel_launch: hipFuncSetAttribute failed\n"); grid = -1; return; }
        if (hipOccupancyMaxActiveBlocksPerMultiprocessor(&per_cu, (const void*)mega, NWAVES * 64, LDS_BYTES) != hipSuccess || per_cu < 1) { fprintf(stderr, "kernel_launch: occupancy query says %d blocks/CU\n", per_cu); (void)hipGetLastError(); grid = -1; return; }
        grid = cus;
    }
    if (grid < 0) return;
    const float* const* in = (const float* const*)d_in;
    float* out = (float*)d_out; char* ws = (char*)d_ws;
    (void)hipMemsetAsync(ws + WS::CTL, 0, WS::CTL_ZERO_BYTES, stream);
    Args a{};
    for (int i = 0; i < 18; ++i) a.in[i] = in[i];
    a.out = out; a.ws = (unsigned char*)d_ws; a.pad = 0;
    a.ph_lo = 0; a.ph_hi = 10; a.li = 0;
    hipLaunchKernelGGL(mega, dim3(grid), dim3(NWAVES * 64), LDS_BYTES, stream, a);

}
```

```cpp
#include <hip/hip_runtime.h>
#include <hip/hip_bf16.h>
#include <cstdint>
#include <cstdio>
#include <cmath>

namespace K {
constexpr int B = 4, S = 4096, M = B * S, D = 1024, DFF = 2816, H = 8, HD = 64, NIH = 4, IDIM = 64, TOPK = 256, MBLK = 256, NBLK = 16;
constexpr int DIN = 5444;
constexpr float EPS = 1e-6f;
constexpr float LOG2E = 1.4426950408889634f;
constexpr float C2 = 0.125f * LOG2E;
}
typedef unsigned short bf16_t;
typedef unsigned long long u64;

__device__ __forceinline__ bf16_t f2bf(float f) { unsigned u = __float_as_uint(f); return (bf16_t)((u + 0x7fffu + ((u >> 16) & 1u)) >> 16); }
__device__ __forceinline__ int t5_bucket(int d) {
    if (d < 16) return d;
    int large = 16 + (int)(logf((float)d / 16.0f) / 2.0794415416798357f * 16.0f);
    return large < 31 ? large : 31;
}
namespace pg8 {
#define PG8_LAS __attribute__((address_space(3)))
typedef short bf16x8 __attribute__((ext_vector_type(8)));
typedef float f32x4 __attribute__((ext_vector_type(4)));
typedef unsigned u32x4 __attribute__((ext_vector_type(4)));
constexpr int BM = 256, BK = 64, HALF = 128, HTB = HALF * BK * 2  , STAGE_BYTES = 8 * HTB, NXCD = 8, WGM = 8;

__host__ __device__ __forceinline__ int lds_byte(int r, int c) { const int st = (r >> 4) * 2 + (c >> 5), rr = r & 15, cc = c & 31, ob = rr * 64 + cc * 2; return st * 1024 + (ob ^ (((ob >> 9) & 1) << 5)); }
__host__ __device__ __forceinline__ void stage_rc(int b, int& R, int& C) { const int st = b / 1024, sb = b % 1024, swz = sb ^ (((sb >> 9) & 1) << 5); R = (st >> 1) * 16 + swz / 64; C = (st & 1) * 32 + (swz % 64) / 2; }
__host__ __device__ __forceinline__ int perm32(int rho) { const int n = rho >> 4, i = rho & 15; return 8 * (i >> 2) + 4 * n + (i & 3); }

__host__ __device__ __forceinline__ size_t tiled_b_off(int nrow, int k, int nkt) {
    const int ht = nrow >> 7, rb = nrow & 127, c = rb & 31, rho = ((c >> 2) & 1) * 16 + ((c >> 3) << 2) + (c & 3), R = (rb & ~31) + rho;
    return ((size_t)ht * nkt + (k >> 6)) * (size_t)(HALF * BK * 2) + (size_t)lds_byte(R, k & 63);
}
struct Unit { int pm, pn; };
struct Gemm { const bf16_t* A; const bf16_t* Bt; int M, N, K, lda, asplit_pn, asplit_off; };

struct StaticOrder {
    int nM, nN, nwg, G, c;
    __host__ __device__ void init(int M, int N, int G_, int c_) { nM = M / BM; nN = N / BM; nwg = nM * nN; G = G_; c = c_; }
    __host__ __device__ bool next(int i, Unit& u) const {
        const long L = (long)i * G + c; if (L >= nwg) return false;
        int wgid = (int)L; { const int q = nwg / NXCD, r = nwg % NXCD, xcd = wgid % NXCD, off = wgid / NXCD; wgid = (xcd < r ? xcd * (q + 1) : r * (q + 1) + (xcd - r) * q) + off; }
        const int nig = WGM * nN, gid = wgid / nig, fm = gid * WGM, gsz = (nM - fm) < WGM ? (nM - fm) : WGM;
        u.pm = fm + ((wgid % nig) % gsz); u.pn = (wgid % nig) / gsz; return true;
    }
    __device__ __forceinline__ void a_ready(const Unit&) const {}
    __device__ __forceinline__ void done(const Unit&) const {}
};


typedef float f32x2_t __attribute__((ext_vector_type(2))); typedef __bf16 bf16x2_t __attribute__((ext_vector_type(2)));
__device__ __forceinline__ unsigned cvt_pk_bf16(float lo, float hi) { f32x2_t v = {lo, hi}; bf16x2_t b = __builtin_convertvector(v, bf16x2_t); return __builtin_bit_cast(unsigned, b); }
__device__ __forceinline__ float row_rstd(const float* __restrict__ ssq, int row) {
    const f32x4* p = (const f32x4*)(ssq + (size_t)row * 16);
    const f32x4 a = p[0], b = p[1], c = p[2], d = p[3];
    const float s = (((a[0] + a[1]) + (a[2] + a[3])) + ((b[0] + b[1]) + (b[2] + b[3]))) + (((c[0] + c[1]) + (c[2] + c[3])) + ((d[0] + d[1]) + (d[2] + d[3])));
    return 1.0f / sqrtf(s * (1.0f / 1024.0f) + 1e-6f);
}
__device__ __forceinline__ void rstd_stage(const float* __restrict__ ssq, PG8_LAS float* tab, int pm, int wr, int fr, int fq) {
    const int l = fq * 16 + fr;
    tab[l] = row_rstd(ssq, pm * BM + wr * 64 + l);
    tab[64 + l] = row_rstd(ssq, pm * BM + HALF + wr * 64 + l);
    asm volatile("s_waitcnt lgkmcnt(0)" ::: "memory");
}
__device__ __forceinline__ float xrow_sum4(float v) {
    { auto r = __builtin_amdgcn_permlane16_swap(__float_as_uint(v), __float_as_uint(v), false, false); v = __uint_as_float(r[0]) + __uint_as_float(r[1]); }
    { auto r = __builtin_amdgcn_permlane32_swap(__float_as_uint(v), __float_as_uint(v), false, false); v = __uint_as_float(r[0]) + __uint_as_float(r[1]); }
    return v;
}
__device__ __forceinline__ float silu_f(float g) { return g * __builtin_amdgcn_rcpf(1.0f + __builtin_amdgcn_exp2f(-1.4426950408889634f * g)); }
__device__ __forceinline__ float sigmoid_f(float g) { return __builtin_amdgcn_rcpf(1.0f + __builtin_amdgcn_exp2f(-1.4426950408889634f * g)); }

struct EpiGu {
    static constexpr bool PERM = true, AFTER_DRAIN = false, HAS_MID = false;
    bf16_t* act; const float* ssq; PG8_LAS float* rtab;
    __device__ __forceinline__ void operator()(const f32x4 (&acc)[2][2][4][2], const Unit& u, int wr, int wc, int fr, int fq) const {
        asm volatile("" : "+v"(fr), "+v"(fq));
        const int row0 = u.pm * BM + wr * 64 + fr, col0 = u.pn * 128 + wc * 32 + 8 * fq;
        PG8_LAS float* tab = rtab + (wr * 4 + wc) * 128; rstd_stage(ssq, tab, u.pm, wr, fr, fq);
#pragma unroll
        for (int ai = 0; ai < 2; ++ai)
#pragma unroll
            for (int m = 0; m < 4; ++m) {
                const int row = row0 + ai * HALF + m * 16; const float rs = tab[64 * ai + 16 * m + fr];
                float o[8];
#pragma unroll
                for (int n = 0; n < 2; ++n)
#pragma unroll
                    for (int i = 0; i < 4; ++i) o[n * 4 + i] = silu_f(acc[ai][0][m][n][i] * rs) * (acc[ai][1][m][n][i] * rs);
                u32x4 w; w.x = cvt_pk_bf16(o[0], o[1]); w.y = cvt_pk_bf16(o[2], o[3]); w.z = cvt_pk_bf16(o[4], o[5]); w.w = cvt_pk_bf16(o[6], o[7]);
                *(u32x4*)(act + (size_t)row * 2816 + col0) = w;
            }
    }
};
template <bool RIN32, bool OUT32, bool STATS> struct EpiRes {
    static constexpr bool PERM = true, AFTER_DRAIN = false, HAS_MID = false;
    const float* hin32; const bf16_t* hin16; float* hout; bf16_t* hb; float* ssq; float scale;
    __device__ __forceinline__ void operator()(const f32x4 (&acc)[2][2][4][2], const Unit& u, int wr, int wc, int fr, int fq) const {
        asm volatile("" : "+v"(fr), "+v"(fq));
        const int row0 = u.pm * BM + wr * 64 + fr, col0 = u.pn * BM + wc * 32 + 8 * fq;
#pragma unroll
        for (int ai = 0; ai < 2; ++ai)
#pragma unroll
            for (int m = 0; m < 4; ++m) {
                const int row = row0 + ai * HALF + m * 16; float ss = 0.f;
#pragma unroll
                for (int bj = 0; bj < 2; ++bj) {
                    const size_t off = (size_t)row * 1024 + col0 + bj * HALF;
                    f32x4 r0, r1;
                    if (RIN32) { r0 = *(const f32x4*)(hin32 + off); r1 = *(const f32x4*)(hin32 + off + 4); }
                    else { const u32x4 rw = *(const u32x4*)(hin16 + off);
                        r0 = (f32x4){__uint_as_float(rw.x << 16), __uint_as_float(rw.x & 0xffff0000u), __uint_as_float(rw.y << 16), __uint_as_float(rw.y & 0xffff0000u)};
                        r1 = (f32x4){__uint_as_float(rw.z << 16), __uint_as_float(rw.z & 0xffff0000u), __uint_as_float(rw.w << 16), __uint_as_float(rw.w & 0xffff0000u)}; }
                    const f32x4 v0 = r0 + acc[ai][bj][m][0] * scale, v1 = r1 + acc[ai][bj][m][1] * scale;
                    if (OUT32) { *(f32x4*)(hout + off) = v0; *(f32x4*)(hout + off + 4) = v1; }
                    if (STATS) {
                        u32x4 w; w.x = cvt_pk_bf16(v0[0], v0[1]); w.y = cvt_pk_bf16(v0[2], v0[3]); w.z = cvt_pk_bf16(v1[0], v1[1]); w.w = cvt_pk_bf16(v1[2], v1[3]);
                        *(u32x4*)(hb + off) = w;
                        ss += (v0[0] * v0[0] + v0[1] * v0[1]) + (v0[2] * v0[2] + v0[3] * v0[3]) + (v1[0] * v1[0] + v1[1] * v1[1]) + (v1[2] * v1[2] + v1[3] * v1[3]);
                    }
                }
                if (STATS) { ss = xrow_sum4(ss); if (fq == 0) ssq[(size_t)row * 16 + u.pn * 4 + wc] = ss; }
            }
    }
};
struct EpiIn {
    static constexpr bool PERM = true, AFTER_DRAIN = false, HAS_MID = false;
    bf16_t *QO, *KB, *VB, *GATES, *QI, *KI; float* WI; float* KMEAN; const float* ssq; const float* bgate; const float *qn_a, *kn_a, *qn_b, *kn_b; PG8_LAS float* rtab;
    template <int KIND, bool MOBA> __device__ __forceinline__ void qkv(const f32x4 (&acc)[2][2][4][2], const Unit& u, int wr, int wc, int fr, int fq, PG8_LAS float* tab, bf16_t* base, const float* gn) const {
        const int row0 = u.pm * BM + wr * 64 + fr, head = 4 * (u.pn & 1) + wc;
        bf16_t* dst = base + (MOBA ? 512 : 0) + head * 64 + 8 * fq;
        f32x4 gv[2][2];
#pragma unroll
        for (int bj = 0; bj < 2; ++bj)
#pragma unroll
            for (int n = 0; n < 2; ++n) gv[bj][n] = (KIND < 2) ? *(const f32x4*)(gn + 32 * bj + 8 * fq + 4 * n) : (f32x4){1.f, 1.f, 1.f, 1.f};
        constexpr bool km = (KIND == 1) && MOBA;
        f32x4 ks[2][2];
#pragma unroll
        for (int bj = 0; bj < 2; ++bj)
#pragma unroll
            for (int n = 0; n < 2; ++n) ks[bj][n] = (f32x4){0.f, 0.f, 0.f, 0.f};
#pragma unroll
        for (int ai = 0; ai < 2; ++ai)
#pragma unroll
            for (int m = 0; m < 4; ++m) {
                const int row = row0 + ai * HALF + m * 16; const float rs = tab[64 * ai + 16 * m + fr];
                f32x4 v[2][2]; float ss = 0.f;
#pragma unroll
                for (int bj = 0; bj < 2; ++bj)
#pragma unroll
                    for (int n = 0; n < 2; ++n) { v[bj][n] = acc[ai][bj][m][n] * rs; ss += (v[bj][n][0] * v[bj][n][0] + v[bj][n][1] * v[bj][n][1]) + (v[bj][n][2] * v[bj][n][2] + v[bj][n][3] * v[bj][n][3]); }
                if (KIND < 2) {
                    ss = xrow_sum4(ss);
                    float r = 1.0f / sqrtf(ss * (1.0f / 64.0f) + 1e-6f); if (KIND == 0) r *= K::C2;
#pragma unroll
                    for (int bj = 0; bj < 2; ++bj)
#pragma unroll
                        for (int n = 0; n < 2; ++n) v[bj][n] = v[bj][n] * gv[bj][n] * r;
                }
#pragma unroll
                for (int bj = 0; bj < 2; ++bj) {
                    u32x4 w; w.x = cvt_pk_bf16(v[bj][0][0], v[bj][0][1]); w.y = cvt_pk_bf16(v[bj][0][2], v[bj][0][3]); w.z = cvt_pk_bf16(v[bj][1][0], v[bj][1][1]); w.w = cvt_pk_bf16(v[bj][1][2], v[bj][1][3]);
                    *(u32x4*)(dst + (size_t)row * 1024 + 32 * bj) = w;
                    if (km) { ks[bj][0] += v[bj][0]; ks[bj][1] += v[bj][1]; }
                }
                if (km) asm volatile("" : "+v"(ks[0][0]), "+v"(ks[0][1]), "+v"(ks[1][0]), "+v"(ks[1][1]));
                asm volatile("" ::: "memory");
            }
        if (km) {
            float* kd = KMEAN + ((size_t)u.pm * 8 + head) * 64 + 8 * fq;
#pragma unroll
            for (int bj = 0; bj < 2; ++bj)
#pragma unroll
                for (int n = 0; n < 2; ++n)
#pragma unroll
                    for (int i = 0; i < 4; ++i) { float s = ks[bj][n][i]; s += __shfl_xor(s, 1); s += __shfl_xor(s, 2); s += __shfl_xor(s, 4); s += __shfl_xor(s, 8);
                        if (fr == 0) atomicAdd(kd + 32 * bj + 4 * n + i, s); }
        }
    }
    __device__ __forceinline__ void operator()(const f32x4 (&acc)[2][2][4][2], const Unit& u, int wr, int wc, int fr, int fq) const {
        asm volatile("" : "+v"(fr), "+v"(fq));
        const int pn = u.pn, row0 = u.pm * BM + wr * 64 + fr;
        PG8_LAS float* tab = rtab + (wr * 4 + wc) * 128; rstd_stage(ssq, tab, u.pm, wr, fr, fq);
        if (pn < 2) qkv<0, false>(acc, u, wr, wc, fr, fq, tab, QO, qn_a);
        else if (pn < 4) qkv<1, false>(acc, u, wr, wc, fr, fq, tab, KB, kn_a);
        else if (pn < 6) qkv<2, false>(acc, u, wr, wc, fr, fq, tab, VB, nullptr);
        else if (pn < 8) qkv<0, true>(acc, u, wr, wc, fr, fq, tab, QO, qn_b);
        else if (pn < 10) qkv<1, true>(acc, u, wr, wc, fr, fq, tab, KB, kn_b);
        else if (pn < 12) qkv<2, true>(acc, u, wr, wc, fr, fq, tab, VB, nullptr);
        else if (pn == 12) {
#pragma unroll
            for (int ai = 0; ai < 2; ++ai)
#pragma unroll
                for (int m = 0; m < 4; ++m) { const int row = row0 + ai * HALF + m * 16; const float rs = tab[64 * ai + 16 * m + fr];
#pragma unroll
                    for (int bj = 0; bj < 2; ++bj) { const f32x4 a = acc[ai][bj][m][0] * rs, b = acc[ai][bj][m][1] * rs;
                        u32x4 w; w.x = cvt_pk_bf16(a[0], a[1]); w.y = cvt_pk_bf16(a[2], a[3]); w.z = cvt_pk_bf16(b[0], b[1]); w.w = cvt_pk_bf16(b[2], b[3]);
                        *(u32x4*)(QI + (size_t)row * 256 + 128 * bj + 32 * wc + 8 * fq) = w; } }
        } else if (pn == 13) {
#pragma unroll
            for (int ai = 0; ai < 2; ++ai)
#pragma unroll
                for (int m = 0; m < 4; ++m) { const int row = row0 + ai * HALF + m * 16; const float rs = tab[64 * ai + 16 * m + fr];
                    const f32x4 a = acc[ai][0][m][0] * rs, b = acc[ai][0][m][1] * rs;
                    if (wc < 2) { u32x4 w; w.x = cvt_pk_bf16(a[0], a[1]); w.y = cvt_pk_bf16(a[2], a[3]); w.z = cvt_pk_bf16(b[0], b[1]); w.w = cvt_pk_bf16(b[2], b[3]);
                        *(u32x4*)(KI + (size_t)row * 64 + 32 * wc + 8 * fq) = w; }
                    else if (wc == 2 && fq == 0) *(f32x4*)(WI + (size_t)row * 4) = a * 0.5f; }
        } else {
            const int cg0 = 256 * (pn - 14) + 32 * wc + 8 * fq;
            f32x4 bv[2][2];
#pragma unroll
            for (int bj = 0; bj < 2; ++bj)
#pragma unroll
                for (int n = 0; n < 2; ++n) bv[bj][n] = *(const f32x4*)(bgate + cg0 + 128 * bj + 4 * n);
#pragma unroll
            for (int ai = 0; ai < 2; ++ai)
#pragma unroll
                for (int m = 0; m < 4; ++m) { const int row = row0 + ai * HALF + m * 16; const float rs = tab[64 * ai + 16 * m + fr];
#pragma unroll
                    for (int bj = 0; bj < 2; ++bj) { const f32x4 a = acc[ai][bj][m][0] * rs + bv[bj][0], b = acc[ai][bj][m][1] * rs + bv[bj][1];
                        u32x4 w; w.x = cvt_pk_bf16(sigmoid_f(a[0]), sigmoid_f(a[1])); w.y = cvt_pk_bf16(sigmoid_f(a[2]), sigmoid_f(a[3])); w.z = cvt_pk_bf16(sigmoid_f(b[0]), sigmoid_f(b[1])); w.w = cvt_pk_bf16(sigmoid_f(b[2]), sigmoid_f(b[3]));
                        *(u32x4*)(GATES + (size_t)row * 2048 + cg0 + 128 * bj) = w; } }
        }
    }
};
struct EpiBranch2 {
    static constexpr bool PERM = true, AFTER_DRAIN = false, HAS_MID = true;
    const bf16_t* gates; bf16_t* mx;
    __device__ __forceinline__ void mid(f32x4 (&acc)[2][2][4][2], const Unit& u, int wr, int wc, int fr, int fq) const {
        asm volatile("" : "+v"(fr), "+v"(fq));
        const int row0 = u.pm * BM + wr * 64 + fr, col0 = u.pn * BM + wc * 32 + 8 * fq;
#pragma unroll
        for (int ai = 0; ai < 2; ++ai)
#pragma unroll
            for (int m = 0; m < 4; ++m) {
                const int row = row0 + ai * HALF + m * 16;
#pragma unroll
                for (int bj = 0; bj < 2; ++bj) {
                    const size_t off = (size_t)row * 2048 + col0 + bj * HALF;
                    const u32x4 ga = *(const u32x4*)(gates + off), gb = *(const u32x4*)(gates + off + 1024);
                    float r[8];
#pragma unroll
                    for (int x = 0; x < 4; ++x) {
                        r[2 * x] = __uint_as_float(ga[x] << 16) * __builtin_amdgcn_rcpf(__builtin_fmaxf(__uint_as_float(gb[x] << 16), 1e-30f));
                        r[2 * x + 1] = __uint_as_float(ga[x] & 0xffff0000u) * __builtin_amdgcn_rcpf(__builtin_fmaxf(__uint_as_float(gb[x] & 0xffff0000u), 1e-30f)); }
                    acc[ai][bj][m][0] = acc[ai][bj][m][0] * (f32x4){r[0], r[1], r[2], r[3]};
                    acc[ai][bj][m][1] = acc[ai][bj][m][1] * (f32x4){r[4], r[5], r[6], r[7]};
                }
                asm volatile("" ::: "memory");
            }
    }
    __device__ __forceinline__ void operator()(const f32x4 (&acc)[2][2][4][2], const Unit& u, int wr, int wc, int fr, int fq) const {
        asm volatile("" : "+v"(fr), "+v"(fq));
        const int row0 = u.pm * BM + wr * 64 + fr, col0 = u.pn * BM + wc * 32 + 8 * fq;
#pragma unroll
        for (int ai = 0; ai < 2; ++ai)
#pragma unroll
            for (int m = 0; m < 4; ++m) {
                const int row = row0 + ai * HALF + m * 16;
#pragma unroll
                for (int bj = 0; bj < 2; ++bj) {
                    const u32x4 gw = *(const u32x4*)(gates + (size_t)row * 2048 + 1024 + col0 + bj * HALF);
                    const f32x4 a = acc[ai][bj][m][0], b = acc[ai][bj][m][1];
                    u32x4 w;
                    w.x = cvt_pk_bf16(a[0] * __builtin_fmaxf(__uint_as_float(gw.x << 16), 1e-30f), a[1] * __builtin_fmaxf(__uint_as_float(gw.x & 0xffff0000u), 1e-30f));
                    w.y = cvt_pk_bf16(a[2] * __builtin_fmaxf(__uint_as_float(gw.y << 16), 1e-30f), a[3] * __builtin_fmaxf(__uint_as_float(gw.y & 0xffff0000u), 1e-30f));
                    w.z = cvt_pk_bf16(b[0] * __builtin_fmaxf(__uint_as_float(gw.z << 16), 1e-30f), b[1] * __builtin_fmaxf(__uint_as_float(gw.z & 0xffff0000u), 1e-30f));
                    w.w = cvt_pk_bf16(b[2] * __builtin_fmaxf(__uint_as_float(gw.w << 16), 1e-30f), b[3] * __builtin_fmaxf(__uint_as_float(gw.w & 0xffff0000u), 1e-30f));
                    *(u32x4*)(mx + (size_t)row * 1024 + col0 + bj * HALF) = w;
                }
                asm volatile("" ::: "memory");
            }
    }
};
template <class Epi, class Sched, bool ALIGN_EPI = false, bool SP2 = false>
__device__ __forceinline__ void gemm_phase(PG8_LAS unsigned char* lds, const Gemm g, const Sched& S, const Epi& E) {
    const int tid = threadIdx.x, wid = __builtin_amdgcn_readfirstlane(tid >> 6), lane = tid & 63, wr = wid >> 2, wc = wid & 3, fr = lane & 15, fq = lane >> 4;
    const int K = g.K, nt = K / BK;
    unsigned voffA[2], voffB[2];
#pragma unroll
    for (int i = 0; i < 2; ++i) { int R, C; stage_rc(tid * 16 + i * 8192, R, C); const int Rb = Epi::PERM ? ((R & ~31) + perm32(R & 31)) : R;
        voffA[i] = (unsigned)(R * g.lda + C) * 2u; voffB[i] = (unsigned)(tid * 16 + i * 8192); (void)Rb; }
    const size_t kstep = (size_t)(BK * 2), kstepB = (size_t)HTB;
    const size_t hstepA = (size_t)HALF * g.lda * 2, hstepB = (size_t)nt * kstepB;
    const size_t tstepA = 2 * hstepA, tstepB = 2 * hstepB;
#define PG8_ABASE(u_) ((const char*)g.A + (size_t)(u_).pm * tstepA + (((u_).pn >= g.asplit_pn) ? (size_t)g.asplit_off : (size_t)0))
    const unsigned ldsw = (unsigned)wid * 1024u;
    const int aoff = lds_byte(wr * 64 + fr, fq * 8), boff = lds_byte(wc * 32 + fr, fq * 8);
#define PG8_SA(b, h) (((b) * 2 + (h)) * HTB)
#define PG8_SB(b, h) ((4 + (b) * 2 + (h)) * HTB)
#define PG8_STAGE(bufoff, gbase, voff) do { _Pragma("unroll") for (int _i = 0; _i < 2; ++_i) \
        __builtin_amdgcn_global_load_lds((const unsigned*)((const char*)(gbase) + (voff)[_i]), (PG8_LAS unsigned*)(lds + (bufoff) + ldsw + _i * 8192), 16, 0, 0); } while (0)
#define PG8_LDA(dst, b, h) do { _Pragma("unroll") for (int m = 0; m < 4; ++m) _Pragma("unroll") for (int k = 0; k < 2; ++k) dst[m][k] = *(const PG8_LAS bf16x8*)(lds + PG8_SA(b, h) + aoff + m * 2048 + k * 1024); } while (0)
#define PG8_LDB(dst, b, h) do { _Pragma("unroll") for (int n = 0; n < 2; ++n) _Pragma("unroll") for (int k = 0; k < 2; ++k) dst[n][k] = *(const PG8_LAS bf16x8*)(lds + PG8_SB(b, h) + boff + n * 2048 + k * 1024); } while (0)
#define PG8_MMA(ai, bj, At, Bt) do { __builtin_amdgcn_s_setprio(1); _Pragma("unroll") for (int m = 0; m < 4; ++m) _Pragma("unroll") for (int n = 0; n < 2; ++n) _Pragma("unroll") for (int k = 0; k < 2; ++k) \
        acc[ai][bj][m][n] = __builtin_amdgcn_mfma_f32_16x16x32_bf16(Bt[n][k], At[m][k], acc[ai][bj][m][n], 0, 0, 0); __builtin_amdgcn_s_setprio(0); } while (0)
#define PG8_WAIT_V(n) asm volatile("s_waitcnt vmcnt(" #n ")" ::: "memory")
#define PG8_WAIT_L(n) asm volatile("s_waitcnt lgkmcnt(" #n ")" ::: "memory")
#define PG8_BAR __builtin_amdgcn_s_barrier()
#define PG8_SCHED __builtin_amdgcn_sched_barrier(0)
    Unit cur, nxt; int ui = 0;
    if (!S.next(0, cur)) return;
    f32x4 acc[2][2][4][2];
#pragma unroll
    for (int a = 0; a < 2; ++a)
#pragma unroll
        for (int b = 0; b < 2; ++b)
#pragma unroll
            for (int m = 0; m < 4; ++m)
#pragma unroll
                for (int n = 0; n < 2; ++n) acc[a][b][m][n] = (f32x4){0.f, 0.f, 0.f, 0.f};
    bf16x8 At[4][2], B0[2][2], B1[2][2];
    const char* cA = PG8_ABASE(cur); const char* cB = (const char*)g.Bt + (size_t)cur.pn * tstepB;
    S.a_ready(cur);
    if constexpr (SP2) {
        PG8_STAGE(PG8_SB(0, 0), cB, voffB); PG8_STAGE(PG8_SB(0, 1), cB + hstepB, voffB); PG8_STAGE(PG8_SA(0, 0), cA, voffA); PG8_STAGE(PG8_SA(0, 1), cA + hstepA, voffA);
        PG8_STAGE(PG8_SB(1, 0), cB + kstepB, voffB); PG8_STAGE(PG8_SA(1, 0), cA + kstep, voffA); PG8_STAGE(PG8_SB(1, 1), cB + hstepB + kstepB, voffB);
        if (wr == 1) PG8_BAR;
        PG8_WAIT_V(8); PG8_BAR;
        PG8_WAIT_V(6); PG8_BAR;
    } else {
        PG8_STAGE(PG8_SB(0, 0), cB, voffB); PG8_STAGE(PG8_SA(0, 0), cA, voffA); PG8_STAGE(PG8_SB(0, 1), cB + hstepB, voffB); PG8_STAGE(PG8_SA(0, 1), cA + hstepA, voffA);
        if (wr == 1) PG8_BAR;
        PG8_WAIT_V(4); PG8_BAR;
        PG8_STAGE(PG8_SB(1, 0), cB + kstepB, voffB); PG8_STAGE(PG8_SA(1, 0), cA + kstep, voffA); PG8_STAGE(PG8_SB(1, 1), cB + hstepB + kstepB, voffB);
        PG8_WAIT_V(6); PG8_BAR;
    }
    for (;;) {
        const bool has_next = S.next(ui + 1, nxt);
        const char* nA = has_next ? PG8_ABASE(nxt) : cA; const char* nB = has_next ? (const char*)g.Bt + (size_t)nxt.pn * tstepB : cB;
        for (int t = 0; t < nt; t += 2) {
            const bool last = (t == nt - 2);
            const char* a1 = cA + (size_t)(t + 1) * kstep;
            const char* a2 = last ? nA : cA + (size_t)(t + 2) * kstep; const char* b2 = last ? nB : cB + (size_t)(t + 2) * kstepB;
            const char* a3 = a2 + kstep; const char* b3 = b2 + kstepB;
            if (last && has_next) S.a_ready(nxt);
            if constexpr (SP2) {
            PG8_LDB(B0, 0, 0); PG8_LDB(B1, 0, 1); PG8_SCHED; PG8_LDA(At, 0, 0); PG8_STAGE(PG8_SA(1, 1), a1 + hstepA, voffA);
            PG8_WAIT_V(8); PG8_WAIT_L(0); PG8_BAR; PG8_MMA(0, 0, At, B0); PG8_MMA(0, 1, At, B1); PG8_BAR; PG8_SCHED;
            PG8_LDA(At, 0, 1); PG8_STAGE(PG8_SB(0, 0), b2, voffB); PG8_STAGE(PG8_SB(0, 1), b2 + hstepB, voffB); PG8_STAGE(PG8_SA(0, 0), a2, voffA);
            PG8_WAIT_V(8); PG8_WAIT_L(0); PG8_BAR; PG8_MMA(1, 0, At, B0); PG8_MMA(1, 1, At, B1); PG8_BAR; PG8_SCHED;
            PG8_LDB(B0, 1, 0); PG8_LDB(B1, 1, 1); PG8_SCHED; PG8_LDA(At, 1, 0); PG8_STAGE(PG8_SA(0, 1), a2 + hstepA, voffA);
            PG8_WAIT_V(8); PG8_WAIT_L(0); PG8_BAR; PG8_MMA(0, 0, At, B0); PG8_MMA(0, 1, At, B1); PG8_BAR; PG8_SCHED;
            PG8_LDA(At, 1, 1); PG8_STAGE(PG8_SB(1, 0), b3, voffB); PG8_STAGE(PG8_SB(1, 1), b3 + hstepB, voffB); PG8_STAGE(PG8_SA(1, 0), a3, voffA);
            PG8_WAIT_V(8); PG8_WAIT_L(0); PG8_BAR; PG8_MMA(1, 0, At, B0); PG8_MMA(1, 1, At, B1); PG8_BAR; PG8_SCHED;
            } else {
            PG8_LDB(B0, 0, 0); PG8_SCHED; PG8_LDA(At, 0, 0); PG8_STAGE(PG8_SA(1, 1), a1 + hstepA, voffA);
            PG8_WAIT_L(8); PG8_BAR; PG8_WAIT_L(0); PG8_MMA(0, 0, At, B0); PG8_BAR; PG8_SCHED;
            PG8_LDB(B1, 0, 1); PG8_STAGE(PG8_SB(0, 0), b2, voffB);
            PG8_BAR; PG8_WAIT_L(0); PG8_MMA(0, 1, At, B1); PG8_BAR;
            PG8_LDA(At, 0, 1); PG8_STAGE(PG8_SA(0, 0), a2, voffA);
            PG8_BAR; PG8_WAIT_L(0); PG8_MMA(1, 0, At, B0); PG8_BAR; PG8_SCHED;
            PG8_STAGE(PG8_SB(0, 1), b2 + hstepB, voffB);
            PG8_WAIT_V(6); PG8_BAR; PG8_MMA(1, 1, At, B1); PG8_BAR;
            PG8_LDB(B0, 1, 0); PG8_SCHED; PG8_LDA(At, 1, 0); PG8_STAGE(PG8_SA(0, 1), a2 + hstepA, voffA);
            PG8_WAIT_L(8); PG8_BAR; PG8_WAIT_L(0); PG8_MMA(0, 0, At, B0); PG8_BAR; PG8_SCHED;
            PG8_LDB(B1, 1, 1); PG8_STAGE(PG8_SB(1, 0), b3, voffB);
            PG8_BAR; PG8_WAIT_L(0); PG8_MMA(0, 1, At, B1); PG8_BAR;
            PG8_LDA(At, 1, 1); PG8_STAGE(PG8_SA(1, 0), a3, voffA);
            PG8_BAR; PG8_WAIT_L(0); PG8_MMA(1, 0, At, B0); PG8_BAR; PG8_SCHED;
            PG8_STAGE(PG8_SB(1, 1), b3 + hstepB, voffB);
            PG8_WAIT_V(6); PG8_BAR; PG8_MMA(1, 1, At, B1); PG8_BAR;
            }
            if constexpr (Epi::HAS_MID) { if (t + 2 == nt / 2) E.mid(acc, cur, wr, wc, fr, fq); }
        }
        if constexpr (ALIGN_EPI) { if (wr == 0) PG8_BAR; }
        if constexpr (!Epi::AFTER_DRAIN) { E(acc, cur, wr, wc, fr, fq); S.done(cur); }
        if (!has_next) break;
#pragma unroll
        for (int a = 0; a < 2; ++a)
#pragma unroll
            for (int b = 0; b < 2; ++b)
#pragma unroll
                for (int m = 0; m < 4; ++m)
#pragma unroll
                    for (int n = 0; n < 2; ++n) acc[a][b][m][n] = (f32x4){0.f, 0.f, 0.f, 0.f};
        cur = nxt; cA = nA; cB = nB; ++ui;
        if constexpr (ALIGN_EPI) { if (wr == 1) PG8_BAR; }
    }
    PG8_WAIT_V(0);
    if constexpr (!ALIGN_EPI) { if (wr == 0) PG8_BAR; }
    PG8_BAR;
    if constexpr (Epi::AFTER_DRAIN) { E.fused(acc, cur, wr, wc, fr, fq, lds, wid, lane); S.done(cur); }
#undef PG8_ABASE
#undef PG8_SA
#undef PG8_SB
#undef PG8_STAGE
#undef PG8_LDA
#undef PG8_LDB
#undef PG8_MMA
#undef PG8_WAIT_V
#undef PG8_WAIT_L
#undef PG8_BAR
#undef PG8_SCHED
}
}

constexpr int NWAVES = 8;
namespace WS {
constexpr size_t MiB = 1u << 20;
constexpr size_t CTL = 0, CTL_ZERO_BYTES = 1 * MiB;
constexpr size_t KMEAN = 512 * 1024;
constexpr size_t SSQ = 1 * MiB;
constexpr size_t GU1 = 2 * MiB, DN1 = 13 * MiB, WIN = 19 * MiB, WB = 30 * MiB, WO = 32 * MiB, GU2 = 36 * MiB, DN2 = 47 * MiB;
constexpr size_t XB = 53 * MiB;
constexpr size_t QO = 85 * MiB, KB = 117 * MiB, VB = 149 * MiB;
constexpr size_t GATES = 181 * MiB;
constexpr size_t QI = 245 * MiB, KI = 253 * MiB, WI = 255 * MiB, BMASK = 255 * MiB + 256 * 1024;
constexpr size_t ACT = 85 * MiB;
constexpr size_t GM = 117 * MiB;
constexpr size_t END = 256 * MiB;
}
constexpr int CW_BAR = 4096;
constexpr int RING_OFF = 0, RING_BYTES = 131072;
constexpr int LDSCTL_OFF = RING_BYTES, MISC_OFF = LDSCTL_OFF + 320;
constexpr int RTAB_OFF = LDSCTL_OFF + 1024;
constexpr int LDS_BYTES = 147456;

#define GAS __attribute__((address_space(1)))
#define LAS __attribute__((address_space(3)))
typedef unsigned v4u __attribute__((ext_vector_type(4)));
typedef float f32x4 __attribute__((ext_vector_type(4)));
typedef GAS unsigned gu32;
#define LDS_WAIT() asm volatile("s_waitcnt lgkmcnt(0)" ::: "memory")
#define VM_WAIT() asm volatile("s_waitcnt vmcnt(0)" ::: "memory")
__device__ __forceinline__ unsigned pk2(float lo, float hi) { return (unsigned)f2bf(lo) | ((unsigned)f2bf(hi) << 16); }
#define XB_TMO      128
#define XB_XCNT(j)  (256  + 64 * (j))
#define XB_XSUB(j)  (1280 + 64 * (j))
#define XB_XGEN(j)  (2304 + 64 * (j))
#define XB_TOP      3328
#define XB_TOPGEN   3392
#define XCD_BAR_WORDS 3456
#define XB_SPIN_CAP (1u << 18)

__device__ __forceinline__ unsigned xb_ld(unsigned* p)              { return __hip_atomic_load(p, __ATOMIC_RELAXED, __HIP_MEMORY_SCOPE_AGENT); }
__device__ __forceinline__ unsigned xb_add(unsigned* p, unsigned v) { return __hip_atomic_fetch_add(p, v, __ATOMIC_RELAXED, __HIP_MEMORY_SCOPE_AGENT); }
__device__ __forceinline__ unsigned xb_xcc_id() { return (unsigned)__builtin_amdgcn_s_getreg((3 << 11) | 20) & 0xFu; }
#define XB_SPIN(cond, bar) do { unsigned _sp = 0; while (cond) { __builtin_amdgcn_s_sleep(1); \
    if ((++_sp & 255u) == 0u) { if (xb_ld(&(bar)[XB_TMO])) break; if (_sp > XB_SPIN_CAP) { atomicAdd(&(bar)[XB_TMO], 1u); break; } } } } while (0)

struct XcdBarrier {
    unsigned* bar; unsigned x;
    volatile LAS unsigned* st;
};

__device__ __forceinline__ XcdBarrier xcd_barrier_post(unsigned* bar, volatile LAS unsigned* st) {
    XcdBarrier b; b.bar = bar; b.x = xb_xcc_id(); b.st = st;
    if (threadIdx.x == 0) (void)xb_add(&bar[XB_XCNT(b.x)], 1u);
    return b;
}
__device__ __forceinline__ void xcd_barrier_complete(unsigned* bar, unsigned x, unsigned& nloc, unsigned& nx) {
    const unsigned G = gridDim.x * gridDim.y * gridDim.z;
    unsigned sum, cnt, mine, sp = 0u;
    for (;;) {
        sum = 0u; cnt = 0u; mine = 0u;
#pragma unroll
        for (unsigned j = 0; j < 16; ++j) { const unsigned c = xb_ld(&bar[XB_XCNT(j)]); sum += c; cnt += (c > 0u) ? 1u : 0u; mine = (j == x) ? c : mine; }
        if (sum == G) break;
        __builtin_amdgcn_s_sleep(1);
        if ((++sp & 255u) == 0u) { if (xb_ld(&bar[XB_TMO])) break; if (sp > XB_SPIN_CAP) { atomicAdd(&bar[XB_TMO], 1u); break; } }
    }
    nloc = mine > 0u ? mine : 1u; nx = cnt > 0u ? cnt : 1u;
}

__device__ __forceinline__ void xcd_barrier(const XcdBarrier& b) {
    asm volatile("s_waitcnt vmcnt(0)" ::: "memory");
    __syncthreads();
    if (threadIdx.x == 0) {
        unsigned* bar = b.bar;
        __builtin_amdgcn_s_waitcnt(0);
        unsigned nloc = b.st[0], nx = b.st[1];
        if (nloc == 0u) { xcd_barrier_complete(bar, b.x, nloc, nx); b.st[0] = nloc; b.st[1] = nx; }
        const unsigned old = xb_add(&bar[XB_XSUB(b.x)], 1u);
        const unsigned gen = old / nloc;
        if (old + 1u == (gen + 1u) * nloc) {
            __builtin_amdgcn_fence(__ATOMIC_RELEASE, "agent");
            asm volatile("s_waitcnt vmcnt(0)" ::: "memory");
            const unsigned og = xb_add(&bar[XB_TOP], 1u);
            const unsigned tg = og / nx;
            if (og + 1u == (tg + 1u) * nx) xb_add(&bar[XB_TOPGEN], 1u);
            else XB_SPIN(xb_ld(&bar[XB_TOPGEN]) == tg, bar);
            __builtin_amdgcn_fence(__ATOMIC_ACQUIRE, "agent");
            xb_add(&bar[XB_XGEN(b.x)], 1u);
            asm volatile("s_waitcnt vmcnt(0)" ::: "memory");
        } else {
            XB_SPIN(xb_ld(&bar[XB_XGEN(b.x)]) == gen, bar);
            __builtin_amdgcn_fence(__ATOMIC_ACQUIRE, "agent");
            asm volatile("s_waitcnt vmcnt(0)" ::: "memory");
        }
    }
    __syncthreads();
}

namespace tk {
typedef short bf16x8 __attribute__((ext_vector_type(8)));
typedef float f32x4 __attribute__((ext_vector_type(4)));
constexpr int HIST_OFF = 0, HSTR = 1025;
constexpr int TCNT_OFF = 65664;
constexpr int MSTG_OFF = TCNT_OFF + 16384;
constexpr int TBASE_OFF = MSTG_OFF + 8192;
constexpr int RES_OFF = TBASE_OFF + 8192;
constexpr int QST_OFF = 102400;
#define TK_BAR() do { asm volatile("s_waitcnt lgkmcnt(0)" ::: "memory"); __builtin_amdgcn_s_barrier(); asm volatile("" ::: "memory"); } while (0)

__device__ __forceinline__ unsigned wave_prefix_incl(unsigned x) {
    x += (unsigned)__builtin_amdgcn_update_dpp(0, (int)x, 0x111, 0xf, 0xf, true);
    x += (unsigned)__builtin_amdgcn_update_dpp(0, (int)x, 0x112, 0xf, 0xf, true);
    x += (unsigned)__builtin_amdgcn_update_dpp(0, (int)x, 0x114, 0xf, 0xf, true);
    x += (unsigned)__builtin_amdgcn_update_dpp(0, (int)x, 0x118, 0xf, 0xf, true);
    x += (unsigned)__builtin_amdgcn_update_dpp(0, (int)x, 0x142, 0xa, 0xf, false);
    x += (unsigned)__builtin_amdgcn_update_dpp(0, (int)x, 0x143, 0xc, 0xf, false);
    return x;
}
template <int NW>
__device__ __forceinline__ void scan_query(const LAS unsigned* hq, LAS unsigned* res, int qq, unsigned r, int lane) {
    unsigned w[NW]; unsigned tot = 0; const int wbase = (63 - lane) * NW;
#pragma unroll
    for (int x = 0; x < NW; ++x) { w[x] = hq[wbase + x]; tot += (w[x] & 0xffffu) + (w[x] >> 16); }
    const unsigned incl = wave_prefix_incl(tot);
    const unsigned above = incl - tot;
    if (above < r && incl >= r) {
        unsigned c = above, bin = 0, cnt = 0, cb = 0; bool found = false;
#pragma unroll
        for (int x = NW - 1; x >= 0; --x) {
            const unsigned hi = w[x] >> 16, lo = w[x] & 0xffffu;
            if (!found && c + hi >= r) { found = true; bin = (unsigned)(wbase + x) * 2u + 1u; cnt = hi; cb = c; }
            c += hi;
            if (!found && c + lo >= r) { found = true; bin = (unsigned)(wbase + x) * 2u; cnt = lo; cb = c; }
            c += lo;
        }
        res[qq] = bin; res[16 + qq] = r - cb; res[32 + qq] = cnt;
    }
}

__device__ __forceinline__ void tk_prefetch_q(LAS unsigned char* L, const bf16_t* __restrict__ QI, const float* __restrict__ WI, int b, int tq0, int lane) {
    const size_t row = (size_t)b * K::S + tq0 + (lane & 15);
#pragma unroll
    for (int f = 0; f < 8; ++f) __builtin_amdgcn_global_load_lds((const unsigned*)(QI + row * 256 + (f >> 1) * 64 + (f & 1) * 32 + (lane >> 4) * 8), (LAS unsigned*)(L + QST_OFF + f * 1024), 16, 0, 0);
    __builtin_amdgcn_global_load_lds((const unsigned*)(WI + row * 4), (LAS unsigned*)(L + QST_OFF + 8192), 16, 0, 0);
}
__device__ __forceinline__ void topk_group(LAS unsigned char* L, const bf16_t* __restrict__ QI, const bf16_t* __restrict__ KI, const float* __restrict__ WI, u64* __restrict__ MASK,
                                           int b, int tq0, int nb, int ntq0, int tid, int lane, int wave) {
    using namespace K;
    const int q = lane & 15, g = lane >> 4;
    const int row0 = b * S + tq0, jmax = tq0 >> 4;
    LAS unsigned* hist = (LAS unsigned*)(L + HIST_OFF); LAS unsigned* tcnt = (LAS unsigned*)(L + TCNT_OFF);
    LAS unsigned short* mstg = (LAS unsigned short*)(L + MSTG_OFF); LAS unsigned short* tbase = (LAS unsigned short*)(L + TBASE_OFF); LAS unsigned* res = (LAS unsigned*)(L + RES_OFF);
    for (int i = tid; i < (16384 + 8192) / 4; i += NWAVES * 64) tcnt[i] = 0u;
    LAS unsigned* const tc_q = tcnt + q * 256 + wave; LAS unsigned short* const tb_q = tbase + q * 256 + wave;
    LAS unsigned* const ms32_q = (LAS unsigned*)mstg + ((q * 256 + wave) >> 1); const unsigned sh_q = 16u * (wave & 1) + 4u * g;
    if (tq0 < TOPK) {
        if (wave == 0 && ntq0 >= TOPK) tk_prefetch_q(L, QI, WI, nb, ntq0, lane);
        TK_BAR();
        for (int idx = tid; idx < 16 * (jmax + 1); idx += NWAVES * 64) { const int qq = idx & 15, j = idx >> 4; mstg[qq * 256 + j] = (unsigned short)((j < jmax) ? 0xffffu : ((2u << qq) - 1u)); }
    } else {
        unsigned key[32][4];
        for (int i = tid; i < 16 * HSTR / 4; i += NWAVES * 64) ((LAS v4u*)hist)[i] = (v4u){0u, 0u, 0u, 0u};
        if (wave == 0) asm volatile("s_waitcnt vmcnt(0)" ::: "memory");
        TK_BAR();
        bf16x8 qf[4][2];
#pragma unroll
        for (int h = 0; h < 4; ++h)
#pragma unroll
            for (int ks = 0; ks < 2; ++ks) qf[h][ks] = *(const LAS bf16x8*)(L + QST_OFF + (h * 2 + ks) * 1024 + lane * 16);
        const f32x4 wv = *(const LAS f32x4*)(L + QST_OFF + 8192 + lane * 16);
        bf16x8 kk[3][2][2];
#define TK_LOADK(c_) do { _Pragma("unroll") for (int s_ = 0; s_ < 2; ++s_) { const int j_ = wave + 8 * (2 * (c_) + s_), jc_ = j_ < jmax ? j_ : jmax; \
            const bf16_t* kp_ = KI + (size_t)(b * S + jc_ * 16 + q) * 64 + g * 8; kk[(c_) % 3][s_][0] = *(const bf16x8*)kp_; kk[(c_) % 3][s_][1] = *(const bf16x8*)(kp_ + 32); } } while (0)
        TK_LOADK(0); if (16 <= jmax) TK_LOADK(1);
#pragma unroll
        for (int c = 0; c < 16; ++c) {
            if (16 * c <= jmax) {
                if (c < 14 && 16 * (c + 2) <= jmax) TK_LOADK(c + 2);
#pragma unroll
                for (int s = 0; s < 2; ++s) {
                    const int i = 2 * c + s, j = wave + 8 * i;
                    f32x4 sc = {0.f, 0.f, 0.f, 0.f};
#pragma unroll
                    for (int h = 0; h < 4; ++h) {
                        f32x4 d = __builtin_amdgcn_mfma_f32_16x16x32_bf16(kk[c % 3][s][0], qf[h][0], (f32x4){0.f, 0.f, 0.f, 0.f}, 0, 0, 0);
                        d = __builtin_amdgcn_mfma_f32_16x16x32_bf16(kk[c % 3][s][1], qf[h][1], d, 0, 0, 0);
#pragma unroll
                        for (int r = 0; r < 4; ++r) { const int di = __float_as_int(d[r]); sc[r] = __builtin_fmaf(wv[h], __int_as_float(di > 0 ? di : 0), sc[r]); }
                    }
#pragma unroll
                    for (int r = 0; r < 4; ++r) {
                        const unsigned u = __float_as_uint(sc[r]);
                        unsigned k = u ^ ((unsigned)((int)u >> 31) | 0x80000000u);
                        if (j > jmax || (j == jmax && 4 * g + r > q)) k = 0u;
                        key[i][r] = k;
                        if (k != 0u) { const unsigned bin = k >> 21; __hip_atomic_fetch_add(hist + q * HSTR + (bin >> 1), 1u << (16 * (bin & 1u)), __ATOMIC_RELAXED, __HIP_MEMORY_SCOPE_WORKGROUP); }
                    }
                }
            } else {
#pragma unroll
                for (int s = 0; s < 2; ++s)
#pragma unroll
                    for (int r = 0; r < 4; ++r) key[2 * c + s][r] = 0u;
            }
        }
#undef TK_LOADK
        unsigned prefix = 0u, rnk = (unsigned)TOPK, cnt_eq = 0u;
#pragma unroll
        for (int pass = 0; pass < 3; ++pass) {
            const int shift = (pass == 0) ? 21 : (pass == 1 ? 10 : 0), pshift = (pass == 1) ? 21 : 10; const unsigned bmask = (pass == 2) ? 1023u : 2047u;
            if (pass != 0) {
            TK_BAR();
            if (pass == 1 && wave == 0 && ntq0 >= TOPK) tk_prefetch_q(L, QI, WI, nb, ntq0, lane);
            for (int i = tid; i < 16 * HSTR / 4; i += NWAVES * 64) ((LAS v4u*)hist)[i] = (v4u){0u, 0u, 0u, 0u};
            TK_BAR();
#pragma unroll
            for (int i = 0; i < 32; ++i) {
                if (wave + 8 * i <= jmax) {
#pragma unroll
                    for (int r = 0; r < 4; ++r) {
                        const unsigned k = key[i][r];
                        const bool m = (pass == 0) ? (k != 0u) : ((k >> pshift) == prefix);
                        if (m) { const unsigned bin = (k >> shift) & bmask; __hip_atomic_fetch_add(hist + q * HSTR + (bin >> 1), 1u << (16 * (bin & 1u)), __ATOMIC_RELAXED, __HIP_MEMORY_SCOPE_WORKGROUP); }
                    }
                }
            }
            }
            TK_BAR();
            { const unsigned r0 = (unsigned)__builtin_amdgcn_readlane((int)rnk, 2 * wave), r1 = (unsigned)__builtin_amdgcn_readlane((int)rnk, 2 * wave + 1);
              if (pass < 2) { scan_query<16>(hist + (2 * wave) * HSTR, res, 2 * wave, r0, lane); scan_query<16>(hist + (2 * wave + 1) * HSTR, res, 2 * wave + 1, r1, lane); }
              else { scan_query<8>(hist + (2 * wave) * HSTR, res, 2 * wave, r0, lane); scan_query<8>(hist + (2 * wave + 1) * HSTR, res, 2 * wave + 1, r1, lane); } }
            TK_BAR();
            prefix = (prefix << ((pass == 2) ? 10 : 11)) | res[q]; rnk = res[16 + q]; cnt_eq = res[32 + q];
        }
        const unsigned T = prefix, need = rnk;
        const bool slow = __any(need != cnt_eq);
        if (slow) {
#pragma unroll
            for (int i = 0; i < 32; ++i) {
                if (wave + 8 * i <= jmax) {
                    unsigned c = 0;
#pragma unroll
                    for (int r = 0; r < 4; ++r) c += (key[i][r] == T) ? 1u : 0u;
                    if (c) __hip_atomic_fetch_add(tc_q + 8 * i, c << (8 * g), __ATOMIC_RELAXED, __HIP_MEMORY_SCOPE_WORKGROUP);
                }
            }
            TK_BAR();
#pragma unroll
            for (int s = 0; s < 2; ++s) {
                const int qq = 2 * wave + s; unsigned tt[4], tot = 0;
#pragma unroll
                for (int x = 0; x < 4; ++x) { const unsigned e = tcnt[qq * 256 + lane * 4 + x]; tt[x] = (e & 255u) + ((e >> 8) & 255u) + ((e >> 16) & 255u) + (e >> 24); tot += tt[x]; }
                const unsigned incl = wave_prefix_incl(tot);
                unsigned base = incl - tot;
#pragma unroll
                for (int x = 0; x < 4; ++x) { tbase[qq * 256 + lane * 4 + x] = (unsigned short)base; base += tt[x]; }
            }
            TK_BAR();
        }
#pragma unroll
        for (int i = 0; i < 32; ++i) {
            const int j = wave + 8 * i;
            if (j <= jmax) {
                unsigned nib = 0;
                if (!slow) {
#pragma unroll
                    for (int r = 0; r < 4; ++r) nib |= (key[i][r] >= T && key[i][r] != 0u) ? (1u << r) : 0u;
                } else {
                    const unsigned e = tc_q[8 * i]; unsigned rank = tb_q[8 * i];
                    if (g > 0) rank += e & 255u; if (g > 1) rank += (e >> 8) & 255u; if (g > 2) rank += (e >> 16) & 255u;
#pragma unroll
                    for (int r = 0; r < 4; ++r) { const unsigned k = key[i][r];
                        if (k > T) nib |= 1u << r; else if (k == T && k != 0u) { if (rank < need) nib |= 1u << r; ++rank; } }
                }
                if (nib) __hip_atomic_fetch_or(ms32_q + 4 * i, nib << sh_q, __ATOMIC_RELAXED, __HIP_MEMORY_SCOPE_WORKGROUP);
            }
        }
    }
    TK_BAR();
    for (int idx = tid; idx < 1024; idx += NWAVES * 64) {
        const int qq = idx & 15, t64 = idx >> 4;
        const u64 wd = *(const LAS u64*)(mstg + qq * 256 + t64 * 4);
        MASK[((size_t)b * 64 + t64) * S + tq0 + qq] = wd;
    }
    TK_BAR();
}

__device__ __forceinline__ void gating_block(LAS unsigned char* L, const bf16_t* __restrict__ QO, const float* __restrict__ KMEAN, unsigned* __restrict__ BMASK, int blk64, int tid) {
    using namespace K;
    const int row0 = 64 * blk64, b = row0 / S;
    LAS float* km = (LAS float*)L;
    const int r = tid >> 3, h = tid & 7, row = row0 + r, t = row % S, own = t / MBLK;
    uint4 qraw[8];
#pragma unroll
    for (int x = 0; x < 8; ++x) qraw[x] = *(const uint4*)(QO + (size_t)row * 1024 + 512 + h * 64 + 8 * x);
    for (int i = tid; i < 16 * 8 * 64; i += NWAVES * 64) { const int n = i >> 9, hh = (i >> 6) & 7, d = i & 63; km[(n * 8 + hh) * 68 + d] = KMEAN[((size_t)(b * 16 + n) * 8 + hh) * 64 + d]; }
    TK_BAR();
    float qv[64];
#pragma unroll
    for (int x = 0; x < 8; ++x) { const uint4 u = qraw[x];
        qv[8 * x + 0] = __uint_as_float(u.x << 16); qv[8 * x + 1] = __uint_as_float(u.x & 0xffff0000u); qv[8 * x + 2] = __uint_as_float(u.y << 16); qv[8 * x + 3] = __uint_as_float(u.y & 0xffff0000u);
        qv[8 * x + 4] = __uint_as_float(u.z << 16); qv[8 * x + 5] = __uint_as_float(u.z & 0xffff0000u); qv[8 * x + 6] = __uint_as_float(u.w << 16); qv[8 * x + 7] = __uint_as_float(u.w & 0xffff0000u); }
    float b0 = -INFINITY, b1 = -INFINITY, b2 = -INFINITY; int i0 = -1, i1 = -1, i2 = -1;
    for (int n = 0; n < own; ++n) {
        const LAS f32x4* kp = (const LAS f32x4*)(km + (n * 8 + h) * 68); float gs = 0.f;
#pragma unroll
        for (int d4 = 0; d4 < 16; ++d4) { const f32x4 kv = kp[d4]; gs = __builtin_fmaf(qv[4 * d4], kv[0], gs); gs = __builtin_fmaf(qv[4 * d4 + 1], kv[1], gs); gs = __builtin_fmaf(qv[4 * d4 + 2], kv[2], gs); gs = __builtin_fmaf(qv[4 * d4 + 3], kv[3], gs); }
        if (gs > b0) { b2 = b1; i2 = i1; b1 = b0; i1 = i0; b0 = gs; i0 = n; }
        else if (gs > b1) { b2 = b1; i2 = i1; b1 = gs; i1 = n; }
        else if (gs > b2) { b2 = gs; i2 = n; }
    }
    unsigned bm = 1u << own;
    if (i0 >= 0) bm |= 1u << i0; if (i1 >= 0) bm |= 1u << i1; if (i2 >= 0) bm |= 1u << i2;
    BMASK[(size_t)row * 8 + h] = bm;
    TK_BAR();
}
#undef TK_BAR
}
namespace attn_body {
using bf16=__hip_bfloat16;
using bf16x8=__attribute__((ext_vector_type(8)))short;
using s16x4=__attribute__((ext_vector_type(4)))short;
using f32x16=__attribute__((ext_vector_type(16)))float;
using u32x4=__attribute__((ext_vector_type(4)))unsigned;
constexpr int BATCH=4,NHEAD=16,SEQ=4096,D=64,DM=NHEAD*D;
constexpr int NW=8,QBLK=32,QB=QBLK*NW,KVBLK=64,NQB=SEQ/QB;
constexpr int ATTN_PITCH=DM, ATTN_UNIT_ROWS=QB;
__device__ __forceinline__ int crow(int r,int hi){return (r&3)+8*(r>>2)+4*hi;}
#define SBAR() __builtin_amdgcn_sched_barrier(0)
typedef __attribute__((address_space(3))) const float* lds_fptr;
__device__ __forceinline__ void addbias(f32x16&p0,f32x16&p1,int jb6,int qrel,int hi,lds_fptr bt){
  const lds_fptr b=bt+(qrel+128-64*jb6-4*hi+197);
  #pragma unroll
  for(int r=0;r<16;++r){const int c=(r&3)+8*(r>>2); p0[r]+=b[59-c]; p1[r]+=b[27-c];}
}

constexpr int BT_N=640;
constexpr int NSLOT=3, SLOTB=8192;
#define EXM(p,w) do{ if(MOBA) asm volatile("v_sub_f32 %0, %0, %2\n\tv_exp_f32 %0, %0\n\tv_add_co_u32 %1, vcc, %1, %1\n\tv_cndmask_b32 %0, 0, %0, vcc":"+v"(p),"+v"(w):"v"(mhat):"vcc"); \
  else asm volatile("v_exp_f32 %0, %0\n\tv_add_co_u32 %1, vcc, %1, %1\n\tv_cndmask_b32 %0, 0, %0, vcc":"+v"(p),"+v"(w)::"vcc"); }while(0)
#define EXS(p,mh) asm volatile("v_sub_f32 %0, %0, %1\n\tv_exp_f32 %0, %0\n\ts_nop 0":"+v"(p):"v"(mh))
#define EXM16(P,w) do{ EXM(P[15],w);EXM(P[14],w);EXM(P[13],w);EXM(P[12],w); w<<=4; EXM(P[11],w);EXM(P[10],w);EXM(P[9],w);EXM(P[8],w); w<<=4; EXM(P[7],w);EXM(P[6],w);EXM(P[5],w);EXM(P[4],w); w<<=4; EXM(P[3],w);EXM(P[2],w);EXM(P[1],w);EXM(P[0],w); }while(0)
__device__ __forceinline__ int cbit(int r){return (r&3)+8*(r>>2);}
constexpr int LDS_K=0, LDS_V=NSLOT*SLOTB, LDS_WS=2*NSLOT*SLOTB, LDS_OST=LDS_WS+NW*64*4, LDS_BT=LDS_OST+NW*4096, LDS_BYTES=LDS_BT+BT_N*4;
constexpr float C2=0.125f*1.4426950408889634f;
__device__ __forceinline__ void glds16(const void*gsrc,unsigned lds_dst){unsigned keep;
  asm volatile("s_mov_b32 %0, m0\n\ts_mov_b32 m0, %2\n\ts_nop 0\n\tglobal_load_lds_dwordx4 %1, off\n\ts_mov_b32 m0, %0":"=&s"(keep):"v"(gsrc),"s"(lds_dst):"memory");}
__device__ __forceinline__ float max3f(float a,float b,float c){float r;asm("v_max3_f32 %0, %1, %2, %3":"=v"(r):"v"(a),"v"(b),"v"(c));return r;}
__device__ __forceinline__ float max2f(float a,float b){float r;asm("v_max_f32_e32 %0, %1, %2":"=v"(r):"v"(a),"v"(b));return r;}
__device__ __forceinline__ float fadd_s(float a,float b){float r;asm("v_add_f32_e32 %0, %1, %2":"=v"(r):"v"(a),"v"(b));return r;}
__device__ __forceinline__ float fsub_s(float a,float b){float r;asm("v_sub_f32_e32 %0, %1, %2":"=v"(r):"v"(a),"v"(b));return r;}
typedef float f32x2_t __attribute__((ext_vector_type(2))); typedef __bf16 bf16x2_t __attribute__((ext_vector_type(2)));
__device__ __forceinline__ unsigned cvtpk_s(float lo,float hi){f32x2_t v={lo,hi};bf16x2_t b=__builtin_convertvector(v,bf16x2_t);return __builtin_bit_cast(unsigned,b);}
#define WAIT_BAR(N) asm volatile("s_waitcnt vmcnt(" #N ") lgkmcnt(0)\n\ts_barrier":::"memory")

__device__ __forceinline__ void qkt(f32x16&p0,f32x16&p1,const char*Kslot,const bf16x8*qr,const f32x16&c0,int r32,int hi){
  const char*kb=Kslot+hi*1024+r32*16;
  #pragma unroll
  for(int d0=0;d0<4;++d0){
    const bf16x8 b0=*reinterpret_cast<const bf16x8*>(kb+d0*2048);
    const bf16x8 b1=*reinterpret_cast<const bf16x8*>(kb+d0*2048+512);
    if(d0==0){p0=__builtin_amdgcn_mfma_f32_32x32x16_bf16(b0,qr[0],c0,0,0,0);p1=__builtin_amdgcn_mfma_f32_32x32x16_bf16(b1,qr[0],c0,0,0,0);}
    else{p0=__builtin_amdgcn_mfma_f32_32x32x16_bf16(b0,qr[d0],p0,0,0,0);p1=__builtin_amdgcn_mfma_f32_32x32x16_bf16(b1,qr[d0],p1,0,0,0);}}
}
typedef __attribute__((address_space(3))) const char* lds_cptr;
typedef short v4i16_t __attribute__((ext_vector_type(4)));
__device__ __forceinline__ void kload8(bf16x8*kf,lds_cptr kp){
  kf[0]=*(const __attribute__((address_space(3))) bf16x8*)(kp);      kf[1]=*(const __attribute__((address_space(3))) bf16x8*)(kp+512);
  kf[2]=*(const __attribute__((address_space(3))) bf16x8*)(kp+2048); kf[3]=*(const __attribute__((address_space(3))) bf16x8*)(kp+2560);
  kf[4]=*(const __attribute__((address_space(3))) bf16x8*)(kp+4096); kf[5]=*(const __attribute__((address_space(3))) bf16x8*)(kp+4608);
  kf[6]=*(const __attribute__((address_space(3))) bf16x8*)(kp+6144); kf[7]=*(const __attribute__((address_space(3))) bf16x8*)(kp+6656);
}
__device__ __forceinline__ void kload2(bf16x8*kf,lds_cptr kp,int j){ kf[2*j]=*(const __attribute__((address_space(3))) bf16x8*)(kp+j*2048); kf[2*j+1]=*(const __attribute__((address_space(3))) bf16x8*)(kp+j*2048+512); }
__device__ __forceinline__ s16x4 vtr(lds_cptr p){ return __builtin_bit_cast(s16x4,__builtin_amdgcn_ds_read_tr16_b64_v4i16((__attribute__((address_space(3))) v4i16_t*)p)); }
__device__ __forceinline__ float rowmax(const f32x16&p0,const f32x16&p1){
  float a=max3f(p0[0],p0[1],p1[0]),b=max3f(p0[2],p0[3],p1[1]);a=max3f(a,p1[2],p1[3]);
  #pragma unroll
  for(int r=4;r<16;r+=4){a=max3f(a,p0[r],p0[r+1]);b=max3f(b,p0[r+2],p0[r+3]);a=max3f(a,p1[r],p1[r+1]);b=max3f(b,p1[r+2],p1[r+3]);}
  const float m=max2f(a,b);
  auto rr=__builtin_amdgcn_permlane32_swap(__float_as_uint(m),__float_as_uint(m),false,false);
  return max2f(__uint_as_float(rr[0]),__uint_as_float(rr[1]));
}
__device__ __forceinline__ void pv(f32x16*o,int vb,bf16x8 pa0,bf16x8 pa1,bf16x8 pa2,bf16x8 pa3){
  #pragma unroll
  for(int d0=0;d0<2;++d0){s16x4 lo[4],hi[4];
    #pragma unroll
    for(int ks=0;ks<4;++ks){
      asm volatile("ds_read_b64_tr_b16 %0,%1 offset:%c2":"=&v"(lo[ks]):"v"(vb),"i"(d0*4096+ks*1024):"memory");
      asm volatile("ds_read_b64_tr_b16 %0,%1 offset:%c2":"=&v"(hi[ks]):"v"(vb),"i"(d0*4096+ks*1024+512):"memory");}
    asm volatile("s_waitcnt lgkmcnt(0)":::"memory");SBAR();
    #define PK(k) (bf16x8){lo[k][0],lo[k][1],lo[k][2],lo[k][3],hi[k][0],hi[k][1],hi[k][2],hi[k][3]}
    o[d0]=__builtin_amdgcn_mfma_f32_32x32x16_bf16(pa0,PK(0),o[d0],0,0,0);
    o[d0]=__builtin_amdgcn_mfma_f32_32x32x16_bf16(pa1,PK(1),o[d0],0,0,0);
    o[d0]=__builtin_amdgcn_mfma_f32_32x32x16_bf16(pa2,PK(2),o[d0],0,0,0);
    o[d0]=__builtin_amdgcn_mfma_f32_32x32x16_bf16(pa3,PK(3),o[d0],0,0,0);
    #undef PK
  }
}

#ifndef ATTN_STORE16
#define ATTN_STORE16(p,v) (*(u32x4*)(p)=(v))
#endif
template<int THRL,bool MOBA> __device__ __forceinline__ void attn_unit(int b,int h,int qb,const bf16*Q,const bf16*__restrict__ K,const bf16*__restrict__ V,bf16*O,const unsigned long long*__restrict__ MASKW,const unsigned*__restrict__ BMASK,const float*__restrict__ relb,const float*__restrict__ gq,const float*__restrict__ gk,char*shm){
  const int tid=threadIdx.x,lane=tid&63,r32=lane&31,hi=lane>>5; const int wid=__builtin_amdgcn_readfirstlane(tid>>6);
  const long rowbase=(long)b*SEQ; const int q0=qb*QB;
  const bf16*Qw=Q+(rowbase+q0+wid*QBLK)*DM+h*D;
  const bf16*Kh=K+rowbase*DM+h*D,*Vh=V+rowbase*DM+h*D;
  const unsigned lds0=(unsigned)(uintptr_t)shm;
  float*wsf=(float*)(shm+LDS_WS)+wid*64;
  const bf16*ksrc=Kh+(long)lane*DM+wid*8;
  const bf16*vsrc=Vh+(long)(16*(wid&3)+(lane>>2))*DM+(wid>>2)*32+(lane&3)*8;
  const unsigned kdst=lds0+LDS_K+wid*1024, vdst=lds0+LDS_V+wid*1024;
  #define DMA_K(t,slot) glds16(ksrc+(long)(t)*KVBLK*DM,(unsigned)__builtin_amdgcn_readfirstlane(kdst+(slot)))
  #define DMA_V(t,slot) glds16(vsrc+(long)(t)*KVBLK*DM,(unsigned)__builtin_amdgcn_readfirstlane(vdst+(slot)))
  const int vb0=(int)(lds0+LDS_V)+((lane>>4)&1)*32+(lane&3)*8+(4*hi+((lane&15)>>2))*64;
  const char*Kbase=shm+LDS_K; bf16x8 kf[8];
  const lds_cptr shm3=(lds_cptr)shm; const lds_cptr kp0=shm3+LDS_K+hi*1024+r32*16; const lds_cptr vp0=shm3+LDS_V+((lane>>4)&1)*32+(lane&3)*8+(4*hi+((lane&15)>>2))*64;
  const int NT=(q0+QB)/KVBLK;
  const int qrel=wid*QBLK+r32; constexpr bool moba=MOBA;
  const lds_fptr bt=(lds_fptr)(shm3+LDS_BT);
  unsigned bm=0u;
  const unsigned mvoff=(unsigned)(q0+qrel)*8u; unsigned long long mraw=0ull; unsigned mlo=0u,mhi=0u;
  #define MLOAD(tt) do{ if(!moba&&(tt)<NT){ const unsigned long long*mb_=MASKW+((size_t)(b*64+(tt)))*SEQ; \
      asm volatile("s_nop 4\n\tglobal_load_dwordx2 %0, %1, %2":"=v"(mraw):"v"(mvoff),"s"(mb_):"memory"); } }while(0)
  #define MSET(tt) do{ if(!moba){ asm volatile("":"+v"(mraw)); mlo=(unsigned)mraw<<(4-4*hi); mhi=(unsigned)(mraw>>32)<<(4-4*hi); } \
      else{ unsigned wl=((bm>>((tt)>>2))&1u)?0xffffffffu:0u, wh=wl; const int jb_=(tt)-(NT-4); \
        if(jb_>=0){ const int n=qrel-64*jb_, n2=n-32; wl&=(n<0)?0u:((n>=31)?0xffffffffu:((2u<<n)-1u)); wh&=(n2<0)?0u:((n2>=31)?0xffffffffu:((2u<<n2)-1u)); } \
        mlo=wl<<(4-4*hi); mhi=wh<<(4-4*hi); } }while(0)
  MLOAD(0);
  DMA_K(0,0);DMA_V(0,0);DMA_K(1,SLOTB);
  bf16x8 qr[4];
  #pragma unroll
  for(int d0=0;d0<4;++d0)qr[d0]=*reinterpret_cast<const bf16x8*>(&Qw[(long)r32*DM+d0*16+hi*8]);
  if(moba)bm=BMASK[(size_t)(rowbase+q0+qrel)*8+(h-8)];
  { __attribute__((address_space(3))) float*btw=(__attribute__((address_space(3))) float*)(shm3+LDS_BT); const float b31=relb[31*16+h];
    for(int i=tid;i<BT_N;i+=NW*64){ const int d=i-256; btw[i]=(d>=0&&d<=112)?(relb[t5_bucket(d)*16+h]-b31)*1.4426950408889634f:0.f; } }
  constexpr float mhat=16.0f; float l_reg=0.f;f32x16 o[2];o[0]=f32x16{};o[1]=f32x16{}; f32x16 negm=f32x16{}; (void)gq; (void)gk;
  if(!MOBA){ _Pragma("unroll") for(int r=0;r<16;++r)negm[r]=-mhat; asm volatile("":"+v"(negm)); }
  #define CMASK(P0,P1,t) do{int jb_=(t)-(NT-6); if(jb_>=0)addbias(P0,P1,jb_,qrel,hi,bt);}while(0)
  #define START(P0,P1) do{ EXM16(P0,mlo); }while(0)
  #define RESC() do{}while(0)
  f32x16 pA0,pA1,pB0,pB1;
  int sl_prev=0,sl_cur=0,sl_next=SLOTB;
  #define ROT() do{sl_prev=sl_cur;sl_cur=sl_next;sl_next=(sl_next==(NSLOT-1)*SLOTB)?0:sl_next+SLOTB;}while(0)
  DMA_K(2,2*SLOTB);
  WAIT_BAR(3);
  MSET(0); MLOAD(1);
  qkt(pA0,pA1,Kbase,qr,(MOBA?f32x16{}:negm),r32,hi);asm volatile("s_nop 15\n\ts_nop 7":"+v"(pA0),"+v"(pA1));CMASK(pA0,pA1,0);
  START(pA0,pA1);
  EXM16(pA1,mhi);
  WAIT_BAR(0);
  MSET(1);
  DMA_K(3,0);DMA_V(1,SLOTB);
  ROT();
  kload8(kf,kp0+sl_cur);
  WAIT_BAR(2);
  s16x4 vlo[8],vhi[8]; u32x4 pw0,pw1,pw2,pw3;
  #define PKW(P,B) cvtpk_s(P[B],P[B+1])
  #define PAF(k) __builtin_bit_cast(bf16x8,pw##k)
  #define VFR(i) (bf16x8){vlo[i][0],vlo[i][1],vlo[i][2],vlo[i][3],vhi[i][0],vhi[i][1],vhi[i][2],vhi[i][3]}
  #define PIN(x) asm volatile("":"+v"(x))
  #define MX3(a,b,c) __builtin_fmaxf(__builtin_fmaxf((a),(b)),(c))
  #define GAPA(MF,A0,A1,A2,A3,W0,W1,PW) do{ MF; sacc+=A0; sacc+=A1; sacc+=A2; sacc+=A3; PIN(sacc); W0; W1; PIN(PW); SBAR(); }while(0)
  #define EX(v) __builtin_amdgcn_exp2f(v)
  #define GAPB(MF,X,B,MW,CH) do{ MF; if(CH){ EXS(X[B+3],mh_); EXS(X[B+2],mh_); EXS(X[B+1],mh_); EXS(X[B],mh_); } else { EXM(X[B+3],MW); EXM(X[B+2],MW); EXM(X[B+1],MW); EXM(X[B],MW); if((B)>0)MW<<=4; } PIN(X); SBAR(); }while(0)
  #define VRD(i) do{ vlo[i]=vtr(vp_+(((i)>>2)*4096+((i)&3)*1024)); vhi[i]=vtr(vp_+(((i)>>2)*4096+((i)&3)*1024+512)); }while(0)
  #define KRD(G,j) do{ if(G){ kload2(kf,kp0+sl_next,j); SBAR(); } }while(0)
  #define STEP(C0,C1,P0,P1,t,GK,GV,GL,CH) do{ SBAR(); \
    const lds_cptr vp_=vp0+sl_prev; \
    VRD(0); SBAR(); float sacc=(P0[0]+P0[1]); \
    GAPA(C0=__builtin_amdgcn_mfma_f32_32x32x16_bf16(kf[0],qr[0],(MOBA?f32x16{}:negm),0,0,0), P0[2],P0[3],P0[4],P0[5],     pw0[0]=PKW(P0,0), pw0[1]=PKW(P0,2), pw0); \
    VRD(4); SBAR(); GAPA(C1=__builtin_amdgcn_mfma_f32_32x32x16_bf16(kf[1],qr[0],(MOBA?f32x16{}:negm),0,0,0), P0[6],P0[7],P0[8],P0[9],     pw0[2]=PKW(P0,4), pw0[3]=PKW(P0,6), pw0); \
    VRD(1); SBAR(); GAPA(C0=__builtin_amdgcn_mfma_f32_32x32x16_bf16(kf[2],qr[1],C0,0,0,0),   P0[10],P0[11],P0[12],P0[13], pw1[0]=PKW(P0,8), pw1[1]=PKW(P0,10), pw1); \
    VRD(5); SBAR(); GAPA(C1=__builtin_amdgcn_mfma_f32_32x32x16_bf16(kf[3],qr[1],C1,0,0,0),   P0[14],P0[15],P1[0],P1[1],   pw1[2]=PKW(P0,12),pw1[3]=PKW(P0,14), pw1); \
    VRD(2); SBAR(); GAPA(C0=__builtin_amdgcn_mfma_f32_32x32x16_bf16(kf[4],qr[2],C0,0,0,0),   P1[2],P1[3],P1[4],P1[5],     pw2[0]=PKW(P1,0), pw2[1]=PKW(P1,2), pw2); \
    VRD(6); SBAR(); GAPA(C1=__builtin_amdgcn_mfma_f32_32x32x16_bf16(kf[5],qr[2],C1,0,0,0),   P1[6],P1[7],P1[8],P1[9],     pw2[2]=PKW(P1,4), pw2[3]=PKW(P1,6), pw2); \
    VRD(3); SBAR(); GAPA(C0=__builtin_amdgcn_mfma_f32_32x32x16_bf16(kf[6],qr[3],C0,0,0,0),   P1[10],P1[11],P1[12],P1[13], pw3[0]=PKW(P1,8), pw3[1]=PKW(P1,10), pw3); \
    VRD(7); SBAR(); GAPA(C1=__builtin_amdgcn_mfma_f32_32x32x16_bf16(kf[7],qr[3],C1,0,0,0),   P1[14],P1[15],0.f,0.f,       pw3[2]=PKW(P1,12),pw3[3]=PKW(P1,14), pw3); \
    l_reg+=sacc; \
    if(GK){DMA_K((t)+3,sl_cur);} if(GV){DMA_V((t)+1,sl_next);} \
    CMASK(C0,C1,t); \
    const float mh_=(CH)?((mlo!=0u)?mhat:__builtin_inff()):0.f; (void)mh_; \
    SBAR(); \
    GAPB(o[0]=__builtin_amdgcn_mfma_f32_32x32x16_bf16(PAF(0),VFR(0),o[0],0,0,0), C0,12,mlo,CH); \
    GAPB(o[1]=__builtin_amdgcn_mfma_f32_32x32x16_bf16(PAF(0),VFR(4),o[1],0,0,0), C0,8,mlo,CH); \
    KRD(GL,0); GAPB(o[0]=__builtin_amdgcn_mfma_f32_32x32x16_bf16(PAF(1),VFR(1),o[0],0,0,0), C0,4,mlo,CH); \
    KRD(GL,1); GAPB(o[1]=__builtin_amdgcn_mfma_f32_32x32x16_bf16(PAF(1),VFR(5),o[1],0,0,0), C0,0,mlo,CH); \
    KRD(GL,2); GAPB(o[0]=__builtin_amdgcn_mfma_f32_32x32x16_bf16(PAF(2),VFR(2),o[0],0,0,0), C1,12,mhi,CH); \
    KRD(GL,3); GAPB(o[1]=__builtin_amdgcn_mfma_f32_32x32x16_bf16(PAF(2),VFR(6),o[1],0,0,0), C1,8,mhi,CH); \
    GAPB(o[0]=__builtin_amdgcn_mfma_f32_32x32x16_bf16(PAF(3),VFR(3),o[0],0,0,0), C1,4,mhi,CH); \
    GAPB(o[1]=__builtin_amdgcn_mfma_f32_32x32x16_bf16(PAF(3),VFR(7),o[1],0,0,0), C1,0,mhi,CH); \
    }while(0)
  int t=1;
  #undef CMASK
  #define CMASK(P0,P1,t) do{}while(0)
  for(;t+7<NT;t+=2){
    MLOAD(t+1); STEP(pB0,pB1,pA0,pA1,t,true,true,true,MOBA);     WAIT_BAR(2); RESC(); ROT(); MSET(t+1);
    MLOAD(t+2); STEP(pA0,pA1,pB0,pB1,t+1,true,true,true,MOBA);   WAIT_BAR(2); RESC(); ROT(); MSET(t+2);
  }
  #undef CMASK
  #define CMASK(P0,P1,t) do{int jb_=(t)-(NT-6); if(jb_>=0)addbias(P0,P1,jb_,qrel,hi,bt);}while(0)
  #define ENDW(tt) do{ if((tt)+3<NT){WAIT_BAR(2);} else if((tt)+2<NT){WAIT_BAR(1);} else {WAIT_BAR(0);} }while(0)
  for(;t+1<NT;t+=2){
    MLOAD(t+1); STEP(pB0,pB1,pA0,pA1,t,(t+3<NT),(t+1<NT),(t+1<NT),0);       ENDW(t);   RESC(); ROT(); MSET(t+1);
    MLOAD(t+2); STEP(pA0,pA1,pB0,pB1,t+1,(t+4<NT),(t+2<NT),(t+2<NT),0);     ENDW(t+1); RESC(); ROT(); MSET(t+2);
  }
  STEP(pB0,pB1,pA0,pA1,NT-1,false,false,false,0); RESC();
  { float sacc=pB0[0]+pB0[1]; _Pragma("unroll") for(int r=2;r<16;++r)sacc+=pB0[r]; _Pragma("unroll") for(int r=0;r<16;++r)sacc+=pB1[r]; l_reg+=sacc;
    pw0=(u32x4){PKW(pB0,0),PKW(pB0,2),PKW(pB0,4),PKW(pB0,6)};pw1=(u32x4){PKW(pB0,8),PKW(pB0,10),PKW(pB0,12),PKW(pB0,14)};pw2=(u32x4){PKW(pB1,0),PKW(pB1,2),PKW(pB1,4),PKW(pB1,6)};pw3=(u32x4){PKW(pB1,8),PKW(pB1,10),PKW(pB1,12),PKW(pB1,14)};
    SBAR(); pv(o,vb0+sl_cur,PAF(0),PAF(1),PAF(2),PAF(3)); }
  #undef PKW
  #undef PAF
  #undef VFR
  #undef PIN
  #undef MX3
  #undef GAPA
  #undef GAPB
  #undef EX
  #undef VRD
  #undef KRD
  #undef STEP
  #undef ENDW
  {auto rr=__builtin_amdgcn_permlane32_swap(__float_as_uint(l_reg),__float_as_uint(l_reg),false,false);l_reg=__uint_as_float(rr[0])+__uint_as_float(rr[1]);}
  if(hi==0)wsf[32+r32]=l_reg;asm volatile("s_waitcnt lgkmcnt(0)":::"memory");
  float rli[16];
  #pragma unroll
  for(int r=0;r<16;++r)rli[r]=__builtin_amdgcn_rcpf(wsf[32+crow(r,hi)]);
  bf16*Ow=O+(rowbase+q0+wid*QBLK)*DM+h*D;
  { bf16*stg=(bf16*)(shm+LDS_OST)+wid*2048;
    #pragma unroll
    for(int r=0;r<16;++r){const int orow=crow(r,hi);
      #pragma unroll
      for(int d0=0;d0<2;++d0)stg[orow*64+d0*32+r32]=__float2bfloat16(o[d0][r]*rli[r]);}
    asm volatile("s_waitcnt lgkmcnt(0)":::"memory");
    #pragma unroll
    for(int i=0;i<4;++i){const int row=i*8+(lane>>3),ch=lane&7; const u32x4 v=*(const u32x4*)(stg+row*64+ch*8); ATTN_STORE16(Ow+(long)row*DM+ch*8,v);} }
  asm volatile("s_waitcnt lgkmcnt(0)\n\ts_barrier":::"memory");
  #undef MLOAD
  #undef MSET
  #undef DMA_K
  #undef DMA_V
  #undef CMASK
  #undef START
  #undef RESC
  #undef ROT
}
constexpr int ATTN_LDS_BYTES=LDS_BYTES;
#undef SBAR
#undef WAIT_BAR
}

__device__ __forceinline__ float wave_sum_fast(float v) {
#define WS_DPP_(ctrl, rm, bc) v += __int_as_float(__builtin_amdgcn_update_dpp(0, __float_as_int(v), ctrl, rm, 0xf, bc))
    WS_DPP_(0x111, 0xf, true); WS_DPP_(0x112, 0xf, true); WS_DPP_(0x114, 0xf, true); WS_DPP_(0x118, 0xf, true); WS_DPP_(0x142, 0xa, false); WS_DPP_(0x143, 0xc, false);
#undef WS_DPP_
    return __int_as_float(__builtin_amdgcn_readlane(__float_as_int(v), 63));
}
__device__ __forceinline__ int rowmap(int map, int n) {
    if (map == 1) { const int up = n >= 2816; const int j = up ? n - 2816 : n; return 256 * (j >> 7) + (up ? 128 : 0) + (j & 127); }
    if (map == 2) {
        if (n < 3072) { const int part = n >> 9, cc = n & 511, tl = cc >> 8, wc = (cc & 255) >> 6, d = cc & 63; return 256 * (2 * part + tl) + 128 * (d >> 5) + 32 * wc + (d & 31); }
        if (n < 3328) return 256 * 12 + (n - 3072);
        if (n < 3396) return 256 * 13 + (n - 3328);
        if (n < 5444) return 256 * 14 + (n - 3396);
        return 256 * 13 + 68 + (n - 5444);
    }
    if (map == 3) return 1024 + n;
    return n;
}
__device__ __forceinline__ void conv_item(const float* __restrict__ W, int ldw, int N, int Nw, const float* __restrict__ gain, bf16_t* WT, int ldk, int map, int koff, LAS float* scr, int item, int lane) {
    const int nblk = (Nw + 31) >> 5, kb = item / nblk, nb = item % nblk, k0 = 64 * kb, n0 = 32 * nb;
    const int rr = lane >> 3, c4 = (lane & 7) * 4; const bool inb = (n0 + c4) < N;
    f32x4 v[8];
#pragma unroll
    for (int i = 0; i < 8; ++i) v[i] = inb ? *(const GAS f32x4*)(W + (size_t)(k0 + 8 * i + rr) * ldw + n0 + c4) : (f32x4){0.f, 0.f, 0.f, 0.f};
#pragma unroll
    for (int i = 0; i < 8; ++i) { const int kk = 8 * i + rr; const float gk = gain ? gain[k0 + kk] : 1.0f; LAS float* s = scr + kk * 33 + c4;
        s[0] = v[i][0] * gk; s[1] = v[i][1] * gk; s[2] = v[i][2] * gk; s[3] = v[i][3] * gk; }
    LDS_WAIT(); asm volatile("" ::: "memory");
    const int c = lane & 7;
#pragma unroll
    for (int j = 0; j < 4; ++j) { const int n = (lane >> 3) + 8 * j; const LAS float* s = scr + (8 * c) * 33 + n;
        if (n0 + n < Nw) {
            v4u o; o.x = pk2(s[0 * 33], s[1 * 33]); o.y = pk2(s[2 * 33], s[3 * 33]); o.z = pk2(s[4 * 33], s[5 * 33]); o.w = pk2(s[6 * 33], s[7 * 33]);
            *(GAS v4u*)((unsigned char*)WT + pg8::tiled_b_off(rowmap(map, n0 + n), koff + k0 + 8 * c, ldk >> 6)) = o; } }
    LDS_WAIT(); asm volatile("" ::: "memory");
}

struct Args { const float* in[18]; float* out; unsigned char* ws; int ph_lo, ph_hi, li, pad; };
enum { I_X = 0, I_N1, I_GU1, I_DN1, I_NM, I_WIN, I_BG, I_QNA, I_KNA, I_QNB, I_KNB, I_WBA, I_WBB, I_WO, I_N2, I_GU2, I_DN2, I_RB };

__device__ __forceinline__ void p0_prologue(const Args& args, LAS unsigned char* L, int gw, int NGW, int lane, int gtid, int ngt) {
    using namespace K;
    unsigned char* ws = args.ws;
    LAS float* scr = (LAS float*)(L + RING_OFF + (gw & 7) * 16384);
    constexpr int I0 = 16 * 176, I1 = 44 * 32, I2 = 16 * 176, I3 = 8 * 32, I4 = 8 * 32, I5 = 16 * 32;
    constexpr int NITEMS = 2 * I0 + 2 * I1 + I2 + I3 + I4 + I5;
    for (int it = gw; it < NITEMS; it += NGW) {
        int r = it;
        if (r < I0) { conv_item(args.in[I_GU1], 2 * DFF, 2 * DFF, 2 * DFF, args.in[I_N1], (bf16_t*)(ws + WS::GU1), D, 1, 0, scr, r, lane); continue; } r -= I0;
        if (r < I0) { conv_item(args.in[I_GU2], 2 * DFF, 2 * DFF, 2 * DFF, args.in[I_N2], (bf16_t*)(ws + WS::GU2), D, 1, 0, scr, r, lane); continue; } r -= I0;
        if (r < I1) { conv_item(args.in[I_DN1], D, D, D, nullptr, (bf16_t*)(ws + WS::DN1), DFF, 0, 0, scr, r, lane); continue; } r -= I1;
        if (r < I1) { conv_item(args.in[I_DN2], D, D, D, nullptr, (bf16_t*)(ws + WS::DN2), DFF, 0, 0, scr, r, lane); continue; } r -= I1;
        if (r < I2) { conv_item(args.in[I_WIN], DIN, DIN, 5632, args.in[I_NM], (bf16_t*)(ws + WS::WIN), D, 2, 0, scr, r, lane); continue; } r -= I2;
        if (r < I3) { conv_item(args.in[I_WBA], D, D, D, nullptr, (bf16_t*)(ws + WS::WB), D, 0, 0, scr, r, lane); continue; } r -= I3;
        if (r < I4) { conv_item(args.in[I_WBB], D, D, D, nullptr, (bf16_t*)(ws + WS::WB), D, 0, 512, scr, r, lane); continue; } r -= I4;
        conv_item(args.in[I_WO], D, D, D, nullptr, (bf16_t*)(ws + WS::WO), D, 0, 0, scr, r, lane);
    }
    const float* x = args.in[I_X];
    for (int m0 = 2 * gw; m0 < M; m0 += 2 * NGW) {
        f32x4 v[2][4]; float s[2] = {0.f, 0.f};
#pragma unroll
        for (int rr = 0; rr < 2; ++rr) { const GAS f32x4* xr = (const GAS f32x4*)(x + (size_t)(m0 + rr) * D) + lane;
#pragma unroll
            for (int j = 0; j < 4; ++j) v[rr][j] = xr[64 * j]; }
#pragma unroll
        for (int rr = 0; rr < 2; ++rr) {
#pragma unroll
            for (int j = 0; j < 4; ++j) s[rr] += (v[rr][j][0] * v[rr][j][0] + v[rr][j][1] * v[rr][j][1]) + (v[rr][j][2] * v[rr][j][2] + v[rr][j][3] * v[rr][j][3]);
            s[rr] = wave_sum_fast(s[rr]);
            GAS unsigned long long* o8 = (GAS unsigned long long*)(ws + WS::XB + (size_t)(m0 + rr) * D * 2) + lane;
#pragma unroll
            for (int j = 0; j < 4; ++j) o8[64 * j] = (unsigned long long)pk2(v[rr][j][0], v[rr][j][1]) | ((unsigned long long)pk2(v[rr][j][2], v[rr][j][3]) << 32);
            if (lane < 4) { f32x4 q = {lane == 0 ? s[rr] : 0.f, 0.f, 0.f, 0.f}; *((GAS f32x4*)(ws + WS::SSQ + (size_t)(m0 + rr) * 64) + lane) = q; }
        }
    }
}

__global__ void __launch_bounds__(NWAVES * 64, 2) mega(Args args) {
    extern __shared__ __attribute__((aligned(16))) unsigned char lds[];
    using namespace K;
    LAS unsigned char* L = (LAS unsigned char*)lds;
    volatile LAS unsigned* MISC = (volatile LAS unsigned*)(L + MISC_OFF);
    const int tid = threadIdx.x, lane = tid & 63, wave = __builtin_amdgcn_readfirstlane(tid >> 6);
    const int G = gridDim.x, bx = blockIdx.x; const int vcu = (G % 8 == 0) ? (bx % 8) * (G / 8) + bx / 8 : bx;
    unsigned char* ws = args.ws;
    for (int u = tid; u < (LDS_BYTES - LDSCTL_OFF) / 4; u += NWAVES * 64) ((LAS unsigned*)(L + LDSCTL_OFF))[u] = 0u;
    __syncthreads();
    XcdBarrier bar = xcd_barrier_post((unsigned*)(ws + WS::CTL) + CW_BAR + args.li * XCD_BAR_WORDS, MISC + 8);
    const int lo = args.ph_lo, hi = args.ph_hi;
#define IN(k) (lo <= (k) && (k) < hi)
#define SEAM(k) do { if (IN(k) && IN((k) + 1)) xcd_barrier(bar); } while (0)
    bf16_t* XB = (bf16_t*)(ws + WS::XB); bf16_t* ACT = (bf16_t*)(ws + WS::ACT); float* SSQ = (float*)(ws + WS::SSQ);

    if (IN(0)) { p0_prologue(args, L, vcu * NWAVES + wave, G * NWAVES, lane, bx * (NWAVES * 64) + tid, G * NWAVES * 64); SEAM(0); }
    if (IN(1)) {
        pg8::Gemm g{XB, (const bf16_t*)(ws + WS::GU1), M, 2 * DFF, D, D, 1 << 30, 0}; pg8::StaticOrder S; S.init(M, 2 * DFF, G, bx);
        pg8::EpiGu E{ACT, SSQ, (LAS float*)(L + RTAB_OFF)};
        pg8::gemm_phase<pg8::EpiGu, pg8::StaticOrder, true, true>(L + RING_OFF, g, S, E);
        SEAM(1);
    }
    if (IN(2)) {
        pg8::Gemm g{ACT, (const bf16_t*)(ws + WS::DN1), M, D, DFF, DFF, 1 << 30, 0}; pg8::StaticOrder S; S.init(M, D, G, bx);
        pg8::EpiRes<true, false, true> E{args.in[I_X], nullptr, nullptr, XB, SSQ, 0.5f};
        pg8::gemm_phase<pg8::EpiRes<true, false, true>, pg8::StaticOrder, false, true>(L + RING_OFF, g, S, E);
        SEAM(2);
    }
    if (IN(3)) {
        pg8::Gemm g{XB, (const bf16_t*)(ws + WS::WIN), M, 5632, D, D, 1 << 30, 0}; pg8::StaticOrder S; S.init(M, 5632, G, bx);
        pg8::EpiIn E{(bf16_t*)(ws + WS::QO), (bf16_t*)(ws + WS::KB), (bf16_t*)(ws + WS::VB), (bf16_t*)(ws + WS::GATES), (bf16_t*)(ws + WS::QI), (bf16_t*)(ws + WS::KI), (float*)(ws + WS::WI), (float*)(ws + WS::KMEAN), SSQ,
                     args.in[I_BG], args.in[I_QNA], args.in[I_KNA], args.in[I_QNB], args.in[I_KNB], (LAS float*)(L + RTAB_OFF)};
        pg8::gemm_phase<pg8::EpiIn, pg8::StaticOrder, true, true>(L + RING_OFF, g, S, E);
        SEAM(3);
    }
    if (IN(4)) {
        {
#define TK_POS(it_, bb_, tq_) do { bb_ = (it_) >> 8; const int v_ = (it_) & 255, vv_ = (v_ + 128 * (bb_ >> 1)) & 255; tq_ = 16 * ((bb_ & 1) ? 255 - vv_ : vv_); } while (0)
            int bb = 0, tq = -1;
            if (vcu < 1024) { TK_POS(vcu, bb, tq); if (wave == 0 && tq >= TOPK) tk::tk_prefetch_q(L, (const bf16_t*)(ws + WS::QI), (const float*)(ws + WS::WI), bb, tq, lane); }
            for (int blk = vcu; blk < M / 64; blk += G) tk::gating_block(L, (const bf16_t*)(ws + WS::QO), (const float*)(ws + WS::KMEAN), (unsigned*)(ws + WS::BMASK), blk, tid);
            for (int it = vcu; it < 1024; it += G) {
                int nb = 0, ntq = -1; if (it + G < 1024) TK_POS(it + G, nb, ntq);
                tk::topk_group(L, (const bf16_t*)(ws + WS::QI), (const bf16_t*)(ws + WS::KI), (const float*)(ws + WS::WI), (u64*)args.out, bb, tq, nb, ntq, tid, lane, wave);
                bb = nb; tq = ntq;
            }
#undef TK_POS
        }
        SEAM(4);
    }
    if (IN(5)) {
        static_assert(attn_body::ATTN_LDS_BYTES <= RING_BYTES, "attention LDS vs frame");
        const attn_body::bf16* Qp = (const attn_body::bf16*)(ws + WS::QO); const attn_body::bf16* Kp = (const attn_body::bf16*)(ws + WS::KB); const attn_body::bf16* Vp = (const attn_body::bf16*)(ws + WS::VB);
        for (int p = vcu; p < 512; p += G) {
            const int s = p & 7, bh = (p < 256) ? (p >> 3) : (32 + (((p - 256) >> 3) ^ 8));
            if ((bh & 15) >= 8) { for (int k = 0; k < 2; ++k)
                attn_body::attn_unit<8, true>(bh >> 4, bh & 15, k ? s : 15 - s, Qp, Kp, Vp, (attn_body::bf16*)(ws + WS::QO), (const unsigned long long*)args.out, (const unsigned*)(ws + WS::BMASK), args.in[I_RB], args.in[I_QNB], args.in[I_KNB], (char*)lds); }
            else { for (int k = 0; k < 2; ++k)
                attn_body::attn_unit<8, false>(bh >> 4, bh & 15, k ? s : 15 - s, Qp, Kp, Vp, (attn_body::bf16*)(ws + WS::QO), (const unsigned long long*)args.out, (const unsigned*)(ws + WS::BMASK), args.in[I_RB], args.in[I_QNA], args.in[I_KNA], (char*)lds); }
        }
        SEAM(5);
    }
    if (IN(6)) {
        pg8::Gemm g{(const bf16_t*)(ws + WS::QO), (const bf16_t*)(ws + WS::WB), M, D, D, D, 1 << 30, 0}; pg8::StaticOrder S; S.init(M, D, G, bx);
        pg8::EpiBranch2 E{(const bf16_t*)(ws + WS::GATES), (bf16_t*)(ws + WS::GM)};
        pg8::gemm_phase<pg8::EpiBranch2, pg8::StaticOrder, false, true>(L + RING_OFF, g, S, E);
        SEAM(6);
    }
    if (IN(7)) {
        pg8::Gemm g{(const bf16_t*)(ws + WS::GM), (const bf16_t*)(ws + WS::WO), M, D, D, D, 1 << 30, 0}; pg8::StaticOrder S; S.init(M, D, G, bx);
        pg8::EpiRes<false, false, true> E{nullptr, XB, nullptr, XB, SSQ, 1.0f};
        pg8::gemm_phase<pg8::EpiRes<false, false, true>, pg8::StaticOrder, false, true>(L + RING_OFF, g, S, E);
        SEAM(7);
    }
    if (IN(8)) {
        pg8::Gemm g{XB, (const bf16_t*)(ws + WS::GU2), M, 2 * DFF, D, D, 1 << 30, 0}; pg8::StaticOrder S; S.init(M, 2 * DFF, G, bx);
        pg8::EpiGu E{ACT, SSQ, (LAS float*)(L + RTAB_OFF)};
        pg8::gemm_phase<pg8::EpiGu, pg8::StaticOrder, true, true>(L + RING_OFF, g, S, E);
        SEAM(8);
    }
    if (IN(9)) {
        pg8::Gemm g{ACT, (const bf16_t*)(ws + WS::DN2), M, D, DFF, DFF, 1 << 30, 0}; pg8::StaticOrder S; S.init(M, D, G, bx);
        pg8::EpiRes<false, true, false> E{nullptr, XB, args.out, nullptr, nullptr, 0.5f};
        pg8::gemm_phase<pg8::EpiRes<false, true, false>, pg8::StaticOrder, false, true>(L + RING_OFF, g, S, E);
    }
#undef IN
#undef SEAM
}

extern "C" void kernel_launch(void* const* d_in, const int* in_sizes, int n_in, void* d_out, int out_size, void* d_ws, size_t ws_size, hipStream_t stream) {
    using namespace K;
    static int grid = 0;
    if (grid == 0) {
        if (n_in != 18 || in_sizes[0] != M * D || out_size != M * D || ws_size < WS::END) { fprintf(stderr, "kernel_launch: unexpected shapes (n_in %d, in0 %d, out %d, ws %zu)\n", n_in, n_in > 0 ? in_sizes[0] : -1, out_size, ws_size); grid = -1; return; }
        int dev = 0, cus = 0, per_cu = 0;
        if (hipGetDevice(&dev) != hipSuccess || hipDeviceGetAttribute(&cus, hipDeviceAttributeMultiprocessorCount, dev) != hipSuccess) { grid = -1; return; }
        if (hipFuncSetAttribute((const void*)mega, hipFuncAttributeMaxDynamicSharedMemorySize, LDS_BYTES) != hipSuccess) { fprintf(stderr, "kernel_launch: hipFuncSetAttribute failed\n"); grid = -1; return; }
        if (hipOccupancyMaxActiveBlocksPerMultiprocessor(&per_cu, (const void*)mega, NWAVES * 64, LDS_BYTES) != hipSuccess || per_cu < 1) { fprintf(stderr, "kernel_launch: occupancy query says %d blocks/CU\n", per_cu); (void)hipGetLastError(); grid = -1; return; }
        grid = cus;
    }
    if (grid < 0) return;
    const float* const* in = (const float* const*)d_in;
    float* out = (float*)d_out; char* ws = (char*)d_ws;
    (void)hipMemsetAsync(ws + WS::CTL, 0, WS::CTL_ZERO_BYTES, stream);
    Args a{};
    for (int i = 0; i < 18; ++i) a.in[i] = in[i];
    a.out = out; a.ws = (unsigned char*)d_ws; a.pad = 0;
    a.ph_lo = 0; a.ph_hi = 10; a.li = 0;
    hipLaunchKernelGGL(mega, dim3(grid), dim3(NWAVES * 64), LDS_BYTES, stream, a);

}
```

```cpp
#include <hip/hip_runtime.h>
#include <hip/hip_bf16.h>
#include <cstdint>
#include <cstdio>
#include <cmath>

namespace K {
constexpr int B = 4, S = 4096, M = B * S, D = 1024, DFF = 2816, H = 8, HD = 64, NIH = 4, IDIM = 64, TOPK = 256, MBLK = 256, NBLK = 16;
constexpr int DIN = 5444;
constexpr float EPS = 1e-6f;
constexpr float LOG2E = 1.4426950408889634f;
constexpr float C2 = 0.125f * LOG2E;
}
typedef unsigned short bf16_t;
typedef unsigned long long u64;

__device__ __forceinline__ bf16_t f2bf(float f) { unsigned u = __float_as_uint(f); return (bf16_t)((u + 0x7fffu + ((u >> 16) & 1u)) >> 16); }
__device__ __forceinline__ int t5_bucket(int d) {
    if (d < 16) return d;
    int large = 16 + (int)(logf((float)d / 16.0f) / 2.0794415416798357f * 16.0f);
    return large < 31 ? large : 31;
}
namespace pg8 {
#define PG8_LAS __attribute__((address_space(3)))
typedef short bf16x8 __attribute__((ext_vector_type(8)));
typedef float f32x4 __attribute__((ext_vector_type(4)));
typedef unsigned u32x4 __attribute__((ext_vector_type(4)));
constexpr int BM = 256, BK = 64, HALF = 128, HTB = HALF * BK * 2  , STAGE_BYTES = 8 * HTB, NXCD = 8, WGM = 8;

__host__ __device__ __forceinline__ int lds_byte(int r, int c) { const int st = (r >> 4) * 2 + (c >> 5), rr = r & 15, cc = c & 31, ob = rr * 64 + cc * 2; return st * 1024 + (ob ^ (((ob >> 9) & 1) << 5)); }
__host__ __device__ __forceinline__ void stage_rc(int b, int& R, int& C) { const int st = b / 1024, sb = b % 1024, swz = sb ^ (((sb >> 9) & 1) << 5); R = (st >> 1) * 16 + swz / 64; C = (st & 1) * 32 + (swz % 64) / 2; }
__host__ __device__ __forceinline__ int perm32(int rho) { const int n = rho >> 4, i = rho & 15; return 8 * (i >> 2) + 4 * n + (i & 3); }

__host__ __device__ __forceinline__ size_t tiled_b_off(int nrow, int k, int nkt) {
    const int ht = nrow >> 7, rb = nrow & 127, c = rb & 31, rho = ((c >> 2) & 1) * 16 + ((c >> 3) << 2) + (c & 3), R = (rb & ~31) + rho;
    return ((size_t)ht * nkt + (k >> 6)) * (size_t)(HALF * BK * 2) + (size_t)lds_byte(R, k & 63);
}
struct Unit { int pm, pn; };
struct Gemm { const bf16_t* A; const bf16_t* Bt; int M, N, K, lda, asplit_pn, asplit_off; };

struct StaticOrder {
    int nM, nN, nwg, G, c;
    __host__ __device__ void init(int M, int N, int G_, int c_) { nM = M / BM; nN = N / BM; nwg = nM * nN; G = G_; c = c_; }
    __host__ __device__ bool next(int i, Unit& u) const {
        const long L = (long)i * G + c; if (L >= nwg) return false;
        int wgid = (int)L; { const int q = nwg / NXCD, r = nwg % NXCD, xcd = wgid % NXCD, off = wgid / NXCD; wgid = (xcd < r ? xcd * (q + 1) : r * (q + 1) + (xcd - r) * q) + off; }
        const int nig = WGM * nN, gid = wgid / nig, fm = gid * WGM, gsz = (nM - fm) < WGM ? (nM - fm) : WGM;
        u.pm = fm + ((wgid % nig) % gsz); u.pn = (wgid % nig) / gsz; return true;
    }
    __device__ __forceinline__ void a_ready(const Unit&) const {}
    __device__ __forceinline__ void done(const Unit&) const {}
};


typedef float f32x2_t __attribute__((ext_vector_type(2))); typedef __bf16 bf16x2_t __attribute__((ext_vector_type(2)));
__device__ __forceinline__ unsigned cvt_pk_bf16(float lo, float hi) { f32x2_t v = {lo, hi}; bf16x2_t b = __builtin_convertvector(v, bf16x2_t); return __builtin_bit_cast(unsigned, b); }
__device__ __forceinline__ float row_rstd(const float* __restrict__ ssq, int row) {
    const f32x4* p = (const f32x4*)(ssq + (size_t)row * 16);
    const f32x4 a = p[0], b = p[1], c = p[2], d = p[3];
    const float s = (((a[0] + a[1]) + (a[2] + a[3])) + ((b[0] + b[1]) + (b[2] + b[3]))) + (((c[0] + c[1]) + (c[2] + c[3])) + ((d[0] + d[1]) + (d[2] + d[3])));
    return 1.0f / sqrtf(s * (1.0f / 1024.0f) + 1e-6f);
}
__device__ __forceinline__ void rstd_stage(const float* __restrict__ ssq, PG8_LAS float* tab, int pm, int wr, int fr, int fq) {
    const int l = fq * 16 + fr;
    tab[l] = row_rstd(ssq, pm * BM + wr * 64 + l);
    tab[64 + l] = row_rstd(ssq, pm * BM + HALF + wr * 64 + l);
    asm volatile("s_waitcnt lgkmcnt(0)" ::: "memory");
}
__device__ __forceinline__ float xrow_sum4(float v) {
    { auto r = __builtin_amdgcn_permlane16_swap(__float_as_uint(v), __float_as_uint(v), false, false); v = __uint_as_float(r[0]) + __uint_as_float(r[1]); }
    { auto r = __builtin_amdgcn_permlane32_swap(__float_as_uint(v), __float_as_uint(v), false, false); v = __uint_as_float(r[0]) + __uint_as_float(r[1]); }
    return v;
}
__device__ __forceinline__ float silu_f(float g) { return g * __builtin_amdgcn_rcpf(1.0f + __builtin_amdgcn_exp2f(-1.4426950408889634f * g)); }
__device__ __forceinline__ float sigmoid_f(float g) { return __builtin_amdgcn_rcpf(1.0f + __builtin_amdgcn_exp2f(-1.4426950408889634f * g)); }

struct EpiGu {
    static constexpr bool PERM = true, AFTER_DRAIN = false, HAS_MID = false;
    bf16_t* act; const float* ssq; PG8_LAS float* rtab;
    __device__ __forceinline__ void operator()(const f32x4 (&acc)[2][2][4][2], const Unit& u, int wr, int wc, int fr, int fq) const {
        asm volatile("" : "+v"(fr), "+v"(fq));
        const int row0 = u.pm * BM + wr * 64 + fr, col0 = u.pn * 128 + wc * 32 + 8 * fq;
        PG8_LAS float* tab = rtab + (wr * 4 + wc) * 128; rstd_stage(ssq, tab, u.pm, wr, fr, fq);
#pragma unroll
        for (int ai = 0; ai < 2; ++ai)
#pragma unroll
            for (int m = 0; m < 4; ++m) {
                const int row = row0 + ai * HALF + m * 16; const float rs = tab[64 * ai + 16 * m + fr];
                float o[8];
#pragma unroll
                for (int n = 0; n < 2; ++n)
#pragma unroll
                    for (int i = 0; i < 4; ++i) o[n * 4 + i] = silu_f(acc[ai][0][m][n][i] * rs) * (acc[ai][1][m][n][i] * rs);
                u32x4 w; w.x = cvt_pk_bf16(o[0], o[1]); w.y = cvt_pk_bf16(o[2], o[3]); w.z = cvt_pk_bf16(o[4], o[5]); w.w = cvt_pk_bf16(o[6], o[7]);
                *(u32x4*)(act + (size_t)row * 2816 + col0) = w;
            }
    }
};
template <bool RIN32, bool OUT32, bool STATS> struct EpiRes {
    static constexpr bool PERM = true, AFTER_DRAIN = false, HAS_MID = false;
    const float* hin32; const bf16_t* hin16; float* hout; bf16_t* hb; float* ssq; float scale;
    __device__ __forceinline__ void operator()(const f32x4 (&acc)[2][2][4][2], const Unit& u, int wr, int wc, int fr, int fq) const {
        asm volatile("" : "+v"(fr), "+v"(fq));
        const int row0 = u.pm * BM + wr * 64 + fr, col0 = u.pn * BM + wc * 32 + 8 * fq;
#pragma unroll
        for (int ai = 0; ai < 2; ++ai)
#pragma unroll
            for (int m = 0; m < 4; ++m) {
                const int row = row0 + ai * HALF + m * 16; float ss = 0.f;
#pragma unroll
                for (int bj = 0; bj < 2; ++bj) {
                    const size_t off = (size_t)row * 1024 + col0 + bj * HALF;
                    f32x4 r0, r1;
                    if (RIN32) { r0 = *(const f32x4*)(hin32 + off); r1 = *(const f32x4*)(hin32 + off + 4); }
                    else { const u32x4 rw = *(const u32x4*)(hin16 + off);
                        r0 = (f32x4){__uint_as_float(rw.x << 16), __uint_as_float(rw.x & 0xffff0000u), __uint_as_float(rw.y << 16), __uint_as_float(rw.y & 0xffff0000u)};
                        r1 = (f32x4){__uint_as_float(rw.z << 16), __uint_as_float(rw.z & 0xffff0000u), __uint_as_float(rw.w << 16), __uint_as_float(rw.w & 0xffff0000u)}; }
                    const f32x4 v0 = r0 + acc[ai][bj][m][0] * scale, v1 = r1 + acc[ai][bj][m][1] * scale;
                    if (OUT32) { *(f32x4*)(hout + off) = v0; *(f32x4*)(hout + off + 4) = v1; }
                    if (STATS) {
                        u32x4 w; w.x = cvt_pk_bf16(v0[0], v0[1]); w.y = cvt_pk_bf16(v0[2], v0[3]); w.z = cvt_pk_bf16(v1[0], v1[1]); w.w = cvt_pk_bf16(v1[2], v1[3]);
                        *(u32x4*)(hb + off) = w;
                        ss += (v0[0] * v0[0] + v0[1] * v0[1]) + (v0[2] * v0[2] + v0[3] * v0[3]) + (v1[0] * v1[0] + v1[1] * v1[1]) + (v1[2] * v1[2] + v1[3] * v1[3]);
                    }
                }
                if (STATS) { ss = xrow_sum4(ss); if (fq == 0) ssq[(size_t)row * 16 + u.pn * 4 + wc] = ss; }
            }
    }
};
struct EpiIn {
    static constexpr bool PERM = true, AFTER_DRAIN = false, HAS_MID = false;
    bf16_t *QO, *KB, *VB, *GATES, *QI, *KI; float* WI; float* KMEAN; const float* ssq; const float* bgate; const float *qn_a, *kn_a, *qn_b, *kn_b; PG8_LAS float* rtab;
    template <int KIND, bool MOBA> __device__ __forceinline__ void qkv(const f32x4 (&acc)[2][2][4][2], const Unit& u, int wr, int wc, int fr, int fq, PG8_LAS float* tab, bf16_t* base, const float* gn) const {
        const int row0 = u.pm * BM + wr * 64 + fr, head = 4 * (u.pn & 1) + wc;
        bf16_t* dst = base + (MOBA ? 512 : 0) + head * 64 + 8 * fq;
        f32x4 gv[2][2];
#pragma unroll
        for (int bj = 0; bj < 2; ++bj)
#pragma unroll
            for (int n = 0; n < 2; ++n) gv[bj][n] = (KIND < 2) ? *(const f32x4*)(gn + 32 * bj + 8 * fq + 4 * n) : (f32x4){1.f, 1.f, 1.f, 1.f};
        constexpr bool km = (KIND == 1) && MOBA;
        f32x4 ks[2][2];
#pragma unroll
        for (int bj = 0; bj < 2; ++bj)
#pragma unroll
            for (int n = 0; n < 2; ++n) ks[bj][n] = (f32x4){0.f, 0.f, 0.f, 0.f};
#pragma unroll
        for (int ai = 0; ai < 2; ++ai)
#pragma unroll
            for (int m = 0; m < 4; ++m) {
                const int row = row0 + ai * HALF + m * 16; const float rs = tab[64 * ai + 16 * m + fr];
                f32x4 v[2][2]; float ss = 0.f;
#pragma unroll
                for (int bj = 0; bj < 2; ++bj)
#pragma unroll
                    for (int n = 0; n < 2; ++n) { v[bj][n] = acc[ai][bj][m][n] * rs; ss += (v[bj][n][0] * v[bj][n][0] + v[bj][n][1] * v[bj][n][1]) + (v[bj][n][2] * v[bj][n][2] + v[bj][n][3] * v[bj][n][3]); }
                if (KIND < 2) {
                    ss = xrow_sum4(ss);
                    float r = 1.0f / sqrtf(ss * (1.0f / 64.0f) + 1e-6f); if (KIND == 0) r *= K::C2;
#pragma unroll
                    for (int bj = 0; bj < 2; ++bj)
#pragma unroll
                        for (int n = 0; n < 2; ++n) v[bj][n] = v[bj][n] * gv[bj][n] * r;
                }
#pragma unroll
                for (int bj = 0; bj < 2; ++bj) {
                    u32x4 w; w.x = cvt_pk_bf16(v[bj][0][0], v[bj][0][1]); w.y = cvt_pk_bf16(v[bj][0][2], v[bj][0][3]); w.z = cvt_pk_bf16(v[bj][1][0], v[bj][1][1]); w.w = cvt_pk_bf16(v[bj][1][2], v[bj][1][3]);
                    *(u32x4*)(dst + (size_t)row * 1024 + 32 * bj) = w;
                    if (km) { ks[bj][0] += v[bj][0]; ks[bj][1] += v[bj][1]; }
                }
                if (km) asm volatile("" : "+v"(ks[0][0]), "+v"(ks[0][1]), "+v"(ks[1][0]), "+v"(ks[1][1]));
                asm volatile("" ::: "memory");
            }
        if (km) {
            float* kd = KMEAN + ((size_t)u.pm * 8 + head) * 64 + 8 * fq;
#pragma unroll
            for (int bj = 0; bj < 2; ++bj)
#pragma unroll
                for (int n = 0; n < 2; ++n)
#pragma unroll
                    for (int i = 0; i < 4; ++i) { float s = ks[bj][n][i]; s += __shfl_xor(s, 1); s += __shfl_xor(s, 2); s += __shfl_xor(s, 4); s += __shfl_xor(s, 8);
                        if (fr == 0) atomicAdd(kd + 32 * bj + 4 * n + i, s); }
        }
    }
    __device__ __forceinline__ void operator()(const f32x4 (&acc)[2][2][4][2], const Unit& u, int wr, int wc, int fr, int fq) const {
        asm volatile("" : "+v"(fr), "+v"(fq));
        const int pn = u.pn, row0 = u.pm * BM + wr * 64 + fr;
        PG8_LAS float* tab = rtab + (wr * 4 + wc) * 128; rstd_stage(ssq, tab, u.pm, wr, fr, fq);
        if (pn < 2) qkv<0, false>(acc, u, wr, wc, fr, fq, tab, QO, qn_a);
        else if (pn < 4) qkv<1, false>(acc, u, wr, wc, fr, fq, tab, KB, kn_a);
        else if (pn < 6) qkv<2, false>(acc, u, wr, wc, fr, fq, tab, VB, nullptr);
        else if (pn < 8) qkv<0, true>(acc, u, wr, wc, fr, fq, tab, QO, qn_b);
        else if (pn < 10) qkv<1, true>(acc, u, wr, wc, fr, fq, tab, KB, kn_b);
        else if (pn < 12) qkv<2, true>(acc, u, wr, wc, fr, fq, tab, VB, nullptr);
        else if (pn == 12) {
#pragma unroll
            for (int ai = 0; ai < 2; ++ai)
#pragma unroll
                for (int m = 0; m < 4; ++m) { const int row = row0 + ai * HALF + m * 16; const float rs = tab[64 * ai + 16 * m + fr];
#pragma unroll
                    for (int bj = 0; bj < 2; ++bj) { const f32x4 a = acc[ai][bj][m][0] * rs, b = acc[ai][bj][m][1] * rs;
                        u32x4 w; w.x = cvt_pk_bf16(a[0], a[1]); w.y = cvt_pk_bf16(a[2], a[3]); w.z = cvt_pk_bf16(b[0], b[1]); w.w = cvt_pk_bf16(b[2], b[3]);
                        *(u32x4*)(QI + (size_t)row * 256 + 128 * bj + 32 * wc + 8 * fq) = w; } }
        } else if (pn == 13) {
#pragma unroll
            for (int ai = 0; ai < 2; ++ai)
#pragma unroll
                for (int m = 0; m < 4; ++m) { const int row = row0 + ai * HALF + m * 16; const float rs = tab[64 * ai + 16 * m + fr];
                    const f32x4 a = acc[ai][0][m][0] * rs, b = acc[ai][0][m][1] * rs;
                    if (wc < 2) { u32x4 w; w.x = cvt_pk_bf16(a[0], a[1]); w.y = cvt_pk_bf16(a[2], a[3]); w.z = cvt_pk_bf16(b[0], b[1]); w.w = cvt_pk_bf16(b[2], b[3]);
                        *(u32x4*)(KI + (size_t)row * 64 + 32 * wc + 8 * fq) = w; }
                    else if (wc == 2 && fq == 0) *(f32x4*)(WI + (size_t)row * 4) = a * 0.5f; }
        } else {
            const int cg0 = 256 * (pn - 14) + 32 * wc + 8 * fq;
            f32x4 bv[2][2];
#pragma unroll
            for (int bj = 0; bj < 2; ++bj)
#pragma unroll
                for (int n = 0; n < 2; ++n) bv[bj][n] = *(const f32x4*)(bgate + cg0 + 128 * bj + 4 * n);
#pragma unroll
            for (int ai = 0; ai < 2; ++ai)
#pragma unroll
                for (int m = 0; m < 4; ++m) { const int row = row0 + ai * HALF + m * 16; const float rs = tab[64 * ai + 16 * m + fr];
#pragma unroll
                    for (int bj = 0; bj < 2; ++bj) { const f32x4 a = acc[ai][bj][m][0] * rs + bv[bj][0], b = acc[ai][bj][m][1] * rs + bv[bj][1];
                        u32x4 w; w.x = cvt_pk_bf16(sigmoid_f(a[0]), sigmoid_f(a[1])); w.y = cvt_pk_bf16(sigmoid_f(a[2]), sigmoid_f(a[3])); w.z = cvt_pk_bf16(sigmoid_f(b[0]), sigmoid_f(b[1])); w.w = cvt_pk_bf16(sigmoid_f(b[2]), sigmoid_f(b[3]));
                        *(u32x4*)(GATES + (size_t)row * 2048 + cg0 + 128 * bj) = w; } }
        }
    }
};
struct EpiBranch2 {
    static constexpr bool PERM = true, AFTER_DRAIN = false, HAS_MID = true;
    const bf16_t* gates; bf16_t* mx;
    __device__ __forceinline__ void mid(f32x4 (&acc)[2][2][4][2], const Unit& u, int wr, int wc, int fr, int fq) const {
        asm volatile("" : "+v"(fr), "+v"(fq));
        const int row0 = u.pm * BM + wr * 64 + fr, col0 = u.pn * BM + wc * 32 + 8 * fq;
#pragma unroll
        for (int ai = 0; ai < 2; ++ai)
#pragma unroll
            for (int m = 0; m < 4; ++m) {
                const int row = row0 + ai * HALF + m * 16;
#pragma unroll
                for (int bj = 0; bj < 2; ++bj) {
                    const size_t off = (size_t)row * 2048 + col0 + bj * HALF;
                    const u32x4 ga = *(const u32x4*)(gates + off), gb = *(const u32x4*)(gates + off + 1024);
                    float r[8];
#pragma unroll
                    for (int x = 0; x < 4; ++x) {
                        r[2 * x] = __uint_as_float(ga[x] << 16) * __builtin_amdgcn_rcpf(__builtin_fmaxf(__uint_as_float(gb[x] << 16), 1e-30f));
                        r[2 * x + 1] = __uint_as_float(ga[x] & 0xffff0000u) * __builtin_amdgcn_rcpf(__builtin_fmaxf(__uint_as_float(gb[x] & 0xffff0000u), 1e-30f)); }
                    acc[ai][bj][m][0] = acc[ai][bj][m][0] * (f32x4){r[0], r[1], r[2], r[3]};
                    acc[ai][bj][m][1] = acc[ai][bj][m][1] * (f32x4){r[4], r[5], r[6], r[7]};
                }
                asm volatile("" ::: "memory");
            }
    }
    __device__ __forceinline__ void operator()(const f32x4 (&acc)[2][2][4][2], const Unit& u, int wr, int wc, int fr, int fq) const {
        asm volatile("" : "+v"(fr), "+v"(fq));
        const int row0 = u.pm * BM + wr * 64 + fr, col0 = u.pn * BM + wc * 32 + 8 * fq;
#pragma unroll
        for (int ai = 0; ai < 2; ++ai)
#pragma unroll
            for (int m = 0; m < 4; ++m) {
                const int row = row0 + ai * HALF + m * 16;
#pragma unroll
                for (int bj = 0; bj < 2; ++bj) {
                    const u32x4 gw = *(const u32x4*)(gates + (size_t)row * 2048 + 1024 + col0 + bj * HALF);
                    const f32x4 a = acc[ai][bj][m][0], b = acc[ai][bj][m][1];
                    u32x4 w;
                    w.x = cvt_pk_bf16(a[0] * __builtin_fmaxf(__uint_as_float(gw.x << 16), 1e-30f), a[1] * __builtin_fmaxf(__uint_as_float(gw.x & 0xffff0000u), 1e-30f));
                    w.y = cvt_pk_bf16(a[2] * __builtin_fmaxf(__uint_as_float(gw.y << 16), 1e-30f), a[3] * __builtin_fmaxf(__uint_as_float(gw.y & 0xffff0000u), 1e-30f));
                    w.z = cvt_pk_bf16(b[0] * __builtin_fmaxf(__uint_as_float(gw.z << 16), 1e-30f), b[1] * __builtin_fmaxf(__uint_as_float(gw.z & 0xffff0000u), 1e-30f));
                    w.w = cvt_pk_bf16(b[2] * __builtin_fmaxf(__uint_as_float(gw.w << 16), 1e-30f), b[3] * __builtin_fmaxf(__uint_as_float(gw.w & 0xffff0000u), 1e-30f));
                    *(u32x4*)(mx + (size_t)row * 1024 + col0 + bj * HALF) = w;
                }
                asm volatile("" ::: "memory");
            }
    }
};
template <class Epi, class Sched, bool ALIGN_EPI = false, bool SP2 = false>
__device__ __forceinline__ void gemm_phase(PG8_LAS unsigned char* lds, const Gemm g, const Sched& S, const Epi& E) {
    const int tid = threadIdx.x, wid = __builtin_amdgcn_readfirstlane(tid >> 6), lane = tid & 63, wr = wid >> 2, wc = wid & 3, fr = lane & 15, fq = lane >> 4;
    const int K = g.K, nt = K / BK;
    unsigned voffA[2], voffB[2];
#pragma unroll
    for (int i = 0; i < 2; ++i) { int R, C; stage_rc(tid * 16 + i * 8192, R, C); const int Rb = Epi::PERM ? ((R & ~31) + perm32(R & 31)) : R;
        voffA[i] = (unsigned)(R * g.lda + C) * 2u; voffB[i] = (unsigned)(tid * 16 + i * 8192); (void)Rb; }
    const size_t kstep = (size_t)(BK * 2), kstepB = (size_t)HTB;
    const size_t hstepA = (size_t)HALF * g.lda * 2, hstepB = (size_t)nt * kstepB;
    const size_t tstepA = 2 * hstepA, tstepB = 2 * hstepB;
#define PG8_ABASE(u_) ((const char*)g.A + (size_t)(u_).pm * tstepA + (((u_).pn >= g.asplit_pn) ? (size_t)g.asplit_off : (size_t)0))
    const unsigned ldsw = (unsigned)wid * 1024u;
    const int aoff = lds_byte(wr * 64 + fr, fq * 8), boff = lds_byte(wc * 32 + fr, fq * 8);
#define PG8_SA(b, h) (((b) * 2 + (h)) * HTB)
#define PG8_SB(b, h) ((4 + (b) * 2 + (h)) * HTB)
#define PG8_STAGE(bufoff, gbase, voff) do { _Pragma("unroll") for (int _i = 0; _i < 2; ++_i) \
        __builtin_amdgcn_global_load_lds((const unsigned*)((const char*)(gbase) + (voff)[_i]), (PG8_LAS unsigned*)(lds + (bufoff) + ldsw + _i * 8192), 16, 0, 0); } while (0)
#define PG8_LDA(dst, b, h) do { _Pragma("unroll") for (int m = 0; m < 4; ++m) _Pragma("unroll") for (int k = 0; k < 2; ++k) dst[m][k] = *(const PG8_LAS bf16x8*)(lds + PG8_SA(b, h) + aoff + m * 2048 + k * 1024); } while (0)
#define PG8_LDB(dst, b, h) do { _Pragma("unroll") for (int n = 0; n < 2; ++n) _Pragma("unroll") for (int k = 0; k < 2; ++k) dst[n][k] = *(const PG8_LAS bf16x8*)(lds + PG8_SB(b, h) + boff + n * 2048 + k * 1024); } while (0)
#define PG8_MMA(ai, bj, At, Bt) do { __builtin_amdgcn_s_setprio(1); _Pragma("unroll") for (int m = 0; m < 4; ++m) _Pragma("unroll") for (int n = 0; n < 2; ++n) _Pragma("unroll") for (int k = 0; k < 2; ++k) \
        acc[ai][bj][m][n] = __builtin_amdgcn_mfma_f32_16x16x32_bf16(Bt[n][k], At[m][k], acc[ai][bj][m][n], 0, 0, 0); __builtin_amdgcn_s_setprio(0); } while (0)
#define PG8_WAIT_V(n) asm volatile("s_waitcnt vmcnt(" #n ")" ::: "memory")
#define PG8_WAIT_L(n) asm volatile("s_waitcnt lgkmcnt(" #n ")" ::: "memory")
#define PG8_BAR __builtin_amdgcn_s_barrier()
#define PG8_SCHED __builtin_amdgcn_sched_barrier(0)
    Unit cur, nxt; int ui = 0;
    if (!S.next(0, cur)) return;
    f32x4 acc[2][2][4][2];
#pragma unroll
    for (int a = 0; a < 2; ++a)
#pragma unroll
        for (int b = 0; b < 2; ++b)
#pragma unroll
            for (int m = 0; m < 4; ++m)
#pragma unroll
                for (int n = 0; n < 2; ++n) acc[a][b][m][n] = (f32x4){0.f, 0.f, 0.f, 0.f};
    bf16x8 At[4][2], B0[2][2], B1[2][2];
    const char* cA = PG8_ABASE(cur); const char* cB = (const char*)g.Bt + (size_t)cur.pn * tstepB;
    S.a_ready(cur);
    if constexpr (SP2) {
        PG8_STAGE(PG8_SB(0, 0), cB, voffB); PG8_STAGE(PG8_SB(0, 1), cB + hstepB, voffB); PG8_STAGE(PG8_SA(0, 0), cA, voffA); PG8_STAGE(PG8_SA(0, 1), cA + hstepA, voffA);
        PG8_STAGE(PG8_SB(1, 0), cB + kstepB, voffB); PG8_STAGE(PG8_SA(1, 0), cA + kstep, voffA); PG8_STAGE(PG8_SB(1, 1), cB + hstepB + kstepB, voffB);
        if (wr == 1) PG8_BAR;
        PG8_WAIT_V(8); PG8_BAR;
        PG8_WAIT_V(6); PG8_BAR;
    } else {
        PG8_STAGE(PG8_SB(0, 0), cB, voffB); PG8_STAGE(PG8_SA(0, 0), cA, voffA); PG8_STAGE(PG8_SB(0, 1), cB + hstepB, voffB); PG8_STAGE(PG8_SA(0, 1), cA + hstepA, voffA);
        if (wr == 1) PG8_BAR;
        PG8_WAIT_V(4); PG8_BAR;
        PG8_STAGE(PG8_SB(1, 0), cB + kstepB, voffB); PG8_STAGE(PG8_SA(1, 0), cA + kstep, voffA); PG8_STAGE(PG8_SB(1, 1), cB + hstepB + kstepB, voffB);
        PG8_WAIT_V(6); PG8_BAR;
    }
    for (;;) {
        const bool has_next = S.next(ui + 1, nxt);
        const char* nA = has_next ? PG8_ABASE(nxt) : cA; const char* nB = has_next ? (const char*)g.Bt + (size_t)nxt.pn * tstepB : cB;
        for (int t = 0; t < nt; t += 2) {
            const bool last = (t == nt - 2);
            const char* a1 = cA + (size_t)(t + 1) * kstep;
            const char* a2 = last ? nA : cA + (size_t)(t + 2) * kstep; const char* b2 = last ? nB : cB + (size_t)(t + 2) * kstepB;
            const char* a3 = a2 + kstep; const char* b3 = b2 + kstepB;
            if (last && has_next) S.a_ready(nxt);
            if constexpr (SP2) {
            PG8_LDB(B0, 0, 0); PG8_LDB(B1, 0, 1); PG8_SCHED; PG8_LDA(At, 0, 0); PG8_STAGE(PG8_SA(1, 1), a1 + hstepA, voffA);
            PG8_WAIT_V(8); PG8_WAIT_L(0); PG8_BAR; PG8_MMA(0, 0, At, B0); PG8_MMA(0, 1, At, B1); PG8_BAR; PG8_SCHED;
            PG8_LDA(At, 0, 1); PG8_STAGE(PG8_SB(0, 0), b2, voffB); PG8_STAGE(PG8_SB(0, 1), b2 + hstepB, voffB); PG8_STAGE(PG8_SA(0, 0), a2, voffA);
            PG8_WAIT_V(8); PG8_WAIT_L(0); PG8_BAR; PG8_MMA(1, 0, At, B0); PG8_MMA(1, 1, At, B1); PG8_BAR; PG8_SCHED;
            PG8_LDB(B0, 1, 0); PG8_LDB(B1, 1, 1); PG8_SCHED; PG8_LDA(At, 1, 0); PG8_STAGE(PG8_SA(0, 1), a2 + hstepA, voffA);
            PG8_WAIT_V(8); PG8_WAIT_L(0); PG8_BAR; PG8_MMA(0, 0, At, B0); PG8_MMA(0, 1, At, B1); PG8_BAR; PG8_SCHED;
            PG8_LDA(At, 1, 1); PG8_STAGE(PG8_SB(1, 0), b3, voffB); PG8_STAGE(PG8_SB(1, 1), b3 + hstepB, voffB); PG8_STAGE(PG8_SA(1, 0), a3, voffA);
            PG8_WAIT_V(8); PG8_WAIT_L(0); PG8_BAR; PG8_MMA(1, 0, At, B0); PG8_MMA(1, 1, At, B1); PG8_BAR; PG8_SCHED;
            } else {
            PG8_LDB(B0, 0, 0); PG8_SCHED; PG8_LDA(At, 0, 0); PG8_STAGE(PG8_SA(1, 1), a1 + hstepA, voffA);
            PG8_WAIT_L(8); PG8_BAR; PG8_WAIT_L(0); PG8_MMA(0, 0, At, B0); PG8_BAR; PG8_SCHED;
            PG8_LDB(B1, 0, 1); PG8_STAGE(PG8_SB(0, 0), b2, voffB);
            PG8_BAR; PG8_WAIT_L(0); PG8_MMA(0, 1, At, B1); PG8_BAR;
            PG8_LDA(At, 0, 1); PG8_STAGE(PG8_SA(0, 0), a2, voffA);
            PG8_BAR; PG8_WAIT_L(0); PG8_MMA(1, 0, At, B0); PG8_BAR; PG8_SCHED;
            PG8_STAGE(PG8_SB(0, 1), b2 + hstepB, voffB);
            PG8_WAIT_V(6); PG8_BAR; PG8_MMA(1, 1, At, B1); PG8_BAR;
            PG8_LDB(B0, 1, 0); PG8_SCHED; PG8_LDA(At, 1, 0); PG8_STAGE(PG8_SA(0, 1), a2 + hstepA, voffA);
            PG8_WAIT_L(8); PG8_BAR; PG8_WAIT_L(0); PG8_MMA(0, 0, At, B0); PG8_BAR; PG8_SCHED;
            PG8_LDB(B1, 1, 1); PG8_STAGE(PG8_SB(1, 0), b3, voffB);
            PG8_BAR; PG8_WAIT_L(0); PG8_MMA(0, 1, At, B1); PG8_BAR;
            PG8_LDA(At, 1, 1); PG8_STAGE(PG8_SA(1, 0), a3, voffA);
            PG8_BAR; PG8_WAIT_L(0); PG8_MMA(1, 0, At, B0); PG8_BAR; PG8_SCHED;
            PG8_STAGE(PG8_SB(1, 1), b3 + hstepB, voffB);
            PG8_WAIT_V(6); PG8_BAR; PG8_MMA(1, 1, At, B1); PG8_BAR;
            }
            if constexpr (Epi::HAS_MID) { if (t + 2 == nt / 2) E.mid(acc, cur, wr, wc, fr, fq); }
        }
        if constexpr (ALIGN_EPI) { if (wr == 0) PG8_BAR; }
        if constexpr (!Epi::AFTER_DRAIN) { E(acc, cur, wr, wc, fr, fq); S.done(cur); }
        if (!has_next) break;
#pragma unroll
        for (int a = 0; a < 2; ++a)
#pragma unroll
            for (int b = 0; b < 2; ++b)
#pragma unroll
                for (int m = 0; m < 4; ++m)
#pragma unroll
                    for (int n = 0; n < 2; ++n) acc[a][b][m][n] = (f32x4){0.f, 0.f, 0.f, 0.f};
        cur = nxt; cA = nA; cB = nB; ++ui;
        if constexpr (ALIGN_EPI) { if (wr == 1) PG8_BAR; }
    }
    PG8_WAIT_V(0);
    if constexpr (!ALIGN_EPI) { if (wr == 0) PG8_BAR; }
    PG8_BAR;
    if constexpr (Epi::AFTER_DRAIN) { E.fused(acc, cur, wr, wc, fr, fq, lds, wid, lane); S.done(cur); }
#undef PG8_ABASE
#undef PG8_SA
#undef PG8_SB
#undef PG8_STAGE
#undef PG8_LDA
#undef PG8_LDB
#undef PG8_MMA
#undef PG8_WAIT_V
#undef PG8_WAIT_L
#undef PG8_BAR
#undef PG8_SCHED
}
}

constexpr int NWAVES = 8;
namespace WS {
constexpr size_t MiB = 1u << 20;
constexpr size_t CTL = 0, CTL_ZERO_BYTES = 1 * MiB;
constexpr size_t KMEAN = 512 * 1024;
constexpr size_t SSQ = 1 * MiB;
constexpr size_t GU1 = 2 * MiB, DN1 = 13 * MiB, WIN = 19 * MiB, WB = 30 * MiB, WO = 32 * MiB, GU2 = 36 * MiB, DN2 = 47 * MiB;
constexpr size_t XB = 53 * MiB;
constexpr size_t QO = 85 * MiB, KB = 117 * MiB, VB = 149 * MiB;
constexpr size_t GATES = 181 * MiB;
constexpr size_t QI = 245 * MiB, KI = 253 * MiB, WI = 255 * MiB, BMASK = 255 * MiB + 256 * 1024;
constexpr size_t ACT = 85 * MiB;
constexpr size_t GM = 117 * MiB;
constexpr size_t END = 256 * MiB;
}
constexpr int CW_BAR = 4096;
constexpr int RING_OFF = 0, RING_BYTES = 131072;
constexpr int LDSCTL_OFF = RING_BYTES, MISC_OFF = LDSCTL_OFF + 320;
constexpr int RTAB_OFF = LDSCTL_OFF + 1024;
constexpr int LDS_BYTES = 147456;

#define GAS __attribute__((address_space(1)))
#define LAS __attribute__((address_space(3)))
typedef unsigned v4u __attribute__((ext_vector_type(4)));
typedef float f32x4 __attribute__((ext_vector_type(4)));
typedef GAS unsigned gu32;
#define LDS_WAIT() asm volatile("s_waitcnt lgkmcnt(0)" ::: "memory")
#define VM_WAIT() asm volatile("s_waitcnt vmcnt(0)" ::: "memory")
__device__ __forceinline__ unsigned pk2(float lo, float hi) { return (unsigned)f2bf(lo) | ((unsigned)f2bf(hi) << 16); }
#define XB_TMO      128
#define XB_XCNT(j)  (256  + 64 * (j))
#define XB_XSUB(j)  (1280 + 64 * (j))
#define XB_XGEN(j)  (2304 + 64 * (j))
#define XB_TOP      3328
#define XB_TOPGEN   3392
#define XCD_BAR_WORDS 3456
#define XB_SPIN_CAP (1u << 18)

__device__ __forceinline__ unsigned xb_ld(unsigned* p)              { return __hip_atomic_load(p, __ATOMIC_RELAXED, __HIP_MEMORY_SCOPE_AGENT); }
__device__ __forceinline__ unsigned xb_add(unsigned* p, unsigned v) { return __hip_atomic_fetch_add(p, v, __ATOMIC_RELAXED, __HIP_MEMORY_SCOPE_AGENT); }
__device__ __forceinline__ unsigned xb_xcc_id() { return (unsigned)__builtin_amdgcn_s_getreg((3 << 11) | 20) & 0xFu; }
#define XB_SPIN(cond, bar) do { unsigned _sp = 0; while (cond) { __builtin_amdgcn_s_sleep(1); \
    if ((++_sp & 255u) == 0u) { if (xb_ld(&(bar)[XB_TMO])) break; if (_sp > XB_SPIN_CAP) { atomicAdd(&(bar)[XB_TMO], 1u); break; } } } } while (0)

struct XcdBarrier {
    unsigned* bar; unsigned x;
    volatile LAS unsigned* st;
};

__device__ __forceinline__ XcdBarrier xcd_barrier_post(unsigned* bar, volatile LAS unsigned* st) {
    XcdBarrier b; b.bar = bar; b.x = xb_xcc_id(); b.st = st;
    if (threadIdx.x == 0) (void)xb_add(&bar[XB_XCNT(b.x)], 1u);
    return b;
}
__device__ __forceinline__ void xcd_barrier_complete(unsigned* bar, unsigned x, unsigned& nloc, unsigned& nx) {
    const unsigned G = gridDim.x * gridDim.y * gridDim.z;
    unsigned sum, cnt, mine, sp = 0u;
    for (;;) {
        sum = 0u; cnt = 0u; mine = 0u;
#pragma unroll
        for (unsigned j = 0; j < 16; ++j) { const unsigned c = xb_ld(&bar[XB_XCNT(j)]); sum += c; cnt += (c > 0u) ? 1u : 0u; mine = (j == x) ? c : mine; }
        if (sum == G) break;
        __builtin_amdgcn_s_sleep(1);
        if ((++sp & 255u) == 0u) { if (xb_ld(&bar[XB_TMO])) break; if (sp > XB_SPIN_CAP) { atomicAdd(&bar[XB_TMO], 1u); break; } }
    }
    nloc = mine > 0u ? mine : 1u; nx = cnt > 0u ? cnt : 1u;
}

__device__ __forceinline__ void xcd_barrier(const XcdBarrier& b) {
    asm volatile("s_waitcnt vmcnt(0)" ::: "memory");
    __syncthreads();
    if (threadIdx.x == 0) {
        unsigned* bar = b.bar;
        __builtin_amdgcn_s_waitcnt(0);
        unsigned nloc = b.st[0], nx = b.st[1];
        if (nloc == 0u) { xcd_barrier_complete(bar, b.x, nloc, nx); b.st[0] = nloc; b.st[1] = nx; }
        const unsigned old = xb_add(&bar[XB_XSUB(b.x)], 1u);
        const unsigned gen = old / nloc;
        if (old + 1u == (gen + 1u) * nloc) {
            __builtin_amdgcn_fence(__ATOMIC_RELEASE, "agent");
            asm volatile("s_waitcnt vmcnt(0)" ::: "memory");
            const unsigned og = xb_add(&bar[XB_TOP], 1u);
            const unsigned tg = og / nx;
            if (og + 1u == (tg + 1u) * nx) xb_add(&bar[XB_TOPGEN], 1u);
            else XB_SPIN(xb_ld(&bar[XB_TOPGEN]) == tg, bar);
            __builtin_amdgcn_fence(__ATOMIC_ACQUIRE, "agent");
            xb_add(&bar[XB_XGEN(b.x)], 1u);
            asm volatile("s_waitcnt vmcnt(0)" ::: "memory");
        } else {
            XB_SPIN(xb_ld(&bar[XB_XGEN(b.x)]) == gen, bar);
            __builtin_amdgcn_fence(__ATOMIC_ACQUIRE, "agent");
            asm volatile("s_waitcnt vmcnt(0)" ::: "memory");
        }
    }
    __syncthreads();
}

namespace tk {
typedef short bf16x8 __attribute__((ext_vector_type(8)));
typedef float f32x4 __attribute__((ext_vector_type(4)));
constexpr int HIST_OFF = 0, HSTR = 1025;
constexpr int TCNT_OFF = 65664;
constexpr int MSTG_OFF = TCNT_OFF + 16384;
constexpr int TBASE_OFF = MSTG_OFF + 8192;
constexpr int RES_OFF = TBASE_OFF + 8192;
constexpr int QST_OFF = 102400;
#define TK_BAR() do { asm volatile("s_waitcnt lgkmcnt(0)" ::: "memory"); __builtin_amdgcn_s_barrier(); asm volatile("" ::: "memory"); } while (0)

__device__ __forceinline__ unsigned wave_prefix_incl(unsigned x) {
    x += (unsigned)__builtin_amdgcn_update_dpp(0, (int)x, 0x111, 0xf, 0xf, true);
    x += (unsigned)__builtin_amdgcn_update_dpp(0, (int)x, 0x112, 0xf, 0xf, true);
    x += (unsigned)__builtin_amdgcn_update_dpp(0, (int)x, 0x114, 0xf, 0xf, true);
    x += (unsigned)__builtin_amdgcn_update_dpp(0, (int)x, 0x118, 0xf, 0xf, true);
    x += (unsigned)__builtin_amdgcn_update_dpp(0, (int)x, 0x142, 0xa, 0xf, false);
    x += (unsigned)__builtin_amdgcn_update_dpp(0, (int)x, 0x143, 0xc, 0xf, false);
    return x;
}
template <int NW>
__device__ __forceinline__ void scan_query(const LAS unsigned* hq, LAS unsigned* res, int qq, unsigned r, int lane) {
    const int wbase = (63 - lane) * NW;
    unsigned ws = 0;
#pragma unroll
    for (int x = 0; x < NW; ++x) ws += hq[wbase + x];
    const unsigned tot = (ws & 0xffffu) + (ws >> 16);
    const unsigned incl = wave_prefix_incl(tot);
    const unsigned above = incl - tot;
    const unsigned long long bal = __ballot(above < r && incl >= r);
    const int Ls = __builtin_amdgcn_readfirstlane((int)__builtin_ctzll(bal));
    const unsigned r2 = r - (unsigned)__builtin_amdgcn_readlane((int)above, Ls);
    const int word = (63 - Ls) * NW + (NW - 1 - (lane & (NW - 1)));
    const unsigned w = hq[word], hi = w >> 16, lo = w & 0xffffu, t2 = hi + lo;
    unsigned inc2 = t2;
    inc2 += (unsigned)__builtin_amdgcn_update_dpp(0, (int)inc2, 0x111, 0xf, 0xf, true);
    inc2 += (unsigned)__builtin_amdgcn_update_dpp(0, (int)inc2, 0x112, 0xf, 0xf, true);
    inc2 += (unsigned)__builtin_amdgcn_update_dpp(0, (int)inc2, 0x114, 0xf, 0xf, true);
    inc2 += (unsigned)__builtin_amdgcn_update_dpp(0, (int)inc2, 0x118, 0xf, 0xf, true);
    const unsigned ab2 = inc2 - t2;
    if (lane < NW && ab2 < r2 && inc2 >= r2) {
        const bool uh = ab2 + hi >= r2;
        res[qq] = (unsigned)word * 2u + (uh ? 1u : 0u); res[16 + qq] = r2 - (uh ? ab2 : ab2 + hi); res[32 + qq] = uh ? hi : lo;
    }
}

__device__ __forceinline__ void tk_prefetch_q(LAS unsigned char* L, const bf16_t* __restrict__ QI, const float* __restrict__ WI, int b, int tq0, int lane) {
    const size_t row = (size_t)b * K::S + tq0 + (lane & 15);
#pragma unroll
    for (int f = 0; f < 8; ++f) __builtin_amdgcn_global_load_lds((const unsigned*)(QI + row * 256 + (f >> 1) * 64 + (f & 1) * 32 + (lane >> 4) * 8), (LAS unsigned*)(L + QST_OFF + f * 1024), 16, 0, 0);
    __builtin_amdgcn_global_load_lds((const unsigned*)(WI + row * 4), (LAS unsigned*)(L + QST_OFF + 8192), 16, 0, 0);
}
template <int PV>
__device__ __forceinline__ void topk_group(LAS unsigned char* L, const bf16_t* __restrict__ QI, const bf16_t* __restrict__ KI, const float* __restrict__ WI, u64* __restrict__ MASK,
                                           int b, int tq0, int nb, int ntq0, int tid, int lane, int wave) {
    using namespace K;
    const int q = lane & 15, g = lane >> 4;
    const int row0 = b * S + tq0, jmax = tq0 >> 4;
    LAS unsigned* hist = (LAS unsigned*)(L + HIST_OFF); LAS unsigned* tcnt = (LAS unsigned*)(L + TCNT_OFF);
    LAS unsigned short* mstg = (LAS unsigned short*)(L + MSTG_OFF); LAS unsigned short* tbase = (LAS unsigned short*)(L + TBASE_OFF); LAS unsigned* res = (LAS unsigned*)(L + RES_OFF);
    for (int i = tid; i < (16384 + 8192) / 4; i += NWAVES * 64) tcnt[i] = 0u;
    LAS unsigned* const tc_q = tcnt + q * 256 + wave; LAS unsigned short* const tb_q = tbase + q * 256 + wave;
    LAS unsigned* const ms32_q = (LAS unsigned*)mstg + ((q * 256 + wave) >> 1); const unsigned sh_q = 16u * (wave & 1) + 4u * g;
    if (tq0 < TOPK) {
        if (wave == 0 && ntq0 >= TOPK) tk_prefetch_q(L, QI, WI, nb, ntq0, lane);
        TK_BAR();
        for (int idx = tid; idx < 16 * (jmax + 1); idx += NWAVES * 64) { const int qq = idx & 15, j = idx >> 4; mstg[qq * 256 + j] = (unsigned short)((j < jmax) ? 0xffffu : ((2u << qq) - 1u)); }
    } else {
        unsigned key[32][4];
        for (int i = tid; i < 16 * HSTR / 4; i += NWAVES * 64) ((LAS v4u*)hist)[i] = (v4u){0u, 0u, 0u, 0u};
        if (wave == 0) asm volatile("s_waitcnt vmcnt(0)" ::: "memory");
        TK_BAR();
        bf16x8 qf[4][2];
#pragma unroll
        for (int h = 0; h < 4; ++h)
#pragma unroll
            for (int ks = 0; ks < 2; ++ks) qf[h][ks] = *(const LAS bf16x8*)(L + QST_OFF + (h * 2 + ks) * 1024 + lane * 16);
        const f32x4 wv = *(const LAS f32x4*)(L + QST_OFF + 8192 + lane * 16);
        bf16x8 kk[3][2][2];
#define TK_LOADK(c_) do { _Pragma("unroll") for (int s_ = 0; s_ < 2; ++s_) { const int j_ = wave + 8 * (2 * (c_) + s_), jc_ = j_ < jmax ? j_ : jmax; \
            const bf16_t* kp_ = KI + (size_t)(b * S + jc_ * 16 + q) * 64 + g * 8; kk[(c_) % 3][s_][0] = *(const bf16x8*)kp_; kk[(c_) % 3][s_][1] = *(const bf16x8*)(kp_ + 32); } } while (0)
        TK_LOADK(0); if (16 <= jmax) TK_LOADK(1);
#pragma unroll
        for (int c = 0; c < 16; ++c) {
            if (16 * c <= jmax) {
                if (c < 14 && 16 * (c + 2) <= jmax) TK_LOADK(c + 2);
#pragma unroll
                for (int s = 0; s < 2; ++s) {
                    const int i = 2 * c + s, j = wave + 8 * i;
                    f32x4 sc = {0.f, 0.f, 0.f, 0.f};
#pragma unroll
                    for (int h = 0; h < 4; ++h) {
                        f32x4 d = __builtin_amdgcn_mfma_f32_16x16x32_bf16(kk[c % 3][s][0], qf[h][0], (f32x4){0.f, 0.f, 0.f, 0.f}, 0, 0, 0);
                        d = __builtin_amdgcn_mfma_f32_16x16x32_bf16(kk[c % 3][s][1], qf[h][1], d, 0, 0, 0);
#pragma unroll
                        for (int r = 0; r < 4; ++r) { const int di = __float_as_int(d[r]); sc[r] = __builtin_fmaf(wv[h], __int_as_float(di > 0 ? di : 0), sc[r]); }
                    }
#pragma unroll
                    for (int r = 0; r < 4; ++r) {
                        const unsigned u = __float_as_uint(sc[r]);
                        unsigned k = u ^ ((unsigned)((int)u >> 31) | 0x80000000u);
                        if (j > jmax || (j == jmax && 4 * g + r > q)) k = 0u;
                        key[i][r] = k;
                        if (PV != 3 && k != 0u) { const unsigned bin = k >> 21; __hip_atomic_fetch_add(hist + q * HSTR + (bin >> 1), 1u << (16 * (bin & 1u)), __ATOMIC_RELAXED, __HIP_MEMORY_SCOPE_WORKGROUP); }
                    }
                }
            } else {
#pragma unroll
                for (int s = 0; s < 2; ++s)
#pragma unroll
                    for (int r = 0; r < 4; ++r) key[2 * c + s][r] = 0u;
            }
        }
#undef TK_LOADK
        if (PV == 1 || PV == 3) {
            unsigned xs = 0u;
#pragma unroll
            for (int i = 0; i < 32; ++i)
#pragma unroll
                for (int r = 0; r < 4; ++r) xs ^= key[i][r];
            TK_BAR();
            if (wave == 0 && ntq0 >= TOPK) tk_prefetch_q(L, QI, WI, nb, ntq0, lane);
            res[64 + lane] = xs;
        } else {
        unsigned prefix = 0u, rnk = (unsigned)TOPK, cnt_eq = 0u;
#pragma unroll
        for (int pass = 0; pass < 3; ++pass) {
            const int shift = (pass == 0) ? 21 : (pass == 1 ? 10 : 0), pshift = (pass == 1) ? 21 : 10; const unsigned bmask = (pass == 2) ? 1023u : 2047u;
            if (pass != 0) {
            TK_BAR();
            if (pass == 1 && wave == 0 && ntq0 >= TOPK) tk_prefetch_q(L, QI, WI, nb, ntq0, lane);
            for (int i = tid; i < 16 * HSTR / 4; i += NWAVES * 64) ((LAS v4u*)hist)[i] = (v4u){0u, 0u, 0u, 0u};
            TK_BAR();
#pragma unroll
            for (int i = 0; i < 32; ++i) {
                if (wave + 8 * i <= jmax) {
#pragma unroll
                    for (int r = 0; r < 4; ++r) {
                        const unsigned k = key[i][r];
                        const bool m = (pass == 0) ? (k != 0u) : ((k >> pshift) == prefix);
                        if (m) { const unsigned bin = (k >> shift) & bmask; __hip_atomic_fetch_add(hist + q * HSTR + (bin >> 1), 1u << (16 * (bin & 1u)), __ATOMIC_RELAXED, __HIP_MEMORY_SCOPE_WORKGROUP); }
                    }
                }
            }
            }
            TK_BAR();
            { const unsigned r0 = (unsigned)__builtin_amdgcn_readlane((int)rnk, 2 * wave), r1 = (unsigned)__builtin_amdgcn_readlane((int)rnk, 2 * wave + 1);
              if (pass < 2) { scan_query<16>(hist + (2 * wave) * HSTR, res, 2 * wave, r0, lane); scan_query<16>(hist + (2 * wave + 1) * HSTR, res, 2 * wave + 1, r1, lane); }
              else { scan_query<8>(hist + (2 * wave) * HSTR, res, 2 * wave, r0, lane); scan_query<8>(hist + (2 * wave + 1) * HSTR, res, 2 * wave + 1, r1, lane); } }
            TK_BAR();
            prefix = (prefix << ((pass == 2) ? 10 : 11)) | res[q]; rnk = res[16 + q]; cnt_eq = res[32 + q];
        }
        const unsigned T = prefix, need = rnk;
        const bool slow = __any(need != cnt_eq);
        if (slow) {
#pragma unroll
            for (int i = 0; i < 32; ++i) {
                if (wave + 8 * i <= jmax) {
                    unsigned c = 0;
#pragma unroll
                    for (int r = 0; r < 4; ++r) c += (key[i][r] == T) ? 1u : 0u;
                    if (c) __hip_atomic_fetch_add(tc_q + 8 * i, c << (8 * g), __ATOMIC_RELAXED, __HIP_MEMORY_SCOPE_WORKGROUP);
                }
            }
            TK_BAR();
#pragma unroll
            for (int s = 0; s < 2; ++s) {
                const int qq = 2 * wave + s; unsigned tt[4], tot = 0;
#pragma unroll
                for (int x = 0; x < 4; ++x) { const unsigned e = tcnt[qq * 256 + lane * 4 + x]; tt[x] = (e & 255u) + ((e >> 8) & 255u) + ((e >> 16) & 255u) + (e >> 24); tot += tt[x]; }
                const unsigned incl = wave_prefix_incl(tot);
                unsigned base = incl - tot;
#pragma unroll
                for (int x = 0; x < 4; ++x) { tbase[qq * 256 + lane * 4 + x] = (unsigned short)base; base += tt[x]; }
            }
            TK_BAR();
        }
#pragma unroll
        for (int i = 0; i < 32; ++i) {
            const int j = wave + 8 * i;
            if (j <= jmax) {
                unsigned nib = 0;
                if (!slow) {
#pragma unroll
                    for (int r = 0; r < 4; ++r) nib |= (key[i][r] >= T && key[i][r] != 0u) ? (1u << r) : 0u;
                } else {
                    const unsigned e = tc_q[8 * i]; unsigned rank = tb_q[8 * i];
                    if (g > 0) rank += e & 255u; if (g > 1) rank += (e >> 8) & 255u; if (g > 2) rank += (e >> 16) & 255u;
#pragma unroll
                    for (int r = 0; r < 4; ++r) { const unsigned k = key[i][r];
                        if (k > T) nib |= 1u << r; else if (k == T && k != 0u) { if (rank < need) nib |= 1u << r; ++rank; } }
                }
                if (nib) __hip_atomic_fetch_or(ms32_q + 4 * i, nib << sh_q, __ATOMIC_RELAXED, __HIP_MEMORY_SCOPE_WORKGROUP);
            }
        }
        }
    }
    TK_BAR();
    if (PV == 0)
    for (int idx = tid; idx < 1024; idx += NWAVES * 64) {
        const int qq = idx & 15, t64 = idx >> 4;
        const u64 wd = *(const LAS u64*)(mstg + qq * 256 + t64 * 4);
        MASK[((size_t)b * 64 + t64) * S + tq0 + qq] = wd;
    }
    TK_BAR();
}

__device__ __forceinline__ void gating_block(LAS unsigned char* L, const bf16_t* __restrict__ QO, const float* __restrict__ KMEAN, unsigned* __restrict__ BMASK, int blk64, int tid) {
    using namespace K;
    const int row0 = 64 * blk64, b = row0 / S;
    LAS float* km = (LAS float*)L;
    const int r = tid >> 3, h = tid & 7, row = row0 + r, t = row % S, own = t / MBLK;
    uint4 qraw[8];
#pragma unroll
    for (int x = 0; x < 8; ++x) qraw[x] = *(const uint4*)(QO + (size_t)row * 1024 + 512 + h * 64 + 8 * x);
    for (int i = tid; i < 16 * 8 * 64; i += NWAVES * 64) { const int n = i >> 9, hh = (i >> 6) & 7, d = i & 63; km[(n * 8 + hh) * 68 + d] = KMEAN[((size_t)(b * 16 + n) * 8 + hh) * 64 + d]; }
    TK_BAR();
    float qv[64];
#pragma unroll
    for (int x = 0; x < 8; ++x) { const uint4 u = qraw[x];
        qv[8 * x + 0] = __uint_as_float(u.x << 16); qv[8 * x + 1] = __uint_as_float(u.x & 0xffff0000u); qv[8 * x + 2] = __uint_as_float(u.y << 16); qv[8 * x + 3] = __uint_as_float(u.y & 0xffff0000u);
        qv[8 * x + 4] = __uint_as_float(u.z << 16); qv[8 * x + 5] = __uint_as_float(u.z & 0xffff0000u); qv[8 * x + 6] = __uint_as_float(u.w << 16); qv[8 * x + 7] = __uint_as_float(u.w & 0xffff0000u); }
    float b0 = -INFINITY, b1 = -INFINITY, b2 = -INFINITY; int i0 = -1, i1 = -1, i2 = -1;
    for (int n = 0; n < own; ++n) {
        const LAS f32x4* kp = (const LAS f32x4*)(km + (n * 8 + h) * 68); float gs = 0.f;
#pragma unroll
        for (int d4 = 0; d4 < 16; ++d4) { const f32x4 kv = kp[d4]; gs = __builtin_fmaf(qv[4 * d4], kv[0], gs); gs = __builtin_fmaf(qv[4 * d4 + 1], kv[1], gs); gs = __builtin_fmaf(qv[4 * d4 + 2], kv[2], gs); gs = __builtin_fmaf(qv[4 * d4 + 3], kv[3], gs); }
        if (gs > b0) { b2 = b1; i2 = i1; b1 = b0; i1 = i0; b0 = gs; i0 = n; }
        else if (gs > b1) { b2 = b1; i2 = i1; b1 = gs; i1 = n; }
        else if (gs > b2) { b2 = gs; i2 = n; }
    }
    unsigned bm = 1u << own;
    if (i0 >= 0) bm |= 1u << i0; if (i1 >= 0) bm |= 1u << i1; if (i2 >= 0) bm |= 1u << i2;
    BMASK[(size_t)row * 8 + h] = bm;
    TK_BAR();
}
#undef TK_BAR
}
namespace attn_body {
using bf16=__hip_bfloat16;
using bf16x8=__attribute__((ext_vector_type(8)))short;
using s16x4=__attribute__((ext_vector_type(4)))short;
using f32x16=__attribute__((ext_vector_type(16)))float;
using u32x4=__attribute__((ext_vector_type(4)))unsigned;
constexpr int BATCH=4,NHEAD=16,SEQ=4096,D=64,DM=NHEAD*D;
constexpr int NW=8,QBLK=32,QB=QBLK*NW,KVBLK=64,NQB=SEQ/QB;
constexpr int ATTN_PITCH=DM, ATTN_UNIT_ROWS=QB;
__device__ __forceinline__ int crow(int r,int hi){return (r&3)+8*(r>>2)+4*hi;}
#define SBAR() __builtin_amdgcn_sched_barrier(0)
typedef __attribute__((address_space(3))) const float* lds_fptr;
__device__ __forceinline__ void addbias(f32x16&p0,f32x16&p1,int jb6,int qrel,int hi,lds_fptr bt){
  const lds_fptr b=bt+(qrel+128-64*jb6-4*hi+197);
  #pragma unroll
  for(int r=0;r<16;++r){const int c=(r&3)+8*(r>>2); p0[r]+=b[59-c]; p1[r]+=b[27-c];}
}

constexpr int BT_N=640;
constexpr int NSLOT=3, SLOTB=8192;
#define EXM(p,w) do{ if(MOBA) asm volatile("v_sub_f32 %0, %0, %2\n\tv_exp_f32 %0, %0\n\tv_add_co_u32 %1, vcc, %1, %1\n\tv_cndmask_b32 %0, 0, %0, vcc":"+v"(p),"+v"(w):"v"(mhat):"vcc"); \
  else asm volatile("v_exp_f32 %0, %0\n\tv_add_co_u32 %1, vcc, %1, %1\n\tv_cndmask_b32 %0, 0, %0, vcc":"+v"(p),"+v"(w)::"vcc"); }while(0)
#define EXS(p,mh) asm volatile("v_sub_f32 %0, %0, %1\n\tv_exp_f32 %0, %0\n\ts_nop 0":"+v"(p):"v"(mh))
#define EXM16(P,w) do{ EXM(P[15],w);EXM(P[14],w);EXM(P[13],w);EXM(P[12],w); w<<=4; EXM(P[11],w);EXM(P[10],w);EXM(P[9],w);EXM(P[8],w); w<<=4; EXM(P[7],w);EXM(P[6],w);EXM(P[5],w);EXM(P[4],w); w<<=4; EXM(P[3],w);EXM(P[2],w);EXM(P[1],w);EXM(P[0],w); }while(0)
__device__ __forceinline__ int cbit(int r){return (r&3)+8*(r>>2);}
constexpr int LDS_K=0, LDS_V=NSLOT*SLOTB, LDS_WS=2*NSLOT*SLOTB, LDS_OST=LDS_WS+NW*64*4, LDS_BT=LDS_OST+NW*4096, LDS_BYTES=LDS_BT+BT_N*4;
constexpr float C2=0.125f*1.4426950408889634f;
__device__ __forceinline__ void glds16(const void*gsrc,unsigned lds_dst){unsigned keep;
  asm volatile("s_mov_b32 %0, m0\n\ts_mov_b32 m0, %2\n\ts_nop 0\n\tglobal_load_lds_dwordx4 %1, off\n\ts_mov_b32 m0, %0":"=&s"(keep):"v"(gsrc),"s"(lds_dst):"memory");}
__device__ __forceinline__ float max3f(float a,float b,float c){float r;asm("v_max3_f32 %0, %1, %2, %3":"=v"(r):"v"(a),"v"(b),"v"(c));return r;}
__device__ __forceinline__ float max2f(float a,float b){float r;asm("v_max_f32_e32 %0, %1, %2":"=v"(r):"v"(a),"v"(b));return r;}
__device__ __forceinline__ float fadd_s(float a,float b){float r;asm("v_add_f32_e32 %0, %1, %2":"=v"(r):"v"(a),"v"(b));return r;}
__device__ __forceinline__ float fsub_s(float a,float b){float r;asm("v_sub_f32_e32 %0, %1, %2":"=v"(r):"v"(a),"v"(b));return r;}
typedef float f32x2_t __attribute__((ext_vector_type(2))); typedef __bf16 bf16x2_t __attribute__((ext_vector_type(2)));
__device__ __forceinline__ unsigned cvtpk_s(float lo,float hi){f32x2_t v={lo,hi};bf16x2_t b=__builtin_convertvector(v,bf16x2_t);return __builtin_bit_cast(unsigned,b);}
#define WAIT_BAR(N) asm volatile("s_waitcnt vmcnt(" #N ") lgkmcnt(0)\n\ts_barrier":::"memory")

__device__ __forceinline__ void qkt(f32x16&p0,f32x16&p1,const char*Kslot,const bf16x8*qr,const f32x16&c0,int r32,int hi){
  const char*kb=Kslot+hi*1024+r32*16;
  #pragma unroll
  for(int d0=0;d0<4;++d0){
    const bf16x8 b0=*reinterpret_cast<const bf16x8*>(kb+d0*2048);
    const bf16x8 b1=*reinterpret_cast<const bf16x8*>(kb+d0*2048+512);
    if(d0==0){p0=__builtin_amdgcn_mfma_f32_32x32x16_bf16(b0,qr[0],c0,0,0,0);p1=__builtin_amdgcn_mfma_f32_32x32x16_bf16(b1,qr[0],c0,0,0,0);}
    else{p0=__builtin_amdgcn_mfma_f32_32x32x16_bf16(b0,qr[d0],p0,0,0,0);p1=__builtin_amdgcn_mfma_f32_32x32x16_bf16(b1,qr[d0],p1,0,0,0);}}
}
typedef __attribute__((address_space(3))) const char* lds_cptr;
typedef short v4i16_t __attribute__((ext_vector_type(4)));
__device__ __forceinline__ void kload8(bf16x8*kf,lds_cptr kp){
  kf[0]=*(const __attribute__((address_space(3))) bf16x8*)(kp);      kf[1]=*(const __attribute__((address_space(3))) bf16x8*)(kp+512);
  kf[2]=*(const __attribute__((address_space(3))) bf16x8*)(kp+2048); kf[3]=*(const __attribute__((address_space(3))) bf16x8*)(kp+2560);
  kf[4]=*(const __attribute__((address_space(3))) bf16x8*)(kp+4096); kf[5]=*(const __attribute__((address_space(3))) bf16x8*)(kp+4608);
  kf[6]=*(const __attribute__((address_space(3))) bf16x8*)(kp+6144); kf[7]=*(const __attribute__((address_space(3))) bf16x8*)(kp+6656);
}
__device__ __forceinline__ void kload2(bf16x8*kf,lds_cptr kp,int j){ kf[2*j]=*(const __attribute__((address_space(3))) bf16x8*)(kp+j*2048); kf[2*j+1]=*(const __attribute__((address_space(3))) bf16x8*)(kp+j*2048+512); }
__device__ __forceinline__ s16x4 vtr(lds_cptr p){ return __builtin_bit_cast(s16x4,__builtin_amdgcn_ds_read_tr16_b64_v4i16((__attribute__((address_space(3))) v4i16_t*)p)); }
__device__ __forceinline__ float rowmax(const f32x16&p0,const f32x16&p1){
  float a=max3f(p0[0],p0[1],p1[0]),b=max3f(p0[2],p0[3],p1[1]);a=max3f(a,p1[2],p1[3]);
  #pragma unroll
  for(int r=4;r<16;r+=4){a=max3f(a,p0[r],p0[r+1]);b=max3f(b,p0[r+2],p0[r+3]);a=max3f(a,p1[r],p1[r+1]);b=max3f(b,p1[r+2],p1[r+3]);}
  const float m=max2f(a,b);
  auto rr=__builtin_amdgcn_permlane32_swap(__float_as_uint(m),__float_as_uint(m),false,false);
  return max2f(__uint_as_float(rr[0]),__uint_as_float(rr[1]));
}
__device__ __forceinline__ void pv(f32x16*o,int vb,bf16x8 pa0,bf16x8 pa1,bf16x8 pa2,bf16x8 pa3){
  #pragma unroll
  for(int d0=0;d0<2;++d0){s16x4 lo[4],hi[4];
    #pragma unroll
    for(int ks=0;ks<4;++ks){
      asm volatile("ds_read_b64_tr_b16 %0,%1 offset:%c2":"=&v"(lo[ks]):"v"(vb),"i"(d0*4096+ks*1024):"memory");
      asm volatile("ds_read_b64_tr_b16 %0,%1 offset:%c2":"=&v"(hi[ks]):"v"(vb),"i"(d0*4096+ks*1024+512):"memory");}
    asm volatile("s_waitcnt lgkmcnt(0)":::"memory");SBAR();
    #define PK(k) (bf16x8){lo[k][0],lo[k][1],lo[k][2],lo[k][3],hi[k][0],hi[k][1],hi[k][2],hi[k][3]}
    o[d0]=__builtin_amdgcn_mfma_f32_32x32x16_bf16(pa0,PK(0),o[d0],0,0,0);
    o[d0]=__builtin_amdgcn_mfma_f32_32x32x16_bf16(pa1,PK(1),o[d0],0,0,0);
    o[d0]=__builtin_amdgcn_mfma_f32_32x32x16_bf16(pa2,PK(2),o[d0],0,0,0);
    o[d0]=__builtin_amdgcn_mfma_f32_32x32x16_bf16(pa3,PK(3),o[d0],0,0,0);
    #undef PK
  }
}

#ifndef ATTN_STORE16
#define ATTN_STORE16(p,v) (*(u32x4*)(p)=(v))
#endif
template<int THRL,bool MOBA> __device__ __forceinline__ void attn_unit(int b,int h,int qb,const bf16*Q,const bf16*__restrict__ K,const bf16*__restrict__ V,bf16*O,const unsigned long long*__restrict__ MASKW,const unsigned*__restrict__ BMASK,const float*__restrict__ relb,const float*__restrict__ gq,const float*__restrict__ gk,char*shm){
  const int tid=threadIdx.x,lane=tid&63,r32=lane&31,hi=lane>>5; const int wid=__builtin_amdgcn_readfirstlane(tid>>6);
  const long rowbase=(long)b*SEQ; const int q0=qb*QB;
  const bf16*Qw=Q+(rowbase+q0+wid*QBLK)*DM+h*D;
  const bf16*Kh=K+rowbase*DM+h*D,*Vh=V+rowbase*DM+h*D;
  const unsigned lds0=(unsigned)(uintptr_t)shm;
  float*wsf=(float*)(shm+LDS_WS)+wid*64;
  const bf16*ksrc=Kh+(long)lane*DM+wid*8;
  const bf16*vsrc=Vh+(long)(16*(wid&3)+(lane>>2))*DM+(wid>>2)*32+(lane&3)*8;
  const unsigned kdst=lds0+LDS_K+wid*1024, vdst=lds0+LDS_V+wid*1024;
  #define DMA_K(t,slot) glds16(ksrc+(long)(t)*KVBLK*DM,(unsigned)__builtin_amdgcn_readfirstlane(kdst+(slot)))
  #define DMA_V(t,slot) glds16(vsrc+(long)(t)*KVBLK*DM,(unsigned)__builtin_amdgcn_readfirstlane(vdst+(slot)))
  const int vb0=(int)(lds0+LDS_V)+((lane>>4)&1)*32+(lane&3)*8+(4*hi+((lane&15)>>2))*64;
  const char*Kbase=shm+LDS_K; bf16x8 kf[8];
  const lds_cptr shm3=(lds_cptr)shm; const lds_cptr kp0=shm3+LDS_K+hi*1024+r32*16; const lds_cptr vp0=shm3+LDS_V+((lane>>4)&1)*32+(lane&3)*8+(4*hi+((lane&15)>>2))*64;
  const int NT=(q0+QB)/KVBLK;
  const int qrel=wid*QBLK+r32; constexpr bool moba=MOBA;
  const lds_fptr bt=(lds_fptr)(shm3+LDS_BT);
  unsigned bm=0u;
  const unsigned mvoff=(unsigned)(q0+qrel)*8u; unsigned long long mraw=0ull; unsigned mlo=0u,mhi=0u;
  #define MLOAD(tt) do{ if(!moba&&(tt)<NT){ const unsigned long long*mb_=MASKW+((size_t)(b*64+(tt)))*SEQ; \
      asm volatile("s_nop 4\n\tglobal_load_dwordx2 %0, %1, %2":"=v"(mraw):"v"(mvoff),"s"(mb_):"memory"); } }while(0)
  #define MSET(tt) do{ if(!moba){ asm volatile("":"+v"(mraw)); mlo=(unsigned)mraw<<(4-4*hi); mhi=(unsigned)(mraw>>32)<<(4-4*hi); } \
      else{ unsigned wl=((bm>>((tt)>>2))&1u)?0xffffffffu:0u, wh=wl; const int jb_=(tt)-(NT-4); \
        if(jb_>=0){ const int n=qrel-64*jb_, n2=n-32; wl&=(n<0)?0u:((n>=31)?0xffffffffu:((2u<<n)-1u)); wh&=(n2<0)?0u:((n2>=31)?0xffffffffu:((2u<<n2)-1u)); } \
        mlo=wl<<(4-4*hi); mhi=wh<<(4-4*hi); } }while(0)
  MLOAD(0);
  DMA_K(0,0);DMA_V(0,0);DMA_K(1,SLOTB);
  bf16x8 qr[4];
  #pragma unroll
  for(int d0=0;d0<4;++d0)qr[d0]=*reinterpret_cast<const bf16x8*>(&Qw[(long)r32*DM+d0*16+hi*8]);
  if(moba)bm=BMASK[(size_t)(rowbase+q0+qrel)*8+(h-8)];
  { __attribute__((address_space(3))) float*btw=(__attribute__((address_space(3))) float*)(shm3+LDS_BT); const float b31=relb[31*16+h];
    for(int i=tid;i<BT_N;i+=NW*64){ const int d=i-256; btw[i]=(d>=0&&d<=112)?(relb[t5_bucket(d)*16+h]-b31)*1.4426950408889634f:0.f; } }
  constexpr float mhat=16.0f; float l_reg=0.f;f32x16 o[2];o[0]=f32x16{};o[1]=f32x16{}; f32x16 negm=f32x16{}; (void)gq; (void)gk;
  if(!MOBA){ _Pragma("unroll") for(int r=0;r<16;++r)negm[r]=-mhat; asm volatile("":"+v"(negm)); }
  #define CMASK(P0,P1,t) do{int jb_=(t)-(NT-6); if(jb_>=0)addbias(P0,P1,jb_,qrel,hi,bt);}while(0)
  #define START(P0,P1) do{ EXM16(P0,mlo); }while(0)
  #define RESC() do{}while(0)
  f32x16 pA0,pA1,pB0,pB1;
  int sl_prev=0,sl_cur=0,sl_next=SLOTB;
  #define ROT() do{sl_prev=sl_cur;sl_cur=sl_next;sl_next=(sl_next==(NSLOT-1)*SLOTB)?0:sl_next+SLOTB;}while(0)
  DMA_K(2,2*SLOTB);
  WAIT_BAR(3);
  MSET(0); MLOAD(1);
  qkt(pA0,pA1,Kbase,qr,(MOBA?f32x16{}:negm),r32,hi);asm volatile("s_nop 15\n\ts_nop 7":"+v"(pA0),"+v"(pA1));CMASK(pA0,pA1,0);
  START(pA0,pA1);
  EXM16(pA1,mhi);
  WAIT_BAR(0);
  MSET(1);
  DMA_K(3,0);DMA_V(1,SLOTB);
  ROT();
  kload8(kf,kp0+sl_cur);
  WAIT_BAR(2);
  s16x4 vlo[8],vhi[8]; u32x4 pw0,pw1,pw2,pw3;
  #define PKW(P,B) cvtpk_s(P[B],P[B+1])
  #define PAF(k) __builtin_bit_cast(bf16x8,pw##k)
  #define VFR(i) (bf16x8){vlo[i][0],vlo[i][1],vlo[i][2],vlo[i][3],vhi[i][0],vhi[i][1],vhi[i][2],vhi[i][3]}
  #define PIN(x) asm volatile("":"+v"(x))
  #define MX3(a,b,c) __builtin_fmaxf(__builtin_fmaxf((a),(b)),(c))
  #define GAPA(MF,A0,A1,A2,A3,W0,W1,PW) do{ MF; sacc+=A0; sacc+=A1; sacc+=A2; sacc+=A3; PIN(sacc); W0; W1; PIN(PW); SBAR(); }while(0)
  #define EX(v) __builtin_amdgcn_exp2f(v)
  #define GAPB(MF,X,B,MW,CH) do{ MF; if(CH){ EXS(X[B+3],mh_); EXS(X[B+2],mh_); EXS(X[B+1],mh_); EXS(X[B],mh_); } else { EXM(X[B+3],MW); EXM(X[B+2],MW); EXM(X[B+1],MW); EXM(X[B],MW); if((B)>0)MW<<=4; } PIN(X); SBAR(); }while(0)
  #define VRD(i) do{ vlo[i]=vtr(vp_+(((i)>>2)*4096+((i)&3)*1024)); vhi[i]=vtr(vp_+(((i)>>2)*4096+((i)&3)*1024+512)); }while(0)
  #define KRD(G,j) do{ if(G){ kload2(kf,kp0+sl_next,j); SBAR(); } }while(0)
  #define STEP(C0,C1,P0,P1,t,GK,GV,GL,CH) do{ SBAR(); \
    const lds_cptr vp_=vp0+sl_prev; \
    VRD(0); SBAR(); float sacc=(P0[0]+P0[1]); \
    GAPA(C0=__builtin_amdgcn_mfma_f32_32x32x16_bf16(kf[0],qr[0],(MOBA?f32x16{}:negm),0,0,0), P0[2],P0[3],P0[4],P0[5],     pw0[0]=PKW(P0,0), pw0[1]=PKW(P0,2), pw0); \
    VRD(4); SBAR(); GAPA(C1=__builtin_amdgcn_mfma_f32_32x32x16_bf16(kf[1],qr[0],(MOBA?f32x16{}:negm),0,0,0), P0[6],P0[7],P0[8],P0[9],     pw0[2]=PKW(P0,4), pw0[3]=PKW(P0,6), pw0); \
    VRD(1); SBAR(); GAPA(C0=__builtin_amdgcn_mfma_f32_32x32x16_bf16(kf[2],qr[1],C0,0,0,0),   P0[10],P0[11],P0[12],P0[13], pw1[0]=PKW(P0,8), pw1[1]=PKW(P0,10), pw1); \
    VRD(5); SBAR(); GAPA(C1=__builtin_amdgcn_mfma_f32_32x32x16_bf16(kf[3],qr[1],C1,0,0,0),   P0[14],P0[15],P1[0],P1[1],   pw1[2]=PKW(P0,12),pw1[3]=PKW(P0,14), pw1); \
    VRD(2); SBAR(); GAPA(C0=__builtin_amdgcn_mfma_f32_32x32x16_bf16(kf[4],qr[2],C0,0,0,0),   P1[2],P1[3],P1[4],P1[5],     pw2[0]=PKW(P1,0), pw2[1]=PKW(P1,2), pw2); \
    VRD(6); SBAR(); GAPA(C1=__builtin_amdgcn_mfma_f32_32x32x16_bf16(kf[5],qr[2],C1,0,0,0),   P1[6],P1[7],P1[8],P1[9],     pw2[2]=PKW(P1,4), pw2[3]=PKW(P1,6), pw2); \
    VRD(3); SBAR(); GAPA(C0=__builtin_amdgcn_mfma_f32_32x32x16_bf16(kf[6],qr[3],C0,0,0,0),   P1[10],P1[11],P1[12],P1[13], pw3[0]=PKW(P1,8), pw3[1]=PKW(P1,10), pw3); \
    VRD(7); SBAR(); GAPA(C1=__builtin_amdgcn_mfma_f32_32x32x16_bf16(kf[7],qr[3],C1,0,0,0),   P1[14],P1[15],0.f,0.f,       pw3[2]=PKW(P1,12),pw3[3]=PKW(P1,14), pw3); \
    l_reg+=sacc; \
    if(GK){DMA_K((t)+3,sl_cur);} if(GV){DMA_V((t)+1,sl_next);} \
    CMASK(C0,C1,t); \
    const float mh_=(CH)?((mlo!=0u)?mhat:__builtin_inff()):0.f; (void)mh_; \
    SBAR(); \
    GAPB(o[0]=__builtin_amdgcn_mfma_f32_32x32x16_bf16(PAF(0),VFR(0),o[0],0,0,0), C0,12,mlo,CH); \
    GAPB(o[1]=__builtin_amdgcn_mfma_f32_32x32x16_bf16(PAF(0),VFR(4),o[1],0,0,0), C0,8,mlo,CH); \
    KRD(GL,0); GAPB(o[0]=__builtin_amdgcn_mfma_f32_32x32x16_bf16(PAF(1),VFR(1),o[0],0,0,0), C0,4,mlo,CH); \
    KRD(GL,1); GAPB(o[1]=__builtin_amdgcn_mfma_f32_32x32x16_bf16(PAF(1),VFR(5),o[1],0,0,0), C0,0,mlo,CH); \
    KRD(GL,2); GAPB(o[0]=__builtin_amdgcn_mfma_f32_32x32x16_bf16(PAF(2),VFR(2),o[0],0,0,0), C1,12,mhi,CH); \
    KRD(GL,3); GAPB(o[1]=__builtin_amdgcn_mfma_f32_32x32x16_bf16(PAF(2),VFR(6),o[1],0,0,0), C1,8,mhi,CH); \
    GAPB(o[0]=__builtin_amdgcn_mfma_f32_32x32x16_bf16(PAF(3),VFR(3),o[0],0,0,0), C1,4,mhi,CH); \
    GAPB(o[1]=__builtin_amdgcn_mfma_f32_32x32x16_bf16(PAF(3),VFR(7),o[1],0,0,0), C1,0,mhi,CH); \
    }while(0)
  int t=1;
  #undef CMASK
  #define CMASK(P0,P1,t) do{}while(0)
  for(;t+7<NT;t+=2){
    MLOAD(t+1); STEP(pB0,pB1,pA0,pA1,t,true,true,true,MOBA);     WAIT_BAR(2); RESC(); ROT(); MSET(t+1);
    MLOAD(t+2); STEP(pA0,pA1,pB0,pB1,t+1,true,true,true,MOBA);   WAIT_BAR(2); RESC(); ROT(); MSET(t+2);
  }
  #undef CMASK
  #define CMASK(P0,P1,t) do{int jb_=(t)-(NT-6); if(jb_>=0)addbias(P0,P1,jb_,qrel,hi,bt);}while(0)
  #define ENDW(tt) do{ if((tt)+3<NT){WAIT_BAR(2);} else if((tt)+2<NT){WAIT_BAR(1);} else {WAIT_BAR(0);} }while(0)
  for(;t+1<NT;t+=2){
    MLOAD(t+1); STEP(pB0,pB1,pA0,pA1,t,(t+3<NT),(t+1<NT),(t+1<NT),0);       ENDW(t);   RESC(); ROT(); MSET(t+1);
    MLOAD(t+2); STEP(pA0,pA1,pB0,pB1,t+1,(t+4<NT),(t+2<NT),(t+2<NT),0);     ENDW(t+1); RESC(); ROT(); MSET(t+2);
  }
  STEP(pB0,pB1,pA0,pA1,NT-1,false,false,false,0); RESC();
  { float sacc=pB0[0]+pB0[1]; _Pragma("unroll") for(int r=2;r<16;++r)sacc+=pB0[r]; _Pragma("unroll") for(int r=0;r<16;++r)sacc+=pB1[r]; l_reg+=sacc;
    pw0=(u32x4){PKW(pB0,0),PKW(pB0,2),PKW(pB0,4),PKW(pB0,6)};pw1=(u32x4){PKW(pB0,8),PKW(pB0,10),PKW(pB0,12),PKW(pB0,14)};pw2=(u32x4){PKW(pB1,0),PKW(pB1,2),PKW(pB1,4),PKW(pB1,6)};pw3=(u32x4){PKW(pB1,8),PKW(pB1,10),PKW(pB1,12),PKW(pB1,14)};
    SBAR(); pv(o,vb0+sl_cur,PAF(0),PAF(1),PAF(2),PAF(3)); }
  #undef PKW
  #undef PAF
  #undef VFR
  #undef PIN
  #undef MX3
  #undef GAPA
  #undef GAPB
  #undef EX
  #undef VRD
  #undef KRD
  #undef STEP
  #undef ENDW
  {auto rr=__builtin_amdgcn_permlane32_swap(__float_as_uint(l_reg),__float_as_uint(l_reg),false,false);l_reg=__uint_as_float(rr[0])+__uint_as_float(rr[1]);}
  if(hi==0)wsf[32+r32]=l_reg;asm volatile("s_waitcnt lgkmcnt(0)":::"memory");
  float rli[16];
  #pragma unroll
  for(int r=0;r<16;++r)rli[r]=__builtin_amdgcn_rcpf(wsf[32+crow(r,hi)]);
  bf16*Ow=O+(rowbase+q0+wid*QBLK)*DM+h*D;
  { bf16*stg=(bf16*)(shm+LDS_OST)+wid*2048;
    #pragma unroll
    for(int r=0;r<16;++r){const int orow=crow(r,hi);
      #pragma unroll
      for(int d0=0;d0<2;++d0)stg[orow*64+d0*32+r32]=__float2bfloat16(o[d0][r]*rli[r]);}
    asm volatile("s_waitcnt lgkmcnt(0)":::"memory");
    #pragma unroll
    for(int i=0;i<4;++i){const int row=i*8+(lane>>3),ch=lane&7; const u32x4 v=*(const u32x4*)(stg+row*64+ch*8); ATTN_STORE16(Ow+(long)row*DM+ch*8,v);} }
  asm volatile("s_waitcnt lgkmcnt(0)\n\ts_barrier":::"memory");
  #undef MLOAD
  #undef MSET
  #undef DMA_K
  #undef DMA_V
  #undef CMASK
  #undef START
  #undef RESC
  #undef ROT
}
constexpr int ATTN_LDS_BYTES=LDS_BYTES;
#undef SBAR
#undef WAIT_BAR
}

__device__ __forceinline__ float wave_sum_fast(float v) {
#define WS_DPP_(ctrl, rm, bc) v += __int_as_float(__builtin_amdgcn_update_dpp(0, __float_as_int(v), ctrl, rm, 0xf, bc))
    WS_DPP_(0x111, 0xf, true); WS_DPP_(0x112, 0xf, true); WS_DPP_(0x114, 0xf, true); WS_DPP_(0x118, 0xf, true); WS_DPP_(0x142, 0xa, false); WS_DPP_(0x143, 0xc, false);
#undef WS_DPP_
    return __int_as_float(__builtin_amdgcn_readlane(__float_as_int(v), 63));
}
__device__ __forceinline__ int rowmap(int map, int n) {
    if (map == 1) { const int up = n >= 2816; const int j = up ? n - 2816 : n; return 256 * (j >> 7) + (up ? 128 : 0) + (j & 127); }
    if (map == 2) {
        if (n < 3072) { const int part = n >> 9, cc = n & 511, tl = cc >> 8, wc = (cc & 255) >> 6, d = cc & 63; return 256 * (2 * part + tl) + 128 * (d >> 5) + 32 * wc + (d & 31); }
        if (n < 3328) return 256 * 12 + (n - 3072);
        if (n < 3396) return 256 * 13 + (n - 3328);
        if (n < 5444) return 256 * 14 + (n - 3396);
        return 256 * 13 + 68 + (n - 5444);
    }
    if (map == 3) return 1024 + n;
    return n;
}
__device__ __forceinline__ void conv_item(const float* __restrict__ W, int ldw, int N, int Nw, const float* __restrict__ gain, bf16_t* WT, int ldk, int map, int koff, LAS float* scr, int item, int lane) {
    const int nblk = (Nw + 31) >> 5, kb = item / nblk, nb = item % nblk, k0 = 64 * kb, n0 = 32 * nb;
    const int rr = lane >> 3, c4 = (lane & 7) * 4; const bool inb = (n0 + c4) < N;
    f32x4 v[8];
#pragma unroll
    for (int i = 0; i < 8; ++i) v[i] = inb ? *(const GAS f32x4*)(W + (size_t)(k0 + 8 * i + rr) * ldw + n0 + c4) : (f32x4){0.f, 0.f, 0.f, 0.f};
#pragma unroll
    for (int i = 0; i < 8; ++i) { const int kk = 8 * i + rr; const float gk = gain ? gain[k0 + kk] : 1.0f; LAS float* s = scr + kk * 33 + c4;
        s[0] = v[i][0] * gk; s[1] = v[i][1] * gk; s[2] = v[i][2] * gk; s[3] = v[i][3] * gk; }
    LDS_WAIT(); asm volatile("" ::: "memory");
    const int c = lane & 7;
#pragma unroll
    for (int j = 0; j < 4; ++j) { const int n = (lane >> 3) + 8 * j; const LAS float* s = scr + (8 * c) * 33 + n;
        if (n0 + n < Nw) {
            v4u o; o.x = pk2(s[0 * 33], s[1 * 33]); o.y = pk2(s[2 * 33], s[3 * 33]); o.z = pk2(s[4 * 33], s[5 * 33]); o.w = pk2(s[6 * 33], s[7 * 33]);
            *(GAS v4u*)((unsigned char*)WT + pg8::tiled_b_off(rowmap(map, n0 + n), koff + k0 + 8 * c, ldk >> 6)) = o; } }
    LDS_WAIT(); asm volatile("" ::: "memory");
}

struct Args { const float* in[18]; float* out; unsigned char* ws; int ph_lo, ph_hi, li, pad; };
enum { I_X = 0, I_N1, I_GU1, I_DN1, I_NM, I_WIN, I_BG, I_QNA, I_KNA, I_QNB, I_KNB, I_WBA, I_WBB, I_WO, I_N2, I_GU2, I_DN2, I_RB };

__device__ __forceinline__ void p0_prologue(const Args& args, LAS unsigned char* L, int gw, int NGW, int lane, int gtid, int ngt) {
    using namespace K;
    unsigned char* ws = args.ws;
    LAS float* scr = (LAS float*)(L + RING_OFF + (gw & 7) * 16384);
    constexpr int I0 = 16 * 176, I1 = 44 * 32, I2 = 16 * 176, I3 = 8 * 32, I4 = 8 * 32, I5 = 16 * 32;
    constexpr int NITEMS = 2 * I0 + 2 * I1 + I2 + I3 + I4 + I5;
    for (int it = gw; it < NITEMS; it += NGW) {
        int r = it;
        if (r < I0) { conv_item(args.in[I_GU1], 2 * DFF, 2 * DFF, 2 * DFF, args.in[I_N1], (bf16_t*)(ws + WS::GU1), D, 1, 0, scr, r, lane); continue; } r -= I0;
        if (r < I0) { conv_item(args.in[I_GU2], 2 * DFF, 2 * DFF, 2 * DFF, args.in[I_N2], (bf16_t*)(ws + WS::GU2), D, 1, 0, scr, r, lane); continue; } r -= I0;
        if (r < I1) { conv_item(args.in[I_DN1], D, D, D, nullptr, (bf16_t*)(ws + WS::DN1), DFF, 0, 0, scr, r, lane); continue; } r -= I1;
        if (r < I1) { conv_item(args.in[I_DN2], D, D, D, nullptr, (bf16_t*)(ws + WS::DN2), DFF, 0, 0, scr, r, lane); continue; } r -= I1;
        if (r < I2) { conv_item(args.in[I_WIN], DIN, DIN, 5632, args.in[I_NM], (bf16_t*)(ws + WS::WIN), D, 2, 0, scr, r, lane); continue; } r -= I2;
        if (r < I3) { conv_item(args.in[I_WBA], D, D, D, nullptr, (bf16_t*)(ws + WS::WB), D, 0, 0, scr, r, lane); continue; } r -= I3;
        if (r < I4) { conv_item(args.in[I_WBB], D, D, D, nullptr, (bf16_t*)(ws + WS::WB), D, 0, 512, scr, r, lane); continue; } r -= I4;
        conv_item(args.in[I_WO], D, D, D, nullptr, (bf16_t*)(ws + WS::WO), D, 0, 0, scr, r, lane);
    }
    const float* x = args.in[I_X];
    for (int m0 = 2 * gw; m0 < M; m0 += 2 * NGW) {
        f32x4 v[2][4]; float s[2] = {0.f, 0.f};
#pragma unroll
        for (int rr = 0; rr < 2; ++rr) { const GAS f32x4* xr = (const GAS f32x4*)(x + (size_t)(m0 + rr) * D) + lane;
#pragma unroll
            for (int j = 0; j < 4; ++j) v[rr][j] = xr[64 * j]; }
#pragma unroll
        for (int rr = 0; rr < 2; ++rr) {
#pragma unroll
            for (int j = 0; j < 4; ++j) s[rr] += (v[rr][j][0] * v[rr][j][0] + v[rr][j][1] * v[rr][j][1]) + (v[rr][j][2] * v[rr][j][2] + v[rr][j][3] * v[rr][j][3]);
            s[rr] = wave_sum_fast(s[rr]);
            GAS unsigned long long* o8 = (GAS unsigned long long*)(ws + WS::XB + (size_t)(m0 + rr) * D * 2) + lane;
#pragma unroll
            for (int j = 0; j < 4; ++j) o8[64 * j] = (unsigned long long)pk2(v[rr][j][0], v[rr][j][1]) | ((unsigned long long)pk2(v[rr][j][2], v[rr][j][3]) << 32);
            if (lane < 4) { f32x4 q = {lane == 0 ? s[rr] : 0.f, 0.f, 0.f, 0.f}; *((GAS f32x4*)(ws + WS::SSQ + (size_t)(m0 + rr) * 64) + lane) = q; }
        }
    }
}

__global__ void __launch_bounds__(NWAVES * 64, 2) mega(Args args) {
    extern __shared__ __attribute__((aligned(16))) unsigned char lds[];
    using namespace K;
    LAS unsigned char* L = (LAS unsigned char*)lds;
    volatile LAS unsigned* MISC = (volatile LAS unsigned*)(L + MISC_OFF);
    const int tid = threadIdx.x, lane = tid & 63, wave = __builtin_amdgcn_readfirstlane(tid >> 6);
    const int G = gridDim.x, bx = blockIdx.x; const int vcu = (G % 8 == 0) ? (bx % 8) * (G / 8) + bx / 8 : bx;
    unsigned char* ws = args.ws;
    for (int u = tid; u < (LDS_BYTES - LDSCTL_OFF) / 4; u += NWAVES * 64) ((LAS unsigned*)(L + LDSCTL_OFF))[u] = 0u;
    __syncthreads();
    XcdBarrier bar = xcd_barrier_post((unsigned*)(ws + WS::CTL) + CW_BAR + args.li * XCD_BAR_WORDS, MISC + 8);
    const int lo = args.ph_lo, hi = args.ph_hi;
#define IN(k) (lo <= (k) && (k) < hi)
#define SEAM(k) do { if (IN(k) && IN((k) + 1)) xcd_barrier(bar); } while (0)
    bf16_t* XB = (bf16_t*)(ws + WS::XB); bf16_t* ACT = (bf16_t*)(ws + WS::ACT); float* SSQ = (float*)(ws + WS::SSQ);

    if (IN(0)) { p0_prologue(args, L, vcu * NWAVES + wave, G * NWAVES, lane, bx * (NWAVES * 64) + tid, G * NWAVES * 64); SEAM(0); }
    if (IN(1)) {
        pg8::Gemm g{XB, (const bf16_t*)(ws + WS::GU1), M, 2 * DFF, D, D, 1 << 30, 0}; pg8::StaticOrder S; S.init(M, 2 * DFF, G, bx);
        pg8::EpiGu E{ACT, SSQ, (LAS float*)(L + RTAB_OFF)};
        pg8::gemm_phase<pg8::EpiGu, pg8::StaticOrder, true, true>(L + RING_OFF, g, S, E);
        SEAM(1);
    }
    if (IN(2)) {
        pg8::Gemm g{ACT, (const bf16_t*)(ws + WS::DN1), M, D, DFF, DFF, 1 << 30, 0}; pg8::StaticOrder S; S.init(M, D, G, bx);
        pg8::EpiRes<true, false, true> E{args.in[I_X], nullptr, nullptr, XB, SSQ, 0.5f};
        pg8::gemm_phase<pg8::EpiRes<true, false, true>, pg8::StaticOrder, false, true>(L + RING_OFF, g, S, E);
        SEAM(2);
    }
    if (IN(3)) {
        pg8::Gemm g{XB, (const bf16_t*)(ws + WS::WIN), M, 5632, D, D, 1 << 30, 0}; pg8::StaticOrder S; S.init(M, 5632, G, bx);
        pg8::EpiIn E{(bf16_t*)(ws + WS::QO), (bf16_t*)(ws + WS::KB), (bf16_t*)(ws + WS::VB), (bf16_t*)(ws + WS::GATES), (bf16_t*)(ws + WS::QI), (bf16_t*)(ws + WS::KI), (float*)(ws + WS::WI), (float*)(ws + WS::KMEAN), SSQ,
                     args.in[I_BG], args.in[I_QNA], args.in[I_KNA], args.in[I_QNB], args.in[I_KNB], (LAS float*)(L + RTAB_OFF)};
        pg8::gemm_phase<pg8::EpiIn, pg8::StaticOrder, true, true>(L + RING_OFF, g, S, E);
        SEAM(3);
    }
    if (IN(4)) {
        {
#define TK_POS(it_, bb_, tq_) do { bb_ = (it_) >> 8; const int v_ = (it_) & 255, vv_ = (v_ + 128 * (bb_ >> 1)) & 255; tq_ = 16 * ((bb_ & 1) ? 255 - vv_ : vv_); } while (0)
            int bb = 0, tq = -1;
            if (vcu < 1024) { TK_POS(vcu, bb, tq); if (wave == 0 && tq >= TOPK) tk::tk_prefetch_q(L, (const bf16_t*)(ws + WS::QI), (const float*)(ws + WS::WI), bb, tq, lane); }
            for (int blk = vcu; blk < M / 64; blk += G) tk::gating_block(L, (const bf16_t*)(ws + WS::QO), (const float*)(ws + WS::KMEAN), (unsigned*)(ws + WS::BMASK), blk, tid);
            for (int it = vcu; it < 1024; it += G) {
                int nb = 0, ntq = -1; if (it + G < 1024) TK_POS(it + G, nb, ntq);
                tk::topk_group<0>(L, (const bf16_t*)(ws + WS::QI), (const bf16_t*)(ws + WS::KI), (const float*)(ws + WS::WI), (u64*)args.out, bb, tq, nb, ntq, tid, lane, wave);
                bb = nb; tq = ntq;
            }
#undef TK_POS
        }
        SEAM(4);
    }
    if (IN(5)) {
        static_assert(attn_body::ATTN_LDS_BYTES <= RING_BYTES, "attention LDS vs frame");
        const attn_body::bf16* Qp = (const attn_body::bf16*)(ws + WS::QO); const attn_body::bf16* Kp = (const attn_body::bf16*)(ws + WS::KB); const attn_body::bf16* Vp = (const attn_body::bf16*)(ws + WS::VB);
        for (int p = vcu; p < 512; p += G) {
            const int s = p & 7, bh = (p < 256) ? (p >> 3) : (32 + (((p - 256) >> 3) ^ 8));
            if ((bh & 15) >= 8) { for (int k = 0; k < 2; ++k)
                attn_body::attn_unit<8, true>(bh >> 4, bh & 15, k ? s : 15 - s, Qp, Kp, Vp, (attn_body::bf16*)(ws + WS::QO), (const unsigned long long*)args.out, (const unsigned*)(ws + WS::BMASK), args.in[I_RB], args.in[I_QNB], args.in[I_KNB], (char*)lds); }
            else { for (int k = 0; k < 2; ++k)
                attn_body::attn_unit<8, false>(bh >> 4, bh & 15, k ? s : 15 - s, Qp, Kp, Vp, (attn_body::bf16*)(ws + WS::QO), (const unsigned long long*)args.out, (const unsigned*)(ws + WS::BMASK), args.in[I_RB], args.in[I_QNA], args.in[I_KNA], (char*)lds); }
        }
        SEAM(5);
    }
    if (IN(6)) {
        pg8::Gemm g{(const bf16_t*)(ws + WS::QO), (const bf16_t*)(ws + WS::WB), M, D, D, D, 1 << 30, 0}; pg8::StaticOrder S; S.init(M, D, G, bx);
        pg8::EpiBranch2 E{(const bf16_t*)(ws + WS::GATES), (bf16_t*)(ws + WS::GM)};
        pg8::gemm_phase<pg8::EpiBranch2, pg8::StaticOrder, false, true>(L + RING_OFF, g, S, E);
        SEAM(6);
    }
    if (IN(7)) {
        pg8::Gemm g{(const bf16_t*)(ws + WS::GM), (const bf16_t*)(ws + WS::WO), M, D, D, D, 1 << 30, 0}; pg8::StaticOrder S; S.init(M, D, G, bx);
        pg8::EpiRes<false, false, true> E{nullptr, XB, nullptr, XB, SSQ, 1.0f};
        pg8::gemm_phase<pg8::EpiRes<false, false, true>, pg8::StaticOrder, false, true>(L + RING_OFF, g, S, E);
        SEAM(7);
    }
    if (IN(8)) {
        pg8::Gemm g{XB, (const bf16_t*)(ws + WS::GU2), M, 2 * DFF, D, D, 1 << 30, 0}; pg8::StaticOrder S; S.init(M, 2 * DFF, G, bx);
        pg8::EpiGu E{ACT, SSQ, (LAS float*)(L + RTAB_OFF)};
        pg8::gemm_phase<pg8::EpiGu, pg8::StaticOrder, true, true>(L + RING_OFF, g, S, E);
        SEAM(8);
    }
    if (IN(9)) {
        pg8::Gemm g{ACT, (const bf16_t*)(ws + WS::DN2), M, D, DFF, DFF, 1 << 30, 0}; pg8::StaticOrder S; S.init(M, D, G, bx);
        pg8::EpiRes<false, true, false> E{nullptr, XB, args.out, nullptr, nullptr, 0.5f};
        pg8::gemm_phase<pg8::EpiRes<false, true, false>, pg8::StaticOrder, false, true>(L + RING_OFF, g, S, E);
    }
#undef IN
#undef SEAM
}

extern "C" void kernel_launch(void* const* d_in, const int* in_sizes, int n_in, void* d_out, int out_size, void* d_ws, size_t ws_size, hipStream_t stream) {
    using namespace K;
    static int grid = 0;
    if (grid == 0) {
        if (n_in != 18 || in_sizes[0] != M * D || out_size != M * D || ws_size < WS::END) { fprintf(stderr, "kernel_launch: unexpected shapes (n_in %d, in0 %d, out %d, ws %zu)\n", n_in, n_in > 0 ? in_sizes[0] : -1, out_size, ws_size); grid = -1; return; }
        int dev = 0, cus = 0, per_cu = 0;
        if (hipGetDevice(&dev) != hipSuccess || hipDeviceGetAttribute(&cus, hipDeviceAttributeMultiprocessorCount, dev) != hipSuccess) { grid = -1; return; }
        if (hipFuncSetAttribute((const void*)mega, hipFuncAttributeMaxDynamicSharedMemorySize, LDS_BYTES) != hipSuccess) { fprintf(stderr, "kernel_launch: hipFuncSetAttribute failed\n"); grid = -1; return; }
        if (hipOccupancyMaxActiveBlocksPerMultiprocessor(&per_cu, (const void*)mega, NWAVES * 64, LDS_BYTES) != hipSuccess || per_cu < 1) { fprintf(stderr, "kernel_launch: occupancy query says %d blocks/CU\n", per_cu); (void)hipGetLastError(); grid = -1; return; }
        grid = cus;
    }
    if (grid < 0) return;
    const float* const* in = (const float* const*)d_in;
    float* out = (float*)d_out; char* ws = (char*)d_ws;
    (void)hipMemsetAsync(ws + WS::CTL, 0, WS::CTL_ZERO_BYTES, stream);
    Args a{};
    for (int i = 0; i < 18; ++i) a.in[i] = in[i];
    a.out = out; a.ws = (unsigned char*)d_ws; a.pad = 0;
    a.ph_lo = 0; a.ph_hi = 10; a.li = 0;
    hipLaunchKernelGGL(mega, dim3(grid), dim3(NWAVES * 64), LDS_BYTES, stream, a);

}
```

```cpp
#include <hip/hip_runtime.h>
#include <hip/hip_bf16.h>
#include <cstdint>
#include <cstdio>
#include <cmath>

namespace K {
constexpr int B = 4, S = 4096, M = B * S, D = 1024, DFF = 2816, H = 8, HD = 64, NIH = 4, IDIM = 64, TOPK = 256, MBLK = 256, NBLK = 16;
constexpr int DIN = 5444;
constexpr float EPS = 1e-6f;
constexpr float LOG2E = 1.4426950408889634f;
constexpr float C2 = 0.125f * LOG2E;
}
typedef unsigned short bf16_t;
typedef unsigned long long u64;

__device__ __forceinline__ bf16_t f2bf(float f) { unsigned u = __float_as_uint(f); return (bf16_t)((u + 0x7fffu + ((u >> 16) & 1u)) >> 16); }
__device__ __forceinline__ int t5_bucket(int d) {
    if (d < 16) return d;
    int large = 16 + (int)(logf((float)d / 16.0f) / 2.0794415416798357f * 16.0f);
    return large < 31 ? large : 31;
}
namespace pg8 {
#define PG8_LAS __attribute__((address_space(3)))
typedef short bf16x8 __attribute__((ext_vector_type(8)));
typedef float f32x4 __attribute__((ext_vector_type(4)));
typedef unsigned u32x4 __attribute__((ext_vector_type(4)));
constexpr int BM = 256, BK = 64, HALF = 128, HTB = HALF * BK * 2  , STAGE_BYTES = 8 * HTB, NXCD = 8, WGM = 8;

__host__ __device__ __forceinline__ int lds_byte(int r, int c) { const int st = (r >> 4) * 2 + (c >> 5), rr = r & 15, cc = c & 31, ob = rr * 64 + cc * 2; return st * 1024 + (ob ^ (((ob >> 9) & 1) << 5)); }
__host__ __device__ __forceinline__ void stage_rc(int b, int& R, int& C) { const int st = b / 1024, sb = b % 1024, swz = sb ^ (((sb >> 9) & 1) << 5); R = (st >> 1) * 16 + swz / 64; C = (st & 1) * 32 + (swz % 64) / 2; }
__host__ __device__ __forceinline__ int perm32(int rho) { const int n = rho >> 4, i = rho & 15; return 8 * (i >> 2) + 4 * n + (i & 3); }

__host__ __device__ __forceinline__ size_t tiled_b_off(int nrow, int k, int nkt) {
    const int ht = nrow >> 7, rb = nrow & 127, c = rb & 31, rho = ((c >> 2) & 1) * 16 + ((c >> 3) << 2) + (c & 3), R = (rb & ~31) + rho;
    return ((size_t)ht * nkt + (k >> 6)) * (size_t)(HALF * BK * 2) + (size_t)lds_byte(R, k & 63);
}
struct Unit { int pm, pn; };
struct Gemm { const bf16_t* A; const bf16_t* Bt; int M, N, K, lda, asplit_pn, asplit_off; };

struct StaticOrder {
    int nM, nN, nwg, G, c;
    __host__ __device__ void init(int M, int N, int G_, int c_) { nM = M / BM; nN = N / BM; nwg = nM * nN; G = G_; c = c_; }
    __host__ __device__ bool next(int i, Unit& u) const {
        const long L = (long)i * G + c; if (L >= nwg) return false;
        int wgid = (int)L; { const int q = nwg / NXCD, r = nwg % NXCD, xcd = wgid % NXCD, off = wgid / NXCD; wgid = (xcd < r ? xcd * (q + 1) : r * (q + 1) + (xcd - r) * q) + off; }
        const int nig = WGM * nN, gid = wgid / nig, fm = gid * WGM, gsz = (nM - fm) < WGM ? (nM - fm) : WGM;
        u.pm = fm + ((wgid % nig) % gsz); u.pn = (wgid % nig) / gsz; return true;
    }
    __device__ __forceinline__ void a_ready(const Unit&) const {}
    __device__ __forceinline__ void done(const Unit&) const {}
};


typedef float f32x2_t __attribute__((ext_vector_type(2))); typedef __bf16 bf16x2_t __attribute__((ext_vector_type(2)));
__device__ __forceinline__ unsigned cvt_pk_bf16(float lo, float hi) { f32x2_t v = {lo, hi}; bf16x2_t b = __builtin_convertvector(v, bf16x2_t); return __builtin_bit_cast(unsigned, b); }
__device__ __forceinline__ float row_rstd(const float* __restrict__ ssq, int row) {
    const f32x4* p = (const f32x4*)(ssq + (size_t)row * 16);
    const f32x4 a = p[0], b = p[1], c = p[2], d = p[3];
    const float s = (((a[0] + a[1]) + (a[2] + a[3])) + ((b[0] + b[1]) + (b[2] + b[3]))) + (((c[0] + c[1]) + (c[2] + c[3])) + ((d[0] + d[1]) + (d[2] + d[3])));
    return 1.0f / sqrtf(s * (1.0f / 1024.0f) + 1e-6f);
}
__device__ __forceinline__ void rstd_stage(const float* __restrict__ ssq, PG8_LAS float* tab, int pm, int wr, int fr, int fq) {
    const int l = fq * 16 + fr;
    tab[l] = row_rstd(ssq, pm * BM + wr * 64 + l);
    tab[64 + l] = row_rstd(ssq, pm * BM + HALF + wr * 64 + l);
    asm volatile("s_waitcnt lgkmcnt(0)" ::: "memory");
}
__device__ __forceinline__ float xrow_sum4(float v) {
    { auto r = __builtin_amdgcn_permlane16_swap(__float_as_uint(v), __float_as_uint(v), false, false); v = __uint_as_float(r[0]) + __uint_as_float(r[1]); }
    { auto r = __builtin_amdgcn_permlane32_swap(__float_as_uint(v), __float_as_uint(v), false, false); v = __uint_as_float(r[0]) + __uint_as_float(r[1]); }
    return v;
}
__device__ __forceinline__ float silu_f(float g) { return g * __builtin_amdgcn_rcpf(1.0f + __builtin_amdgcn_exp2f(-1.4426950408889634f * g)); }
__device__ __forceinline__ float sigmoid_f(float g) { return __builtin_amdgcn_rcpf(1.0f + __builtin_amdgcn_exp2f(-1.4426950408889634f * g)); }

struct EpiGu {
    static constexpr bool PERM = true, AFTER_DRAIN = false, HAS_MID = false;
    bf16_t* act; const float* ssq; PG8_LAS float* rtab;
    __device__ __forceinline__ void operator()(const f32x4 (&acc)[2][2][4][2], const Unit& u, int wr, int wc, int fr, int fq) const {
        asm volatile("" : "+v"(fr), "+v"(fq));
        const int row0 = u.pm * BM + wr * 64 + fr, col0 = u.pn * 128 + wc * 32 + 8 * fq;
        PG8_LAS float* tab = rtab + (wr * 4 + wc) * 128; rstd_stage(ssq, tab, u.pm, wr, fr, fq);
#pragma unroll
        for (int ai = 0; ai < 2; ++ai)
#pragma unroll
            for (int m = 0; m < 4; ++m) {
                const int row = row0 + ai * HALF + m * 16; const float rs = tab[64 * ai + 16 * m + fr];
                float o[8];
#pragma unroll
                for (int n = 0; n < 2; ++n)
#pragma unroll
                    for (int i = 0; i < 4; ++i) o[n * 4 + i] = silu_f(acc[ai][0][m][n][i] * rs) * (acc[ai][1][m][n][i] * rs);
                u32x4 w; w.x = cvt_pk_bf16(o[0], o[1]); w.y = cvt_pk_bf16(o[2], o[3]); w.z = cvt_pk_bf16(o[4], o[5]); w.w = cvt_pk_bf16(o[6], o[7]);
                *(u32x4*)(act + (size_t)row * 2816 + col0) = w;
            }
    }
};
template <bool RIN32, bool OUT32, bool STATS> struct EpiRes {
    static constexpr bool PERM = true, AFTER_DRAIN = false, HAS_MID = false;
    const float* hin32; const bf16_t* hin16; float* hout; bf16_t* hb; float* ssq; float scale;
    __device__ __forceinline__ void operator()(const f32x4 (&acc)[2][2][4][2], const Unit& u, int wr, int wc, int fr, int fq) const {
        asm volatile("" : "+v"(fr), "+v"(fq));
        const int row0 = u.pm * BM + wr * 64 + fr, col0 = u.pn * BM + wc * 32 + 8 * fq;
#pragma unroll
        for (int ai = 0; ai < 2; ++ai)
#pragma unroll
            for (int m = 0; m < 4; ++m) {
                const int row = row0 + ai * HALF + m * 16; float ss = 0.f;
#pragma unroll
                for (int bj = 0; bj < 2; ++bj) {
                    const size_t off = (size_t)row * 1024 + col0 + bj * HALF;
                    f32x4 r0, r1;
                    if (RIN32) { r0 = *(const f32x4*)(hin32 + off); r1 = *(const f32x4*)(hin32 + off + 4); }
                    else { const u32x4 rw = *(const u32x4*)(hin16 + off);
                        r0 = (f32x4){__uint_as_float(rw.x << 16), __uint_as_float(rw.x & 0xffff0000u), __uint_as_float(rw.y << 16), __uint_as_float(rw.y & 0xffff0000u)};
                        r1 = (f32x4){__uint_as_float(rw.z << 16), __uint_as_float(rw.z & 0xffff0000u), __uint_as_float(rw.w << 16), __uint_as_float(rw.w & 0xffff0000u)}; }
                    const f32x4 v0 = r0 + acc[ai][bj][m][0] * scale, v1 = r1 + acc[ai][bj][m][1] * scale;
                    if (OUT32) { *(f32x4*)(hout + off) = v0; *(f32x4*)(hout + off + 4) = v1; }
                    if (STATS) {
                        u32x4 w; w.x = cvt_pk_bf16(v0[0], v0[1]); w.y = cvt_pk_bf16(v0[2], v0[3]); w.z = cvt_pk_bf16(v1[0], v1[1]); w.w = cvt_pk_bf16(v1[2], v1[3]);
                        *(u32x4*)(hb + off) = w;
                        ss += (v0[0] * v0[0] + v0[1] * v0[1]) + (v0[2] * v0[2] + v0[3] * v0[3]) + (v1[0] * v1[0] + v1[1] * v1[1]) + (v1[2] * v1[2] + v1[3] * v1[3]);
                    }
                }
                if (STATS) { ss = xrow_sum4(ss); if (fq == 0) ssq[(size_t)row * 16 + u.pn * 4 + wc] = ss; }
            }
    }
};
struct EpiIn {
    static constexpr bool PERM = true, AFTER_DRAIN = false, HAS_MID = false;
    bf16_t *QO, *KB, *VB, *GATES, *QI, *KI; float* WI; float* KMEAN; const float* ssq; const float* bgate; const float *qn_a, *kn_a, *qn_b, *kn_b; PG8_LAS float* rtab;
    template <int KIND, bool MOBA> __device__ __forceinline__ void qkv(const f32x4 (&acc)[2][2][4][2], const Unit& u, int wr, int wc, int fr, int fq, PG8_LAS float* tab, bf16_t* base, const float* gn) const {
        const int row0 = u.pm * BM + wr * 64 + fr, head = 4 * (u.pn & 1) + wc;
        bf16_t* dst = base + (MOBA ? 512 : 0) + head * 64 + 8 * fq;
        f32x4 gv[2][2];
#pragma unroll
        for (int bj = 0; bj < 2; ++bj)
#pragma unroll
            for (int n = 0; n < 2; ++n) gv[bj][n] = (KIND < 2) ? *(const f32x4*)(gn + 32 * bj + 8 * fq + 4 * n) : (f32x4){1.f, 1.f, 1.f, 1.f};
        constexpr bool km = (KIND == 1) && MOBA;
        f32x4 ks[2][2];
#pragma unroll
        for (int bj = 0; bj < 2; ++bj)
#pragma unroll
            for (int n = 0; n < 2; ++n) ks[bj][n] = (f32x4){0.f, 0.f, 0.f, 0.f};
#pragma unroll
        for (int ai = 0; ai < 2; ++ai)
#pragma unroll
            for (int m = 0; m < 4; ++m) {
                const int row = row0 + ai * HALF + m * 16; const float rs = tab[64 * ai + 16 * m + fr];
                f32x4 v[2][2]; float ss = 0.f;
#pragma unroll
                for (int bj = 0; bj < 2; ++bj)
#pragma unroll
                    for (int n = 0; n < 2; ++n) { v[bj][n] = acc[ai][bj][m][n] * rs; ss += (v[bj][n][0] * v[bj][n][0] + v[bj][n][1] * v[bj][n][1]) + (v[bj][n][2] * v[bj][n][2] + v[bj][n][3] * v[bj][n][3]); }
                if (KIND < 2) {
                    ss = xrow_sum4(ss);
                    float r = 1.0f / sqrtf(ss * (1.0f / 64.0f) + 1e-6f); if (KIND == 0) r *= K::C2;
#pragma unroll
                    for (int bj = 0; bj < 2; ++bj)
#pragma unroll
                        for (int n = 0; n < 2; ++n) v[bj][n] = v[bj][n] * gv[bj][n] * r;
                }
#pragma unroll
                for (int bj = 0; bj < 2; ++bj) {
                    u32x4 w; w.x = cvt_pk_bf16(v[bj][0][0], v[bj][0][1]); w.y = cvt_pk_bf16(v[bj][0][2], v[bj][0][3]); w.z = cvt_pk_bf16(v[bj][1][0], v[bj][1][1]); w.w = cvt_pk_bf16(v[bj][1][2], v[bj][1][3]);
                    *(u32x4*)(dst + (size_t)row * 1024 + 32 * bj) = w;
                    if (km) { ks[bj][0] += v[bj][0]; ks[bj][1] += v[bj][1]; }
                }
                if (km) asm volatile("" : "+v"(ks[0][0]), "+v"(ks[0][1]), "+v"(ks[1][0]), "+v"(ks[1][1]));
                asm volatile("" ::: "memory");
            }
        if (km) {
            float* kd = KMEAN + ((size_t)u.pm * 8 + head) * 64 + 8 * fq;
#pragma unroll
            for (int bj = 0; bj < 2; ++bj)
#pragma unroll
                for (int n = 0; n < 2; ++n)
#pragma unroll
                    for (int i = 0; i < 4; ++i) { float s = ks[bj][n][i]; s += __shfl_xor(s, 1); s += __shfl_xor(s, 2); s += __shfl_xor(s, 4); s += __shfl_xor(s, 8);
                        if (fr == 0) atomicAdd(kd + 32 * bj + 4 * n + i, s); }
        }
    }
    __device__ __forceinline__ void operator()(const f32x4 (&acc)[2][2][4][2], const Unit& u, int wr, int wc, int fr, int fq) const {
        asm volatile("" : "+v"(fr), "+v"(fq));
        const int pn = u.pn, row0 = u.pm * BM + wr * 64 + fr;
        PG8_LAS float* tab = rtab + (wr * 4 + wc) * 128; rstd_stage(ssq, tab, u.pm, wr, fr, fq);
        if (pn < 2) qkv<0, false>(acc, u, wr, wc, fr, fq, tab, QO, qn_a);
        else if (pn < 4) qkv<1, false>(acc, u, wr, wc, fr, fq, tab, KB, kn_a);
        else if (pn < 6) qkv<2, false>(acc, u, wr, wc, fr, fq, tab, VB, nullptr);
        else if (pn < 8) qkv<0, true>(acc, u, wr, wc, fr, fq, tab, QO, qn_b);
        else if (pn < 10) qkv<1, true>(acc, u, wr, wc, fr, fq, tab, KB, kn_b);
        else if (pn < 12) qkv<2, true>(acc, u, wr, wc, fr, fq, tab, VB, nullptr);
        else if (pn == 12) {
#pragma unroll
            for (int ai = 0; ai < 2; ++ai)
#pragma unroll
                for (int m = 0; m < 4; ++m) { const int row = row0 + ai * HALF + m * 16; const float rs = tab[64 * ai + 16 * m + fr];
#pragma unroll
                    for (int bj = 0; bj < 2; ++bj) { const f32x4 a = acc[ai][bj][m][0] * rs, b = acc[ai][bj][m][1] * rs;
                        u32x4 w; w.x = cvt_pk_bf16(a[0], a[1]); w.y = cvt_pk_bf16(a[2], a[3]); w.z = cvt_pk_bf16(b[0], b[1]); w.w = cvt_pk_bf16(b[2], b[3]);
                        *(u32x4*)(QI + (size_t)row * 256 + 128 * bj + 32 * wc + 8 * fq) = w; } }
        } else if (pn == 13) {
#pragma unroll
            for (int ai = 0; ai < 2; ++ai)
#pragma unroll
                for (int m = 0; m < 4; ++m) { const int row = row0 + ai * HALF + m * 16; const float rs = tab[64 * ai + 16 * m + fr];
                    const f32x4 a = acc[ai][0][m][0] * rs, b = acc[ai][0][m][1] * rs;
                    if (wc < 2) { u32x4 w; w.x = cvt_pk_bf16(a[0], a[1]); w.y = cvt_pk_bf16(a[2], a[3]); w.z = cvt_pk_bf16(b[0], b[1]); w.w = cvt_pk_bf16(b[2], b[3]);
                        *(u32x4*)(KI + (size_t)row * 64 + 32 * wc + 8 * fq) = w; }
                    else if (wc == 2 && fq == 0) *(f32x4*)(WI + (size_t)row * 4) = a * 0.5f; }
        } else {
            const int cg0 = 256 * (pn - 14) + 32 * wc + 8 * fq;
            f32x4 bv[2][2];
#pragma unroll
            for (int bj = 0; bj < 2; ++bj)
#pragma unroll
                for (int n = 0; n < 2; ++n) bv[bj][n] = *(const f32x4*)(bgate + cg0 + 128 * bj + 4 * n);
#pragma unroll
            for (int ai = 0; ai < 2; ++ai)
#pragma unroll
                for (int m = 0; m < 4; ++m) { const int row = row0 + ai * HALF + m * 16; const float rs = tab[64 * ai + 16 * m + fr];
#pragma unroll
                    for (int bj = 0; bj < 2; ++bj) { const f32x4 a = acc[ai][bj][m][0] * rs + bv[bj][0], b = acc[ai][bj][m][1] * rs + bv[bj][1];
                        u32x4 w; w.x = cvt_pk_bf16(sigmoid_f(a[0]), sigmoid_f(a[1])); w.y = cvt_pk_bf16(sigmoid_f(a[2]), sigmoid_f(a[3])); w.z = cvt_pk_bf16(sigmoid_f(b[0]), sigmoid_f(b[1])); w.w = cvt_pk_bf16(sigmoid_f(b[2]), sigmoid_f(b[3]));
                        *(u32x4*)(GATES + (size_t)row * 2048 + cg0 + 128 * bj) = w; } }
        }
    }
};
struct EpiBranch2 {
    static constexpr bool PERM = true, AFTER_DRAIN = false, HAS_MID = true;
    const bf16_t* gates; bf16_t* mx;
    __device__ __forceinline__ void mid(f32x4 (&acc)[2][2][4][2], const Unit& u, int wr, int wc, int fr, int fq) const {
        asm volatile("" : "+v"(fr), "+v"(fq));
        const int row0 = u.pm * BM + wr * 64 + fr, col0 = u.pn * BM + wc * 32 + 8 * fq;
#pragma unroll
        for (int ai = 0; ai < 2; ++ai)
#pragma unroll
            for (int m = 0; m < 4; ++m) {
                const int row = row0 + ai * HALF + m * 16;
#pragma unroll
                for (int bj = 0; bj < 2; ++bj) {
                    const size_t off = (size_t)row * 2048 + col0 + bj * HALF;
                    const u32x4 ga = *(const u32x4*)(gates + off), gb = *(const u32x4*)(gates + off + 1024);
                    float r[8];
#pragma unroll
                    for (int x = 0; x < 4; ++x) {
                        r[2 * x] = __uint_as_float(ga[x] << 16) * __builtin_amdgcn_rcpf(__builtin_fmaxf(__uint_as_float(gb[x] << 16), 1e-30f));
                        r[2 * x + 1] = __uint_as_float(ga[x] & 0xffff0000u) * __builtin_amdgcn_rcpf(__builtin_fmaxf(__uint_as_float(gb[x] & 0xffff0000u), 1e-30f)); }
                    acc[ai][bj][m][0] = acc[ai][bj][m][0] * (f32x4){r[0], r[1], r[2], r[3]};
                    acc[ai][bj][m][1] = acc[ai][bj][m][1] * (f32x4){r[4], r[5], r[6], r[7]};
                }
                asm volatile("" ::: "memory");
            }
    }
    __device__ __forceinline__ void operator()(const f32x4 (&acc)[2][2][4][2], const Unit& u, int wr, int wc, int fr, int fq) const {
        asm volatile("" : "+v"(fr), "+v"(fq));
        const int row0 = u.pm * BM + wr * 64 + fr, col0 = u.pn * BM + wc * 32 + 8 * fq;
#pragma unroll
        for (int ai = 0; ai < 2; ++ai)
#pragma unroll
            for (int m = 0; m < 4; ++m) {
                const int row = row0 + ai * HALF + m * 16;
#pragma unroll
                for (int bj = 0; bj < 2; ++bj) {
                    const u32x4 gw = *(const u32x4*)(gates + (size_t)row * 2048 + 1024 + col0 + bj * HALF);
                    const f32x4 a = acc[ai][bj][m][0], b = acc[ai][bj][m][1];
                    u32x4 w;
                    w.x = cvt_pk_bf16(a[0] * __builtin_fmaxf(__uint_as_float(gw.x << 16), 1e-30f), a[1] * __builtin_fmaxf(__uint_as_float(gw.x & 0xffff0000u), 1e-30f));
                    w.y = cvt_pk_bf16(a[2] * __builtin_fmaxf(__uint_as_float(gw.y << 16), 1e-30f), a[3] * __builtin_fmaxf(__uint_as_float(gw.y & 0xffff0000u), 1e-30f));
                    w.z = cvt_pk_bf16(b[0] * __builtin_fmaxf(__uint_as_float(gw.z << 16), 1e-30f), b[1] * __builtin_fmaxf(__uint_as_float(gw.z & 0xffff0000u), 1e-30f));
                    w.w = cvt_pk_bf16(b[2] * __builtin_fmaxf(__uint_as_float(gw.w << 16), 1e-30f), b[3] * __builtin_fmaxf(__uint_as_float(gw.w & 0xffff0000u), 1e-30f));
                    *(u32x4*)(mx + (size_t)row * 1024 + col0 + bj * HALF) = w;
                }
                asm volatile("" ::: "memory");
            }
    }
};
template <class Epi, class Sched, bool ALIGN_EPI = false, bool SP2 = false>
__device__ __forceinline__ void gemm_phase(PG8_LAS unsigned char* lds, const Gemm g, const Sched& S, const Epi& E) {
    const int tid = threadIdx.x, wid = __builtin_amdgcn_readfirstlane(tid >> 6), lane = tid & 63, wr = wid >> 2, wc = wid & 3, fr = lane & 15, fq = lane >> 4;
    const int K = g.K, nt = K / BK;
    unsigned voffA[2], voffB[2];
#pragma unroll
    for (int i = 0; i < 2; ++i) { int R, C; stage_rc(tid * 16 + i * 8192, R, C); const int Rb = Epi::PERM ? ((R & ~31) + perm32(R & 31)) : R;
        voffA[i] = (unsigned)(R * g.lda + C) * 2u; voffB[i] = (unsigned)(tid * 16 + i * 8192); (void)Rb; }
    const size_t kstep = (size_t)(BK * 2), kstepB = (size_t)HTB;
    const size_t hstepA = (size_t)HALF * g.lda * 2, hstepB = (size_t)nt * kstepB;
    const size_t tstepA = 2 * hstepA, tstepB = 2 * hstepB;
#define PG8_ABASE(u_) ((const char*)g.A + (size_t)(u_).pm * tstepA + (((u_).pn >= g.asplit_pn) ? (size_t)g.asplit_off : (size_t)0))
    const unsigned ldsw = (unsigned)wid * 1024u;
    const int aoff = lds_byte(wr * 64 + fr, fq * 8), boff = lds_byte(wc * 32 + fr, fq * 8);
#define PG8_SA(b, h) (((b) * 2 + (h)) * HTB)
#define PG8_SB(b, h) ((4 + (b) * 2 + (h)) * HTB)
#define PG8_STAGE(bufoff, gbase, voff) do { _Pragma("unroll") for (int _i = 0; _i < 2; ++_i) \
        __builtin_amdgcn_global_load_lds((const unsigned*)((const char*)(gbase) + (voff)[_i]), (PG8_LAS unsigned*)(lds + (bufoff) + ldsw + _i * 8192), 16, 0, 0); } while (0)
#define PG8_LDA(dst, b, h) do { _Pragma("unroll") for (int m = 0; m < 4; ++m) _Pragma("unroll") for (int k = 0; k < 2; ++k) dst[m][k] = *(const PG8_LAS bf16x8*)(lds + PG8_SA(b, h) + aoff + m * 2048 + k * 1024); } while (0)
#define PG8_LDB(dst, b, h) do { _Pragma("unroll") for (int n = 0; n < 2; ++n) _Pragma("unroll") for (int k = 0; k < 2; ++k) dst[n][k] = *(const PG8_LAS bf16x8*)(lds + PG8_SB(b, h) + boff + n * 2048 + k * 1024); } while (0)
#define PG8_MMA(ai, bj, At, Bt) do { __builtin_amdgcn_s_setprio(1); _Pragma("unroll") for (int m = 0; m < 4; ++m) _Pragma("unroll") for (int n = 0; n < 2; ++n) _Pragma("unroll") for (int k = 0; k < 2; ++k) \
        acc[ai][bj][m][n] = __builtin_amdgcn_mfma_f32_16x16x32_bf16(Bt[n][k], At[m][k], acc[ai][bj][m][n], 0, 0, 0); __builtin_amdgcn_s_setprio(0); } while (0)
#define PG8_WAIT_V(n) asm volatile("s_waitcnt vmcnt(" #n ")" ::: "memory")
#define PG8_WAIT_L(n) asm volatile("s_waitcnt lgkmcnt(" #n ")" ::: "memory")
#define PG8_BAR __builtin_amdgcn_s_barrier()
#define PG8_SCHED __builtin_amdgcn_sched_barrier(0)
    Unit cur, nxt; int ui = 0;
    if (!S.next(0, cur)) return;
    f32x4 acc[2][2][4][2];
#pragma unroll
    for (int a = 0; a < 2; ++a)
#pragma unroll
        for (int b = 0; b < 2; ++b)
#pragma unroll
            for (int m = 0; m < 4; ++m)
#pragma unroll
                for (int n = 0; n < 2; ++n) acc[a][b][m][n] = (f32x4){0.f, 0.f, 0.f, 0.f};
    bf16x8 At[4][2], B0[2][2], B1[2][2];
    const char* cA = PG8_ABASE(cur); const char* cB = (const char*)g.Bt + (size_t)cur.pn * tstepB;
    S.a_ready(cur);
    if constexpr (SP2) {
        PG8_STAGE(PG8_SB(0, 0), cB, voffB); PG8_STAGE(PG8_SB(0, 1), cB + hstepB, voffB); PG8_STAGE(PG8_SA(0, 0), cA, voffA); PG8_STAGE(PG8_SA(0, 1), cA + hstepA, voffA);
        PG8_STAGE(PG8_SB(1, 0), cB + kstepB, voffB); PG8_STAGE(PG8_SA(1, 0), cA + kstep, voffA); PG8_STAGE(PG8_SB(1, 1), cB + hstepB + kstepB, voffB);
        if (wr == 1) PG8_BAR;
        PG8_WAIT_V(8); PG8_BAR;
        PG8_WAIT_V(6); PG8_BAR;
    } else {
        PG8_STAGE(PG8_SB(0, 0), cB, voffB); PG8_STAGE(PG8_SA(0, 0), cA, voffA); PG8_STAGE(PG8_SB(0, 1), cB + hstepB, voffB); PG8_STAGE(PG8_SA(0, 1), cA + hstepA, voffA);
        if (wr == 1) PG8_BAR;
        PG8_WAIT_V(4); PG8_BAR;
        PG8_STAGE(PG8_SB(1, 0), cB + kstepB, voffB); PG8_STAGE(PG8_SA(1, 0), cA + kstep, voffA); PG8_STAGE(PG8_SB(1, 1), cB + hstepB + kstepB, voffB);
        PG8_WAIT_V(6); PG8_BAR;
    }
    for (;;) {
        const bool has_next = S.next(ui + 1, nxt);
        const char* nA = has_next ? PG8_ABASE(nxt) : cA; const char* nB = has_next ? (const char*)g.Bt + (size_t)nxt.pn * tstepB : cB;
        for (int t = 0; t < nt; t += 2) {
            const bool last = (t == nt - 2);
            const char* a1 = cA + (size_t)(t + 1) * kstep;
            const char* a2 = last ? nA : cA + (size_t)(t + 2) * kstep; const char* b2 = last ? nB : cB + (size_t)(t + 2) * kstepB;
            const char* a3 = a2 + kstep; const char* b3 = b2 + kstepB;
            if (last && has_next) S.a_ready(nxt);
            if constexpr (SP2) {
            PG8_LDB(B0, 0, 0); PG8_LDB(B1, 0, 1); PG8_SCHED; PG8_LDA(At, 0, 0); PG8_STAGE(PG8_SA(1, 1), a1 + hstepA, voffA);
            PG8_WAIT_V(8); PG8_WAIT_L(0); PG8_BAR; PG8_MMA(0, 0, At, B0); PG8_MMA(0, 1, At, B1); PG8_BAR; PG8_SCHED;
            PG8_LDA(At, 0, 1); PG8_STAGE(PG8_SB(0, 0), b2, voffB); PG8_STAGE(PG8_SB(0, 1), b2 + hstepB, voffB); PG8_STAGE(PG8_SA(0, 0), a2, voffA);
            PG8_WAIT_V(8); PG8_WAIT_L(0); PG8_BAR; PG8_MMA(1, 0, At, B0); PG8_MMA(1, 1, At, B1); PG8_BAR; PG8_SCHED;
            PG8_LDB(B0, 1, 0); PG8_LDB(B1, 1, 1); PG8_SCHED; PG8_LDA(At, 1, 0); PG8_STAGE(PG8_SA(0, 1), a2 + hstepA, voffA);
            PG8_WAIT_V(8); PG8_WAIT_L(0); PG8_BAR; PG8_MMA(0, 0, At, B0); PG8_MMA(0, 1, At, B1); PG8_BAR; PG8_SCHED;
            PG8_LDA(At, 1, 1); PG8_STAGE(PG8_SB(1, 0), b3, voffB); PG8_STAGE(PG8_SB(1, 1), b3 + hstepB, voffB); PG8_STAGE(PG8_SA(1, 0), a3, voffA);
            PG8_WAIT_V(8); PG8_WAIT_L(0); PG8_BAR; PG8_MMA(1, 0, At, B0); PG8_MMA(1, 1, At, B1); PG8_BAR; PG8_SCHED;
            } else {
            PG8_LDB(B0, 0, 0); PG8_SCHED; PG8_LDA(At, 0, 0); PG8_STAGE(PG8_SA(1, 1), a1 + hstepA, voffA);
            PG8_WAIT_L(8); PG8_BAR; PG8_WAIT_L(0); PG8_MMA(0, 0, At, B0); PG8_BAR; PG8_SCHED;
            PG8_LDB(B1, 0, 1); PG8_STAGE(PG8_SB(0, 0), b2, voffB);
            PG8_BAR; PG8_WAIT_L(0); PG8_MMA(0, 1, At, B1); PG8_BAR;
            PG8_LDA(At, 0, 1); PG8_STAGE(PG8_SA(0, 0), a2, voffA);
            PG8_BAR; PG8_WAIT_L(0); PG8_MMA(1, 0, At, B0); PG8_BAR; PG8_SCHED;
            PG8_STAGE(PG8_SB(0, 1), b2 + hstepB, voffB);
            PG8_WAIT_V(6); PG8_BAR; PG8_MMA(1, 1, At, B1); PG8_BAR;
            PG8_LDB(B0, 1, 0); PG8_SCHED; PG8_LDA(At, 1, 0); PG8_STAGE(PG8_SA(0, 1), a2 + hstepA, voffA);
            PG8_WAIT_L(8); PG8_BAR; PG8_WAIT_L(0); PG8_MMA(0, 0, At, B0); PG8_BAR; PG8_SCHED;
            PG8_LDB(B1, 1, 1); PG8_STAGE(PG8_SB(1, 0), b3, voffB);
            PG8_BAR; PG8_WAIT_L(0); PG8_MMA(0, 1, At, B1); PG8_BAR;
            PG8_LDA(At, 1, 1); PG8_STAGE(PG8_SA(1, 0), a3, voffA);
            PG8_BAR; PG8_WAIT_L(0); PG8_MMA(1, 0, At, B0); PG8_BAR; PG8_SCHED;
            PG8_STAGE(PG8_SB(1, 1), b3 + hstepB, voffB);
            PG8_WAIT_V(6); PG8_BAR; PG8_MMA(1, 1, At, B1); PG8_BAR;
            }
            if constexpr (Epi::HAS_MID) { if (t + 2 == nt / 2) E.mid(acc, cur, wr, wc, fr, fq); }
        }
        if constexpr (ALIGN_EPI) { if (wr == 0) PG8_BAR; }
        if constexpr (!Epi::AFTER_DRAIN) { E(acc, cur, wr, wc, fr, fq); S.done(cur); }
        if (!has_next) break;
#pragma unroll
        for (int a = 0; a < 2; ++a)
#pragma unroll
            for (int b = 0; b < 2; ++b)
#pragma unroll
                for (int m = 0; m < 4; ++m)
#pragma unroll
                    for (int n = 0; n < 2; ++n) acc[a][b][m][n] = (f32x4){0.f, 0.f, 0.f, 0.f};
        cur = nxt; cA = nA; cB = nB; ++ui;
        if constexpr (ALIGN_EPI) { if (wr == 1) PG8_BAR; }
    }
    PG8_WAIT_V(0);
    if constexpr (!ALIGN_EPI) { if (wr == 0) PG8_BAR; }
    PG8_BAR;
    if constexpr (Epi::AFTER_DRAIN) { E.fused(acc, cur, wr, wc, fr, fq, lds, wid, lane); S.done(cur); }
#undef PG8_ABASE
#undef PG8_SA
#undef PG8_SB
#undef PG8_STAGE
#undef PG8_LDA
#undef PG8_LDB
#undef PG8_MMA
#undef PG8_WAIT_V
#undef PG8_WAIT_L
#undef PG8_BAR
#undef PG8_SCHED
}
}

constexpr int NWAVES = 8;
namespace WS {
constexpr size_t MiB = 1u << 20;
constexpr size_t CTL = 0, CTL_ZERO_BYTES = 1 * MiB;
constexpr size_t KMEAN = 512 * 1024;
constexpr size_t SSQ = 1 * MiB;
constexpr size_t GU1 = 2 * MiB, DN1 = 13 * MiB, WIN = 19 * MiB, WB = 30 * MiB, WO = 32 * MiB, GU2 = 36 * MiB, DN2 = 47 * MiB;
constexpr size_t XB = 53 * MiB;
constexpr size_t QO = 85 * MiB, KB = 117 * MiB, VB = 149 * MiB;
constexpr size_t GATES = 181 * MiB;
constexpr size_t QI = 245 * MiB, KI = 253 * MiB, WI = 255 * MiB, BMASK = 255 * MiB + 256 * 1024;
constexpr size_t ACT = 85 * MiB;
constexpr size_t GM = 117 * MiB;
constexpr size_t END = 256 * MiB;
}
constexpr int CW_BAR = 4096;
constexpr int RING_OFF = 0, RING_BYTES = 131072;
constexpr int LDSCTL_OFF = RING_BYTES, MISC_OFF = LDSCTL_OFF + 320;
constexpr int RTAB_OFF = LDSCTL_OFF + 1024;
constexpr int LDS_BYTES = 147456;

#define GAS __attribute__((address_space(1)))
#define LAS __attribute__((address_space(3)))
typedef unsigned v4u __attribute__((ext_vector_type(4)));
typedef float f32x4 __attribute__((ext_vector_type(4)));
typedef GAS unsigned gu32;
#define LDS_WAIT() asm volatile("s_waitcnt lgkmcnt(0)" ::: "memory")
#define VM_WAIT() asm volatile("s_waitcnt vmcnt(0)" ::: "memory")
__device__ __forceinline__ unsigned pk2(float lo, float hi) { return (unsigned)f2bf(lo) | ((unsigned)f2bf(hi) << 16); }
#define XB_TMO      128
#define XB_XCNT(j)  (256  + 64 * (j))
#define XB_XSUB(j)  (1280 + 64 * (j))
#define XB_XGEN(j)  (2304 + 64 * (j))
#define XB_TOP      3328
#define XB_TOPGEN   3392
#define XCD_BAR_WORDS 3456
#define XB_SPIN_CAP (1u << 18)

__device__ __forceinline__ unsigned xb_ld(unsigned* p)              { return __hip_atomic_load(p, __ATOMIC_RELAXED, __HIP_MEMORY_SCOPE_AGENT); }
__device__ __forceinline__ unsigned xb_add(unsigned* p, unsigned v) { return __hip_atomic_fetch_add(p, v, __ATOMIC_RELAXED, __HIP_MEMORY_SCOPE_AGENT); }
__device__ __forceinline__ unsigned xb_xcc_id() { return (unsigned)__builtin_amdgcn_s_getreg((3 << 11) | 20) & 0xFu; }
#define XB_SPIN(cond, bar) do { unsigned _sp = 0; while (cond) { __builtin_amdgcn_s_sleep(1); \
    if ((++_sp & 255u) == 0u) { if (xb_ld(&(bar)[XB_TMO])) break; if (_sp > XB_SPIN_CAP) { atomicAdd(&(bar)[XB_TMO], 1u); break; } } } } while (0)

struct XcdBarrier {
    unsigned* bar; unsigned x;
    volatile LAS unsigned* st;
};

__device__ __forceinline__ XcdBarrier xcd_barrier_post(unsigned* bar, volatile LAS unsigned* st) {
    XcdBarrier b; b.bar = bar; b.x = xb_xcc_id(); b.st = st;
    if (threadIdx.x == 0) (void)xb_add(&bar[XB_XCNT(b.x)], 1u);
    return b;
}
__device__ __forceinline__ void xcd_barrier_complete(unsigned* bar, unsigned x, unsigned& nloc, unsigned& nx) {
    const unsigned G = gridDim.x * gridDim.y * gridDim.z;
    unsigned sum, cnt, mine, sp = 0u;
    for (;;) {
        sum = 0u; cnt = 0u; mine = 0u;
#pragma unroll
        for (unsigned j = 0; j < 16; ++j) { const unsigned c = xb_ld(&bar[XB_XCNT(j)]); sum += c; cnt += (c > 0u) ? 1u : 0u; mine = (j == x) ? c : mine; }
        if (sum == G) break;
        __builtin_amdgcn_s_sleep(1);
        if ((++sp & 255u) == 0u) { if (xb_ld(&bar[XB_TMO])) break; if (sp > XB_SPIN_CAP) { atomicAdd(&bar[XB_TMO], 1u); break; } }
    }
    nloc = mine > 0u ? mine : 1u; nx = cnt > 0u ? cnt : 1u;
}

__device__ __forceinline__ void xcd_barrier(const XcdBarrier& b) {
    asm volatile("s_waitcnt vmcnt(0)" ::: "memory");
    __syncthreads();
    if (threadIdx.x == 0) {
        unsigned* bar = b.bar;
        __builtin_amdgcn_s_waitcnt(0);
        unsigned nloc = b.st[0], nx = b.st[1];
        if (nloc == 0u) { xcd_barrier_complete(bar, b.x, nloc, nx); b.st[0] = nloc; b.st[1] = nx; }
        const unsigned old = xb_add(&bar[XB_XSUB(b.x)], 1u);
        const unsigned gen = old / nloc;
        if (old + 1u == (gen + 1u) * nloc) {
            __builtin_amdgcn_fence(__ATOMIC_RELEASE, "agent");
            asm volatile("s_waitcnt vmcnt(0)" ::: "memory");
            const unsigned og = xb_add(&bar[XB_TOP], 1u);
            const unsigned tg = og / nx;
            if (og + 1u == (tg + 1u) * nx) xb_add(&bar[XB_TOPGEN], 1u);
            else XB_SPIN(xb_ld(&bar[XB_TOPGEN]) == tg, bar);
            __builtin_amdgcn_fence(__ATOMIC_ACQUIRE, "agent");
            xb_add(&bar[XB_XGEN(b.x)], 1u);
            asm volatile("s_waitcnt vmcnt(0)" ::: "memory");
        } else {
            XB_SPIN(xb_ld(&bar[XB_XGEN(b.x)]) == gen, bar);
            __builtin_amdgcn_fence(__ATOMIC_ACQUIRE, "agent");
            asm volatile("s_waitcnt vmcnt(0)" ::: "memory");
        }
    }
    __syncthreads();
}

namespace tk {
typedef short bf16x8 __attribute__((ext_vector_type(8)));
typedef float f32x4 __attribute__((ext_vector_type(4)));
constexpr int HIST_OFF = 0, HSTR = 1025;
constexpr int TCNT_OFF = 65664;
constexpr int MSTG_OFF = TCNT_OFF + 16384;
constexpr int TBASE_OFF = MSTG_OFF + 8192;
constexpr int RES_OFF = TBASE_OFF + 8192;
constexpr int QST_OFF = 102400;
#define TK_BAR() do { asm volatile("s_waitcnt lgkmcnt(0)" ::: "memory"); __builtin_amdgcn_s_barrier(); asm volatile("" ::: "memory"); } while (0)

__device__ __forceinline__ unsigned wave_prefix_incl(unsigned x) {
    x += (unsigned)__builtin_amdgcn_update_dpp(0, (int)x, 0x111, 0xf, 0xf, true);
    x += (unsigned)__builtin_amdgcn_update_dpp(0, (int)x, 0x112, 0xf, 0xf, true);
    x += (unsigned)__builtin_amdgcn_update_dpp(0, (int)x, 0x114, 0xf, 0xf, true);
    x += (unsigned)__builtin_amdgcn_update_dpp(0, (int)x, 0x118, 0xf, 0xf, true);
    x += (unsigned)__builtin_amdgcn_update_dpp(0, (int)x, 0x142, 0xa, 0xf, false);
    x += (unsigned)__builtin_amdgcn_update_dpp(0, (int)x, 0x143, 0xc, 0xf, false);
    return x;
}
template <int NW>
__device__ __forceinline__ void scan_query(const LAS unsigned* hq, LAS unsigned* res, int qq, unsigned r, int lane) {
    const int wbase = (63 - lane) * NW;
    unsigned ws = 0;
#pragma unroll
    for (int x = 0; x < NW; ++x) ws += hq[wbase + x];
    const unsigned tot = (ws & 0xffffu) + (ws >> 16);
    const unsigned incl = wave_prefix_incl(tot);
    const unsigned above = incl - tot;
    const unsigned long long bal = __ballot(above < r && incl >= r);
    const int Ls = __builtin_amdgcn_readfirstlane((int)__builtin_ctzll(bal));
    const unsigned r2 = r - (unsigned)__builtin_amdgcn_readlane((int)above, Ls);
    const int word = (63 - Ls) * NW + (NW - 1 - (lane & (NW - 1)));
    const unsigned w = hq[word], hi = w >> 16, lo = w & 0xffffu, t2 = hi + lo;
    unsigned inc2 = t2;
    inc2 += (unsigned)__builtin_amdgcn_update_dpp(0, (int)inc2, 0x111, 0xf, 0xf, true);
    inc2 += (unsigned)__builtin_amdgcn_update_dpp(0, (int)inc2, 0x112, 0xf, 0xf, true);
    inc2 += (unsigned)__builtin_amdgcn_update_dpp(0, (int)inc2, 0x114, 0xf, 0xf, true);
    inc2 += (unsigned)__builtin_amdgcn_update_dpp(0, (int)inc2, 0x118, 0xf, 0xf, true);
    const unsigned ab2 = inc2 - t2;
    if (lane < NW && ab2 < r2 && inc2 >= r2) {
        const bool uh = ab2 + hi >= r2;
        res[qq] = (unsigned)word * 2u + (uh ? 1u : 0u); res[16 + qq] = r2 - (uh ? ab2 : ab2 + hi); res[32 + qq] = uh ? hi : lo;
    }
}

__device__ __forceinline__ void tk_prefetch_q(LAS unsigned char* L, const bf16_t* __restrict__ QI, const float* __restrict__ WI, int b, int tq0, int lane) {
    const size_t row = (size_t)b * K::S + tq0 + (lane & 15);
#pragma unroll
    for (int f = 0; f < 8; ++f) __builtin_amdgcn_global_load_lds((const unsigned*)(QI + row * 256 + (f >> 1) * 64 + (f & 1) * 32 + (lane >> 4) * 8), (LAS unsigned*)(L + QST_OFF + f * 1024), 16, 0, 0);
    __builtin_amdgcn_global_load_lds((const unsigned*)(WI + row * 4), (LAS unsigned*)(L + QST_OFF + 8192), 16, 0, 0);
}
#define TK_S(F_, i_, rest_) if (8 * (i_) <= jw) { F_.template operator()<i_>(); rest_ }
#define TK_SLOTS(F_) do { TK_S(F_, 0, TK_S(F_, 1, TK_S(F_, 2, TK_S(F_, 3, TK_S(F_, 4, TK_S(F_, 5, TK_S(F_, 6, TK_S(F_, 7, TK_S(F_, 8, TK_S(F_, 9, TK_S(F_, 10, TK_S(F_, 11, TK_S(F_, 12, TK_S(F_, 13, TK_S(F_, 14, TK_S(F_, 15, TK_S(F_, 16, TK_S(F_, 17, TK_S(F_, 18, TK_S(F_, 19, TK_S(F_, 20, TK_S(F_, 21, TK_S(F_, 22, TK_S(F_, 23, TK_S(F_, 24, TK_S(F_, 25, TK_S(F_, 26, TK_S(F_, 27, TK_S(F_, 28, TK_S(F_, 29, TK_S(F_, 30, TK_S(F_, 31, )))))))))))))))))))))))))))))))) } while (0)
template <int PV>
__device__ __forceinline__ void topk_group(LAS unsigned char* L, const bf16_t* __restrict__ QI, const bf16_t* __restrict__ KI, const float* __restrict__ WI, u64* __restrict__ MASK,
                                           int b, int tq0, int nb, int ntq0, int tid, int lane, int wave, int nrep = 1) {
    using namespace K;
    const int q = lane & 15, g = lane >> 4;
    const int row0 = b * S + tq0, jmax = tq0 >> 4, jw = jmax - wave;
    LAS unsigned* hist = (LAS unsigned*)(L + HIST_OFF); LAS unsigned* tcnt = (LAS unsigned*)(L + TCNT_OFF);
    LAS unsigned short* mstg = (LAS unsigned short*)(L + MSTG_OFF); LAS unsigned short* tbase = (LAS unsigned short*)(L + TBASE_OFF); LAS unsigned* res = (LAS unsigned*)(L + RES_OFF);
    for (int i = tid; i < (16384 + 8192) / 4; i += NWAVES * 64) tcnt[i] = 0u;
    if (tq0 < TOPK) {
        if (wave == 0 && ntq0 >= TOPK) tk_prefetch_q(L, QI, WI, nb, ntq0, lane);
        TK_BAR();
        for (int idx = tid; idx < 16 * (jmax + 1); idx += NWAVES * 64) { const int qq = idx & 15, j = idx >> 4; mstg[qq * 256 + j] = (unsigned short)((j < jmax) ? 0xffffu : ((2u << qq) - 1u)); }
    } else {
        unsigned key[32][4];
        for (int i = tid; i < 16 * HSTR / 4; i += NWAVES * 64) ((LAS v4u*)hist)[i] = (v4u){0u, 0u, 0u, 0u};
        if (wave == 0) asm volatile("s_waitcnt vmcnt(0)" ::: "memory");
        TK_BAR();
        bf16x8 qf[4][2];
#pragma unroll
        for (int h = 0; h < 4; ++h)
#pragma unroll
            for (int ks = 0; ks < 2; ++ks) qf[h][ks] = *(const LAS bf16x8*)(L + QST_OFF + (h * 2 + ks) * 1024 + lane * 16);
        const f32x4 wv = *(const LAS f32x4*)(L + QST_OFF + 8192 + lane * 16);
        bf16x8 kk[3][2];
#define TK_LOADK(i_) do { const int o_ = 8 * (i_), jc_ = wave + (o_ < jw ? o_ : jw); const bf16_t* kp_ = KI + (size_t)(b * S + jc_ * 16 + q) * 64 + g * 8; \
            kk[(i_) % 3][0] = *(const bf16x8*)kp_; kk[(i_) % 3][1] = *(const bf16x8*)(kp_ + 32); } while (0)
        TK_LOADK(0); TK_LOADK(1);
        const int lim = q - 4 * g;
        auto sslot = [&]<int i>() __attribute__((always_inline)) {
            if (i < 30) TK_LOADK(i + 2);
            asm volatile("" ::: "memory");
            f32x4 sc = {0.f, 0.f, 0.f, 0.f};
#pragma unroll
            for (int h = 0; h < 4; ++h) {
                f32x4 d = __builtin_amdgcn_mfma_f32_16x16x32_bf16(kk[i % 3][0], qf[h][0], (f32x4){0.f, 0.f, 0.f, 0.f}, 0, 0, 0);
                d = __builtin_amdgcn_mfma_f32_16x16x32_bf16(kk[i % 3][1], qf[h][1], d, 0, 0, 0);
#pragma unroll
                for (int r = 0; r < 4; ++r) { const int di = __float_as_int(d[r]); sc[r] = __builtin_fmaf(wv[h], __int_as_float(di > 0 ? di : 0), sc[r]); }
            }
            const int tl = (8 * i == jw) ? lim : 3;
#pragma unroll
            for (int r = 0; r < 4; ++r) {
                const unsigned u = __float_as_uint(sc[r]);
                const unsigned k = (r > tl) ? 0u : (u ^ ((unsigned)((int)u >> 31) | 0x80000000u));
                key[i][r] = k;
                if (PV != 3) { const unsigned bin = k >> 21; __hip_atomic_fetch_add(hist + q * HSTR + (bin >> 1), k ? (1u << (16 * (bin & 1u))) : 0u, __ATOMIC_RELAXED, __HIP_MEMORY_SCOPE_WORKGROUP); }
            }
            __builtin_amdgcn_sched_barrier(0);
        };
        TK_SLOTS(sslot);
#undef TK_LOADK
        if (PV == 1 || PV == 3) {
            unsigned xs = 0u;
#pragma unroll
            for (int i = 0; i < 32; ++i) { if (8 * i <= jw) {
#pragma unroll
                for (int r = 0; r < 4; ++r) xs ^= key[i][r]; } }
            TK_BAR();
            if (wave == 0 && ntq0 >= TOPK) tk_prefetch_q(L, QI, WI, nb, ntq0, lane);
            res[64 + lane] = xs;
        } else {
        int ln = lane; asm volatile("" : "+v"(ln));
        LAS unsigned* const tc_q = tcnt + (ln & 15) * 256 + wave; LAS unsigned short* const tb_q = tbase + (ln & 15) * 256 + wave;
        LAS unsigned* const ms32_q = (LAS unsigned*)mstg + (((ln & 15) * 256 + wave) >> 1); const unsigned sh_q = 16u * (wave & 1) + 4u * (unsigned)(ln >> 4);
        unsigned prefix = 0u, rnk = (unsigned)TOPK, cnt_eq = 0u;
#pragma unroll
        for (int pass = 0; pass < ((PV == 5) ? 1 : (PV == 6) ? 2 : 3); ++pass) {
            const int shift = (pass == 0) ? 21 : (pass == 1 ? 10 : 0), pshift = (pass == 1) ? 21 : 10; const unsigned bmask = (pass == 2) ? 1023u : 2047u;
            if (pass != 0) {
            TK_BAR();
            if (pass == 1 && wave == 0 && ntq0 >= TOPK) tk_prefetch_q(L, QI, WI, nb, ntq0, lane);
            for (int i = tid; i < 16 * HSTR / 4; i += NWAVES * 64) ((LAS v4u*)hist)[i] = (v4u){0u, 0u, 0u, 0u};
            TK_BAR();
            const LAS unsigned* const hq_c = hist + q * HSTR; LAS unsigned* const hq = (LAS unsigned*)hq_c;
            auto pslot = [&]<int i>() __attribute__((always_inline)) {
#pragma unroll
                for (int r = 0; r < 4; ++r) {
                    const unsigned k = key[i][r];
                    const unsigned word = (pass == 1) ? ((k >> 11) & 1023u) : ((k >> 1) & 511u);
                    const unsigned inc = (k & ((pass == 1) ? 0x400u : 1u)) ? 0x10000u : 1u;
                    __hip_atomic_fetch_add(hq + word, ((k >> pshift) == prefix) ? inc : 0u, __ATOMIC_RELAXED, __HIP_MEMORY_SCOPE_WORKGROUP);
                }
            };
            TK_SLOTS(pslot);
            }
            TK_BAR();
            { const unsigned r0 = (unsigned)__builtin_amdgcn_readlane((int)rnk, 2 * wave), r1 = (unsigned)__builtin_amdgcn_readlane((int)rnk, 2 * wave + 1);
              if (pass < 2) { scan_query<16>(hist + (2 * wave) * HSTR, res, 2 * wave, r0, lane); scan_query<16>(hist + (2 * wave + 1) * HSTR, res, 2 * wave + 1, r1, lane); }
              else { scan_query<8>(hist + (2 * wave) * HSTR, res, 2 * wave, r0, lane); scan_query<8>(hist + (2 * wave + 1) * HSTR, res, 2 * wave + 1, r1, lane); } }
            TK_BAR();
            prefix = (prefix << ((pass == 2) ? 10 : 11)) | res[q]; rnk = res[16 + q]; cnt_eq = res[32 + q];
        }
        const unsigned T = prefix, need = rnk;
        const bool slow = (PV == 5 || PV == 6) ? false : __any(need != cnt_eq);
        if (slow) {
#pragma unroll
            for (int i = 0; i < 32; ++i) {
                if (8 * i <= jw) {
                    unsigned c = 0;
#pragma unroll
                    for (int r = 0; r < 4; ++r) c += (key[i][r] == T) ? 1u : 0u;
                    if (c) __hip_atomic_fetch_add(tc_q + 8 * i, c << (8 * g), __ATOMIC_RELAXED, __HIP_MEMORY_SCOPE_WORKGROUP);
                }
            }
            TK_BAR();
#pragma unroll
            for (int s = 0; s < 2; ++s) {
                const int qq = 2 * wave + s; unsigned tt[4], tot = 0;
#pragma unroll
                for (int x = 0; x < 4; ++x) { const unsigned e = tcnt[qq * 256 + lane * 4 + x]; tt[x] = (e & 255u) + ((e >> 8) & 255u) + ((e >> 16) & 255u) + (e >> 24); tot += tt[x]; }
                const unsigned incl = wave_prefix_incl(tot);
                unsigned base = incl - tot;
#pragma unroll
                for (int x = 0; x < 4; ++x) { tbase[qq * 256 + lane * 4 + x] = (unsigned short)base; base += tt[x]; }
            }
            TK_BAR();
        }
        if (PV == 7) { if (T == 12345u && need == 77u) mstg[lane] = 1; } else
        if (!slow) {
            auto fslot = [&]<int i>() __attribute__((always_inline)) {
                unsigned nib = 0;
#pragma unroll
                for (int r = 3; r >= 0; --r) nib = nib + nib + ((key[i][r] >= T) ? 1u : 0u);
                __hip_atomic_fetch_or(ms32_q + 4 * i, nib << sh_q, __ATOMIC_RELAXED, __HIP_MEMORY_SCOPE_WORKGROUP);
            };
            TK_SLOTS(fslot);
        } else {
#pragma unroll
            for (int i = 0; i < 32; ++i) {
                if (8 * i > jw) continue;
                unsigned nib = 0;
                const unsigned e = tc_q[8 * i]; unsigned rank = tb_q[8 * i];
                if (g > 0) rank += e & 255u; if (g > 1) rank += (e >> 8) & 255u; if (g > 2) rank += (e >> 16) & 255u;
#pragma unroll
                for (int r = 0; r < 4; ++r) { const unsigned k = key[i][r];
                    if (k > T) nib |= 1u << r; else if (k == T && k != 0u) { if (rank < need) nib |= 1u << r; ++rank; } }
                __hip_atomic_fetch_or(ms32_q + 4 * i, nib << sh_q, __ATOMIC_RELAXED, __HIP_MEMORY_SCOPE_WORKGROUP);
            }
        }
        }
    }
    TK_BAR();
    if (PV == 0 || PV == 5 || PV == 6)
    for (int idx = tid; idx < 1024; idx += NWAVES * 64) {
        const int qq = idx & 15, t64 = idx >> 4;
        const u64 wd = *(const LAS u64*)(mstg + qq * 256 + t64 * 4);
        MASK[((size_t)b * 64 + t64) * S + tq0 + qq] = wd;
    }
    TK_BAR();
}

__device__ __forceinline__ void gating_block(LAS unsigned char* L, const bf16_t* __restrict__ QO, const float* __restrict__ KMEAN, unsigned* __restrict__ BMASK, int blk64, int tid) {
    using namespace K;
    const int row0 = 64 * blk64, b = row0 / S;
    LAS float* km = (LAS float*)L;
    const int r = tid >> 3, h = tid & 7, row = row0 + r, t = row % S, own = t / MBLK;
    uint4 qraw[8];
#pragma unroll
    for (int x = 0; x < 8; ++x) qraw[x] = *(const uint4*)(QO + (size_t)row * 1024 + 512 + h * 64 + 8 * x);
    for (int i = tid; i < 16 * 8 * 64; i += NWAVES * 64) { const int n = i >> 9, hh = (i >> 6) & 7, d = i & 63; km[(n * 8 + hh) * 68 + d] = KMEAN[((size_t)(b * 16 + n) * 8 + hh) * 64 + d]; }
    TK_BAR();
    float qv[64];
#pragma unroll
    for (int x = 0; x < 8; ++x) { const uint4 u = qraw[x];
        qv[8 * x + 0] = __uint_as_float(u.x << 16); qv[8 * x + 1] = __uint_as_float(u.x & 0xffff0000u); qv[8 * x + 2] = __uint_as_float(u.y << 16); qv[8 * x + 3] = __uint_as_float(u.y & 0xffff0000u);
        qv[8 * x + 4] = __uint_as_float(u.z << 16); qv[8 * x + 5] = __uint_as_float(u.z & 0xffff0000u); qv[8 * x + 6] = __uint_as_float(u.w << 16); qv[8 * x + 7] = __uint_as_float(u.w & 0xffff0000u); }
    float b0 = -INFINITY, b1 = -INFINITY, b2 = -INFINITY; int i0 = -1, i1 = -1, i2 = -1;
    for (int n = 0; n < own; ++n) {
        const LAS f32x4* kp = (const LAS f32x4*)(km + (n * 8 + h) * 68); float gs = 0.f;
#pragma unroll
        for (int d4 = 0; d4 < 16; ++d4) { const f32x4 kv = kp[d4]; gs = __builtin_fmaf(qv[4 * d4], kv[0], gs); gs = __builtin_fmaf(qv[4 * d4 + 1], kv[1], gs); gs = __builtin_fmaf(qv[4 * d4 + 2], kv[2], gs); gs = __builtin_fmaf(qv[4 * d4 + 3], kv[3], gs); }
        if (gs > b0) { b2 = b1; i2 = i1; b1 = b0; i1 = i0; b0 = gs; i0 = n; }
        else if (gs > b1) { b2 = b1; i2 = i1; b1 = gs; i1 = n; }
        else if (gs > b2) { b2 = gs; i2 = n; }
    }
    unsigned bm = 1u << own;
    if (i0 >= 0) bm |= 1u << i0; if (i1 >= 0) bm |= 1u << i1; if (i2 >= 0) bm |= 1u << i2;
    BMASK[(size_t)row * 8 + h] = bm;
    TK_BAR();
}
#undef TK_BAR
}
namespace attn_body {
using bf16=__hip_bfloat16;
using bf16x8=__attribute__((ext_vector_type(8)))short;
using s16x4=__attribute__((ext_vector_type(4)))short;
using f32x16=__attribute__((ext_vector_type(16)))float;
using u32x4=__attribute__((ext_vector_type(4)))unsigned;
constexpr int BATCH=4,NHEAD=16,SEQ=4096,D=64,DM=NHEAD*D;
constexpr int NW=8,QBLK=32,QB=QBLK*NW,KVBLK=64,NQB=SEQ/QB;
constexpr int ATTN_PITCH=DM, ATTN_UNIT_ROWS=QB;
__device__ __forceinline__ int crow(int r,int hi){return (r&3)+8*(r>>2)+4*hi;}
#define SBAR() __builtin_amdgcn_sched_barrier(0)
typedef __attribute__((address_space(3))) const float* lds_fptr;
__device__ __forceinline__ void addbias(f32x16&p0,f32x16&p1,int jb6,int qrel,int hi,lds_fptr bt){
  const lds_fptr b=bt+(qrel+128-64*jb6-4*hi+197);
  #pragma unroll
  for(int r=0;r<16;++r){const int c=(r&3)+8*(r>>2); p0[r]+=b[59-c]; p1[r]+=b[27-c];}
}

constexpr int BT_N=640;
constexpr int NSLOT=3, SLOTB=8192;
#define EXM(p,w) do{ if(MOBA) asm volatile("v_sub_f32 %0, %0, %2\n\tv_exp_f32 %0, %0\n\tv_add_co_u32 %1, vcc, %1, %1\n\tv_cndmask_b32 %0, 0, %0, vcc":"+v"(p),"+v"(w):"v"(mhat):"vcc"); \
  else asm volatile("v_exp_f32 %0, %0\n\tv_add_co_u32 %1, vcc, %1, %1\n\tv_cndmask_b32 %0, 0, %0, vcc":"+v"(p),"+v"(w)::"vcc"); }while(0)
#define EXS(p,mh) asm volatile("v_sub_f32 %0, %0, %1\n\tv_exp_f32 %0, %0\n\ts_nop 0":"+v"(p):"v"(mh))
#define EXM16(P,w) do{ EXM(P[15],w);EXM(P[14],w);EXM(P[13],w);EXM(P[12],w); w<<=4; EXM(P[11],w);EXM(P[10],w);EXM(P[9],w);EXM(P[8],w); w<<=4; EXM(P[7],w);EXM(P[6],w);EXM(P[5],w);EXM(P[4],w); w<<=4; EXM(P[3],w);EXM(P[2],w);EXM(P[1],w);EXM(P[0],w); }while(0)
__device__ __forceinline__ int cbit(int r){return (r&3)+8*(r>>2);}
constexpr int LDS_K=0, LDS_V=NSLOT*SLOTB, LDS_WS=2*NSLOT*SLOTB, LDS_OST=LDS_WS+NW*64*4, LDS_BT=LDS_OST+NW*4096, LDS_BYTES=LDS_BT+BT_N*4;
constexpr float C2=0.125f*1.4426950408889634f;
__device__ __forceinline__ void glds16(const void*gsrc,unsigned lds_dst){unsigned keep;
  asm volatile("s_mov_b32 %0, m0\n\ts_mov_b32 m0, %2\n\ts_nop 0\n\tglobal_load_lds_dwordx4 %1, off\n\ts_mov_b32 m0, %0":"=&s"(keep):"v"(gsrc),"s"(lds_dst):"memory");}
__device__ __forceinline__ float max3f(float a,float b,float c){float r;asm("v_max3_f32 %0, %1, %2, %3":"=v"(r):"v"(a),"v"(b),"v"(c));return r;}
__device__ __forceinline__ float max2f(float a,float b){float r;asm("v_max_f32_e32 %0, %1, %2":"=v"(r):"v"(a),"v"(b));return r;}
__device__ __forceinline__ float fadd_s(float a,float b){float r;asm("v_add_f32_e32 %0, %1, %2":"=v"(r):"v"(a),"v"(b));return r;}
__device__ __forceinline__ float fsub_s(float a,float b){float r;asm("v_sub_f32_e32 %0, %1, %2":"=v"(r):"v"(a),"v"(b));return r;}
typedef float f32x2_t __attribute__((ext_vector_type(2))); typedef __bf16 bf16x2_t __attribute__((ext_vector_type(2)));
__device__ __forceinline__ unsigned cvtpk_s(float lo,float hi){f32x2_t v={lo,hi};bf16x2_t b=__builtin_convertvector(v,bf16x2_t);return __builtin_bit_cast(unsigned,b);}
#define WAIT_BAR(N) asm volatile("s_waitcnt vmcnt(" #N ") lgkmcnt(0)\n\ts_barrier":::"memory")

__device__ __forceinline__ void qkt(f32x16&p0,f32x16&p1,const char*Kslot,const bf16x8*qr,const f32x16&c0,int r32,int hi){
  const char*kb=Kslot+hi*1024+r32*16;
  #pragma unroll
  for(int d0=0;d0<4;++d0){
    const bf16x8 b0=*reinterpret_cast<const bf16x8*>(kb+d0*2048);
    const bf16x8 b1=*reinterpret_cast<const bf16x8*>(kb+d0*2048+512);
    if(d0==0){p0=__builtin_amdgcn_mfma_f32_32x32x16_bf16(b0,qr[0],c0,0,0,0);p1=__builtin_amdgcn_mfma_f32_32x32x16_bf16(b1,qr[0],c0,0,0,0);}
    else{p0=__builtin_amdgcn_mfma_f32_32x32x16_bf16(b0,qr[d0],p0,0,0,0);p1=__builtin_amdgcn_mfma_f32_32x32x16_bf16(b1,qr[d0],p1,0,0,0);}}
}
typedef __attribute__((address_space(3))) const char* lds_cptr;
typedef short v4i16_t __attribute__((ext_vector_type(4)));
__device__ __forceinline__ void kload8(bf16x8*kf,lds_cptr kp){
  kf[0]=*(const __attribute__((address_space(3))) bf16x8*)(kp);      kf[1]=*(const __attribute__((address_space(3))) bf16x8*)(kp+512);
  kf[2]=*(const __attribute__((address_space(3))) bf16x8*)(kp+2048); kf[3]=*(const __attribute__((address_space(3))) bf16x8*)(kp+2560);
  kf[4]=*(const __attribute__((address_space(3))) bf16x8*)(kp+4096); kf[5]=*(const __attribute__((address_space(3))) bf16x8*)(kp+4608);
  kf[6]=*(const __attribute__((address_space(3))) bf16x8*)(kp+6144); kf[7]=*(const __attribute__((address_space(3))) bf16x8*)(kp+6656);
}
__device__ __forceinline__ void kload2(bf16x8*kf,lds_cptr kp,int j){ kf[2*j]=*(const __attribute__((address_space(3))) bf16x8*)(kp+j*2048); kf[2*j+1]=*(const __attribute__((address_space(3))) bf16x8*)(kp+j*2048+512); }
__device__ __forceinline__ s16x4 vtr(lds_cptr p){ return __builtin_bit_cast(s16x4,__builtin_amdgcn_ds_read_tr16_b64_v4i16((__attribute__((address_space(3))) v4i16_t*)p)); }
__device__ __forceinline__ float rowmax(const f32x16&p0,const f32x16&p1){
  float a=max3f(p0[0],p0[1],p1[0]),b=max3f(p0[2],p0[3],p1[1]);a=max3f(a,p1[2],p1[3]);
  #pragma unroll
  for(int r=4;r<16;r+=4){a=max3f(a,p0[r],p0[r+1]);b=max3f(b,p0[r+2],p0[r+3]);a=max3f(a,p1[r],p1[r+1]);b=max3f(b,p1[r+2],p1[r+3]);}
  const float m=max2f(a,b);
  auto rr=__builtin_amdgcn_permlane32_swap(__float_as_uint(m),__float_as_uint(m),false,false);
  return max2f(__uint_as_float(rr[0]),__uint_as_float(rr[1]));
}
__device__ __forceinline__ void pv(f32x16*o,int vb,bf16x8 pa0,bf16x8 pa1,bf16x8 pa2,bf16x8 pa3){
  #pragma unroll
  for(int d0=0;d0<2;++d0){s16x4 lo[4],hi[4];
    #pragma unroll
    for(int ks=0;ks<4;++ks){
      asm volatile("ds_read_b64_tr_b16 %0,%1 offset:%c2":"=&v"(lo[ks]):"v"(vb),"i"(d0*4096+ks*1024):"memory");
      asm volatile("ds_read_b64_tr_b16 %0,%1 offset:%c2":"=&v"(hi[ks]):"v"(vb),"i"(d0*4096+ks*1024+512):"memory");}
    asm volatile("s_waitcnt lgkmcnt(0)":::"memory");SBAR();
    #define PK(k) (bf16x8){lo[k][0],lo[k][1],lo[k][2],lo[k][3],hi[k][0],hi[k][1],hi[k][2],hi[k][3]}
    o[d0]=__builtin_amdgcn_mfma_f32_32x32x16_bf16(pa0,PK(0),o[d0],0,0,0);
    o[d0]=__builtin_amdgcn_mfma_f32_32x32x16_bf16(pa1,PK(1),o[d0],0,0,0);
    o[d0]=__builtin_amdgcn_mfma_f32_32x32x16_bf16(pa2,PK(2),o[d0],0,0,0);
    o[d0]=__builtin_amdgcn_mfma_f32_32x32x16_bf16(pa3,PK(3),o[d0],0,0,0);
    #undef PK
  }
}

#ifndef ATTN_STORE16
#define ATTN_STORE16(p,v) (*(u32x4*)(p)=(v))
#endif
template<int THRL,bool MOBA> __device__ __forceinline__ void attn_unit(int b,int h,int qb,const bf16*Q,const bf16*__restrict__ K,const bf16*__restrict__ V,bf16*O,const unsigned long long*__restrict__ MASKW,const unsigned*__restrict__ BMASK,const float*__restrict__ relb,const float*__restrict__ gq,const float*__restrict__ gk,char*shm){
  const int tid=threadIdx.x,lane=tid&63,r32=lane&31,hi=lane>>5; const int wid=__builtin_amdgcn_readfirstlane(tid>>6);
  const long rowbase=(long)b*SEQ; const int q0=qb*QB;
  const bf16*Qw=Q+(rowbase+q0+wid*QBLK)*DM+h*D;
  const bf16*Kh=K+rowbase*DM+h*D,*Vh=V+rowbase*DM+h*D;
  const unsigned lds0=(unsigned)(uintptr_t)shm;
  float*wsf=(float*)(shm+LDS_WS)+wid*64;
  const bf16*ksrc=Kh+(long)lane*DM+wid*8;
  const bf16*vsrc=Vh+(long)(16*(wid&3)+(lane>>2))*DM+(wid>>2)*32+(lane&3)*8;
  const unsigned kdst=lds0+LDS_K+wid*1024, vdst=lds0+LDS_V+wid*1024;
  #define DMA_K(t,slot) glds16(ksrc+(long)(t)*KVBLK*DM,(unsigned)__builtin_amdgcn_readfirstlane(kdst+(slot)))
  #define DMA_V(t,slot) glds16(vsrc+(long)(t)*KVBLK*DM,(unsigned)__builtin_amdgcn_readfirstlane(vdst+(slot)))
  const int vb0=(int)(lds0+LDS_V)+((lane>>4)&1)*32+(lane&3)*8+(4*hi+((lane&15)>>2))*64;
  const char*Kbase=shm+LDS_K; bf16x8 kf[8];
  const lds_cptr shm3=(lds_cptr)shm; const lds_cptr kp0=shm3+LDS_K+hi*1024+r32*16; const lds_cptr vp0=shm3+LDS_V+((lane>>4)&1)*32+(lane&3)*8+(4*hi+((lane&15)>>2))*64;
  const int NT=(q0+QB)/KVBLK;
  const int qrel=wid*QBLK+r32; constexpr bool moba=MOBA;
  const lds_fptr bt=(lds_fptr)(shm3+LDS_BT);
  unsigned bm=0u;
  const unsigned mvoff=(unsigned)(q0+qrel)*8u; unsigned long long mraw=0ull; unsigned mlo=0u,mhi=0u;
  #define MLOAD(tt) do{ if(!moba&&(tt)<NT){ const unsigned long long*mb_=MASKW+((size_t)(b*64+(tt)))*SEQ; \
      asm volatile("s_nop 4\n\tglobal_load_dwordx2 %0, %1, %2":"=v"(mraw):"v"(mvoff),"s"(mb_):"memory"); } }while(0)
  #define MSET(tt) do{ if(!moba){ asm volatile("":"+v"(mraw)); mlo=(unsigned)mraw<<(4-4*hi); mhi=(unsigned)(mraw>>32)<<(4-4*hi); } \
      else{ unsigned wl=((bm>>((tt)>>2))&1u)?0xffffffffu:0u, wh=wl; const int jb_=(tt)-(NT-4); \
        if(jb_>=0){ const int n=qrel-64*jb_, n2=n-32; wl&=(n<0)?0u:((n>=31)?0xffffffffu:((2u<<n)-1u)); wh&=(n2<0)?0u:((n2>=31)?0xffffffffu:((2u<<n2)-1u)); } \
        mlo=wl<<(4-4*hi); mhi=wh<<(4-4*hi); } }while(0)
  MLOAD(0);
  DMA_K(0,0);DMA_V(0,0);DMA_K(1,SLOTB);
  bf16x8 qr[4];
  #pragma unroll
  for(int d0=0;d0<4;++d0)qr[d0]=*reinterpret_cast<const bf16x8*>(&Qw[(long)r32*DM+d0*16+hi*8]);
  if(moba)bm=BMASK[(size_t)(rowbase+q0+qrel)*8+(h-8)];
  { __attribute__((address_space(3))) float*btw=(__attribute__((address_space(3))) float*)(shm3+LDS_BT); const float b31=relb[31*16+h];
    for(int i=tid;i<BT_N;i+=NW*64){ const int d=i-256; btw[i]=(d>=0&&d<=112)?(relb[t5_bucket(d)*16+h]-b31)*1.4426950408889634f:0.f; } }
  constexpr float mhat=16.0f; float l_reg=0.f;f32x16 o[2];o[0]=f32x16{};o[1]=f32x16{}; f32x16 negm=f32x16{}; (void)gq; (void)gk;
  if(!MOBA){ _Pragma("unroll") for(int r=0;r<16;++r)negm[r]=-mhat; asm volatile("":"+v"(negm)); }
  #define CMASK(P0,P1,t) do{int jb_=(t)-(NT-6); if(jb_>=0)addbias(P0,P1,jb_,qrel,hi,bt);}while(0)
  #define START(P0,P1) do{ EXM16(P0,mlo); }while(0)
  #define RESC() do{}while(0)
  f32x16 pA0,pA1,pB0,pB1;
  int sl_prev=0,sl_cur=0,sl_next=SLOTB;
  #define ROT() do{sl_prev=sl_cur;sl_cur=sl_next;sl_next=(sl_next==(NSLOT-1)*SLOTB)?0:sl_next+SLOTB;}while(0)
  DMA_K(2,2*SLOTB);
  WAIT_BAR(3);
  MSET(0); MLOAD(1);
  qkt(pA0,pA1,Kbase,qr,(MOBA?f32x16{}:negm),r32,hi);asm volatile("s_nop 15\n\ts_nop 7":"+v"(pA0),"+v"(pA1));CMASK(pA0,pA1,0);
  START(pA0,pA1);
  EXM16(pA1,mhi);
  WAIT_BAR(0);
  MSET(1);
  DMA_K(3,0);DMA_V(1,SLOTB);
  ROT();
  kload8(kf,kp0+sl_cur);
  WAIT_BAR(2);
  s16x4 vlo[8],vhi[8]; u32x4 pw0,pw1,pw2,pw3;
  #define PKW(P,B) cvtpk_s(P[B],P[B+1])
  #define PAF(k) __builtin_bit_cast(bf16x8,pw##k)
  #define VFR(i) (bf16x8){vlo[i][0],vlo[i][1],vlo[i][2],vlo[i][3],vhi[i][0],vhi[i][1],vhi[i][2],vhi[i][3]}
  #define PIN(x) asm volatile("":"+v"(x))
  #define MX3(a,b,c) __builtin_fmaxf(__builtin_fmaxf((a),(b)),(c))
  #define GAPA(MF,A0,A1,A2,A3,W0,W1,PW) do{ MF; sacc+=A0; sacc+=A1; sacc+=A2; sacc+=A3; PIN(sacc); W0; W1; PIN(PW); SBAR(); }while(0)
  #define EX(v) __builtin_amdgcn_exp2f(v)
  #define GAPB(MF,X,B,MW,CH) do{ MF; if(CH){ EXS(X[B+3],mh_); EXS(X[B+2],mh_); EXS(X[B+1],mh_); EXS(X[B],mh_); } else { EXM(X[B+3],MW); EXM(X[B+2],MW); EXM(X[B+1],MW); EXM(X[B],MW); if((B)>0)MW<<=4; } PIN(X); SBAR(); }while(0)
  #define VRD(i) do{ vlo[i]=vtr(vp_+(((i)>>2)*4096+((i)&3)*1024)); vhi[i]=vtr(vp_+(((i)>>2)*4096+((i)&3)*1024+512)); }while(0)
  #define KRD(G,j) do{ if(G){ kload2(kf,kp0+sl_next,j); SBAR(); } }while(0)
  #define STEP(C0,C1,P0,P1,t,GK,GV,GL,CH) do{ SBAR(); \
    const lds_cptr vp_=vp0+sl_prev; \
    VRD(0); SBAR(); float sacc=(P0[0]+P0[1]); \
    GAPA(C0=__builtin_amdgcn_mfma_f32_32x32x16_bf16(kf[0],qr[0],(MOBA?f32x16{}:negm),0,0,0), P0[2],P0[3],P0[4],P0[5],     pw0[0]=PKW(P0,0), pw0[1]=PKW(P0,2), pw0); \
    VRD(4); SBAR(); GAPA(C1=__builtin_amdgcn_mfma_f32_32x32x16_bf16(kf[1],qr[0],(MOBA?f32x16{}:negm),0,0,0), P0[6],P0[7],P0[8],P0[9],     pw0[2]=PKW(P0,4), pw0[3]=PKW(P0,6), pw0); \
    VRD(1); SBAR(); GAPA(C0=__builtin_amdgcn_mfma_f32_32x32x16_bf16(kf[2],qr[1],C0,0,0,0),   P0[10],P0[11],P0[12],P0[13], pw1[0]=PKW(P0,8), pw1[1]=PKW(P0,10), pw1); \
    VRD(5); SBAR(); GAPA(C1=__builtin_amdgcn_mfma_f32_32x32x16_bf16(kf[3],qr[1],C1,0,0,0),   P0[14],P0[15],P1[0],P1[1],   pw1[2]=PKW(P0,12),pw1[3]=PKW(P0,14), pw1); \
    VRD(2); SBAR(); GAPA(C0=__builtin_amdgcn_mfma_f32_32x32x16_bf16(kf[4],qr[2],C0,0,0,0),   P1[2],P1[3],P1[4],P1[5],     pw2[0]=PKW(P1,0), pw2[1]=PKW(P1,2), pw2); \
    VRD(6); SBAR(); GAPA(C1=__builtin_amdgcn_mfma_f32_32x32x16_bf16(kf[5],qr[2],C1,0,0,0),   P1[6],P1[7],P1[8],P1[9],     pw2[2]=PKW(P1,4), pw2[3]=PKW(P1,6), pw2); \
    VRD(3); SBAR(); GAPA(C0=__builtin_amdgcn_mfma_f32_32x32x16_bf16(kf[6],qr[3],C0,0,0,0),   P1[10],P1[11],P1[12],P1[13], pw3[0]=PKW(P1,8), pw3[1]=PKW(P1,10), pw3); \
    VRD(7); SBAR(); GAPA(C1=__builtin_amdgcn_mfma_f32_32x32x16_bf16(kf[7],qr[3],C1,0,0,0),   P1[14],P1[15],0.f,0.f,       pw3[2]=PKW(P1,12),pw3[3]=PKW(P1,14), pw3); \
    l_reg+=sacc; \
    if(GK){DMA_K((t)+3,sl_cur);} if(GV){DMA_V((t)+1,sl_next);} \
    CMASK(C0,C1,t); \
    const float mh_=(CH)?((mlo!=0u)?mhat:__builtin_inff()):0.f; (void)mh_; \
    SBAR(); \
    GAPB(o[0]=__builtin_amdgcn_mfma_f32_32x32x16_bf16(PAF(0),VFR(0),o[0],0,0,0), C0,12,mlo,CH); \
    GAPB(o[1]=__builtin_amdgcn_mfma_f32_32x32x16_bf16(PAF(0),VFR(4),o[1],0,0,0), C0,8,mlo,CH); \
    KRD(GL,0); GAPB(o[0]=__builtin_amdgcn_mfma_f32_32x32x16_bf16(PAF(1),VFR(1),o[0],0,0,0), C0,4,mlo,CH); \
    KRD(GL,1); GAPB(o[1]=__builtin_amdgcn_mfma_f32_32x32x16_bf16(PAF(1),VFR(5),o[1],0,0,0), C0,0,mlo,CH); \
    KRD(GL,2); GAPB(o[0]=__builtin_amdgcn_mfma_f32_32x32x16_bf16(PAF(2),VFR(2),o[0],0,0,0), C1,12,mhi,CH); \
    KRD(GL,3); GAPB(o[1]=__builtin_amdgcn_mfma_f32_32x32x16_bf16(PAF(2),VFR(6),o[1],0,0,0), C1,8,mhi,CH); \
    GAPB(o[0]=__builtin_amdgcn_mfma_f32_32x32x16_bf16(PAF(3),VFR(3),o[0],0,0,0), C1,4,mhi,CH); \
    GAPB(o[1]=__builtin_amdgcn_mfma_f32_32x32x16_bf16(PAF(3),VFR(7),o[1],0,0,0), C1,0,mhi,CH); \
    }while(0)
  int t=1;
  #undef CMASK
  #define CMASK(P0,P1,t) do{}while(0)
  for(;t+7<NT;t+=2){
    MLOAD(t+1); STEP(pB0,pB1,pA0,pA1,t,true,true,true,MOBA);     WAIT_BAR(2); RESC(); ROT(); MSET(t+1);
    MLOAD(t+2); STEP(pA0,pA1,pB0,pB1,t+1,true,true,true,MOBA);   WAIT_BAR(2); RESC(); ROT(); MSET(t+2);
  }
  #undef CMASK
  #define CMASK(P0,P1,t) do{int jb_=(t)-(NT-6); if(jb_>=0)addbias(P0,P1,jb_,qrel,hi,bt);}while(0)
  #define ENDW(tt) do{ if((tt)+3<NT){WAIT_BAR(2);} else if((tt)+2<NT){WAIT_BAR(1);} else {WAIT_BAR(0);} }while(0)
  for(;t+1<NT;t+=2){
    MLOAD(t+1); STEP(pB0,pB1,pA0,pA1,t,(t+3<NT),(t+1<NT),(t+1<NT),0);       ENDW(t);   RESC(); ROT(); MSET(t+1);
    MLOAD(t+2); STEP(pA0,pA1,pB0,pB1,t+1,(t+4<NT),(t+2<NT),(t+2<NT),0);     ENDW(t+1); RESC(); ROT(); MSET(t+2);
  }
  STEP(pB0,pB1,pA0,pA1,NT-1,false,false,false,0); RESC();
  { float sacc=pB0[0]+pB0[1]; _Pragma("unroll") for(int r=2;r<16;++r)sacc+=pB0[r]; _Pragma("unroll") for(int r=0;r<16;++r)sacc+=pB1[r]; l_reg+=sacc;
    pw0=(u32x4){PKW(pB0,0),PKW(pB0,2),PKW(pB0,4),PKW(pB0,6)};pw1=(u32x4){PKW(pB0,8),PKW(pB0,10),PKW(pB0,12),PKW(pB0,14)};pw2=(u32x4){PKW(pB1,0),PKW(pB1,2),PKW(pB1,4),PKW(pB1,6)};pw3=(u32x4){PKW(pB1,8),PKW(pB1,10),PKW(pB1,12),PKW(pB1,14)};
    SBAR(); pv(o,vb0+sl_cur,PAF(0),PAF(1),PAF(2),PAF(3)); }
  #undef PKW
  #undef PAF
  #undef VFR
  #undef PIN
  #undef MX3
  #undef GAPA
  #undef GAPB
  #undef EX
  #undef VRD
  #undef KRD
  #undef STEP
  #undef ENDW
  {auto rr=__builtin_amdgcn_permlane32_swap(__float_as_uint(l_reg),__float_as_uint(l_reg),false,false);l_reg=__uint_as_float(rr[0])+__uint_as_float(rr[1]);}
  if(hi==0)wsf[32+r32]=l_reg;asm volatile("s_waitcnt lgkmcnt(0)":::"memory");
  float rli[16];
  #pragma unroll
  for(int r=0;r<16;++r)rli[r]=__builtin_amdgcn_rcpf(wsf[32+crow(r,hi)]);
  bf16*Ow=O+(rowbase+q0+wid*QBLK)*DM+h*D;
  { bf16*stg=(bf16*)(shm+LDS_OST)+wid*2048;
    #pragma unroll
    for(int r=0;r<16;++r){const int orow=crow(r,hi);
      #pragma unroll
      for(int d0=0;d0<2;++d0)stg[orow*64+d0*32+r32]=__float2bfloat16(o[d0][r]*rli[r]);}
    asm volatile("s_waitcnt lgkmcnt(0)":::"memory");
    #pragma unroll
    for(int i=0;i<4;++i){const int row=i*8+(lane>>3),ch=lane&7; const u32x4 v=*(const u32x4*)(stg+row*64+ch*8); ATTN_STORE16(Ow+(long)row*DM+ch*8,v);} }
  asm volatile("s_waitcnt lgkmcnt(0)\n\ts_barrier":::"memory");
  #undef MLOAD
  #undef MSET
  #undef DMA_K
  #undef DMA_V
  #undef CMASK
  #undef START
  #undef RESC
  #undef ROT
}
constexpr int ATTN_LDS_BYTES=LDS_BYTES;
#undef SBAR
#undef WAIT_BAR
}

__device__ __forceinline__ float wave_sum_fast(float v) {
#define WS_DPP_(ctrl, rm, bc) v += __int_as_float(__builtin_amdgcn_update_dpp(0, __float_as_int(v), ctrl, rm, 0xf, bc))
    WS_DPP_(0x111, 0xf, true); WS_DPP_(0x112, 0xf, true); WS_DPP_(0x114, 0xf, true); WS_DPP_(0x118, 0xf, true); WS_DPP_(0x142, 0xa, false); WS_DPP_(0x143, 0xc, false);
#undef WS_DPP_
    return __int_as_float(__builtin_amdgcn_readlane(__float_as_int(v), 63));
}
__device__ __forceinline__ int rowmap(int map, int n) {
    if (map == 1) { const int up = n >= 2816; const int j = up ? n - 2816 : n; return 256 * (j >> 7) + (up ? 128 : 0) + (j & 127); }
    if (map == 2) {
        if (n < 3072) { const int part = n >> 9, cc = n & 511, tl = cc >> 8, wc = (cc & 255) >> 6, d = cc & 63; return 256 * (2 * part + tl) + 128 * (d >> 5) + 32 * wc + (d & 31); }
        if (n < 3328) return 256 * 12 + (n - 3072);
        if (n < 3396) return 256 * 13 + (n - 3328);
        if (n < 5444) return 256 * 14 + (n - 3396);
        return 256 * 13 + 68 + (n - 5444);
    }
    if (map == 3) return 1024 + n;
    return n;
}
__device__ __forceinline__ void conv_item(const float* __restrict__ W, int ldw, int N, int Nw, const float* __restrict__ gain, bf16_t* WT, int ldk, int map, int koff, LAS float* scr, int item, int lane) {
    const int nblk = (Nw + 31) >> 5, kb = item / nblk, nb = item % nblk, k0 = 64 * kb, n0 = 32 * nb;
    const int rr = lane >> 3, c4 = (lane & 7) * 4; const bool inb = (n0 + c4) < N;
    f32x4 v[8];
#pragma unroll
    for (int i = 0; i < 8; ++i) v[i] = inb ? *(const GAS f32x4*)(W + (size_t)(k0 + 8 * i + rr) * ldw + n0 + c4) : (f32x4){0.f, 0.f, 0.f, 0.f};
#pragma unroll
    for (int i = 0; i < 8; ++i) { const int kk = 8 * i + rr; const float gk = gain ? gain[k0 + kk] : 1.0f; LAS float* s = scr + kk * 33 + c4;
        s[0] = v[i][0] * gk; s[1] = v[i][1] * gk; s[2] = v[i][2] * gk; s[3] = v[i][3] * gk; }
    LDS_WAIT(); asm volatile("" ::: "memory");
    const int c = lane & 7;
#pragma unroll
    for (int j = 0; j < 4; ++j) { const int n = (lane >> 3) + 8 * j; const LAS float* s = scr + (8 * c) * 33 + n;
        if (n0 + n < Nw) {
            v4u o; o.x = pk2(s[0 * 33], s[1 * 33]); o.y = pk2(s[2 * 33], s[3 * 33]); o.z = pk2(s[4 * 33], s[5 * 33]); o.w = pk2(s[6 * 33], s[7 * 33]);
            *(GAS v4u*)((unsigned char*)WT + pg8::tiled_b_off(rowmap(map, n0 + n), koff + k0 + 8 * c, ldk >> 6)) = o; } }
    LDS_WAIT(); asm volatile("" ::: "memory");
}

struct Args { const float* in[18]; float* out; unsigned char* ws; int ph_lo, ph_hi, li, pad; };
enum { I_X = 0, I_N1, I_GU1, I_DN1, I_NM, I_WIN, I_BG, I_QNA, I_KNA, I_QNB, I_KNB, I_WBA, I_WBB, I_WO, I_N2, I_GU2, I_DN2, I_RB };

__device__ __forceinline__ void p0_prologue(const Args& args, LAS unsigned char* L, int gw, int NGW, int lane, int gtid, int ngt) {
    using namespace K;
    unsigned char* ws = args.ws;
    LAS float* scr = (LAS float*)(L + RING_OFF + (gw & 7) * 16384);
    constexpr int I0 = 16 * 176, I1 = 44 * 32, I2 = 16 * 176, I3 = 8 * 32, I4 = 8 * 32, I5 = 16 * 32;
    constexpr int NITEMS = 2 * I0 + 2 * I1 + I2 + I3 + I4 + I5;
    for (int it = gw; it < NITEMS; it += NGW) {
        int r = it;
        if (r < I0) { conv_item(args.in[I_GU1], 2 * DFF, 2 * DFF, 2 * DFF, args.in[I_N1], (bf16_t*)(ws + WS::GU1), D, 1, 0, scr, r, lane); continue; } r -= I0;
        if (r < I0) { conv_item(args.in[I_GU2], 2 * DFF, 2 * DFF, 2 * DFF, args.in[I_N2], (bf16_t*)(ws + WS::GU2), D, 1, 0, scr, r, lane); continue; } r -= I0;
        if (r < I1) { conv_item(args.in[I_DN1], D, D, D, nullptr, (bf16_t*)(ws + WS::DN1), DFF, 0, 0, scr, r, lane); continue; } r -= I1;
        if (r < I1) { conv_item(args.in[I_DN2], D, D, D, nullptr, (bf16_t*)(ws + WS::DN2), DFF, 0, 0, scr, r, lane); continue; } r -= I1;
        if (r < I2) { conv_item(args.in[I_WIN], DIN, DIN, 5632, args.in[I_NM], (bf16_t*)(ws + WS::WIN), D, 2, 0, scr, r, lane); continue; } r -= I2;
        if (r < I3) { conv_item(args.in[I_WBA], D, D, D, nullptr, (bf16_t*)(ws + WS::WB), D, 0, 0, scr, r, lane); continue; } r -= I3;
        if (r < I4) { conv_item(args.in[I_WBB], D, D, D, nullptr, (bf16_t*)(ws + WS::WB), D, 0, 512, scr, r, lane); continue; } r -= I4;
        conv_item(args.in[I_WO], D, D, D, nullptr, (bf16_t*)(ws + WS::WO), D, 0, 0, scr, r, lane);
    }
    const float* x = args.in[I_X];
    for (int m0 = 2 * gw; m0 < M; m0 += 2 * NGW) {
        f32x4 v[2][4]; float s[2] = {0.f, 0.f};
#pragma unroll
        for (int rr = 0; rr < 2; ++rr) { const GAS f32x4* xr = (const GAS f32x4*)(x + (size_t)(m0 + rr) * D) + lane;
#pragma unroll
            for (int j = 0; j < 4; ++j) v[rr][j] = xr[64 * j]; }
#pragma unroll
        for (int rr = 0; rr < 2; ++rr) {
#pragma unroll
            for (int j = 0; j < 4; ++j) s[rr] += (v[rr][j][0] * v[rr][j][0] + v[rr][j][1] * v[rr][j][1]) + (v[rr][j][2] * v[rr][j][2] + v[rr][j][3] * v[rr][j][3]);
            s[rr] = wave_sum_fast(s[rr]);
            GAS unsigned long long* o8 = (GAS unsigned long long*)(ws + WS::XB + (size_t)(m0 + rr) * D * 2) + lane;
#pragma unroll
            for (int j = 0; j < 4; ++j) o8[64 * j] = (unsigned long long)pk2(v[rr][j][0], v[rr][j][1]) | ((unsigned long long)pk2(v[rr][j][2], v[rr][j][3]) << 32);
            if (lane < 4) { f32x4 q = {lane == 0 ? s[rr] : 0.f, 0.f, 0.f, 0.f}; *((GAS f32x4*)(ws + WS::SSQ + (size_t)(m0 + rr) * 64) + lane) = q; }
        }
    }
}

__global__ void __launch_bounds__(NWAVES * 64, 2) mega(Args args) {
    extern __shared__ __attribute__((aligned(16))) unsigned char lds[];
    using namespace K;
    LAS unsigned char* L = (LAS unsigned char*)lds;
    volatile LAS unsigned* MISC = (volatile LAS unsigned*)(L + MISC_OFF);
    const int tid = threadIdx.x, lane = tid & 63, wave = __builtin_amdgcn_readfirstlane(tid >> 6);
    const int G = gridDim.x, bx = blockIdx.x; const int vcu = (G % 8 == 0) ? (bx % 8) * (G / 8) + bx / 8 : bx;
    unsigned char* ws = args.ws;
    for (int u = tid; u < (LDS_BYTES - LDSCTL_OFF) / 4; u += NWAVES * 64) ((LAS unsigned*)(L + LDSCTL_OFF))[u] = 0u;
    __syncthreads();
    XcdBarrier bar = xcd_barrier_post((unsigned*)(ws + WS::CTL) + CW_BAR + args.li * XCD_BAR_WORDS, MISC + 8);
    const int lo = args.ph_lo, hi = args.ph_hi;
#define IN(k) (lo <= (k) && (k) < hi)
#define SEAM(k) do { if (IN(k) && IN((k) + 1)) xcd_barrier(bar); } while (0)
    bf16_t* XB = (bf16_t*)(ws + WS::XB); bf16_t* ACT = (bf16_t*)(ws + WS::ACT); float* SSQ = (float*)(ws + WS::SSQ);

    if (IN(0)) { p0_prologue(args, L, vcu * NWAVES + wave, G * NWAVES, lane, bx * (NWAVES * 64) + tid, G * NWAVES * 64); SEAM(0); }
    if (IN(1)) {
        pg8::Gemm g{XB, (const bf16_t*)(ws + WS::GU1), M, 2 * DFF, D, D, 1 << 30, 0}; pg8::StaticOrder S; S.init(M, 2 * DFF, G, bx);
        pg8::EpiGu E{ACT, SSQ, (LAS float*)(L + RTAB_OFF)};
        pg8::gemm_phase<pg8::EpiGu, pg8::StaticOrder, true, true>(L + RING_OFF, g, S, E);
        SEAM(1);
    }
    if (IN(2)) {
        pg8::Gemm g{ACT, (const bf16_t*)(ws + WS::DN1), M, D, DFF, DFF, 1 << 30, 0}; pg8::StaticOrder S; S.init(M, D, G, bx);
        pg8::EpiRes<true, false, true> E{args.in[I_X], nullptr, nullptr, XB, SSQ, 0.5f};
        pg8::gemm_phase<pg8::EpiRes<true, false, true>, pg8::StaticOrder, false, true>(L + RING_OFF, g, S, E);
        SEAM(2);
    }
    if (IN(3)) {
        pg8::Gemm g{XB, (const bf16_t*)(ws + WS::WIN), M, 5632, D, D, 1 << 30, 0}; pg8::StaticOrder S; S.init(M, 5632, G, bx);
        pg8::EpiIn E{(bf16_t*)(ws + WS::QO), (bf16_t*)(ws + WS::KB), (bf16_t*)(ws + WS::VB), (bf16_t*)(ws + WS::GATES), (bf16_t*)(ws + WS::QI), (bf16_t*)(ws + WS::KI), (float*)(ws + WS::WI), (float*)(ws + WS::KMEAN), SSQ,
                     args.in[I_BG], args.in[I_QNA], args.in[I_KNA], args.in[I_QNB], args.in[I_KNB], (LAS float*)(L + RTAB_OFF)};
        pg8::gemm_phase<pg8::EpiIn, pg8::StaticOrder, true, true>(L + RING_OFF, g, S, E);
        SEAM(3);
    }
    if (IN(4)) {
        {
#define TK_POS(it_, bb_, tq_) do { bb_ = (it_) >> 8; const int v_ = (it_) & 255, vv_ = (v_ + 128 * (bb_ >> 1)) & 255; tq_ = 16 * ((bb_ & 1) ? 255 - vv_ : vv_); } while (0)
            int bb = 0, tq = -1;
            if (vcu < 1024) { TK_POS(vcu, bb, tq); if (wave == 0 && tq >= TOPK) tk::tk_prefetch_q(L, (const bf16_t*)(ws + WS::QI), (const float*)(ws + WS::WI), bb, tq, lane); }
            for (int blk = vcu; blk < M / 64; blk += G) tk::gating_block(L, (const bf16_t*)(ws + WS::QO), (const float*)(ws + WS::KMEAN), (unsigned*)(ws + WS::BMASK), blk, tid);
            for (int it = vcu; it < 1024; it += G) {
                int nb = 0, ntq = -1; if (it + G < 1024) TK_POS(it + G, nb, ntq);
                tk::topk_group<0>(L, (const bf16_t*)(ws + WS::QI), (const bf16_t*)(ws + WS::KI), (const float*)(ws + WS::WI), (u64*)args.out, bb, tq, nb, ntq, tid, lane, wave);
                bb = nb; tq = ntq;
            }
#undef TK_POS
        }
        SEAM(4);
    }
    if (IN(5)) {
        static_assert(attn_body::ATTN_LDS_BYTES <= RING_BYTES, "attention LDS vs frame");
        const attn_body::bf16* Qp = (const attn_body::bf16*)(ws + WS::QO); const attn_body::bf16* Kp = (const attn_body::bf16*)(ws + WS::KB); const attn_body::bf16* Vp = (const attn_body::bf16*)(ws + WS::VB);
        for (int p = vcu; p < 512; p += G) {
            const int s = p & 7, bh = (p < 256) ? (p >> 3) : (32 + (((p - 256) >> 3) ^ 8));
            if ((bh & 15) >= 8) { for (int k = 0; k < 2; ++k)
                attn_body::attn_unit<8, true>(bh >> 4, bh & 15, k ? s : 15 - s, Qp, Kp, Vp, (attn_body::bf16*)(ws + WS::QO), (const unsigned long long*)args.out, (const unsigned*)(ws + WS::BMASK), args.in[I_RB], args.in[I_QNB], args.in[I_KNB], (char*)lds); }
            else { for (int k = 0; k < 2; ++k)
                attn_body::attn_unit<8, false>(bh >> 4, bh & 15, k ? s : 15 - s, Qp, Kp, Vp, (attn_body::bf16*)(ws + WS::QO), (const unsigned long long*)args.out, (const unsigned*)(ws + WS::BMASK), args.in[I_RB], args.in[I_QNA], args.in[I_KNA], (char*)lds); }
        }
        SEAM(5);
    }
    if (IN(6)) {
        pg8::Gemm g{(const bf16_t*)(ws + WS::QO), (const bf16_t*)(ws + WS::WB), M, D, D, D, 1 << 30, 0}; pg8::StaticOrder S; S.init(M, D, G, bx);
        pg8::EpiBranch2 E{(const bf16_t*)(ws + WS::GATES), (bf16_t*)(ws + WS::GM)};
        pg8::gemm_phase<pg8::EpiBranch2, pg8::StaticOrder, false, true>(L + RING_OFF, g, S, E);
        SEAM(6);
    }
    if (IN(7)) {
        pg8::Gemm g{(const bf16_t*)(ws + WS::GM), (const bf16_t*)(ws + WS::WO), M, D, D, D, 1 << 30, 0}; pg8::StaticOrder S; S.init(M, D, G, bx);
        pg8::EpiRes<false, false, true> E{nullptr, XB, nullptr, XB, SSQ, 1.0f};
        pg8::gemm_phase<pg8::EpiRes<false, false, true>, pg8::StaticOrder, false, true>(L + RING_OFF, g, S, E);
        SEAM(7);
    }
    if (IN(8)) {
        pg8::Gemm g{XB, (const bf16_t*)(ws + WS::GU2), M, 2 * DFF, D, D, 1 << 30, 0}; pg8::StaticOrder S; S.init(M, 2 * DFF, G, bx);
        pg8::EpiGu E{ACT, SSQ, (LAS float*)(L + RTAB_OFF)};
        pg8::gemm_phase<pg8::EpiGu, pg8::StaticOrder, true, true>(L + RING_OFF, g, S, E);
        SEAM(8);
    }
    if (IN(9)) {
        pg8::Gemm g{ACT, (const bf16_t*)(ws + WS::DN2), M, D, DFF, DFF, 1 << 30, 0}; pg8::StaticOrder S; S.init(M, D, G, bx);
        pg8::EpiRes<false, true, false> E{nullptr, XB, args.out, nullptr, nullptr, 0.5f};
        pg8::gemm_phase<pg8::EpiRes<false, true, false>, pg8::StaticOrder, false, true>(L + RING_OFF, g, S, E);
    }
#undef IN
#undef SEAM
}

extern "C" void kernel_launch(void* const* d_in, const int* in_sizes, int n_in, void* d_out, int out_size, void* d_ws, size_t ws_size, hipStream_t stream) {
    using namespace K;
    static int grid = 0;
    if (grid == 0) {
        if (n_in != 18 || in_sizes[0] != M * D || out_size != M * D || ws_size < WS::END) { fprintf(stderr, "kernel_launch: unexpected shapes (n_in %d, in0 %d, out %d, ws %zu)\n", n_in, n_in > 0 ? in_sizes[0] : -1, out_size, ws_size); grid = -1; return; }
        int dev = 0, cus = 0, per_cu = 0;
        if (hipGetDevice(&dev) != hipSuccess || hipDeviceGetAttribute(&cus, hipDeviceAttributeMultiprocessorCount, dev) != hipSuccess) { grid = -1; return; }
        if (hipFuncSetAttribute((const void*)mega, hipFuncAttributeMaxDynamicSharedMemorySize, LDS_BYTES) != hipSuccess) { fprintf(stderr, "kernel_launch: hipFuncSetAttribute failed\n"); grid = -1; return; }
        if (hipOccupancyMaxActiveBlocksPerMultiprocessor(&per_cu, (const void*)mega, NWAVES * 64, LDS_BYTES) != hipSuccess || per_cu < 1) { fprintf(stderr, "kernel_launch: occupancy query says %d blocks/CU\n", per_cu); (void)hipGetLastError(); grid = -1; return; }
        grid = cus;
    }
    if (grid < 0) return;
    const float* const* in = (const float* const*)d_in;
    float* out = (float*)d_out; char* ws = (char*)d_ws;
    (void)hipMemsetAsync(ws + WS::CTL, 0, WS::CTL_ZERO_BYTES, stream);
    Args a{};
    for (int i = 0; i < 18; ++i) a.in[i] = in[i];
    a.out = out; a.ws = (unsigned char*)d_ws; a.pad = 0;
    a.ph_lo = 0; a.ph_hi = 10; a.li = 0;
    hipLaunchKernelGGL(mega, dim3(grid), dim3(NWAVES * 64), LDS_BYTES, stream, a);

}
```

```cpp
#include <hip/hip_runtime.h>
#include <hip/hip_bf16.h>
#include <cstdint>
#include <cstdio>
#include <cmath>

namespace K {
constexpr int B = 4, S = 4096, M = B * S, D = 1024, DFF = 2816, H = 8, HD = 64, NIH = 4, IDIM = 64, TOPK = 256, MBLK = 256, NBLK = 16;
constexpr int DIN = 5444;
constexpr float EPS = 1e-6f;
constexpr float LOG2E = 1.4426950408889634f;
constexpr float C2 = 0.125f * LOG2E;
}
typedef unsigned short bf16_t;
typedef unsigned long long u64;

__device__ __forceinline__ bf16_t f2bf(float f) { unsigned u = __float_as_uint(f); return (bf16_t)((u + 0x7fffu + ((u >> 16) & 1u)) >> 16); }
__device__ __forceinline__ int t5_bucket(int d) {
    if (d < 16) return d;
    int large = 16 + (int)(logf((float)d / 16.0f) / 2.0794415416798357f * 16.0f);
    return large < 31 ? large : 31;
}
namespace pg8 {
#define PG8_LAS __attribute__((address_space(3)))
typedef short bf16x8 __attribute__((ext_vector_type(8)));
typedef float f32x4 __attribute__((ext_vector_type(4)));
typedef unsigned u32x4 __attribute__((ext_vector_type(4)));
constexpr int BM = 256, BK = 64, HALF = 128, HTB = HALF * BK * 2  , STAGE_BYTES = 8 * HTB, NXCD = 8, WGM = 8;

__host__ __device__ __forceinline__ int lds_byte(int r, int c) { const int st = (r >> 4) * 2 + (c >> 5), rr = r & 15, cc = c & 31, ob = rr * 64 + cc * 2; return st * 1024 + (ob ^ (((ob >> 9) & 1) << 5)); }
__host__ __device__ __forceinline__ void stage_rc(int b, int& R, int& C) { const int st = b / 1024, sb = b % 1024, swz = sb ^ (((sb >> 9) & 1) << 5); R = (st >> 1) * 16 + swz / 64; C = (st & 1) * 32 + (swz % 64) / 2; }
__host__ __device__ __forceinline__ int perm32(int rho) { const int n = rho >> 4, i = rho & 15; return 8 * (i >> 2) + 4 * n + (i & 3); }

__host__ __device__ __forceinline__ size_t tiled_b_off(int nrow, int k, int nkt) {
    const int ht = nrow >> 7, rb = nrow & 127, c = rb & 31, rho = ((c >> 2) & 1) * 16 + ((c >> 3) << 2) + (c & 3), R = (rb & ~31) + rho;
    return ((size_t)ht * nkt + (k >> 6)) * (size_t)(HALF * BK * 2) + (size_t)lds_byte(R, k & 63);
}
struct Unit { int pm, pn; };
struct Gemm { const bf16_t* A; const bf16_t* Bt; int M, N, K, lda, asplit_pn, asplit_off; };

struct StaticOrder {
    int nM, nN, nwg, G, c;
    __host__ __device__ void init(int M, int N, int G_, int c_) { nM = M / BM; nN = N / BM; nwg = nM * nN; G = G_; c = c_; }
    __host__ __device__ bool next(int i, Unit& u) const {
        const long L = (long)i * G + c; if (L >= nwg) return false;
        int wgid = (int)L; { const int q = nwg / NXCD, r = nwg % NXCD, xcd = wgid % NXCD, off = wgid / NXCD; wgid = (xcd < r ? xcd * (q + 1) : r * (q + 1) + (xcd - r) * q) + off; }
        const int nig = WGM * nN, gid = wgid / nig, fm = gid * WGM, gsz = (nM - fm) < WGM ? (nM - fm) : WGM;
        u.pm = fm + ((wgid % nig) % gsz); u.pn = (wgid % nig) / gsz; return true;
    }
    __device__ __forceinline__ void a_ready(const Unit&) const {}
    __device__ __forceinline__ void done(const Unit&) const {}
};


typedef float f32x2_t __attribute__((ext_vector_type(2))); typedef __bf16 bf16x2_t __attribute__((ext_vector_type(2)));
__device__ __forceinline__ unsigned cvt_pk_bf16(float lo, float hi) { f32x2_t v = {lo, hi}; bf16x2_t b = __builtin_convertvector(v, bf16x2_t); return __builtin_bit_cast(unsigned, b); }
__device__ __forceinline__ float row_rstd(const float* __restrict__ ssq, int row) {
    const f32x4* p = (const f32x4*)(ssq + (size_t)row * 16);
    const f32x4 a = p[0], b = p[1], c = p[2], d = p[3];
    const float s = (((a[0] + a[1]) + (a[2] + a[3])) + ((b[0] + b[1]) + (b[2] + b[3]))) + (((c[0] + c[1]) + (c[2] + c[3])) + ((d[0] + d[1]) + (d[2] + d[3])));
    return 1.0f / sqrtf(s * (1.0f / 1024.0f) + 1e-6f);
}
__device__ __forceinline__ void rstd_stage(const float* __restrict__ ssq, PG8_LAS float* tab, int pm, int wr, int fr, int fq) {
    const int l = fq * 16 + fr;
    tab[l] = row_rstd(ssq, pm * BM + wr * 64 + l);
    tab[64 + l] = row_rstd(ssq, pm * BM + HALF + wr * 64 + l);
    asm volatile("s_waitcnt lgkmcnt(0)" ::: "memory");
}
__device__ __forceinline__ float xrow_sum4(float v) {
    { auto r = __builtin_amdgcn_permlane16_swap(__float_as_uint(v), __float_as_uint(v), false, false); v = __uint_as_float(r[0]) + __uint_as_float(r[1]); }
    { auto r = __builtin_amdgcn_permlane32_swap(__float_as_uint(v), __float_as_uint(v), false, false); v = __uint_as_float(r[0]) + __uint_as_float(r[1]); }
    return v;
}
__device__ __forceinline__ float silu_f(float g) { return g * __builtin_amdgcn_rcpf(1.0f + __builtin_amdgcn_exp2f(-1.4426950408889634f * g)); }
__device__ __forceinline__ float sigmoid_f(float g) { return __builtin_amdgcn_rcpf(1.0f + __builtin_amdgcn_exp2f(-1.4426950408889634f * g)); }

struct EpiGu {
    static constexpr bool PERM = true, AFTER_DRAIN = false, HAS_MID = false;
    bf16_t* act; const float* ssq; PG8_LAS float* rtab;
    __device__ __forceinline__ void operator()(const f32x4 (&acc)[2][2][4][2], const Unit& u, int wr, int wc, int fr, int fq) const {
        asm volatile("" : "+v"(fr), "+v"(fq));
        const int row0 = u.pm * BM + wr * 64 + fr, col0 = u.pn * 128 + wc * 32 + 8 * fq;
        PG8_LAS float* tab = rtab + (wr * 4 + wc) * 128; rstd_stage(ssq, tab, u.pm, wr, fr, fq);
#pragma unroll
        for (int ai = 0; ai < 2; ++ai)
#pragma unroll
            for (int m = 0; m < 4; ++m) {
                const int row = row0 + ai * HALF + m * 16; const float rs = tab[64 * ai + 16 * m + fr];
                float o[8];
#pragma unroll
                for (int n = 0; n < 2; ++n)
#pragma unroll
                    for (int i = 0; i < 4; ++i) o[n * 4 + i] = silu_f(acc[ai][0][m][n][i] * rs) * (acc[ai][1][m][n][i] * rs);
                u32x4 w; w.x = cvt_pk_bf16(o[0], o[1]); w.y = cvt_pk_bf16(o[2], o[3]); w.z = cvt_pk_bf16(o[4], o[5]); w.w = cvt_pk_bf16(o[6], o[7]);
                *(u32x4*)(act + (size_t)row * 2816 + col0) = w;
            }
    }
};
template <bool RIN32, bool OUT32, bool STATS> struct EpiRes {
    static constexpr bool PERM = true, AFTER_DRAIN = false, HAS_MID = false;
    const float* hin32; const bf16_t* hin16; float* hout; bf16_t* hb; float* ssq; float scale;
    __device__ __forceinline__ void operator()(const f32x4 (&acc)[2][2][4][2], const Unit& u, int wr, int wc, int fr, int fq) const {
        asm volatile("" : "+v"(fr), "+v"(fq));
        const int row0 = u.pm * BM + wr * 64 + fr, col0 = u.pn * BM + wc * 32 + 8 * fq;
#pragma unroll
        for (int ai = 0; ai < 2; ++ai)
#pragma unroll
            for (int m = 0; m < 4; ++m) {
                const int row = row0 + ai * HALF + m * 16; float ss = 0.f;
#pragma unroll
                for (int bj = 0; bj < 2; ++bj) {
                    const size_t off = (size_t)row * 1024 + col0 + bj * HALF;
                    f32x4 r0, r1;
                    if (RIN32) { r0 = *(const f32x4*)(hin32 + off); r1 = *(const f32x4*)(hin32 + off + 4); }
                    else { const u32x4 rw = *(const u32x4*)(hin16 + off);
                        r0 = (f32x4){__uint_as_float(rw.x << 16), __uint_as_float(rw.x & 0xffff0000u), __uint_as_float(rw.y << 16), __uint_as_float(rw.y & 0xffff0000u)};
                        r1 = (f32x4){__uint_as_float(rw.z << 16), __uint_as_float(rw.z & 0xffff0000u), __uint_as_float(rw.w << 16), __uint_as_float(rw.w & 0xffff0000u)}; }
                    const f32x4 v0 = r0 + acc[ai][bj][m][0] * scale, v1 = r1 + acc[ai][bj][m][1] * scale;
                    if (OUT32) { *(f32x4*)(hout + off) = v0; *(f32x4*)(hout + off + 4) = v1; }
                    if (STATS) {
                        u32x4 w; w.x = cvt_pk_bf16(v0[0], v0[1]); w.y = cvt_pk_bf16(v0[2], v0[3]); w.z = cvt_pk_bf16(v1[0], v1[1]); w.w = cvt_pk_bf16(v1[2], v1[3]);
                        *(u32x4*)(hb + off) = w;
                        ss += (v0[0] * v0[0] + v0[1] * v0[1]) + (v0[2] * v0[2] + v0[3] * v0[3]) + (v1[0] * v1[0] + v1[1] * v1[1]) + (v1[2] * v1[2] + v1[3] * v1[3]);
                    }
                }
                if (STATS) { ss = xrow_sum4(ss); if (fq == 0) ssq[(size_t)row * 16 + u.pn * 4 + wc] = ss; }
            }
    }
};
struct EpiIn {
    static constexpr bool PERM = true, AFTER_DRAIN = false, HAS_MID = false;
    bf16_t *QO, *KB, *VB, *GATES, *QI, *KI; float* WI; float* KMEAN; const float* ssq; const float* bgate; const float *qn_a, *kn_a, *qn_b, *kn_b; PG8_LAS float* rtab;
    template <int KIND, bool MOBA> __device__ __forceinline__ void qkv(const f32x4 (&acc)[2][2][4][2], const Unit& u, int wr, int wc, int fr, int fq, PG8_LAS float* tab, bf16_t* base, const float* gn) const {
        const int row0 = u.pm * BM + wr * 64 + fr, head = 4 * (u.pn & 1) + wc;
        bf16_t* dst = base + (MOBA ? 512 : 0) + head * 64 + 8 * fq;
        f32x4 gv[2][2];
#pragma unroll
        for (int bj = 0; bj < 2; ++bj)
#pragma unroll
            for (int n = 0; n < 2; ++n) gv[bj][n] = (KIND < 2) ? *(const f32x4*)(gn + 32 * bj + 8 * fq + 4 * n) : (f32x4){1.f, 1.f, 1.f, 1.f};
        constexpr bool km = (KIND == 1) && MOBA;
        f32x4 ks[2][2];
#pragma unroll
        for (int bj = 0; bj < 2; ++bj)
#pragma unroll
            for (int n = 0; n < 2; ++n) ks[bj][n] = (f32x4){0.f, 0.f, 0.f, 0.f};
#pragma unroll
        for (int ai = 0; ai < 2; ++ai)
#pragma unroll
            for (int m = 0; m < 4; ++m) {
                const int row = row0 + ai * HALF + m * 16; const float rs = tab[64 * ai + 16 * m + fr];
                f32x4 v[2][2]; float ss = 0.f;
#pragma unroll
                for (int bj = 0; bj < 2; ++bj)
#pragma unroll
                    for (int n = 0; n < 2; ++n) { v[bj][n] = acc[ai][bj][m][n] * rs; ss += (v[bj][n][0] * v[bj][n][0] + v[bj][n][1] * v[bj][n][1]) + (v[bj][n][2] * v[bj][n][2] + v[bj][n][3] * v[bj][n][3]); }
                if (KIND < 2) {
                    ss = xrow_sum4(ss);
                    float r = 1.0f / sqrtf(ss * (1.0f / 64.0f) + 1e-6f); if (KIND == 0) r *= K::C2;
#pragma unroll
                    for (int bj = 0; bj < 2; ++bj)
#pragma unroll
                        for (int n = 0; n < 2; ++n) v[bj][n] = v[bj][n] * gv[bj][n] * r;
                }
#pragma unroll
                for (int bj = 0; bj < 2; ++bj) {
                    u32x4 w; w.x = cvt_pk_bf16(v[bj][0][0], v[bj][0][1]); w.y = cvt_pk_bf16(v[bj][0][2], v[bj][0][3]); w.z = cvt_pk_bf16(v[bj][1][0], v[bj][1][1]); w.w = cvt_pk_bf16(v[bj][1][2], v[bj][1][3]);
                    *(u32x4*)(dst + (size_t)row * 1024 + 32 * bj) = w;
                    if (km) { ks[bj][0] += v[bj][0]; ks[bj][1] += v[bj][1]; }
                }
                if (km) asm volatile("" : "+v"(ks[0][0]), "+v"(ks[0][1]), "+v"(ks[1][0]), "+v"(ks[1][1]));
                asm volatile("" ::: "memory");
            }
        if (km) {
            float* kd = KMEAN + ((size_t)u.pm * 8 + head) * 64 + 8 * fq;
#pragma unroll
            for (int bj = 0; bj < 2; ++bj)
#pragma unroll
                for (int n = 0; n < 2; ++n)
#pragma unroll
                    for (int i = 0; i < 4; ++i) { float s = ks[bj][n][i]; s += __shfl_xor(s, 1); s += __shfl_xor(s, 2); s += __shfl_xor(s, 4); s += __shfl_xor(s, 8);
                        if (fr == 0) atomicAdd(kd + 32 * bj + 4 * n + i, s); }
        }
    }
    __device__ __forceinline__ void operator()(const f32x4 (&acc)[2][2][4][2], const Unit& u, int wr, int wc, int fr, int fq) const {
        asm volatile("" : "+v"(fr), "+v"(fq));
        const int pn = u.pn, row0 = u.pm * BM + wr * 64 + fr;
        PG8_LAS float* tab = rtab + (wr * 4 + wc) * 128; rstd_stage(ssq, tab, u.pm, wr, fr, fq);
        if (pn < 2) qkv<0, false>(acc, u, wr, wc, fr, fq, tab, QO, qn_a);
        else if (pn < 4) qkv<1, false>(acc, u, wr, wc, fr, fq, tab, KB, kn_a);
        else if (pn < 6) qkv<2, false>(acc, u, wr, wc, fr, fq, tab, VB, nullptr);
        else if (pn < 8) qkv<0, true>(acc, u, wr, wc, fr, fq, tab, QO, qn_b);
        else if (pn < 10) qkv<1, true>(acc, u, wr, wc, fr, fq, tab, KB, kn_b);
        else if (pn < 12) qkv<2, true>(acc, u, wr, wc, fr, fq, tab, VB, nullptr);
        else if (pn == 12) {
#pragma unroll
            for (int ai = 0; ai < 2; ++ai)
#pragma unroll
                for (int m = 0; m < 4; ++m) { const int row = row0 + ai * HALF + m * 16; const float rs = tab[64 * ai + 16 * m + fr];
#pragma unroll
                    for (int bj = 0; bj < 2; ++bj) { const f32x4 a = acc[ai][bj][m][0] * rs, b = acc[ai][bj][m][1] * rs;
                        u32x4 w; w.x = cvt_pk_bf16(a[0], a[1]); w.y = cvt_pk_bf16(a[2], a[3]); w.z = cvt_pk_bf16(b[0], b[1]); w.w = cvt_pk_bf16(b[2], b[3]);
                        *(u32x4*)(QI + (size_t)row * 256 + 128 * bj + 32 * wc + 8 * fq) = w; } }
        } else if (pn == 13) {
#pragma unroll
            for (int ai = 0; ai < 2; ++ai)
#pragma unroll
                for (int m = 0; m < 4; ++m) { const int row = row0 + ai * HALF + m * 16; const float rs = tab[64 * ai + 16 * m + fr];
                    const f32x4 a = acc[ai][0][m][0] * rs, b = acc[ai][0][m][1] * rs;
                    if (wc < 2) { u32x4 w; w.x = cvt_pk_bf16(a[0], a[1]); w.y = cvt_pk_bf16(a[2], a[3]); w.z = cvt_pk_bf16(b[0], b[1]); w.w = cvt_pk_bf16(b[2], b[3]);
                        *(u32x4*)(KI + (size_t)row * 64 + 32 * wc + 8 * fq) = w; }
                    else if (wc == 2 && fq == 0) *(f32x4*)(WI + (size_t)row * 4) = a * 0.5f; }
        } else {
            const int cg0 = 256 * (pn - 14) + 32 * wc + 8 * fq;
            f32x4 bv[2][2];
#pragma unroll
            for (int bj = 0; bj < 2; ++bj)
#pragma unroll
                for (int n = 0; n < 2; ++n) bv[bj][n] = *(const f32x4*)(bgate + cg0 + 128 * bj + 4 * n);
#pragma unroll
            for (int ai = 0; ai < 2; ++ai)
#pragma unroll
                for (int m = 0; m < 4; ++m) { const int row = row0 + ai * HALF + m * 16; const float rs = tab[64 * ai + 16 * m + fr];
#pragma unroll
                    for (int bj = 0; bj < 2; ++bj) { const f32x4 a = acc[ai][bj][m][0] * rs + bv[bj][0], b = acc[ai][bj][m][1] * rs + bv[bj][1];
                        u32x4 w; w.x = cvt_pk_bf16(sigmoid_f(a[0]), sigmoid_f(a[1])); w.y = cvt_pk_bf16(sigmoid_f(a[2]), sigmoid_f(a[3])); w.z = cvt_pk_bf16(sigmoid_f(b[0]), sigmoid_f(b[1])); w.w = cvt_pk_bf16(sigmoid_f(b[2]), sigmoid_f(b[3]));
                        *(u32x4*)(GATES + (size_t)row * 2048 + cg0 + 128 * bj) = w; } }
        }
    }
};
struct EpiBranch2 {
    static constexpr bool PERM = true, AFTER_DRAIN = false, HAS_MID = true;
    const bf16_t* gates; bf16_t* mx;
    __device__ __forceinline__ void mid(f32x4 (&acc)[2][2][4][2], const Unit& u, int wr, int wc, int fr, int fq) const {
        asm volatile("" : "+v"(fr), "+v"(fq));
        const int row0 = u.pm * BM + wr * 64 + fr, col0 = u.pn * BM + wc * 32 + 8 * fq;
#pragma unroll
        for (int ai = 0; ai < 2; ++ai)
#pragma unroll
            for (int m = 0; m < 4; ++m) {
                const int row = row0 + ai * HALF + m * 16;
#pragma unroll
                for (int bj = 0; bj < 2; ++bj) {
                    const size_t off = (size_t)row * 2048 + col0 + bj * HALF;
                    const u32x4 ga = *(const u32x4*)(gates + off), gb = *(const u32x4*)(gates + off + 1024);
                    float r[8];
#pragma unroll
                    for (int x = 0; x < 4; ++x) {
                        r[2 * x] = __uint_as_float(ga[x] << 16) * __builtin_amdgcn_rcpf(__builtin_fmaxf(__uint_as_float(gb[x] << 16), 1e-30f));
                        r[2 * x + 1] = __uint_as_float(ga[x] & 0xffff0000u) * __builtin_amdgcn_rcpf(__builtin_fmaxf(__uint_as_float(gb[x] & 0xffff0000u), 1e-30f)); }
                    acc[ai][bj][m][0] = acc[ai][bj][m][0] * (f32x4){r[0], r[1], r[2], r[3]};
                    acc[ai][bj][m][1] = acc[ai][bj][m][1] * (f32x4){r[4], r[5], r[6], r[7]};
                }
                asm volatile("" ::: "memory");
            }
    }
    __device__ __forceinline__ void operator()(const f32x4 (&acc)[2][2][4][2], const Unit& u, int wr, int wc, int fr, int fq) const {
        asm volatile("" : "+v"(fr), "+v"(fq));
        const int row0 = u.pm * BM + wr * 64 + fr, col0 = u.pn * BM + wc * 32 + 8 * fq;
#pragma unroll
        for (int ai = 0; ai < 2; ++ai)
#pragma unroll
            for (int m = 0; m < 4; ++m) {
                const int row = row0 + ai * HALF + m * 16;
#pragma unroll
                for (int bj = 0; bj < 2; ++bj) {
                    const u32x4 gw = *(const u32x4*)(gates + (size_t)row * 2048 + 1024 + col0 + bj * HALF);
                    const f32x4 a = acc[ai][bj][m][0], b = acc[ai][bj][m][1];
                    u32x4 w;
                    w.x = cvt_pk_bf16(a[0] * __builtin_fmaxf(__uint_as_float(gw.x << 16), 1e-30f), a[1] * __builtin_fmaxf(__uint_as_float(gw.x & 0xffff0000u), 1e-30f));
                    w.y = cvt_pk_bf16(a[2] * __builtin_fmaxf(__uint_as_float(gw.y << 16), 1e-30f), a[3] * __builtin_fmaxf(__uint_as_float(gw.y & 0xffff0000u), 1e-30f));
                    w.z = cvt_pk_bf16(b[0] * __builtin_fmaxf(__uint_as_float(gw.z << 16), 1e-30f), b[1] * __builtin_fmaxf(__uint_as_float(gw.z & 0xffff0000u), 1e-30f));
                    w.w = cvt_pk_bf16(b[2] * __builtin_fmaxf(__uint_as_float(gw.w << 16), 1e-30f), b[3] * __builtin_fmaxf(__uint_as_float(gw.w & 0xffff0000u), 1e-30f));
                    *(u32x4*)(mx + (size_t)row * 1024 + col0 + bj * HALF) = w;
                }
                asm volatile("" ::: "memory");
            }
    }
};
template <class Epi, class Sched, bool ALIGN_EPI = false, bool SP2 = false>
__device__ __forceinline__ void gemm_phase(PG8_LAS unsigned char* lds, const Gemm g, const Sched& S, const Epi& E) {
    int tid_ = threadIdx.x; asm volatile("" : "+v"(tid_));
    const int tid = tid_, wid = __builtin_amdgcn_readfirstlane(tid >> 6), lane = tid & 63, wr = wid >> 2, wc = wid & 3, fr = lane & 15, fq = lane >> 4;
    const int K = g.K, nt = K / BK;
    unsigned voffA[2], voffB[2];
#pragma unroll
    for (int i = 0; i < 2; ++i) { int R, C; stage_rc(tid * 16 + i * 8192, R, C); const int Rb = Epi::PERM ? ((R & ~31) + perm32(R & 31)) : R;
        voffA[i] = (unsigned)(R * g.lda + C) * 2u; voffB[i] = (unsigned)(tid * 16 + i * 8192); (void)Rb; }
    const size_t kstep = (size_t)(BK * 2), kstepB = (size_t)HTB;
    const size_t hstepA = (size_t)HALF * g.lda * 2, hstepB = (size_t)nt * kstepB;
    const size_t tstepA = 2 * hstepA, tstepB = 2 * hstepB;
#define PG8_ABASE(u_) ((const char*)g.A + (size_t)(u_).pm * tstepA + (((u_).pn >= g.asplit_pn) ? (size_t)g.asplit_off : (size_t)0))
    const unsigned ldsw = (unsigned)wid * 1024u;
    const int aoff = lds_byte(wr * 64 + fr, fq * 8), boff = lds_byte(wc * 32 + fr, fq * 8);
#define PG8_SA(b, h) (((b) * 2 + (h)) * HTB)
#define PG8_SB(b, h) ((4 + (b) * 2 + (h)) * HTB)
#define PG8_STAGE(bufoff, gbase, voff) do { _Pragma("unroll") for (int _i = 0; _i < 2; ++_i) \
        __builtin_amdgcn_global_load_lds((const unsigned*)((const char*)(gbase) + (voff)[_i]), (PG8_LAS unsigned*)(lds + (bufoff) + ldsw + _i * 8192), 16, 0, 0); } while (0)
#define PG8_LDA(dst, b, h) do { _Pragma("unroll") for (int m = 0; m < 4; ++m) _Pragma("unroll") for (int k = 0; k < 2; ++k) dst[m][k] = *(const PG8_LAS bf16x8*)(lds + PG8_SA(b, h) + aoff + m * 2048 + k * 1024); } while (0)
#define PG8_LDB(dst, b, h) do { _Pragma("unroll") for (int n = 0; n < 2; ++n) _Pragma("unroll") for (int k = 0; k < 2; ++k) dst[n][k] = *(const PG8_LAS bf16x8*)(lds + PG8_SB(b, h) + boff + n * 2048 + k * 1024); } while (0)
#define PG8_MMA(ai, bj, At, Bt) do { __builtin_amdgcn_s_setprio(1); _Pragma("unroll") for (int m = 0; m < 4; ++m) _Pragma("unroll") for (int n = 0; n < 2; ++n) _Pragma("unroll") for (int k = 0; k < 2; ++k) \
        acc[ai][bj][m][n] = __builtin_amdgcn_mfma_f32_16x16x32_bf16(Bt[n][k], At[m][k], acc[ai][bj][m][n], 0, 0, 0); __builtin_amdgcn_s_setprio(0); } while (0)
#define PG8_WAIT_V(n) asm volatile("s_waitcnt vmcnt(" #n ")" ::: "memory")
#define PG8_WAIT_L(n) asm volatile("s_waitcnt lgkmcnt(" #n ")" ::: "memory")
#define PG8_BAR __builtin_amdgcn_s_barrier()
#define PG8_SCHED __builtin_amdgcn_sched_barrier(0)
    Unit cur, nxt; int ui = 0;
    if (!S.next(0, cur)) return;
    f32x4 acc[2][2][4][2];
#pragma unroll
    for (int a = 0; a < 2; ++a)
#pragma unroll
        for (int b = 0; b < 2; ++b)
#pragma unroll
            for (int m = 0; m < 4; ++m)
#pragma unroll
                for (int n = 0; n < 2; ++n) acc[a][b][m][n] = (f32x4){0.f, 0.f, 0.f, 0.f};
    bf16x8 At[4][2], B0[2][2], B1[2][2];
    const char* cA = PG8_ABASE(cur); const char* cB = (const char*)g.Bt + (size_t)cur.pn * tstepB;
    S.a_ready(cur);
    if constexpr (SP2) {
        PG8_STAGE(PG8_SB(0, 0), cB, voffB); PG8_STAGE(PG8_SB(0, 1), cB + hstepB, voffB); PG8_STAGE(PG8_SA(0, 0), cA, voffA); PG8_STAGE(PG8_SA(0, 1), cA + hstepA, voffA);
        PG8_STAGE(PG8_SB(1, 0), cB + kstepB, voffB); PG8_STAGE(PG8_SA(1, 0), cA + kstep, voffA); PG8_STAGE(PG8_SB(1, 1), cB + hstepB + kstepB, voffB);
        if (wr == 1) PG8_BAR;
        PG8_WAIT_V(8); PG8_BAR;
        PG8_WAIT_V(6); PG8_BAR;
    } else {
        PG8_STAGE(PG8_SB(0, 0), cB, voffB); PG8_STAGE(PG8_SA(0, 0), cA, voffA); PG8_STAGE(PG8_SB(0, 1), cB + hstepB, voffB); PG8_STAGE(PG8_SA(0, 1), cA + hstepA, voffA);
        if (wr == 1) PG8_BAR;
        PG8_WAIT_V(4); PG8_BAR;
        PG8_STAGE(PG8_SB(1, 0), cB + kstepB, voffB); PG8_STAGE(PG8_SA(1, 0), cA + kstep, voffA); PG8_STAGE(PG8_SB(1, 1), cB + hstepB + kstepB, voffB);
        PG8_WAIT_V(6); PG8_BAR;
    }
    for (;;) {
        const bool has_next = S.next(ui + 1, nxt);
        const char* nA = has_next ? PG8_ABASE(nxt) : cA; const char* nB = has_next ? (const char*)g.Bt + (size_t)nxt.pn * tstepB : cB;
        for (int t = 0; t < nt; t += 2) {
            const bool last = (t == nt - 2);
            const char* a1 = cA + (size_t)(t + 1) * kstep;
            const char* a2 = last ? nA : cA + (size_t)(t + 2) * kstep; const char* b2 = last ? nB : cB + (size_t)(t + 2) * kstepB;
            const char* a3 = a2 + kstep; const char* b3 = b2 + kstepB;
            if (last && has_next) S.a_ready(nxt);
            if constexpr (SP2) {
            PG8_LDB(B0, 0, 0); PG8_LDB(B1, 0, 1); PG8_SCHED; PG8_LDA(At, 0, 0); PG8_STAGE(PG8_SA(1, 1), a1 + hstepA, voffA);
            PG8_WAIT_V(8); PG8_WAIT_L(0); PG8_BAR; PG8_MMA(0, 0, At, B0); PG8_MMA(0, 1, At, B1); PG8_BAR; PG8_SCHED;
            PG8_LDA(At, 0, 1); PG8_STAGE(PG8_SB(0, 0), b2, voffB); PG8_STAGE(PG8_SB(0, 1), b2 + hstepB, voffB); PG8_STAGE(PG8_SA(0, 0), a2, voffA);
            PG8_WAIT_V(8); PG8_WAIT_L(0); PG8_BAR; PG8_MMA(1, 0, At, B0); PG8_MMA(1, 1, At, B1); PG8_BAR; PG8_SCHED;
            PG8_LDB(B0, 1, 0); PG8_LDB(B1, 1, 1); PG8_SCHED; PG8_LDA(At, 1, 0); PG8_STAGE(PG8_SA(0, 1), a2 + hstepA, voffA);
            PG8_WAIT_V(8); PG8_WAIT_L(0); PG8_BAR; PG8_MMA(0, 0, At, B0); PG8_MMA(0, 1, At, B1); PG8_BAR; PG8_SCHED;
            PG8_LDA(At, 1, 1); PG8_STAGE(PG8_SB(1, 0), b3, voffB); PG8_STAGE(PG8_SB(1, 1), b3 + hstepB, voffB); PG8_STAGE(PG8_SA(1, 0), a3, voffA);
            PG8_WAIT_V(8); PG8_WAIT_L(0); PG8_BAR; PG8_MMA(1, 0, At, B0); PG8_MMA(1, 1, At, B1); PG8_BAR; PG8_SCHED;
            } else {
            PG8_LDB(B0, 0, 0); PG8_SCHED; PG8_LDA(At, 0, 0); PG8_STAGE(PG8_SA(1, 1), a1 + hstepA, voffA);
            PG8_WAIT_L(8); PG8_BAR; PG8_WAIT_L(0); PG8_MMA(0, 0, At, B0); PG8_BAR; PG8_SCHED;
            PG8_LDB(B1, 0, 1); PG8_STAGE(PG8_SB(0, 0), b2, voffB);
            PG8_BAR; PG8_WAIT_L(0); PG8_MMA(0, 1, At, B1); PG8_BAR;
            PG8_LDA(At, 0, 1); PG8_STAGE(PG8_SA(0, 0), a2, voffA);
            PG8_BAR; PG8_WAIT_L(0); PG8_MMA(1, 0, At, B0); PG8_BAR; PG8_SCHED;
            PG8_STAGE(PG8_SB(0, 1), b2 + hstepB, voffB);
            PG8_WAIT_V(6); PG8_BAR; PG8_MMA(1, 1, At, B1); PG8_BAR;
            PG8_LDB(B0, 1, 0); PG8_SCHED; PG8_LDA(At, 1, 0); PG8_STAGE(PG8_SA(0, 1), a2 + hstepA, voffA);
            PG8_WAIT_L(8); PG8_BAR; PG8_WAIT_L(0); PG8_MMA(0, 0, At, B0); PG8_BAR; PG8_SCHED;
            PG8_LDB(B1, 1, 1); PG8_STAGE(PG8_SB(1, 0), b3, voffB);
            PG8_BAR; PG8_WAIT_L(0); PG8_MMA(0, 1, At, B1); PG8_BAR;
            PG8_LDA(At, 1, 1); PG8_STAGE(PG8_SA(1, 0), a3, voffA);
            PG8_BAR; PG8_WAIT_L(0); PG8_MMA(1, 0, At, B0); PG8_BAR; PG8_SCHED;
            PG8_STAGE(PG8_SB(1, 1), b3 + hstepB, voffB);
            PG8_WAIT_V(6); PG8_BAR; PG8_MMA(1, 1, At, B1); PG8_BAR;
            }
            if constexpr (Epi::HAS_MID) { if (t + 2 == nt / 2) E.mid(acc, cur, wr, wc, fr, fq); }
        }
        if constexpr (ALIGN_EPI) { if (wr == 0) PG8_BAR; }
        if constexpr (!Epi::AFTER_DRAIN) { E(acc, cur, wr, wc, fr, fq); S.done(cur); }
        if (!has_next) break;
#pragma unroll
        for (int a = 0; a < 2; ++a)
#pragma unroll
            for (int b = 0; b < 2; ++b)
#pragma unroll
                for (int m = 0; m < 4; ++m)
#pragma unroll
                    for (int n = 0; n < 2; ++n) acc[a][b][m][n] = (f32x4){0.f, 0.f, 0.f, 0.f};
        cur = nxt; cA = nA; cB = nB; ++ui;
        if constexpr (ALIGN_EPI) { if (wr == 1) PG8_BAR; }
    }
    PG8_WAIT_V(0);
    if constexpr (!ALIGN_EPI) { if (wr == 0) PG8_BAR; }
    PG8_BAR;
    if constexpr (Epi::AFTER_DRAIN) { E.fused(acc, cur, wr, wc, fr, fq, lds, wid, lane); S.done(cur); }
#undef PG8_ABASE
#undef PG8_SA
#undef PG8_SB
#undef PG8_STAGE
#undef PG8_LDA
#undef PG8_LDB
#undef PG8_MMA
#undef PG8_WAIT_V
#undef PG8_WAIT_L
#undef PG8_BAR
#undef PG8_SCHED
}
}

constexpr int NWAVES = 8;
namespace WS {
constexpr size_t MiB = 1u << 20;
constexpr size_t CTL = 0, CTL_ZERO_BYTES = 1 * MiB;
constexpr size_t KMEAN = 512 * 1024;
constexpr size_t SSQ = 1 * MiB;
constexpr size_t GU1 = 2 * MiB, DN1 = 13 * MiB, WIN = 19 * MiB, WB = 30 * MiB, WO = 32 * MiB, GU2 = 36 * MiB, DN2 = 47 * MiB;
constexpr size_t XB = 53 * MiB;
constexpr size_t QO = 85 * MiB, KB = 117 * MiB, VB = 149 * MiB;
constexpr size_t GATES = 181 * MiB;
constexpr size_t QI = 245 * MiB, KI = 253 * MiB, WI = 255 * MiB, BMASK = 255 * MiB + 256 * 1024;
constexpr size_t ACT = 85 * MiB;
constexpr size_t GM = 117 * MiB;
constexpr size_t END = 256 * MiB;
}
constexpr int CW_BAR = 4096;
constexpr int RING_OFF = 0, RING_BYTES = 131072;
constexpr int LDSCTL_OFF = RING_BYTES, MISC_OFF = LDSCTL_OFF + 320;
constexpr int RTAB_OFF = LDSCTL_OFF + 1024;
constexpr int LDS_BYTES = 147456;

#define GAS __attribute__((address_space(1)))
#define LAS __attribute__((address_space(3)))
typedef unsigned v4u __attribute__((ext_vector_type(4)));
typedef float f32x4 __attribute__((ext_vector_type(4)));
typedef GAS unsigned gu32;
#define LDS_WAIT() asm volatile("s_waitcnt lgkmcnt(0)" ::: "memory")
#define VM_WAIT() asm volatile("s_waitcnt vmcnt(0)" ::: "memory")
__device__ __forceinline__ unsigned pk2(float lo, float hi) { return (unsigned)f2bf(lo) | ((unsigned)f2bf(hi) << 16); }
#define XB_TMO      128
#define XB_XCNT(j)  (256  + 64 * (j))
#define XB_XSUB(j)  (1280 + 64 * (j))
#define XB_XGEN(j)  (2304 + 64 * (j))
#define XB_TOP      3328
#define XB_TOPGEN   3392
#define XCD_BAR_WORDS 3456
#define XB_SPIN_CAP (1u << 18)

__device__ __forceinline__ unsigned xb_ld(unsigned* p)              { return __hip_atomic_load(p, __ATOMIC_RELAXED, __HIP_MEMORY_SCOPE_AGENT); }
__device__ __forceinline__ unsigned xb_add(unsigned* p, unsigned v) { return __hip_atomic_fetch_add(p, v, __ATOMIC_RELAXED, __HIP_MEMORY_SCOPE_AGENT); }
__device__ __forceinline__ unsigned xb_xcc_id() { return (unsigned)__builtin_amdgcn_s_getreg((3 << 11) | 20) & 0xFu; }
#define XB_SPIN(cond, bar) do { unsigned _sp = 0; while (cond) { __builtin_amdgcn_s_sleep(1); \
    if ((++_sp & 255u) == 0u) { if (xb_ld(&(bar)[XB_TMO])) break; if (_sp > XB_SPIN_CAP) { atomicAdd(&(bar)[XB_TMO], 1u); break; } } } } while (0)

struct XcdBarrier {
    unsigned* bar; unsigned x;
    volatile LAS unsigned* st;
};

__device__ __forceinline__ XcdBarrier xcd_barrier_post(unsigned* bar, volatile LAS unsigned* st) {
    XcdBarrier b; b.bar = bar; b.x = xb_xcc_id(); b.st = st;
    if (threadIdx.x == 0) (void)xb_add(&bar[XB_XCNT(b.x)], 1u);
    return b;
}
__device__ __forceinline__ void xcd_barrier_complete(unsigned* bar, unsigned x, unsigned& nloc, unsigned& nx) {
    const unsigned G = gridDim.x * gridDim.y * gridDim.z;
    unsigned sum, cnt, mine, sp = 0u;
    for (;;) {
        sum = 0u; cnt = 0u; mine = 0u;
#pragma unroll
        for (unsigned j = 0; j < 16; ++j) { const unsigned c = xb_ld(&bar[XB_XCNT(j)]); sum += c; cnt += (c > 0u) ? 1u : 0u; mine = (j == x) ? c : mine; }
        if (sum == G) break;
        __builtin_amdgcn_s_sleep(1);
        if ((++sp & 255u) == 0u) { if (xb_ld(&bar[XB_TMO])) break; if (sp > XB_SPIN_CAP) { atomicAdd(&bar[XB_TMO], 1u); break; } }
    }
    nloc = mine > 0u ? mine : 1u; nx = cnt > 0u ? cnt : 1u;
}

__device__ __forceinline__ void xcd_barrier(const XcdBarrier& b) {
    asm volatile("s_waitcnt vmcnt(0)" ::: "memory");
    __syncthreads();
    if (threadIdx.x == 0) {
        unsigned* bar = b.bar;
        __builtin_amdgcn_s_waitcnt(0);
        unsigned nloc = b.st[0], nx = b.st[1];
        if (nloc == 0u) { xcd_barrier_complete(bar, b.x, nloc, nx); b.st[0] = nloc; b.st[1] = nx; }
        const unsigned old = xb_add(&bar[XB_XSUB(b.x)], 1u);
        const unsigned gen = old / nloc;
        if (old + 1u == (gen + 1u) * nloc) {
            __builtin_amdgcn_fence(__ATOMIC_RELEASE, "agent");
            asm volatile("s_waitcnt vmcnt(0)" ::: "memory");
            const unsigned og = xb_add(&bar[XB_TOP], 1u);
            const unsigned tg = og / nx;
            if (og + 1u == (tg + 1u) * nx) xb_add(&bar[XB_TOPGEN], 1u);
            else XB_SPIN(xb_ld(&bar[XB_TOPGEN]) == tg, bar);
            __builtin_amdgcn_fence(__ATOMIC_ACQUIRE, "agent");
            xb_add(&bar[XB_XGEN(b.x)], 1u);
            asm volatile("s_waitcnt vmcnt(0)" ::: "memory");
        } else {
            XB_SPIN(xb_ld(&bar[XB_XGEN(b.x)]) == gen, bar);
            __builtin_amdgcn_fence(__ATOMIC_ACQUIRE, "agent");
            asm volatile("s_waitcnt vmcnt(0)" ::: "memory");
        }
    }
    __syncthreads();
}

namespace tk {
typedef short bf16x8 __attribute__((ext_vector_type(8)));
typedef float f32x4 __attribute__((ext_vector_type(4)));
constexpr int HIST_OFF = 0, HSTR = 1025;
constexpr int TCNT_OFF = 65664;
constexpr int MSTG_OFF = TCNT_OFF + 16384;
constexpr int TBASE_OFF = MSTG_OFF + 8192;
constexpr int RES_OFF = TBASE_OFF + 8192;
constexpr int QST_OFF = 102400;
#define TK_BAR() do { asm volatile("s_waitcnt lgkmcnt(0)" ::: "memory"); __builtin_amdgcn_s_barrier(); asm volatile("" ::: "memory"); } while (0)

__device__ __forceinline__ unsigned wave_prefix_incl(unsigned x) {
    x += (unsigned)__builtin_amdgcn_update_dpp(0, (int)x, 0x111, 0xf, 0xf, true);
    x += (unsigned)__builtin_amdgcn_update_dpp(0, (int)x, 0x112, 0xf, 0xf, true);
    x += (unsigned)__builtin_amdgcn_update_dpp(0, (int)x, 0x114, 0xf, 0xf, true);
    x += (unsigned)__builtin_amdgcn_update_dpp(0, (int)x, 0x118, 0xf, 0xf, true);
    x += (unsigned)__builtin_amdgcn_update_dpp(0, (int)x, 0x142, 0xa, 0xf, false);
    x += (unsigned)__builtin_amdgcn_update_dpp(0, (int)x, 0x143, 0xc, 0xf, false);
    return x;
}
template <int NW>
__device__ __forceinline__ void scan_query(const LAS unsigned* hq, LAS unsigned* res, int qq, unsigned r, int lane) {
    const int wbase = (63 - lane) * NW;
    unsigned ws = 0;
#pragma unroll
    for (int x = 0; x < NW; ++x) ws += hq[wbase + x];
    const unsigned tot = (ws & 0xffffu) + (ws >> 16);
    const unsigned incl = wave_prefix_incl(tot);
    const unsigned above = incl - tot;
    const unsigned long long bal = __ballot(above < r && incl >= r);
    const int Ls = __builtin_amdgcn_readfirstlane((int)__builtin_ctzll(bal));
    const unsigned r2 = r - (unsigned)__builtin_amdgcn_readlane((int)above, Ls);
    const int word = (63 - Ls) * NW + (NW - 1 - (lane & (NW - 1)));
    const unsigned w = hq[word], hi = w >> 16, lo = w & 0xffffu, t2 = hi + lo;
    unsigned inc2 = t2;
    inc2 += (unsigned)__builtin_amdgcn_update_dpp(0, (int)inc2, 0x111, 0xf, 0xf, true);
    inc2 += (unsigned)__builtin_amdgcn_update_dpp(0, (int)inc2, 0x112, 0xf, 0xf, true);
    inc2 += (unsigned)__builtin_amdgcn_update_dpp(0, (int)inc2, 0x114, 0xf, 0xf, true);
    inc2 += (unsigned)__builtin_amdgcn_update_dpp(0, (int)inc2, 0x118, 0xf, 0xf, true);
    const unsigned ab2 = inc2 - t2;
    if (lane < NW && ab2 < r2 && inc2 >= r2) {
        const bool uh = ab2 + hi >= r2;
        res[qq] = (unsigned)word * 2u + (uh ? 1u : 0u); res[16 + qq] = r2 - (uh ? ab2 : ab2 + hi); res[32 + qq] = uh ? hi : lo;
    }
}

__device__ __forceinline__ v4u tk_load_q(const bf16_t* __restrict__ QI, int b, int tq0, int lane, int wave) {
    const size_t row = (size_t)b * K::S + tq0 + (lane & 15);
    return *(const v4u*)(QI + row * 256 + (wave >> 1) * 64 + (wave & 1) * 32 + (lane >> 4) * 8);
}
__device__ __forceinline__ void tk_store_q(LAS unsigned char* L, v4u v, int lane, int wave) { *(LAS v4u*)(L + QST_OFF + wave * 1024 + lane * 16) = v; }
#define TK_S(F_, i_, rest_) if (8 * (i_) <= jw) { F_.template operator()<i_>(); rest_ }
#define TK_SLOTS(F_) do { TK_S(F_, 0, TK_S(F_, 1, TK_S(F_, 2, TK_S(F_, 3, TK_S(F_, 4, TK_S(F_, 5, TK_S(F_, 6, TK_S(F_, 7, TK_S(F_, 8, TK_S(F_, 9, TK_S(F_, 10, TK_S(F_, 11, TK_S(F_, 12, TK_S(F_, 13, TK_S(F_, 14, TK_S(F_, 15, TK_S(F_, 16, TK_S(F_, 17, TK_S(F_, 18, TK_S(F_, 19, TK_S(F_, 20, TK_S(F_, 21, TK_S(F_, 22, TK_S(F_, 23, TK_S(F_, 24, TK_S(F_, 25, TK_S(F_, 26, TK_S(F_, 27, TK_S(F_, 28, TK_S(F_, 29, TK_S(F_, 30, TK_S(F_, 31, )))))))))))))))))))))))))))))))) } while (0)
template <int PV>
__device__ __forceinline__ void topk_group(LAS unsigned char* L, const bf16_t* __restrict__ QI, const bf16_t* __restrict__ KI, const float* __restrict__ WI, u64* __restrict__ MASK,
                                           int b, int tq0, int nb, int ntq0, int tid, int lane, int wave, int nrep = 1) {
    using namespace K;
    const int q = lane & 15, g = lane >> 4;
    const int row0 = b * S + tq0, jmax = tq0 >> 4, jw = jmax - wave;
    LAS unsigned* hist = (LAS unsigned*)(L + HIST_OFF); LAS unsigned* tcnt = (LAS unsigned*)(L + TCNT_OFF);
    LAS unsigned short* mstg = (LAS unsigned short*)(L + MSTG_OFF); LAS unsigned short* tbase = (LAS unsigned short*)(L + TBASE_OFF); LAS unsigned* res = (LAS unsigned*)(L + RES_OFF);
    for (int i = tid; i < (16384 + 8192) / 4; i += NWAVES * 64) tcnt[i] = 0u;
    if (tq0 < TOPK) {
        if (ntq0 >= TOPK) tk_store_q(L, tk_load_q(QI, nb, ntq0, lane, wave), lane, wave);
        TK_BAR();
        for (int idx = tid; idx < 16 * (jmax + 1); idx += NWAVES * 64) { const int qq = idx & 15, j = idx >> 4; mstg[qq * 256 + j] = (unsigned short)((j < jmax) ? 0xffffu : ((2u << qq) - 1u)); }
    } else {
        v4u key[32];
        for (int i = tid; i < 16 * HSTR / 4; i += NWAVES * 64) ((LAS v4u*)hist)[i] = (v4u){0u, 0u, 0u, 0u};
        TK_BAR();
        bf16x8 qf[4][2];
#pragma unroll
        for (int h = 0; h < 4; ++h)
#pragma unroll
            for (int ks = 0; ks < 2; ++ks) qf[h][ks] = *(const LAS bf16x8*)(L + QST_OFF + (h * 2 + ks) * 1024 + lane * 16);
        const f32x4 wv = *(const f32x4*)(WI + (size_t)(row0 + q) * 4);
        bf16x8 kk[2][2];
#define TK_LOADK(i_) do { const int o_ = 8 * (i_), jc_ = wave + (o_ < jw ? o_ : jw); const bf16_t* kp_ = KI + (size_t)(b * S + jc_ * 16 + q) * 64 + g * 8; \
            kk[(i_) % 2][0] = *(const bf16x8*)kp_; kk[(i_) % 2][1] = *(const bf16x8*)(kp_ + 32); } while (0)
        TK_LOADK(0);
        const int lim = q - 4 * g;
        auto sslot = [&]<int i>() __attribute__((always_inline)) {
            if (i < 31) TK_LOADK(i + 1);
            asm volatile("" ::: "memory");
            f32x4 sc = {0.f, 0.f, 0.f, 0.f};
#pragma unroll
            for (int h = 0; h < 4; ++h) {
                f32x4 d = __builtin_amdgcn_mfma_f32_16x16x32_bf16(kk[i % 2][0], qf[h][0], (f32x4){0.f, 0.f, 0.f, 0.f}, 0, 0, 0);
                d = __builtin_amdgcn_mfma_f32_16x16x32_bf16(kk[i % 2][1], qf[h][1], d, 0, 0, 0);
#pragma unroll
                for (int r = 0; r < 4; ++r) { const int di = __float_as_int(d[r]); sc[r] = __builtin_fmaf(wv[h], __int_as_float(di > 0 ? di : 0), sc[r]); }
                if (h == 1) __builtin_amdgcn_sched_barrier(0);
            }
            const int tl = (8 * i == jw) ? lim : 3;
#pragma unroll
            for (int r = 0; r < 4; ++r) {
                const unsigned u = __float_as_uint(sc[r]);
                const unsigned k = (r > tl) ? 0u : (u ^ ((unsigned)((int)u >> 31) | 0x80000000u));
                key[i][r] = k;
                if (PV != 3) { const unsigned bin = k >> 21; __hip_atomic_fetch_add(hist + q * HSTR + (bin >> 1), k ? (1u << (16 * (bin & 1u))) : 0u, __ATOMIC_RELAXED, __HIP_MEMORY_SCOPE_WORKGROUP); }
            }
            __builtin_amdgcn_sched_barrier(0);
        };
        TK_SLOTS(sslot);
#undef TK_LOADK
        if (PV == 1 || PV == 3) {
            unsigned xs = 0u;
#pragma unroll
            for (int i = 0; i < 32; ++i) { if (8 * i <= jw) {
#pragma unroll
                for (int r = 0; r < 4; ++r) xs ^= key[i][r]; } }
            TK_BAR();
            if (ntq0 >= TOPK) tk_store_q(L, tk_load_q(QI, nb, ntq0, lane, wave), lane, wave);
            res[64 + lane] = xs;
        } else {
        int ln = lane; asm volatile("" : "+v"(ln));
        LAS unsigned* const tc_q = tcnt + (ln & 15) * 256 + wave; LAS unsigned short* const tb_q = tbase + (ln & 15) * 256 + wave;
        LAS unsigned* const ms32_q = (LAS unsigned*)mstg + (((ln & 15) * 256 + wave) >> 1); const unsigned sh_q = 16u * (wave & 1) + 4u * (unsigned)(ln >> 4);
        unsigned prefix = 0u, rnk = (unsigned)TOPK, cnt_eq = 0u; v4u qnext = {0u, 0u, 0u, 0u};
        const LAS unsigned* const hq_c = hist + q * HSTR; LAS unsigned* const hq = (LAS unsigned*)hq_c;
        LAS unsigned* const lcnt = (LAS unsigned*)(L + TBASE_OFF);
        LAS unsigned* const lstk = (LAS unsigned*)(L + TBASE_OFF + 64), * const lsti = lstk + 256;
        constexpr unsigned LCAP = 16;
        if (tid < 16) lcnt[tid] = 0u;
        auto radix = [&]<int pass>() __attribute__((always_inline)) {
            constexpr int pshift = (pass == 1) ? 21 : 10;
            if (pass != 0) {
                TK_BAR();
                if (pass == 1 && ntq0 >= TOPK) qnext = tk_load_q(QI, nb, ntq0, lane, wave);
                for (int i = tid; i < 16 * HSTR / 4; i += NWAVES * 64) ((LAS v4u*)hist)[i] = (v4u){0u, 0u, 0u, 0u};
                TK_BAR();
                auto pslot = [&]<int i>() __attribute__((always_inline)) {
#pragma unroll
                    for (int r = 0; r < 4; ++r) {
                        const unsigned k = key[i][r];
                        const unsigned word = (pass == 1) ? ((k >> 11) & 1023u) : ((k >> 1) & 511u);
                        const unsigned inc = (k & ((pass == 1) ? 0x400u : 1u)) ? 0x10000u : 1u;
                        __hip_atomic_fetch_add(hq + word, ((k >> pshift) == prefix) ? inc : 0u, __ATOMIC_RELAXED, __HIP_MEMORY_SCOPE_WORKGROUP);
                    }
                };
                TK_SLOTS(pslot);
            }
            TK_BAR();
            { const unsigned r0 = (unsigned)__builtin_amdgcn_readlane((int)rnk, 2 * wave), r1 = (unsigned)__builtin_amdgcn_readlane((int)rnk, 2 * wave + 1);
              if (pass < 2) { scan_query<16>(hist + (2 * wave) * HSTR, res, 2 * wave, r0, lane); scan_query<16>(hist + (2 * wave + 1) * HSTR, res, 2 * wave + 1, r1, lane); }
              else { scan_query<8>(hist + (2 * wave) * HSTR, res, 2 * wave, r0, lane); scan_query<8>(hist + (2 * wave + 1) * HSTR, res, 2 * wave + 1, r1, lane); } }
            TK_BAR();
            prefix = (prefix << ((pass == 2) ? 10 : 11)) | res[q]; rnk = res[16 + q]; cnt_eq = res[32 + q];
        };
        radix.template operator()<0>();
        if (PV != 5) radix.template operator()<1>();
        const bool amb = rnk != cnt_eq;
        const bool fb = (PV == 20) ? true : (PV == 5 || PV == 6) ? false : __any(amb && cnt_eq > LCAP);
        if (!fb) {
            const unsigned base = prefix << 10, Tsel = amb ? base + 1024u : base, clim = amb ? 1024u : 0u;
            unsigned idx0 = ((unsigned)wave << 4) + 4u * (unsigned)(ln >> 4);
            asm volatile("" : "+v"(idx0));
            auto fslot = [&]<int i>() __attribute__((always_inline)) {
                unsigned nib = 0;
#pragma unroll
                for (int r = 3; r >= 0; --r) nib = nib + nib + ((key[i][r] >= Tsel) ? 1u : 0u);
                __hip_atomic_fetch_or(ms32_q + 4 * i, nib << sh_q, __ATOMIC_RELAXED, __HIP_MEMORY_SCOPE_WORKGROUP);
                const unsigned t0 = key[i][0] - base, t1 = key[i][1] - base, t2 = key[i][2] - base, t3 = key[i][3] - base;
                const unsigned ta = t0 < t1 ? t0 : t1, tb = t2 < t3 ? t2 : t3, tm = ta < tb ? ta : tb;
                if (__builtin_expect(tm < clim, 0)) {
#pragma unroll
                    for (int r = 0; r < 4; ++r) {
                        const unsigned k = key[i][r];
                        if (k - base < clim) { const unsigned pos = __hip_atomic_fetch_add(lcnt + q, 1u, __ATOMIC_RELAXED, __HIP_MEMORY_SCOPE_WORKGROUP);
                            lstk[q * LCAP + (pos & (LCAP - 1))] = k; lsti[q * LCAP + (pos & (LCAP - 1))] = ~(idx0 + 128u * i + r); }
                    }
                }
            };
            TK_SLOTS(fslot);
            TK_BAR();
#pragma unroll
            for (int s2 = 0; s2 < 2; ++s2) {
                const int qq = 2 * wave + s2;
                const unsigned n = (unsigned)__builtin_amdgcn_readfirstlane((int)lcnt[qq]), rq = (unsigned)__builtin_amdgcn_readlane((int)rnk, qq);
                const unsigned mk = lstk[qq * LCAP + (lane & (LCAP - 1))], mi = lsti[qq * LCAP + (lane & (LCAP - 1))];
                unsigned better = 0;
                for (unsigned e = 0; e < n; ++e) { const unsigned ek = lstk[qq * LCAP + e], ei = lsti[qq * LCAP + e]; better += (ek > mk || (ek == mk && ei > mi)) ? 1u : 0u; }
                if ((unsigned)lane < n && better < rq) {
                    const unsigned idx = ~mi, j = idx >> 4;
                    __hip_atomic_fetch_or((LAS unsigned*)mstg + ((qq * 256 + j) >> 1), 1u << (16u * (j & 1u) + (idx & 15u)), __ATOMIC_RELAXED, __HIP_MEMORY_SCOPE_WORKGROUP);
                }
            }
        } else {
        radix.template operator()<2>();
        const unsigned T = prefix, need = rnk;
        const bool slow = __any(need != cnt_eq);
        if (slow) {
#pragma unroll
            for (int i = 0; i < 32; ++i) {
                if (8 * i <= jw) {
                    unsigned c = 0;
#pragma unroll
                    for (int r = 0; r < 4; ++r) c += (key[i][r] == T) ? 1u : 0u;
                    if (c) __hip_atomic_fetch_add(tc_q + 8 * i, c << (8 * g), __ATOMIC_RELAXED, __HIP_MEMORY_SCOPE_WORKGROUP);
                }
            }
            TK_BAR();
#pragma unroll
            for (int s = 0; s < 2; ++s) {
                const int qq = 2 * wave + s; unsigned tt[4], tot = 0;
#pragma unroll
                for (int x = 0; x < 4; ++x) { const unsigned e = tcnt[qq * 256 + lane * 4 + x]; tt[x] = (e & 255u) + ((e >> 8) & 255u) + ((e >> 16) & 255u) + (e >> 24); tot += tt[x]; }
                const unsigned incl = wave_prefix_incl(tot);
                unsigned base = incl - tot;
#pragma unroll
                for (int x = 0; x < 4; ++x) { tbase[qq * 256 + lane * 4 + x] = (unsigned short)base; base += tt[x]; }
            }
            TK_BAR();
        }
#pragma unroll
        for (int i = 0; i < 32; ++i) {
            if (8 * i > jw) continue;
            unsigned nib = 0;
            if (!slow) {
#pragma unroll
                for (int r = 0; r < 4; ++r) nib |= (key[i][r] >= T) ? (1u << r) : 0u;
            } else {
                const unsigned e = tc_q[8 * i]; unsigned rank = tb_q[8 * i];
                if (g > 0) rank += e & 255u; if (g > 1) rank += (e >> 8) & 255u; if (g > 2) rank += (e >> 16) & 255u;
#pragma unroll
                for (int r = 0; r < 4; ++r) { const unsigned k = key[i][r];
                    if (k > T) nib |= 1u << r; else if (k == T && k != 0u) { if (rank < need) nib |= 1u << r; ++rank; } }
            }
            __hip_atomic_fetch_or(ms32_q + 4 * i, nib << sh_q, __ATOMIC_RELAXED, __HIP_MEMORY_SCOPE_WORKGROUP);
        }
        }
        if (ntq0 >= TOPK) tk_store_q(L, qnext, lane, wave);
        }
    }
    TK_BAR();
    if (PV == 0 || PV == 5 || PV == 6 || PV == 13 || PV == 14 || PV == 20)
    for (int idx = tid; idx < 1024; idx += NWAVES * 64) {
        const int qq = idx & 15, t64 = idx >> 4;
        const u64 wd = *(const LAS u64*)(mstg + qq * 256 + t64 * 4);
        MASK[((size_t)b * 64 + t64) * S + tq0 + qq] = wd;
    }
    TK_BAR();
}

__device__ __forceinline__ void gating_block(LAS unsigned char* L, const bf16_t* __restrict__ QO, const float* __restrict__ KMEAN, unsigned* __restrict__ BMASK, int blk64, int tid) {
    using namespace K;
    const int row0 = 64 * blk64, b = row0 / S;
    LAS float* km = (LAS float*)L;
    const int r = tid >> 3, h = tid & 7, row = row0 + r, t = row % S, own = t / MBLK;
    uint4 qraw[8];
#pragma unroll
    for (int x = 0; x < 8; ++x) qraw[x] = *(const uint4*)(QO + (size_t)row * 1024 + 512 + h * 64 + 8 * x);
    for (int i = tid; i < 16 * 8 * 64; i += NWAVES * 64) { const int n = i >> 9, hh = (i >> 6) & 7, d = i & 63; km[(n * 8 + hh) * 68 + d] = KMEAN[((size_t)(b * 16 + n) * 8 + hh) * 64 + d]; }
    TK_BAR();
    float qv[64];
#pragma unroll
    for (int x = 0; x < 8; ++x) { const uint4 u = qraw[x];
        qv[8 * x + 0] = __uint_as_float(u.x << 16); qv[8 * x + 1] = __uint_as_float(u.x & 0xffff0000u); qv[8 * x + 2] = __uint_as_float(u.y << 16); qv[8 * x + 3] = __uint_as_float(u.y & 0xffff0000u);
        qv[8 * x + 4] = __uint_as_float(u.z << 16); qv[8 * x + 5] = __uint_as_float(u.z & 0xffff0000u); qv[8 * x + 6] = __uint_as_float(u.w << 16); qv[8 * x + 7] = __uint_as_float(u.w & 0xffff0000u); }
    float b0 = -INFINITY, b1 = -INFINITY, b2 = -INFINITY; int i0 = -1, i1 = -1, i2 = -1;
    for (int n = 0; n < own; ++n) {
        const LAS f32x4* kp = (const LAS f32x4*)(km + (n * 8 + h) * 68); float gs = 0.f;
#pragma unroll
        for (int d4 = 0; d4 < 16; ++d4) { const f32x4 kv = kp[d4]; gs = __builtin_fmaf(qv[4 * d4], kv[0], gs); gs = __builtin_fmaf(qv[4 * d4 + 1], kv[1], gs); gs = __builtin_fmaf(qv[4 * d4 + 2], kv[2], gs); gs = __builtin_fmaf(qv[4 * d4 + 3], kv[3], gs); }
        if (gs > b0) { b2 = b1; i2 = i1; b1 = b0; i1 = i0; b0 = gs; i0 = n; }
        else if (gs > b1) { b2 = b1; i2 = i1; b1 = gs; i1 = n; }
        else if (gs > b2) { b2 = gs; i2 = n; }
    }
    unsigned bm = 1u << own;
    if (i0 >= 0) bm |= 1u << i0; if (i1 >= 0) bm |= 1u << i1; if (i2 >= 0) bm |= 1u << i2;
    BMASK[(size_t)row * 8 + h] = bm;
    TK_BAR();
}
#undef TK_BAR
}
namespace attn_body {
using bf16=__hip_bfloat16;
using bf16x8=__attribute__((ext_vector_type(8)))short;
using s16x4=__attribute__((ext_vector_type(4)))short;
using f32x16=__attribute__((ext_vector_type(16)))float;
using u32x4=__attribute__((ext_vector_type(4)))unsigned;
constexpr int BATCH=4,NHEAD=16,SEQ=4096,D=64,DM=NHEAD*D;
constexpr int NW=8,QBLK=32,QB=QBLK*NW,KVBLK=64,NQB=SEQ/QB;
constexpr int ATTN_PITCH=DM, ATTN_UNIT_ROWS=QB;
__device__ __forceinline__ int crow(int r,int hi){return (r&3)+8*(r>>2)+4*hi;}
#define SBAR() __builtin_amdgcn_sched_barrier(0)
typedef __attribute__((address_space(3))) const float* lds_fptr;
__device__ __forceinline__ void addbias(f32x16&p0,f32x16&p1,int jb6,int qrel,int hi,lds_fptr bt){
  const lds_fptr b=bt+(qrel+128-64*jb6-4*hi+197);
  #pragma unroll
  for(int r=0;r<16;++r){const int c=(r&3)+8*(r>>2); p0[r]+=b[59-c]; p1[r]+=b[27-c];}
}

constexpr int BT_N=640;
constexpr int NSLOT=3, SLOTB=8192;
#define EXM(p,w) do{ if(MOBA) asm volatile("v_sub_f32 %0, %0, %2\n\tv_exp_f32 %0, %0\n\tv_add_co_u32 %1, vcc, %1, %1\n\tv_cndmask_b32 %0, 0, %0, vcc":"+v"(p),"+v"(w):"v"(mhat):"vcc"); \
  else asm volatile("v_exp_f32 %0, %0\n\tv_add_co_u32 %1, vcc, %1, %1\n\tv_cndmask_b32 %0, 0, %0, vcc":"+v"(p),"+v"(w)::"vcc"); }while(0)
#define EXS(p,mh) asm volatile("v_sub_f32 %0, %0, %1\n\tv_exp_f32 %0, %0\n\ts_nop 0":"+v"(p):"v"(mh))
#define EXM16(P,w) do{ EXM(P[15],w);EXM(P[14],w);EXM(P[13],w);EXM(P[12],w); w<<=4; EXM(P[11],w);EXM(P[10],w);EXM(P[9],w);EXM(P[8],w); w<<=4; EXM(P[7],w);EXM(P[6],w);EXM(P[5],w);EXM(P[4],w); w<<=4; EXM(P[3],w);EXM(P[2],w);EXM(P[1],w);EXM(P[0],w); }while(0)
__device__ __forceinline__ int cbit(int r){return (r&3)+8*(r>>2);}
constexpr int LDS_K=0, LDS_V=NSLOT*SLOTB, LDS_WS=2*NSLOT*SLOTB, LDS_OST=LDS_WS+NW*64*4, LDS_BT=LDS_OST+NW*4096, LDS_BYTES=LDS_BT+BT_N*4;
constexpr float C2=0.125f*1.4426950408889634f;
__device__ __forceinline__ void glds16(const void*gsrc,unsigned lds_dst){unsigned keep;
  asm volatile("s_mov_b32 %0, m0\n\ts_mov_b32 m0, %2\n\ts_nop 0\n\tglobal_load_lds_dwordx4 %1, off\n\ts_mov_b32 m0, %0":"=&s"(keep):"v"(gsrc),"s"(lds_dst):"memory");}
__device__ __forceinline__ float max3f(float a,float b,float c){float r;asm("v_max3_f32 %0, %1, %2, %3":"=v"(r):"v"(a),"v"(b),"v"(c));return r;}
__device__ __forceinline__ float max2f(float a,float b){float r;asm("v_max_f32_e32 %0, %1, %2":"=v"(r):"v"(a),"v"(b));return r;}
__device__ __forceinline__ float fadd_s(float a,float b){float r;asm("v_add_f32_e32 %0, %1, %2":"=v"(r):"v"(a),"v"(b));return r;}
__device__ __forceinline__ float fsub_s(float a,float b){float r;asm("v_sub_f32_e32 %0, %1, %2":"=v"(r):"v"(a),"v"(b));return r;}
typedef float f32x2_t __attribute__((ext_vector_type(2))); typedef __bf16 bf16x2_t __attribute__((ext_vector_type(2)));
__device__ __forceinline__ unsigned cvtpk_s(float lo,float hi){f32x2_t v={lo,hi};bf16x2_t b=__builtin_convertvector(v,bf16x2_t);return __builtin_bit_cast(unsigned,b);}
#define WAIT_BAR(N) asm volatile("s_waitcnt vmcnt(" #N ") lgkmcnt(0)\n\ts_barrier":::"memory")

__device__ __forceinline__ void qkt(f32x16&p0,f32x16&p1,const char*Kslot,const bf16x8*qr,const f32x16&c0,int r32,int hi){
  const char*kb=Kslot+hi*1024+r32*16;
  #pragma unroll
  for(int d0=0;d0<4;++d0){
    const bf16x8 b0=*reinterpret_cast<const bf16x8*>(kb+d0*2048);
    const bf16x8 b1=*reinterpret_cast<const bf16x8*>(kb+d0*2048+512);
    if(d0==0){p0=__builtin_amdgcn_mfma_f32_32x32x16_bf16(b0,qr[0],c0,0,0,0);p1=__builtin_amdgcn_mfma_f32_32x32x16_bf16(b1,qr[0],c0,0,0,0);}
    else{p0=__builtin_amdgcn_mfma_f32_32x32x16_bf16(b0,qr[d0],p0,0,0,0);p1=__builtin_amdgcn_mfma_f32_32x32x16_bf16(b1,qr[d0],p1,0,0,0);}}
}
typedef __attribute__((address_space(3))) const char* lds_cptr;
typedef short v4i16_t __attribute__((ext_vector_type(4)));
__device__ __forceinline__ void kload8(bf16x8*kf,lds_cptr kp){
  kf[0]=*(const __attribute__((address_space(3))) bf16x8*)(kp);      kf[1]=*(const __attribute__((address_space(3))) bf16x8*)(kp+512);
  kf[2]=*(const __attribute__((address_space(3))) bf16x8*)(kp+2048); kf[3]=*(const __attribute__((address_space(3))) bf16x8*)(kp+2560);
  kf[4]=*(const __attribute__((address_space(3))) bf16x8*)(kp+4096); kf[5]=*(const __attribute__((address_space(3))) bf16x8*)(kp+4608);
  kf[6]=*(const __attribute__((address_space(3))) bf16x8*)(kp+6144); kf[7]=*(const __attribute__((address_space(3))) bf16x8*)(kp+6656);
}
__device__ __forceinline__ void kload2(bf16x8*kf,lds_cptr kp,int j){ kf[2*j]=*(const __attribute__((address_space(3))) bf16x8*)(kp+j*2048); kf[2*j+1]=*(const __attribute__((address_space(3))) bf16x8*)(kp+j*2048+512); }
__device__ __forceinline__ s16x4 vtr(lds_cptr p){ return __builtin_bit_cast(s16x4,__builtin_amdgcn_ds_read_tr16_b64_v4i16((__attribute__((address_space(3))) v4i16_t*)p)); }
__device__ __forceinline__ float rowmax(const f32x16&p0,const f32x16&p1){
  float a=max3f(p0[0],p0[1],p1[0]),b=max3f(p0[2],p0[3],p1[1]);a=max3f(a,p1[2],p1[3]);
  #pragma unroll
  for(int r=4;r<16;r+=4){a=max3f(a,p0[r],p0[r+1]);b=max3f(b,p0[r+2],p0[r+3]);a=max3f(a,p1[r],p1[r+1]);b=max3f(b,p1[r+2],p1[r+3]);}
  const float m=max2f(a,b);
  auto rr=__builtin_amdgcn_permlane32_swap(__float_as_uint(m),__float_as_uint(m),false,false);
  return max2f(__uint_as_float(rr[0]),__uint_as_float(rr[1]));
}
__device__ __forceinline__ void pv(f32x16*o,int vb,bf16x8 pa0,bf16x8 pa1,bf16x8 pa2,bf16x8 pa3){
  #pragma unroll
  for(int d0=0;d0<2;++d0){s16x4 lo[4],hi[4];
    #pragma unroll
    for(int ks=0;ks<4;++ks){
      asm volatile("ds_read_b64_tr_b16 %0,%1 offset:%c2":"=&v"(lo[ks]):"v"(vb),"i"(d0*4096+ks*1024):"memory");
      asm volatile("ds_read_b64_tr_b16 %0,%1 offset:%c2":"=&v"(hi[ks]):"v"(vb),"i"(d0*4096+ks*1024+512):"memory");}
    asm volatile("s_waitcnt lgkmcnt(0)":::"memory");SBAR();
    #define PK(k) (bf16x8){lo[k][0],lo[k][1],lo[k][2],lo[k][3],hi[k][0],hi[k][1],hi[k][2],hi[k][3]}
    o[d0]=__builtin_amdgcn_mfma_f32_32x32x16_bf16(pa0,PK(0),o[d0],0,0,0);
    o[d0]=__builtin_amdgcn_mfma_f32_32x32x16_bf16(pa1,PK(1),o[d0],0,0,0);
    o[d0]=__builtin_amdgcn_mfma_f32_32x32x16_bf16(pa2,PK(2),o[d0],0,0,0);
    o[d0]=__builtin_amdgcn_mfma_f32_32x32x16_bf16(pa3,PK(3),o[d0],0,0,0);
    #undef PK
  }
}

#ifndef ATTN_STORE16
#define ATTN_STORE16(p,v) (*(u32x4*)(p)=(v))
#endif
template<int THRL,bool MOBA> __device__ __forceinline__ void attn_unit(int b,int h,int qb,const bf16*Q,const bf16*__restrict__ K,const bf16*__restrict__ V,bf16*O,const unsigned long long*__restrict__ MASKW,const unsigned*__restrict__ BMASK,const float*__restrict__ relb,const float*__restrict__ gq,const float*__restrict__ gk,char*shm){
  int tid_=threadIdx.x; asm volatile("":"+v"(tid_)); const int tid=tid_,lane=tid&63,r32=lane&31,hi=lane>>5; const int wid=__builtin_amdgcn_readfirstlane(tid>>6);
  const long rowbase=(long)b*SEQ; const int q0=qb*QB;
  const bf16*Qw=Q+(rowbase+q0+wid*QBLK)*DM+h*D;
  const bf16*Kh=K+rowbase*DM+h*D,*Vh=V+rowbase*DM+h*D;
  const unsigned lds0=(unsigned)(uintptr_t)shm;
  float*wsf=(float*)(shm+LDS_WS)+wid*64;
  const bf16*ksrc=Kh+(long)lane*DM+wid*8;
  const bf16*vsrc=Vh+(long)(16*(wid&3)+(lane>>2))*DM+(wid>>2)*32+(lane&3)*8;
  const unsigned kdst=lds0+LDS_K+wid*1024, vdst=lds0+LDS_V+wid*1024;
  #define DMA_K(t,slot) glds16(ksrc+(long)(t)*KVBLK*DM,(unsigned)__builtin_amdgcn_readfirstlane(kdst+(slot)))
  #define DMA_V(t,slot) glds16(vsrc+(long)(t)*KVBLK*DM,(unsigned)__builtin_amdgcn_readfirstlane(vdst+(slot)))
  const int vb0=(int)(lds0+LDS_V)+((lane>>4)&1)*32+(lane&3)*8+(4*hi+((lane&15)>>2))*64;
  const char*Kbase=shm+LDS_K; bf16x8 kf[8];
  const lds_cptr shm3=(lds_cptr)shm; const lds_cptr kp0=shm3+LDS_K+hi*1024+r32*16; const lds_cptr vp0=shm3+LDS_V+((lane>>4)&1)*32+(lane&3)*8+(4*hi+((lane&15)>>2))*64;
  const int NT=(q0+QB)/KVBLK;
  const int qrel=wid*QBLK+r32; constexpr bool moba=MOBA;
  const lds_fptr bt=(lds_fptr)(shm3+LDS_BT);
  unsigned bm=0u;
  const unsigned mvoff=(unsigned)(q0+qrel)*8u; unsigned long long mraw=0ull; unsigned mlo=0u,mhi=0u;
  #define MLOAD(tt) do{ if(!moba&&(tt)<NT){ const unsigned long long*mb_=MASKW+((size_t)(b*64+(tt)))*SEQ; \
      asm volatile("s_nop 4\n\tglobal_load_dwordx2 %0, %1, %2":"=v"(mraw):"v"(mvoff),"s"(mb_):"memory"); } }while(0)
  #define MSET(tt) do{ if(!moba){ asm volatile("":"+v"(mraw)); mlo=(unsigned)mraw<<(4-4*hi); mhi=(unsigned)(mraw>>32)<<(4-4*hi); } \
      else{ unsigned wl=((bm>>((tt)>>2))&1u)?0xffffffffu:0u, wh=wl; const int jb_=(tt)-(NT-4); \
        if(jb_>=0){ const int n=qrel-64*jb_, n2=n-32; wl&=(n<0)?0u:((n>=31)?0xffffffffu:((2u<<n)-1u)); wh&=(n2<0)?0u:((n2>=31)?0xffffffffu:((2u<<n2)-1u)); } \
        mlo=wl<<(4-4*hi); mhi=wh<<(4-4*hi); } }while(0)
  MLOAD(0);
  DMA_K(0,0);DMA_V(0,0);DMA_K(1,SLOTB);
  bf16x8 qr[4];
  #pragma unroll
  for(int d0=0;d0<4;++d0)qr[d0]=*reinterpret_cast<const bf16x8*>(&Qw[(long)r32*DM+d0*16+hi*8]);
  if(moba)bm=BMASK[(size_t)(rowbase+q0+qrel)*8+(h-8)];
  { __attribute__((address_space(3))) float*btw=(__attribute__((address_space(3))) float*)(shm3+LDS_BT); const float b31=relb[31*16+h];
    for(int i=tid;i<BT_N;i+=NW*64){ const int d=i-256; btw[i]=(d>=0&&d<=112)?(relb[t5_bucket(d)*16+h]-b31)*1.4426950408889634f:0.f; } }
  constexpr float mhat=16.0f; float l_reg=0.f;f32x16 o[2];o[0]=f32x16{};o[1]=f32x16{}; f32x16 negm=f32x16{}; (void)gq; (void)gk;
  if(!MOBA){ _Pragma("unroll") for(int r=0;r<16;++r)negm[r]=-mhat; asm volatile("":"+v"(negm)); }
  #define CMASK(P0,P1,t) do{int jb_=(t)-(NT-6); if(jb_>=0)addbias(P0,P1,jb_,qrel,hi,bt);}while(0)
  #define START(P0,P1) do{ EXM16(P0,mlo); }while(0)
  #define RESC() do{}while(0)
  f32x16 pA0,pA1,pB0,pB1;
  int sl_prev=0,sl_cur=0,sl_next=SLOTB;
  #define ROT() do{sl_prev=sl_cur;sl_cur=sl_next;sl_next=(sl_next==(NSLOT-1)*SLOTB)?0:sl_next+SLOTB;}while(0)
  DMA_K(2,2*SLOTB);
  WAIT_BAR(3);
  MSET(0); MLOAD(1);
  qkt(pA0,pA1,Kbase,qr,(MOBA?f32x16{}:negm),r32,hi);asm volatile("s_nop 15\n\ts_nop 7":"+v"(pA0),"+v"(pA1));CMASK(pA0,pA1,0);
  START(pA0,pA1);
  EXM16(pA1,mhi);
  WAIT_BAR(0);
  MSET(1);
  DMA_K(3,0);DMA_V(1,SLOTB);
  ROT();
  kload8(kf,kp0+sl_cur);
  WAIT_BAR(2);
  s16x4 vlo[8],vhi[8]; u32x4 pw0,pw1,pw2,pw3;
  #define PKW(P,B) cvtpk_s(P[B],P[B+1])
  #define PAF(k) __builtin_bit_cast(bf16x8,pw##k)
  #define VFR(i) (bf16x8){vlo[i][0],vlo[i][1],vlo[i][2],vlo[i][3],vhi[i][0],vhi[i][1],vhi[i][2],vhi[i][3]}
  #define PIN(x) asm volatile("":"+v"(x))
  #define MX3(a,b,c) __builtin_fmaxf(__builtin_fmaxf((a),(b)),(c))
  #define GAPA(MF,A0,A1,A2,A3,W0,W1,PW) do{ MF; sacc+=A0; sacc+=A1; sacc+=A2; sacc+=A3; PIN(sacc); W0; W1; PIN(PW); SBAR(); }while(0)
  #define EX(v) __builtin_amdgcn_exp2f(v)
  #define GAPB(MF,X,B,MW,CH) do{ MF; if(CH){ EXS(X[B+3],mh_); EXS(X[B+2],mh_); EXS(X[B+1],mh_); EXS(X[B],mh_); } else { EXM(X[B+3],MW); EXM(X[B+2],MW); EXM(X[B+1],MW); EXM(X[B],MW); if((B)>0)MW<<=4; } PIN(X); SBAR(); }while(0)
  #define VRD(i) do{ vlo[i]=vtr(vp_+(((i)>>2)*4096+((i)&3)*1024)); vhi[i]=vtr(vp_+(((i)>>2)*4096+((i)&3)*1024+512)); }while(0)
  #define KRD(G,j) do{ if(G){ kload2(kf,kp0+sl_next,j); SBAR(); } }while(0)
  #define STEP(C0,C1,P0,P1,t,GK,GV,GL,CH) do{ SBAR(); \
    const lds_cptr vp_=vp0+sl_prev; \
    VRD(0); SBAR(); float sacc=(P0[0]+P0[1]); \
    GAPA(C0=__builtin_amdgcn_mfma_f32_32x32x16_bf16(kf[0],qr[0],(MOBA?f32x16{}:negm),0,0,0), P0[2],P0[3],P0[4],P0[5],     pw0[0]=PKW(P0,0), pw0[1]=PKW(P0,2), pw0); \
    VRD(4); SBAR(); GAPA(C1=__builtin_amdgcn_mfma_f32_32x32x16_bf16(kf[1],qr[0],(MOBA?f32x16{}:negm),0,0,0), P0[6],P0[7],P0[8],P0[9],     pw0[2]=PKW(P0,4), pw0[3]=PKW(P0,6), pw0); \
    VRD(1); SBAR(); GAPA(C0=__builtin_amdgcn_mfma_f32_32x32x16_bf16(kf[2],qr[1],C0,0,0,0),   P0[10],P0[11],P0[12],P0[13], pw1[0]=PKW(P0,8), pw1[1]=PKW(P0,10), pw1); \
    VRD(5); SBAR(); GAPA(C1=__builtin_amdgcn_mfma_f32_32x32x16_bf16(kf[3],qr[1],C1,0,0,0),   P0[14],P0[15],P1[0],P1[1],   pw1[2]=PKW(P0,12),pw1[3]=PKW(P0,14), pw1); \
    VRD(2); SBAR(); GAPA(C0=__builtin_amdgcn_mfma_f32_32x32x16_bf16(kf[4],qr[2],C0,0,0,0),   P1[2],P1[3],P1[4],P1[5],     pw2[0]=PKW(P1,0), pw2[1]=PKW(P1,2), pw2); \
    VRD(6); SBAR(); GAPA(C1=__builtin_amdgcn_mfma_f32_32x32x16_bf16(kf[5],qr[2],C1,0,0,0),   P1[6],P1[7],P1[8],P1[9],     pw2[2]=PKW(P1,4), pw2[3]=PKW(P1,6), pw2); \
    VRD(3); SBAR(); GAPA(C0=__builtin_amdgcn_mfma_f32_32x32x16_bf16(kf[6],qr[3],C0,0,0,0),   P1[10],P1[11],P1[12],P1[13], pw3[0]=PKW(P1,8), pw3[1]=PKW(P1,10), pw3); \
    VRD(7); SBAR(); GAPA(C1=__builtin_amdgcn_mfma_f32_32x32x16_bf16(kf[7],qr[3],C1,0,0,0),   P1[14],P1[15],0.f,0.f,       pw3[2]=PKW(P1,12),pw3[3]=PKW(P1,14), pw3); \
    l_reg+=sacc; \
    if(GK){DMA_K((t)+3,sl_cur);} if(GV){DMA_V((t)+1,sl_next);} \
    CMASK(C0,C1,t); \
    const float mh_=(CH)?((mlo!=0u)?mhat:__builtin_inff()):0.f; (void)mh_; \
    SBAR(); \
    GAPB(o[0]=__builtin_amdgcn_mfma_f32_32x32x16_bf16(PAF(0),VFR(0),o[0],0,0,0), C0,12,mlo,CH); \
    GAPB(o[1]=__builtin_amdgcn_mfma_f32_32x32x16_bf16(PAF(0),VFR(4),o[1],0,0,0), C0,8,mlo,CH); \
    KRD(GL,0); GAPB(o[0]=__builtin_amdgcn_mfma_f32_32x32x16_bf16(PAF(1),VFR(1),o[0],0,0,0), C0,4,mlo,CH); \
    KRD(GL,1); GAPB(o[1]=__builtin_amdgcn_mfma_f32_32x32x16_bf16(PAF(1),VFR(5),o[1],0,0,0), C0,0,mlo,CH); \
    KRD(GL,2); GAPB(o[0]=__builtin_amdgcn_mfma_f32_32x32x16_bf16(PAF(2),VFR(2),o[0],0,0,0), C1,12,mhi,CH); \
    KRD(GL,3); GAPB(o[1]=__builtin_amdgcn_mfma_f32_32x32x16_bf16(PAF(2),VFR(6),o[1],0,0,0), C1,8,mhi,CH); \
    GAPB(o[0]=__builtin_amdgcn_mfma_f32_32x32x16_bf16(PAF(3),VFR(3),o[0],0,0,0), C1,4,mhi,CH); \
    GAPB(o[1]=__builtin_amdgcn_mfma_f32_32x32x16_bf16(PAF(3),VFR(7),o[1],0,0,0), C1,0,mhi,CH); \
    }while(0)
  int t=1;
  #undef CMASK
  #define CMASK(P0,P1,t) do{}while(0)
  for(;t+7<NT;t+=2){
    MLOAD(t+1); STEP(pB0,pB1,pA0,pA1,t,true,true,true,MOBA);     WAIT_BAR(2); RESC(); ROT(); MSET(t+1);
    MLOAD(t+2); STEP(pA0,pA1,pB0,pB1,t+1,true,true,true,MOBA);   WAIT_BAR(2); RESC(); ROT(); MSET(t+2);
  }
  #undef CMASK
  #define CMASK(P0,P1,t) do{int jb_=(t)-(NT-6); if(jb_>=0)addbias(P0,P1,jb_,qrel,hi,bt);}while(0)
  #define ENDW(tt) do{ if((tt)+3<NT){WAIT_BAR(2);} else if((tt)+2<NT){WAIT_BAR(1);} else {WAIT_BAR(0);} }while(0)
  for(;t+1<NT;t+=2){
    MLOAD(t+1); STEP(pB0,pB1,pA0,pA1,t,(t+3<NT),(t+1<NT),(t+1<NT),0);       ENDW(t);   RESC(); ROT(); MSET(t+1);
    MLOAD(t+2); STEP(pA0,pA1,pB0,pB1,t+1,(t+4<NT),(t+2<NT),(t+2<NT),0);     ENDW(t+1); RESC(); ROT(); MSET(t+2);
  }
  STEP(pB0,pB1,pA0,pA1,NT-1,false,false,false,0); RESC();
  { float sacc=pB0[0]+pB0[1]; _Pragma("unroll") for(int r=2;r<16;++r)sacc+=pB0[r]; _Pragma("unroll") for(int r=0;r<16;++r)sacc+=pB1[r]; l_reg+=sacc;
    pw0=(u32x4){PKW(pB0,0),PKW(pB0,2),PKW(pB0,4),PKW(pB0,6)};pw1=(u32x4){PKW(pB0,8),PKW(pB0,10),PKW(pB0,12),PKW(pB0,14)};pw2=(u32x4){PKW(pB1,0),PKW(pB1,2),PKW(pB1,4),PKW(pB1,6)};pw3=(u32x4){PKW(pB1,8),PKW(pB1,10),PKW(pB1,12),PKW(pB1,14)};
    SBAR(); pv(o,vb0+sl_cur,PAF(0),PAF(1),PAF(2),PAF(3)); }
  #undef PKW
  #undef PAF
  #undef VFR
  #undef PIN
  #undef MX3
  #undef GAPA
  #undef GAPB
  #undef EX
  #undef VRD
  #undef KRD
  #undef STEP
  #undef ENDW
  {auto rr=__builtin_amdgcn_permlane32_swap(__float_as_uint(l_reg),__float_as_uint(l_reg),false,false);l_reg=__uint_as_float(rr[0])+__uint_as_float(rr[1]);}
  if(hi==0)wsf[32+r32]=l_reg;asm volatile("s_waitcnt lgkmcnt(0)":::"memory");
  float rli[16];
  #pragma unroll
  for(int r=0;r<16;++r)rli[r]=__builtin_amdgcn_rcpf(wsf[32+crow(r,hi)]);
  bf16*Ow=O+(rowbase+q0+wid*QBLK)*DM+h*D;
  { bf16*stg=(bf16*)(shm+LDS_OST)+wid*2048;
    #pragma unroll
    for(int r=0;r<16;++r){const int orow=crow(r,hi);
      #pragma unroll
      for(int d0=0;d0<2;++d0)stg[orow*64+d0*32+r32]=__float2bfloat16(o[d0][r]*rli[r]);}
    asm volatile("s_waitcnt lgkmcnt(0)":::"memory");
    #pragma unroll
    for(int i=0;i<4;++i){const int row=i*8+(lane>>3),ch=lane&7; const u32x4 v=*(const u32x4*)(stg+row*64+ch*8); ATTN_STORE16(Ow+(long)row*DM+ch*8,v);} }
  asm volatile("s_waitcnt lgkmcnt(0)\n\ts_barrier":::"memory");
  #undef MLOAD
  #undef MSET
  #undef DMA_K
  #undef DMA_V
  #undef CMASK
  #undef START
  #undef RESC
  #undef ROT
}
constexpr int ATTN_LDS_BYTES=LDS_BYTES;
#undef SBAR
#undef WAIT_BAR
}

__device__ __forceinline__ float wave_sum_fast(float v) {
#define WS_DPP_(ctrl, rm, bc) v += __int_as_float(__builtin_amdgcn_update_dpp(0, __float_as_int(v), ctrl, rm, 0xf, bc))
    WS_DPP_(0x111, 0xf, true); WS_DPP_(0x112, 0xf, true); WS_DPP_(0x114, 0xf, true); WS_DPP_(0x118, 0xf, true); WS_DPP_(0x142, 0xa, false); WS_DPP_(0x143, 0xc, false);
#undef WS_DPP_
    return __int_as_float(__builtin_amdgcn_readlane(__float_as_int(v), 63));
}
__device__ __forceinline__ int rowmap(int map, int n) {
    if (map == 1) { const int up = n >= 2816; const int j = up ? n - 2816 : n; return 256 * (j >> 7) + (up ? 128 : 0) + (j & 127); }
    if (map == 2) {
        if (n < 3072) { const int part = n >> 9, cc = n & 511, tl = cc >> 8, wc = (cc & 255) >> 6, d = cc & 63; return 256 * (2 * part + tl) + 128 * (d >> 5) + 32 * wc + (d & 31); }
        if (n < 3328) return 256 * 12 + (n - 3072);
        if (n < 3396) return 256 * 13 + (n - 3328);
        if (n < 5444) return 256 * 14 + (n - 3396);
        return 256 * 13 + 68 + (n - 5444);
    }
    if (map == 3) return 1024 + n;
    return n;
}
__device__ __forceinline__ void conv_item(const float* __restrict__ W, int ldw, int N, int Nw, const float* __restrict__ gain, bf16_t* WT, int ldk, int map, int koff, LAS float* scr, int item, int lane) {
    const int nblk = (Nw + 31) >> 5, kb = item / nblk, nb = item % nblk, k0 = 64 * kb, n0 = 32 * nb;
    const int rr = lane >> 3, c4 = (lane & 7) * 4; const bool inb = (n0 + c4) < N;
    f32x4 v[8];
#pragma unroll
    for (int i = 0; i < 8; ++i) v[i] = inb ? *(const GAS f32x4*)(W + (size_t)(k0 + 8 * i + rr) * ldw + n0 + c4) : (f32x4){0.f, 0.f, 0.f, 0.f};
#pragma unroll
    for (int i = 0; i < 8; ++i) { const int kk = 8 * i + rr; const float gk = gain ? gain[k0 + kk] : 1.0f; LAS float* s = scr + kk * 33 + c4;
        s[0] = v[i][0] * gk; s[1] = v[i][1] * gk; s[2] = v[i][2] * gk; s[3] = v[i][3] * gk; }
    LDS_WAIT(); asm volatile("" ::: "memory");
    const int c = lane & 7;
#pragma unroll
    for (int j = 0; j < 4; ++j) { const int n = (lane >> 3) + 8 * j; const LAS float* s = scr + (8 * c) * 33 + n;
        if (n0 + n < Nw) {
            v4u o; o.x = pk2(s[0 * 33], s[1 * 33]); o.y = pk2(s[2 * 33], s[3 * 33]); o.z = pk2(s[4 * 33], s[5 * 33]); o.w = pk2(s[6 * 33], s[7 * 33]);
            *(GAS v4u*)((unsigned char*)WT + pg8::tiled_b_off(rowmap(map, n0 + n), koff + k0 + 8 * c, ldk >> 6)) = o; } }
    LDS_WAIT(); asm volatile("" ::: "memory");
}

struct Args { const float* in[18]; float* out; unsigned char* ws; int ph_lo, ph_hi, li, pad; };
enum { I_X = 0, I_N1, I_GU1, I_DN1, I_NM, I_WIN, I_BG, I_QNA, I_KNA, I_QNB, I_KNB, I_WBA, I_WBB, I_WO, I_N2, I_GU2, I_DN2, I_RB };

__device__ __forceinline__ void p0_prologue(const Args& args, LAS unsigned char* L, int gw, int NGW, int lane, int gtid, int ngt) {
    using namespace K;
    unsigned char* ws = args.ws;
    LAS float* scr = (LAS float*)(L + RING_OFF + (gw & 7) * 16384);
    constexpr int I0 = 16 * 176, I1 = 44 * 32, I2 = 16 * 176, I3 = 8 * 32, I4 = 8 * 32, I5 = 16 * 32;
    constexpr int NITEMS = 2 * I0 + 2 * I1 + I2 + I3 + I4 + I5;
    for (int it = gw; it < NITEMS; it += NGW) {
        int r = it;
        if (r < I0) { conv_item(args.in[I_GU1], 2 * DFF, 2 * DFF, 2 * DFF, args.in[I_N1], (bf16_t*)(ws + WS::GU1), D, 1, 0, scr, r, lane); continue; } r -= I0;
        if (r < I0) { conv_item(args.in[I_GU2], 2 * DFF, 2 * DFF, 2 * DFF, args.in[I_N2], (bf16_t*)(ws + WS::GU2), D, 1, 0, scr, r, lane); continue; } r -= I0;
        if (r < I1) { conv_item(args.in[I_DN1], D, D, D, nullptr, (bf16_t*)(ws + WS::DN1), DFF, 0, 0, scr, r, lane); continue; } r -= I1;
        if (r < I1) { conv_item(args.in[I_DN2], D, D, D, nullptr, (bf16_t*)(ws + WS::DN2), DFF, 0, 0, scr, r, lane); continue; } r -= I1;
        if (r < I2) { conv_item(args.in[I_WIN], DIN, DIN, 5632, args.in[I_NM], (bf16_t*)(ws + WS::WIN), D, 2, 0, scr, r, lane); continue; } r -= I2;
        if (r < I3) { conv_item(args.in[I_WBA], D, D, D, nullptr, (bf16_t*)(ws + WS::WB), D, 0, 0, scr, r, lane); continue; } r -= I3;
        if (r < I4) { conv_item(args.in[I_WBB], D, D, D, nullptr, (bf16_t*)(ws + WS::WB), D, 0, 512, scr, r, lane); continue; } r -= I4;
        conv_item(args.in[I_WO], D, D, D, nullptr, (bf16_t*)(ws + WS::WO), D, 0, 0, scr, r, lane);
    }
    const float* x = args.in[I_X];
    for (int m0 = 2 * gw; m0 < M; m0 += 2 * NGW) {
        f32x4 v[2][4]; float s[2] = {0.f, 0.f};
#pragma unroll
        for (int rr = 0; rr < 2; ++rr) { const GAS f32x4* xr = (const GAS f32x4*)(x + (size_t)(m0 + rr) * D) + lane;
#pragma unroll
            for (int j = 0; j < 4; ++j) v[rr][j] = xr[64 * j]; }
#pragma unroll
        for (int rr = 0; rr < 2; ++rr) {
#pragma unroll
            for (int j = 0; j < 4; ++j) s[rr] += (v[rr][j][0] * v[rr][j][0] + v[rr][j][1] * v[rr][j][1]) + (v[rr][j][2] * v[rr][j][2] + v[rr][j][3] * v[rr][j][3]);
            s[rr] = wave_sum_fast(s[rr]);
            GAS unsigned long long* o8 = (GAS unsigned long long*)(ws + WS::XB + (size_t)(m0 + rr) * D * 2) + lane;
#pragma unroll
            for (int j = 0; j < 4; ++j) o8[64 * j] = (unsigned long long)pk2(v[rr][j][0], v[rr][j][1]) | ((unsigned long long)pk2(v[rr][j][2], v[rr][j][3]) << 32);
            if (lane < 4) { f32x4 q = {lane == 0 ? s[rr] : 0.f, 0.f, 0.f, 0.f}; *((GAS f32x4*)(ws + WS::SSQ + (size_t)(m0 + rr) * 64) + lane) = q; }
        }
    }
}

__global__ void __launch_bounds__(NWAVES * 64, 2) mega(Args args) {
    extern __shared__ __attribute__((aligned(16))) unsigned char lds[];
    using namespace K;
    LAS unsigned char* L = (LAS unsigned char*)lds;
    volatile LAS unsigned* MISC = (volatile LAS unsigned*)(L + MISC_OFF);
    const int tid = threadIdx.x, lane = tid & 63, wave = __builtin_amdgcn_readfirstlane(tid >> 6);
    const int G = gridDim.x, bx = blockIdx.x; const int vcu = (G % 8 == 0) ? (bx % 8) * (G / 8) + bx / 8 : bx;
    unsigned char* ws = args.ws;
    for (int u = tid; u < (LDS_BYTES - LDSCTL_OFF) / 4; u += NWAVES * 64) ((LAS unsigned*)(L + LDSCTL_OFF))[u] = 0u;
    __syncthreads();
    XcdBarrier bar = xcd_barrier_post((unsigned*)(ws + WS::CTL) + CW_BAR + args.li * XCD_BAR_WORDS, MISC + 8);
    const int lo = args.ph_lo, hi = args.ph_hi;
#define IN(k) (lo <= (k) && (k) < hi)
#define SEAM(k) do { if (IN(k) && IN((k) + 1)) xcd_barrier(bar); } while (0)
    bf16_t* XB = (bf16_t*)(ws + WS::XB); bf16_t* ACT = (bf16_t*)(ws + WS::ACT); float* SSQ = (float*)(ws + WS::SSQ);

    if (IN(0)) { p0_prologue(args, L, vcu * NWAVES + wave, G * NWAVES, lane, bx * (NWAVES * 64) + tid, G * NWAVES * 64); SEAM(0); }
    if (IN(1)) {
        pg8::Gemm g{XB, (const bf16_t*)(ws + WS::GU1), M, 2 * DFF, D, D, 1 << 30, 0}; pg8::StaticOrder S; S.init(M, 2 * DFF, G, bx);
        pg8::EpiGu E{ACT, SSQ, (LAS float*)(L + RTAB_OFF)};
        pg8::gemm_phase<pg8::EpiGu, pg8::StaticOrder, true, true>(L + RING_OFF, g, S, E);
        SEAM(1);
    }
    if (IN(2)) {
        pg8::Gemm g{ACT, (const bf16_t*)(ws + WS::DN1), M, D, DFF, DFF, 1 << 30, 0}; pg8::StaticOrder S; S.init(M, D, G, bx);
        pg8::EpiRes<true, false, true> E{args.in[I_X], nullptr, nullptr, XB, SSQ, 0.5f};
        pg8::gemm_phase<pg8::EpiRes<true, false, true>, pg8::StaticOrder, false, true>(L + RING_OFF, g, S, E);
        SEAM(2);
    }
    if (IN(3)) {
        pg8::Gemm g{XB, (const bf16_t*)(ws + WS::WIN), M, 5632, D, D, 1 << 30, 0}; pg8::StaticOrder S; S.init(M, 5632, G, bx);
        pg8::EpiIn E{(bf16_t*)(ws + WS::QO), (bf16_t*)(ws + WS::KB), (bf16_t*)(ws + WS::VB), (bf16_t*)(ws + WS::GATES), (bf16_t*)(ws + WS::QI), (bf16_t*)(ws + WS::KI), (float*)(ws + WS::WI), (float*)(ws + WS::KMEAN), SSQ,
                     args.in[I_BG], args.in[I_QNA], args.in[I_KNA], args.in[I_QNB], args.in[I_KNB], (LAS float*)(L + RTAB_OFF)};
        pg8::gemm_phase<pg8::EpiIn, pg8::StaticOrder, true, true>(L + RING_OFF, g, S, E);
        SEAM(3);
    }
    if (IN(4)) {
        int tid4_ = threadIdx.x; asm volatile("" : "+v"(tid4_)); const int tid = tid4_, lane = tid & 63;
        {
#define TK_POS(it_, bb_, tq_) do { bb_ = (it_) >> 8; const int v_ = (it_) & 255, vv_ = (v_ + 128 * (bb_ >> 1)) & 255; tq_ = 16 * ((bb_ & 1) ? 255 - vv_ : vv_); } while (0)
            int bb = 0, tq = -1;
            if (vcu < 1024) { TK_POS(vcu, bb, tq); if (tq >= TOPK) tk::tk_store_q(L, tk::tk_load_q((const bf16_t*)(ws + WS::QI), bb, tq, lane, wave), lane, wave); }
            for (int blk = vcu; blk < M / 64; blk += G) tk::gating_block(L, (const bf16_t*)(ws + WS::QO), (const float*)(ws + WS::KMEAN), (unsigned*)(ws + WS::BMASK), blk, tid);
            for (int it = vcu; it < 1024; it += G) {
                int nb = 0, ntq = -1; if (it + G < 1024) TK_POS(it + G, nb, ntq);
                tk::topk_group<0>(L, (const bf16_t*)(ws + WS::QI), (const bf16_t*)(ws + WS::KI), (const float*)(ws + WS::WI), (u64*)args.out, bb, tq, nb, ntq, tid, lane, wave);
                bb = nb; tq = ntq;
            }
#undef TK_POS
        }
        SEAM(4);
    }
    if (IN(5)) {
        static_assert(attn_body::ATTN_LDS_BYTES <= RING_BYTES, "attention LDS vs frame");
        const attn_body::bf16* Qp = (const attn_body::bf16*)(ws + WS::QO); const attn_body::bf16* Kp = (const attn_body::bf16*)(ws + WS::KB); const attn_body::bf16* Vp = (const attn_body::bf16*)(ws + WS::VB);
        for (int p = vcu; p < 512; p += G) {
            const int s = p & 7, bh = (p < 256) ? (p >> 3) : (32 + (((p - 256) >> 3) ^ 8));
            if ((bh & 15) >= 8) { for (int k = 0; k < 2; ++k)
                attn_body::attn_unit<8, true>(bh >> 4, bh & 15, k ? s : 15 - s, Qp, Kp, Vp, (attn_body::bf16*)(ws + WS::QO), (const unsigned long long*)args.out, (const unsigned*)(ws + WS::BMASK), args.in[I_RB], args.in[I_QNB], args.in[I_KNB], (char*)lds); }
            else { for (int k = 0; k < 2; ++k)
                attn_body::attn_unit<8, false>(bh >> 4, bh & 15, k ? s : 15 - s, Qp, Kp, Vp, (attn_body::bf16*)(ws + WS::QO), (const unsigned long long*)args.out, (const unsigned*)(ws + WS::BMASK), args.in[I_RB], args.in[I_QNA], args.in[I_KNA], (char*)lds); }
        }
        SEAM(5);
    }
    if (IN(6)) {
        pg8::Gemm g{(const bf16_t*)(ws + WS::QO), (const bf16_t*)(ws + WS::WB), M, D, D, D, 1 << 30, 0}; pg8::StaticOrder S; S.init(M, D, G, bx);
        pg8::EpiBranch2 E{(const bf16_t*)(ws + WS::GATES), (bf16_t*)(ws + WS::GM)};
        pg8::gemm_phase<pg8::EpiBranch2, pg8::StaticOrder, false, true>(L + RING_OFF, g, S, E);
        SEAM(6);
    }
    if (IN(7)) {
        pg8::Gemm g{(const bf16_t*)(ws + WS::GM), (const bf16_t*)(ws + WS::WO), M, D, D, D, 1 << 30, 0}; pg8::StaticOrder S; S.init(M, D, G, bx);
        pg8::EpiRes<false, false, true> E{nullptr, XB, nullptr, XB, SSQ, 1.0f};
        pg8::gemm_phase<pg8::EpiRes<false, false, true>, pg8::StaticOrder, false, true>(L + RING_OFF, g, S, E);
        SEAM(7);
    }
    if (IN(8)) {
        pg8::Gemm g{XB, (const bf16_t*)(ws + WS::GU2), M, 2 * DFF, D, D, 1 << 30, 0}; pg8::StaticOrder S; S.init(M, 2 * DFF, G, bx);
        pg8::EpiGu E{ACT, SSQ, (LAS float*)(L + RTAB_OFF)};
        pg8::gemm_phase<pg8::EpiGu, pg8::StaticOrder, true, true>(L + RING_OFF, g, S, E);
        SEAM(8);
    }
    if (IN(9)) {
        pg8::Gemm g{ACT, (const bf16_t*)(ws + WS::DN2), M, D, DFF, DFF, 1 << 30, 0}; pg8::StaticOrder S; S.init(M, D, G, bx);
        pg8::EpiRes<false, true, false> E{nullptr, XB, args.out, nullptr, nullptr, 0.5f};
        pg8::gemm_phase<pg8::EpiRes<false, true, false>, pg8::StaticOrder, false, true>(L + RING_OFF, g, S, E);
    }
#undef IN
#undef SEAM
}

extern "C" void kernel_launch(void* const* d_in, const int* in_sizes, int n_in, void* d_out, int out_size, void* d_ws, size_t ws_size, hipStream_t stream) {
    using namespace K;
    static int grid = 0;
    if (grid == 0) {
        if (n_in != 18 || in_sizes[0] != M * D || out_size != M * D || ws_size < WS::END) { fprintf(stderr, "kernel_launch: unexpected shapes (n_in %d, in0 %d, out %d, ws %zu)\n", n_in, n_in > 0 ? in_sizes[0] : -1, out_size, ws_size); grid = -1; return; }
        int dev = 0, cus = 0, per_cu = 0;
        if (hipGetDevice(&dev) != hipSuccess || hipDeviceGetAttribute(&cus, hipDeviceAttributeMultiprocessorCount, dev) != hipSuccess) { grid = -1; return; }
        if (hipFuncSetAttribute((const void*)mega, hipFuncAttributeMaxDynamicSharedMemorySize, LDS_BYTES) != hipSuccess) { fprintf(stderr, "kernel_launch: hipFuncSetAttribute failed\n"); grid = -1; return; }
        if (hipOccupancyMaxActiveBlocksPerMultiprocessor(&per_cu, (const void*)mega, NWAVES * 64, LDS_BYTES) != hipSuccess || per_cu < 1) { fprintf(stderr, "kernel_launch: occupancy query says %d blocks/CU\n", per_cu); (void)hipGetLastError(); grid = -1; return; }
        grid = cus;
    }
    if (grid < 0) return;
    const float* const* in = (const float* const*)d_in;
    float* out = (float*)d_out; char* ws = (char*)d_ws;
    (void)hipMemsetAsync(ws + WS::CTL, 0, WS::CTL_ZERO_BYTES, stream);
    Args a{};
    for (int i = 0; i < 18; ++i) a.in[i] = in[i];
    a.out = out; a.ws = (unsigned char*)d_ws; a.pad = 0;
    a.ph_lo = 0; a.ph_hi = 10; a.li = 0;
    hipLaunchKernelGGL(mega, dim3(grid), dim3(NWAVES * 64), LDS_BYTES, stream, a);

}
```

```cpp
#include <hip/hip_runtime.h>
#include <hip/hip_bf16.h>
#include <cstdint>
#include <cstdio>
#include <cmath>

namespace K {
constexpr int B = 4, S = 4096, M = B * S, D = 1024, DFF = 2816, H = 8, HD = 64, NIH = 4, IDIM = 64, TOPK = 256, MBLK = 256, NBLK = 16;
constexpr int DIN = 5444;
constexpr float EPS = 1e-6f;
constexpr float LOG2E = 1.4426950408889634f;
constexpr float C2 = 0.125f * LOG2E;
}
typedef unsigned short bf16_t;
typedef unsigned long long u64;

__device__ __forceinline__ bf16_t f2bf(float f) { unsigned u = __float_as_uint(f); return (bf16_t)((u + 0x7fffu + ((u >> 16) & 1u)) >> 16); }
__device__ __forceinline__ int t5_bucket(int d) {
    if (d < 16) return d;
    int large = 16 + (int)(logf((float)d / 16.0f) / 2.0794415416798357f * 16.0f);
    return large < 31 ? large : 31;
}
namespace pg8 {
#define PG8_LAS __attribute__((address_space(3)))
typedef short bf16x8 __attribute__((ext_vector_type(8)));
typedef float f32x4 __attribute__((ext_vector_type(4)));
typedef unsigned u32x4 __attribute__((ext_vector_type(4)));
constexpr int BM = 256, BK = 64, HALF = 128, HTB = HALF * BK * 2  , STAGE_BYTES = 8 * HTB, NXCD = 8, WGM = 8;

__host__ __device__ __forceinline__ int lds_byte(int r, int c) { const int st = (r >> 4) * 2 + (c >> 5), rr = r & 15, cc = c & 31, ob = rr * 64 + cc * 2; return st * 1024 + (ob ^ (((ob >> 9) & 1) << 5)); }
__host__ __device__ __forceinline__ void stage_rc(int b, int& R, int& C) { const int st = b / 1024, sb = b % 1024, swz = sb ^ (((sb >> 9) & 1) << 5); R = (st >> 1) * 16 + swz / 64; C = (st & 1) * 32 + (swz % 64) / 2; }
__host__ __device__ __forceinline__ int perm32(int rho) { const int n = rho >> 4, i = rho & 15; return 8 * (i >> 2) + 4 * n + (i & 3); }

__host__ __device__ __forceinline__ size_t tiled_b_off(int nrow, int k, int nkt) {
    const int ht = nrow >> 7, rb = nrow & 127, c = rb & 31, rho = ((c >> 2) & 1) * 16 + ((c >> 3) << 2) + (c & 3), R = (rb & ~31) + rho;
    return ((size_t)ht * nkt + (k >> 6)) * (size_t)(HALF * BK * 2) + (size_t)lds_byte(R, k & 63);
}
struct Unit { int pm, pn; };
struct Gemm { const bf16_t* A; const bf16_t* Bt; int M, N, K, lda, asplit_pn, asplit_off; };

struct StaticOrder {
    int nM, nN, nwg, G, c;
    __host__ __device__ void init(int M, int N, int G_, int c_) { nM = M / BM; nN = N / BM; nwg = nM * nN; G = G_; c = c_; }
    __host__ __device__ bool next(int i, Unit& u) const {
        const long L = (long)i * G + c; if (L >= nwg) return false;
        int wgid = (int)L; { const int q = nwg / NXCD, r = nwg % NXCD, xcd = wgid % NXCD, off = wgid / NXCD; wgid = (xcd < r ? xcd * (q + 1) : r * (q + 1) + (xcd - r) * q) + off; }
        const int nig = WGM * nN, gid = wgid / nig, fm = gid * WGM, gsz = (nM - fm) < WGM ? (nM - fm) : WGM;
        u.pm = fm + ((wgid % nig) % gsz); u.pn = (wgid % nig) / gsz; return true;
    }
    __device__ __forceinline__ void a_ready(const Unit&) const {}
    __device__ __forceinline__ void done(const Unit&) const {}
};


typedef float f32x2_t __attribute__((ext_vector_type(2))); typedef __bf16 bf16x2_t __attribute__((ext_vector_type(2)));
__device__ __forceinline__ unsigned cvt_pk_bf16(float lo, float hi) { f32x2_t v = {lo, hi}; bf16x2_t b = __builtin_convertvector(v, bf16x2_t); return __builtin_bit_cast(unsigned, b); }
__device__ __forceinline__ float row_rstd(const float* __restrict__ ssq, int row) {
    const f32x4* p = (const f32x4*)(ssq + (size_t)row * 16);
    const f32x4 a = p[0], b = p[1], c = p[2], d = p[3];
    const float s = (((a[0] + a[1]) + (a[2] + a[3])) + ((b[0] + b[1]) + (b[2] + b[3]))) + (((c[0] + c[1]) + (c[2] + c[3])) + ((d[0] + d[1]) + (d[2] + d[3])));
    return 1.0f / sqrtf(s * (1.0f / 1024.0f) + 1e-6f);
}
__device__ __forceinline__ void rstd_stage(const float* __restrict__ ssq, PG8_LAS float* tab, int pm, int wr, int fr, int fq) {
    const int l = fq * 16 + fr;
    tab[l] = row_rstd(ssq, pm * BM + wr * 64 + l);
    tab[64 + l] = row_rstd(ssq, pm * BM + HALF + wr * 64 + l);
    asm volatile("s_waitcnt lgkmcnt(0)" ::: "memory");
}
__device__ __forceinline__ float xrow_sum4(float v) {
    { auto r = __builtin_amdgcn_permlane16_swap(__float_as_uint(v), __float_as_uint(v), false, false); v = __uint_as_float(r[0]) + __uint_as_float(r[1]); }
    { auto r = __builtin_amdgcn_permlane32_swap(__float_as_uint(v), __float_as_uint(v), false, false); v = __uint_as_float(r[0]) + __uint_as_float(r[1]); }
    return v;
}
__device__ __forceinline__ float silu_f(float g) { return g * __builtin_amdgcn_rcpf(1.0f + __builtin_amdgcn_exp2f(-1.4426950408889634f * g)); }
__device__ __forceinline__ float sigmoid_f(float g) { return __builtin_amdgcn_rcpf(1.0f + __builtin_amdgcn_exp2f(-1.4426950408889634f * g)); }

struct EpiGu {
    static constexpr bool PERM = true, AFTER_DRAIN = false, HAS_MID = false;
    bf16_t* act; const float* ssq; PG8_LAS float* rtab;
    __device__ __forceinline__ void operator()(const f32x4 (&acc)[2][2][4][2], const Unit& u, int wr, int wc, int fr, int fq) const {
        asm volatile("" : "+v"(fr), "+v"(fq));
        const int row0 = u.pm * BM + wr * 64 + fr, col0 = u.pn * 128 + wc * 32 + 8 * fq;
        PG8_LAS float* tab = rtab + (wr * 4 + wc) * 128; rstd_stage(ssq, tab, u.pm, wr, fr, fq);
#pragma unroll
        for (int ai = 0; ai < 2; ++ai)
#pragma unroll
            for (int m = 0; m < 4; ++m) {
                const int row = row0 + ai * HALF + m * 16; const float rs = tab[64 * ai + 16 * m + fr];
                float o[8];
#pragma unroll
                for (int n = 0; n < 2; ++n)
#pragma unroll
                    for (int i = 0; i < 4; ++i) o[n * 4 + i] = silu_f(acc[ai][0][m][n][i] * rs) * (acc[ai][1][m][n][i] * rs);
                u32x4 w; w.x = cvt_pk_bf16(o[0], o[1]); w.y = cvt_pk_bf16(o[2], o[3]); w.z = cvt_pk_bf16(o[4], o[5]); w.w = cvt_pk_bf16(o[6], o[7]);
                *(u32x4*)(act + (size_t)row * 2816 + col0) = w;
            }
    }
};
template <bool RIN32, bool OUT32, bool STATS> struct EpiRes {
    static constexpr bool PERM = true, AFTER_DRAIN = false, HAS_MID = false;
    const float* hin32; const bf16_t* hin16; float* hout; bf16_t* hb; float* ssq; float scale;
    __device__ __forceinline__ void operator()(const f32x4 (&acc)[2][2][4][2], const Unit& u, int wr, int wc, int fr, int fq) const {
        asm volatile("" : "+v"(fr), "+v"(fq));
        const int row0 = u.pm * BM + wr * 64 + fr, col0 = u.pn * BM + wc * 32 + 8 * fq;
#pragma unroll
        for (int ai = 0; ai < 2; ++ai)
#pragma unroll
            for (int m = 0; m < 4; ++m) {
                const int row = row0 + ai * HALF + m * 16; float ss = 0.f;
#pragma unroll
                for (int bj = 0; bj < 2; ++bj) {
                    const size_t off = (size_t)row * 1024 + col0 + bj * HALF;
                    f32x4 r0, r1;
                    if (RIN32) { r0 = *(const f32x4*)(hin32 + off); r1 = *(const f32x4*)(hin32 + off + 4); }
                    else { const u32x4 rw = *(const u32x4*)(hin16 + off);
                        r0 = (f32x4){__uint_as_float(rw.x << 16), __uint_as_float(rw.x & 0xffff0000u), __uint_as_float(rw.y << 16), __uint_as_float(rw.y & 0xffff0000u)};
                        r1 = (f32x4){__uint_as_float(rw.z << 16), __uint_as_float(rw.z & 0xffff0000u), __uint_as_float(rw.w << 16), __uint_as_float(rw.w & 0xffff0000u)}; }
                    const f32x4 v0 = r0 + acc[ai][bj][m][0] * scale, v1 = r1 + acc[ai][bj][m][1] * scale;
                    if (OUT32) { *(f32x4*)(hout + off) = v0; *(f32x4*)(hout + off + 4) = v1; }
                    if (STATS) {
                        u32x4 w; w.x = cvt_pk_bf16(v0[0], v0[1]); w.y = cvt_pk_bf16(v0[2], v0[3]); w.z = cvt_pk_bf16(v1[0], v1[1]); w.w = cvt_pk_bf16(v1[2], v1[3]);
                        *(u32x4*)(hb + off) = w;
                        ss += (v0[0] * v0[0] + v0[1] * v0[1]) + (v0[2] * v0[2] + v0[3] * v0[3]) + (v1[0] * v1[0] + v1[1] * v1[1]) + (v1[2] * v1[2] + v1[3] * v1[3]);
                    }
                }
                if (STATS) { ss = xrow_sum4(ss); if (fq == 0) ssq[(size_t)row * 16 + u.pn * 4 + wc] = ss; }
            }
    }
};
struct EpiIn {
    static constexpr bool PERM = true, AFTER_DRAIN = false, HAS_MID = false;
    bf16_t *QO, *KB, *VB, *GATES, *QI, *KI; float* WI; float* KMEAN; const float* ssq; const float* bgate; const float *qn_a, *kn_a, *qn_b, *kn_b; PG8_LAS float* rtab;
    template <int KIND, bool MOBA> __device__ __forceinline__ void qkv(const f32x4 (&acc)[2][2][4][2], const Unit& u, int wr, int wc, int fr, int fq, PG8_LAS float* tab, bf16_t* base, const float* gn) const {
        const int row0 = u.pm * BM + wr * 64 + fr, head = 4 * (u.pn & 1) + wc;
        bf16_t* dst = base + (MOBA ? 512 : 0) + head * 64 + 8 * fq;
        f32x4 gv[2][2];
#pragma unroll
        for (int bj = 0; bj < 2; ++bj)
#pragma unroll
            for (int n = 0; n < 2; ++n) gv[bj][n] = (KIND < 2) ? *(const f32x4*)(gn + 32 * bj + 8 * fq + 4 * n) : (f32x4){1.f, 1.f, 1.f, 1.f};
        constexpr bool km = (KIND == 1) && MOBA;
        f32x4 ks[2][2];
#pragma unroll
        for (int bj = 0; bj < 2; ++bj)
#pragma unroll
            for (int n = 0; n < 2; ++n) ks[bj][n] = (f32x4){0.f, 0.f, 0.f, 0.f};
#pragma unroll
        for (int ai = 0; ai < 2; ++ai)
#pragma unroll
            for (int m = 0; m < 4; ++m) {
                const int row = row0 + ai * HALF + m * 16; const float rs = tab[64 * ai + 16 * m + fr];
                f32x4 v[2][2]; float ss = 0.f;
#pragma unroll
                for (int bj = 0; bj < 2; ++bj)
#pragma unroll
                    for (int n = 0; n < 2; ++n) { v[bj][n] = acc[ai][bj][m][n] * rs; ss += (v[bj][n][0] * v[bj][n][0] + v[bj][n][1] * v[bj][n][1]) + (v[bj][n][2] * v[bj][n][2] + v[bj][n][3] * v[bj][n][3]); }
                if (KIND < 2) {
                    ss = xrow_sum4(ss);
                    float r = 1.0f / sqrtf(ss * (1.0f / 64.0f) + 1e-6f); if (KIND == 0) r *= K::C2;
#pragma unroll
                    for (int bj = 0; bj < 2; ++bj)
#pragma unroll
                        for (int n = 0; n < 2; ++n) v[bj][n] = v[bj][n] * gv[bj][n] * r;
                }
#pragma unroll
                for (int bj = 0; bj < 2; ++bj) {
                    u32x4 w; w.x = cvt_pk_bf16(v[bj][0][0], v[bj][0][1]); w.y = cvt_pk_bf16(v[bj][0][2], v[bj][0][3]); w.z = cvt_pk_bf16(v[bj][1][0], v[bj][1][1]); w.w = cvt_pk_bf16(v[bj][1][2], v[bj][1][3]);
                    *(u32x4*)(dst + (size_t)row * 1024 + 32 * bj) = w;
                    if (km) { ks[bj][0] += v[bj][0]; ks[bj][1] += v[bj][1]; }
                }
                if (km) asm volatile("" : "+v"(ks[0][0]), "+v"(ks[0][1]), "+v"(ks[1][0]), "+v"(ks[1][1]));
                asm volatile("" ::: "memory");
            }
        if (km) {
            float* kd = KMEAN + ((size_t)u.pm * 8 + head) * 64 + 8 * fq;
#pragma unroll
            for (int bj = 0; bj < 2; ++bj)
#pragma unroll
                for (int n = 0; n < 2; ++n)
#pragma unroll
                    for (int i = 0; i < 4; ++i) { float s = ks[bj][n][i]; s += __shfl_xor(s, 1); s += __shfl_xor(s, 2); s += __shfl_xor(s, 4); s += __shfl_xor(s, 8);
                        if (fr == 0) atomicAdd(kd + 32 * bj + 4 * n + i, s); }
        }
    }
    __device__ __forceinline__ void operator()(const f32x4 (&acc)[2][2][4][2], const Unit& u, int wr, int wc, int fr, int fq) const {
        asm volatile("" : "+v"(fr), "+v"(fq));
        const int pn = u.pn, row0 = u.pm * BM + wr * 64 + fr;
        PG8_LAS float* tab = rtab + (wr * 4 + wc) * 128; rstd_stage(ssq, tab, u.pm, wr, fr, fq);
        if (pn < 2) qkv<0, false>(acc, u, wr, wc, fr, fq, tab, QO, qn_a);
        else if (pn < 4) qkv<1, false>(acc, u, wr, wc, fr, fq, tab, KB, kn_a);
        else if (pn < 6) qkv<2, false>(acc, u, wr, wc, fr, fq, tab, VB, nullptr);
        else if (pn < 8) qkv<0, true>(acc, u, wr, wc, fr, fq, tab, QO, qn_b);
        else if (pn < 10) qkv<1, true>(acc, u, wr, wc, fr, fq, tab, KB, kn_b);
        else if (pn < 12) qkv<2, true>(acc, u, wr, wc, fr, fq, tab, VB, nullptr);
        else if (pn == 12) {
#pragma unroll
            for (int ai = 0; ai < 2; ++ai)
#pragma unroll
                for (int m = 0; m < 4; ++m) { const int row = row0 + ai * HALF + m * 16; const float rs = tab[64 * ai + 16 * m + fr];
#pragma unroll
                    for (int bj = 0; bj < 2; ++bj) { const f32x4 a = acc[ai][bj][m][0] * rs, b = acc[ai][bj][m][1] * rs;
                        u32x4 w; w.x = cvt_pk_bf16(a[0], a[1]); w.y = cvt_pk_bf16(a[2], a[3]); w.z = cvt_pk_bf16(b[0], b[1]); w.w = cvt_pk_bf16(b[2], b[3]);
                        *(u32x4*)(QI + (size_t)row * 256 + 128 * bj + 32 * wc + 8 * fq) = w; } }
        } else if (pn == 13) {
#pragma unroll
            for (int ai = 0; ai < 2; ++ai)
#pragma unroll
                for (int m = 0; m < 4; ++m) { const int row = row0 + ai * HALF + m * 16; const float rs = tab[64 * ai + 16 * m + fr];
                    const f32x4 a = acc[ai][0][m][0] * rs, b = acc[ai][0][m][1] * rs;
                    if (wc < 2) { u32x4 w; w.x = cvt_pk_bf16(a[0], a[1]); w.y = cvt_pk_bf16(a[2], a[3]); w.z = cvt_pk_bf16(b[0], b[1]); w.w = cvt_pk_bf16(b[2], b[3]);
                        *(u32x4*)(KI + (size_t)row * 64 + 32 * wc + 8 * fq) = w; }
                    else if (wc == 2 && fq == 0) *(f32x4*)(WI + (size_t)row * 4) = a * 0.5f; }
        } else {
            const int cg0 = 256 * (pn - 14) + 32 * wc + 8 * fq;
            f32x4 bv[2][2];
#pragma unroll
            for (int bj = 0; bj < 2; ++bj)
#pragma unroll
                for (int n = 0; n < 2; ++n) bv[bj][n] = *(const f32x4*)(bgate + cg0 + 128 * bj + 4 * n);
#pragma unroll
            for (int ai = 0; ai < 2; ++ai)
#pragma unroll
                for (int m = 0; m < 4; ++m) { const int row = row0 + ai * HALF + m * 16; const float rs = tab[64 * ai + 16 * m + fr];
#pragma unroll
                    for (int bj = 0; bj < 2; ++bj) { const f32x4 a = acc[ai][bj][m][0] * rs + bv[bj][0], b = acc[ai][bj][m][1] * rs + bv[bj][1];
                        u32x4 w; w.x = cvt_pk_bf16(sigmoid_f(a[0]), sigmoid_f(a[1])); w.y = cvt_pk_bf16(sigmoid_f(a[2]), sigmoid_f(a[3])); w.z = cvt_pk_bf16(sigmoid_f(b[0]), sigmoid_f(b[1])); w.w = cvt_pk_bf16(sigmoid_f(b[2]), sigmoid_f(b[3]));
                        *(u32x4*)(GATES + (size_t)row * 2048 + cg0 + 128 * bj) = w; } }
        }
    }
};
struct EpiBranch2 {
    static constexpr bool PERM = true, AFTER_DRAIN = false, HAS_MID = true;
    const bf16_t* gates; bf16_t* mx;
    __device__ __forceinline__ void mid(f32x4 (&acc)[2][2][4][2], const Unit& u, int wr, int wc, int fr, int fq) const {
        asm volatile("" : "+v"(fr), "+v"(fq));
        const int row0 = u.pm * BM + wr * 64 + fr, col0 = u.pn * BM + wc * 32 + 8 * fq;
#pragma unroll
        for (int ai = 0; ai < 2; ++ai)
#pragma unroll
            for (int m = 0; m < 4; ++m) {
                const int row = row0 + ai * HALF + m * 16;
#pragma unroll
                for (int bj = 0; bj < 2; ++bj) {
                    const size_t off = (size_t)row * 2048 + col0 + bj * HALF;
                    const u32x4 ga = *(const u32x4*)(gates + off), gb = *(const u32x4*)(gates + off + 1024);
                    float r[8];
#pragma unroll
                    for (int x = 0; x < 4; ++x) {
                        r[2 * x] = __uint_as_float(ga[x] << 16) * __builtin_amdgcn_rcpf(__builtin_fmaxf(__uint_as_float(gb[x] << 16), 1e-30f));
                        r[2 * x + 1] = __uint_as_float(ga[x] & 0xffff0000u) * __builtin_amdgcn_rcpf(__builtin_fmaxf(__uint_as_float(gb[x] & 0xffff0000u), 1e-30f)); }
                    acc[ai][bj][m][0] = acc[ai][bj][m][0] * (f32x4){r[0], r[1], r[2], r[3]};
                    acc[ai][bj][m][1] = acc[ai][bj][m][1] * (f32x4){r[4], r[5], r[6], r[7]};
                }
                asm volatile("" ::: "memory");
            }
    }
    __device__ __forceinline__ void operator()(const f32x4 (&acc)[2][2][4][2], const Unit& u, int wr, int wc, int fr, int fq) const {
        asm volatile("" : "+v"(fr), "+v"(fq));
        const int row0 = u.pm * BM + wr * 64 + fr, col0 = u.pn * BM + wc * 32 + 8 * fq;
#pragma unroll
        for (int ai = 0; ai < 2; ++ai)
#pragma unroll
            for (int m = 0; m < 4; ++m) {
                const int row = row0 + ai * HALF + m * 16;
#pragma unroll
                for (int bj = 0; bj < 2; ++bj) {
                    const u32x4 gw = *(const u32x4*)(gates + (size_t)row * 2048 + 1024 + col0 + bj * HALF);
                    const f32x4 a = acc[ai][bj][m][0], b = acc[ai][bj][m][1];
                    u32x4 w;
                    w.x = cvt_pk_bf16(a[0] * __builtin_fmaxf(__uint_as_float(gw.x << 16), 1e-30f), a[1] * __builtin_fmaxf(__uint_as_float(gw.x & 0xffff0000u), 1e-30f));
                    w.y = cvt_pk_bf16(a[2] * __builtin_fmaxf(__uint_as_float(gw.y << 16), 1e-30f), a[3] * __builtin_fmaxf(__uint_as_float(gw.y & 0xffff0000u), 1e-30f));
                    w.z = cvt_pk_bf16(b[0] * __builtin_fmaxf(__uint_as_float(gw.z << 16), 1e-30f), b[1] * __builtin_fmaxf(__uint_as_float(gw.z & 0xffff0000u), 1e-30f));
                    w.w = cvt_pk_bf16(b[2] * __builtin_fmaxf(__uint_as_float(gw.w << 16), 1e-30f), b[3] * __builtin_fmaxf(__uint_as_float(gw.w & 0xffff0000u), 1e-30f));
                    *(u32x4*)(mx + (size_t)row * 1024 + col0 + bj * HALF) = w;
                }
                asm volatile("" ::: "memory");
            }
    }
};
template <class Epi, class Sched, bool ALIGN_EPI = false, bool SP2 = false>
__device__ __forceinline__ void gemm_phase(PG8_LAS unsigned char* lds, const Gemm g, const Sched& S, const Epi& E) {
    int tid_ = threadIdx.x; asm volatile("" : "+v"(tid_));
    const int tid = tid_, wid = __builtin_amdgcn_readfirstlane(tid >> 6), lane = tid & 63, wr = wid >> 2, wc = wid & 3, fr = lane & 15, fq = lane >> 4;
    const int K = g.K, nt = K / BK;
    unsigned voffA[2], voffB[2];
#pragma unroll
    for (int i = 0; i < 2; ++i) { int R, C; stage_rc(tid * 16 + i * 8192, R, C); const int Rb = Epi::PERM ? ((R & ~31) + perm32(R & 31)) : R;
        voffA[i] = (unsigned)(R * g.lda + C) * 2u; voffB[i] = (unsigned)(tid * 16 + i * 8192); (void)Rb; }
    const size_t kstep = (size_t)(BK * 2), kstepB = (size_t)HTB;
    const size_t hstepA = (size_t)HALF * g.lda * 2, hstepB = (size_t)nt * kstepB;
    const size_t tstepA = 2 * hstepA, tstepB = 2 * hstepB;
#define PG8_ABASE(u_) ((const char*)g.A + (size_t)(u_).pm * tstepA + (((u_).pn >= g.asplit_pn) ? (size_t)g.asplit_off : (size_t)0))
    const unsigned ldsw = (unsigned)wid * 1024u;
    const int aoff = lds_byte(wr * 64 + fr, fq * 8), boff = lds_byte(wc * 32 + fr, fq * 8);
#define PG8_SA(b, h) (((b) * 2 + (h)) * HTB)
#define PG8_SB(b, h) ((4 + (b) * 2 + (h)) * HTB)
#define PG8_STAGE(bufoff, gbase, voff) do { _Pragma("unroll") for (int _i = 0; _i < 2; ++_i) \
        __builtin_amdgcn_global_load_lds((const unsigned*)((const char*)(gbase) + (voff)[_i]), (PG8_LAS unsigned*)(lds + (bufoff) + ldsw + _i * 8192), 16, 0, 0); } while (0)
#define PG8_LDA(dst, b, h) do { _Pragma("unroll") for (int m = 0; m < 4; ++m) _Pragma("unroll") for (int k = 0; k < 2; ++k) dst[m][k] = *(const PG8_LAS bf16x8*)(lds + PG8_SA(b, h) + aoff + m * 2048 + k * 1024); } while (0)
#define PG8_LDB(dst, b, h) do { _Pragma("unroll") for (int n = 0; n < 2; ++n) _Pragma("unroll") for (int k = 0; k < 2; ++k) dst[n][k] = *(const PG8_LAS bf16x8*)(lds + PG8_SB(b, h) + boff + n * 2048 + k * 1024); } while (0)
#define PG8_MMA(ai, bj, At, Bt) do { __builtin_amdgcn_s_setprio(1); _Pragma("unroll") for (int m = 0; m < 4; ++m) _Pragma("unroll") for (int n = 0; n < 2; ++n) _Pragma("unroll") for (int k = 0; k < 2; ++k) \
        acc[ai][bj][m][n] = __builtin_amdgcn_mfma_f32_16x16x32_bf16(Bt[n][k], At[m][k], acc[ai][bj][m][n], 0, 0, 0); __builtin_amdgcn_s_setprio(0); } while (0)
#define PG8_WAIT_V(n) asm volatile("s_waitcnt vmcnt(" #n ")" ::: "memory")
#define PG8_WAIT_L(n) asm volatile("s_waitcnt lgkmcnt(" #n ")" ::: "memory")
#define PG8_BAR __builtin_amdgcn_s_barrier()
#define PG8_SCHED __builtin_amdgcn_sched_barrier(0)
    Unit cur, nxt; int ui = 0;
    if (!S.next(0, cur)) return;
    f32x4 acc[2][2][4][2];
#pragma unroll
    for (int a = 0; a < 2; ++a)
#pragma unroll
        for (int b = 0; b < 2; ++b)
#pragma unroll
            for (int m = 0; m < 4; ++m)
#pragma unroll
                for (int n = 0; n < 2; ++n) acc[a][b][m][n] = (f32x4){0.f, 0.f, 0.f, 0.f};
    bf16x8 At[4][2], B0[2][2], B1[2][2];
    const char* cA = PG8_ABASE(cur); const char* cB = (const char*)g.Bt + (size_t)cur.pn * tstepB;
    S.a_ready(cur);
    if constexpr (SP2) {
        PG8_STAGE(PG8_SB(0, 0), cB, voffB); PG8_STAGE(PG8_SB(0, 1), cB + hstepB, voffB); PG8_STAGE(PG8_SA(0, 0), cA, voffA); PG8_STAGE(PG8_SA(0, 1), cA + hstepA, voffA);
        PG8_STAGE(PG8_SB(1, 0), cB + kstepB, voffB); PG8_STAGE(PG8_SA(1, 0), cA + kstep, voffA); PG8_STAGE(PG8_SB(1, 1), cB + hstepB + kstepB, voffB);
        if (wr == 1) PG8_BAR;
        PG8_WAIT_V(8); PG8_BAR;
        PG8_WAIT_V(6); PG8_BAR;
    } else {
        PG8_STAGE(PG8_SB(0, 0), cB, voffB); PG8_STAGE(PG8_SA(0, 0), cA, voffA); PG8_STAGE(PG8_SB(0, 1), cB + hstepB, voffB); PG8_STAGE(PG8_SA(0, 1), cA + hstepA, voffA);
        if (wr == 1) PG8_BAR;
        PG8_WAIT_V(4); PG8_BAR;
        PG8_STAGE(PG8_SB(1, 0), cB + kstepB, voffB); PG8_STAGE(PG8_SA(1, 0), cA + kstep, voffA); PG8_STAGE(PG8_SB(1, 1), cB + hstepB + kstepB, voffB);
        PG8_WAIT_V(6); PG8_BAR;
    }
    for (;;) {
        const bool has_next = S.next(ui + 1, nxt);
        const char* nA = has_next ? PG8_ABASE(nxt) : cA; const char* nB = has_next ? (const char*)g.Bt + (size_t)nxt.pn * tstepB : cB;
        for (int t = 0; t < nt; t += 2) {
            const bool last = (t == nt - 2);
            const char* a1 = cA + (size_t)(t + 1) * kstep;
            const char* a2 = last ? nA : cA + (size_t)(t + 2) * kstep; const char* b2 = last ? nB : cB + (size_t)(t + 2) * kstepB;
            const char* a3 = a2 + kstep; const char* b3 = b2 + kstepB;
            if (last && has_next) S.a_ready(nxt);
            if constexpr (SP2) {
            PG8_LDB(B0, 0, 0); PG8_LDB(B1, 0, 1); PG8_SCHED; PG8_LDA(At, 0, 0); PG8_STAGE(PG8_SA(1, 1), a1 + hstepA, voffA);
            PG8_WAIT_V(8); PG8_WAIT_L(0); PG8_BAR; PG8_MMA(0, 0, At, B0); PG8_MMA(0, 1, At, B1); PG8_BAR; PG8_SCHED;
            PG8_LDA(At, 0, 1); PG8_STAGE(PG8_SB(0, 0), b2, voffB); PG8_STAGE(PG8_SB(0, 1), b2 + hstepB, voffB); PG8_STAGE(PG8_SA(0, 0), a2, voffA);
            PG8_WAIT_V(8); PG8_WAIT_L(0); PG8_BAR; PG8_MMA(1, 0, At, B0); PG8_MMA(1, 1, At, B1); PG8_BAR; PG8_SCHED;
            PG8_LDB(B0, 1, 0); PG8_LDB(B1, 1, 1); PG8_SCHED; PG8_LDA(At, 1, 0); PG8_STAGE(PG8_SA(0, 1), a2 + hstepA, voffA);
            PG8_WAIT_V(8); PG8_WAIT_L(0); PG8_BAR; PG8_MMA(0, 0, At, B0); PG8_MMA(0, 1, At, B1); PG8_BAR; PG8_SCHED;
            PG8_LDA(At, 1, 1); PG8_STAGE(PG8_SB(1, 0), b3, voffB); PG8_STAGE(PG8_SB(1, 1), b3 + hstepB, voffB); PG8_STAGE(PG8_SA(1, 0), a3, voffA);
            PG8_WAIT_V(8); PG8_WAIT_L(0); PG8_BAR; PG8_MMA(1, 0, At, B0); PG8_MMA(1, 1, At, B1); PG8_BAR; PG8_SCHED;
            } else {
            PG8_LDB(B0, 0, 0); PG8_SCHED; PG8_LDA(At, 0, 0); PG8_STAGE(PG8_SA(1, 1), a1 + hstepA, voffA);
            PG8_WAIT_L(8); PG8_BAR; PG8_WAIT_L(0); PG8_MMA(0, 0, At, B0); PG8_BAR; PG8_SCHED;
            PG8_LDB(B1, 0, 1); PG8_STAGE(PG8_SB(0, 0), b2, voffB);
            PG8_BAR; PG8_WAIT_L(0); PG8_MMA(0, 1, At, B1); PG8_BAR;
            PG8_LDA(At, 0, 1); PG8_STAGE(PG8_SA(0, 0), a2, voffA);
            PG8_BAR; PG8_WAIT_L(0); PG8_MMA(1, 0, At, B0); PG8_BAR; PG8_SCHED;
            PG8_STAGE(PG8_SB(0, 1), b2 + hstepB, voffB);
            PG8_WAIT_V(6); PG8_BAR; PG8_MMA(1, 1, At, B1); PG8_BAR;
            PG8_LDB(B0, 1, 0); PG8_SCHED; PG8_LDA(At, 1, 0); PG8_STAGE(PG8_SA(0, 1), a2 + hstepA, voffA);
            PG8_WAIT_L(8); PG8_BAR; PG8_WAIT_L(0); PG8_MMA(0, 0, At, B0); PG8_BAR; PG8_SCHED;
            PG8_LDB(B1, 1, 1); PG8_STAGE(PG8_SB(1, 0), b3, voffB);
            PG8_BAR; PG8_WAIT_L(0); PG8_MMA(0, 1, At, B1); PG8_BAR;
            PG8_LDA(At, 1, 1); PG8_STAGE(PG8_SA(1, 0), a3, voffA);
            PG8_BAR; PG8_WAIT_L(0); PG8_MMA(1, 0, At, B0); PG8_BAR; PG8_SCHED;
            PG8_STAGE(PG8_SB(1, 1), b3 + hstepB, voffB);
            PG8_WAIT_V(6); PG8_BAR; PG8_MMA(1, 1, At, B1); PG8_BAR;
            }
            if constexpr (Epi::HAS_MID) { if (t + 2 == nt / 2) E.mid(acc, cur, wr, wc, fr, fq); }
        }
        if constexpr (ALIGN_EPI) { if (wr == 0) PG8_BAR; }
        if constexpr (!Epi::AFTER_DRAIN) { E(acc, cur, wr, wc, fr, fq); S.done(cur); }
        if (!has_next) break;
#pragma unroll
        for (int a = 0; a < 2; ++a)
#pragma unroll
            for (int b = 0; b < 2; ++b)
#pragma unroll
                for (int m = 0; m < 4; ++m)
#pragma unroll
                    for (int n = 0; n < 2; ++n) acc[a][b][m][n] = (f32x4){0.f, 0.f, 0.f, 0.f};
        cur = nxt; cA = nA; cB = nB; ++ui;
        if constexpr (ALIGN_EPI) { if (wr == 1) PG8_BAR; }
    }
    PG8_WAIT_V(0);
    if constexpr (!ALIGN_EPI) { if (wr == 0) PG8_BAR; }
    PG8_BAR;
    if constexpr (Epi::AFTER_DRAIN) { E.fused(acc, cur, wr, wc, fr, fq, lds, wid, lane); S.done(cur); }
#undef PG8_ABASE
#undef PG8_SA
#undef PG8_SB
#undef PG8_STAGE
#undef PG8_LDA
#undef PG8_LDB
#undef PG8_MMA
#undef PG8_WAIT_V
#undef PG8_WAIT_L
#undef PG8_BAR
#undef PG8_SCHED
}
}

constexpr int NWAVES = 8;
namespace WS {
constexpr size_t MiB = 1u << 20;
constexpr size_t CTL = 0, CTL_ZERO_BYTES = 1 * MiB;
constexpr size_t KMEAN = 512 * 1024;
constexpr size_t SSQ = 1 * MiB;
constexpr size_t GU1 = 2 * MiB, DN1 = 13 * MiB, WIN = 19 * MiB, WB = 30 * MiB, WO = 32 * MiB, GU2 = 36 * MiB, DN2 = 47 * MiB;
constexpr size_t XB = 53 * MiB;
constexpr size_t QO = 85 * MiB, KB = 117 * MiB, VB = 149 * MiB;
constexpr size_t GATES = 181 * MiB;
constexpr size_t QI = 245 * MiB, KI = 253 * MiB, WI = 255 * MiB, BMASK = 255 * MiB + 256 * 1024;
constexpr size_t ACT = 85 * MiB;
constexpr size_t GM = 117 * MiB;
constexpr size_t END = 256 * MiB;
}
constexpr int CW_BAR = 4096;
constexpr int RING_OFF = 0, RING_BYTES = 131072;
constexpr int LDSCTL_OFF = RING_BYTES, MISC_OFF = LDSCTL_OFF + 320;
constexpr int RTAB_OFF = LDSCTL_OFF + 1024;
constexpr int LDS_BYTES = 147456;

#define GAS __attribute__((address_space(1)))
#define LAS __attribute__((address_space(3)))
typedef unsigned v4u __attribute__((ext_vector_type(4)));
typedef float f32x4 __attribute__((ext_vector_type(4)));
typedef GAS unsigned gu32;
#define LDS_WAIT() asm volatile("s_waitcnt lgkmcnt(0)" ::: "memory")
#define VM_WAIT() asm volatile("s_waitcnt vmcnt(0)" ::: "memory")
__device__ __forceinline__ unsigned pk2(float lo, float hi) { return (unsigned)f2bf(lo) | ((unsigned)f2bf(hi) << 16); }
#define XB_TMO      128
#define XB_XCNT(j)  (256  + 64 * (j))
#define XB_XSUB(j)  (1280 + 64 * (j))
#define XB_XGEN(j)  (2304 + 64 * (j))
#define XB_TOP      3328
#define XB_TOPGEN   3392
#define XCD_BAR_WORDS 3456
#define XB_SPIN_CAP (1u << 18)

__device__ __forceinline__ unsigned xb_ld(unsigned* p)              { return __hip_atomic_load(p, __ATOMIC_RELAXED, __HIP_MEMORY_SCOPE_AGENT); }
__device__ __forceinline__ unsigned xb_add(unsigned* p, unsigned v) { return __hip_atomic_fetch_add(p, v, __ATOMIC_RELAXED, __HIP_MEMORY_SCOPE_AGENT); }
__device__ __forceinline__ unsigned xb_xcc_id() { return (unsigned)__builtin_amdgcn_s_getreg((3 << 11) | 20) & 0xFu; }
#define XB_SPIN(cond, bar) do { unsigned _sp = 0; while (cond) { __builtin_amdgcn_s_sleep(1); \
    if ((++_sp & 255u) == 0u) { if (xb_ld(&(bar)[XB_TMO])) break; if (_sp > XB_SPIN_CAP) { atomicAdd(&(bar)[XB_TMO], 1u); break; } } } } while (0)

struct XcdBarrier {
    unsigned* bar; unsigned x;
    volatile LAS unsigned* st;
};

__device__ __forceinline__ XcdBarrier xcd_barrier_post(unsigned* bar, volatile LAS unsigned* st) {
    XcdBarrier b; b.bar = bar; b.x = xb_xcc_id(); b.st = st;
    if (threadIdx.x == 0) (void)xb_add(&bar[XB_XCNT(b.x)], 1u);
    return b;
}
__device__ __forceinline__ void xcd_barrier_complete(unsigned* bar, unsigned x, unsigned& nloc, unsigned& nx) {
    const unsigned G = gridDim.x * gridDim.y * gridDim.z;
    unsigned sum, cnt, mine, sp = 0u;
    for (;;) {
        sum = 0u; cnt = 0u; mine = 0u;
#pragma unroll
        for (unsigned j = 0; j < 16; ++j) { const unsigned c = xb_ld(&bar[XB_XCNT(j)]); sum += c; cnt += (c > 0u) ? 1u : 0u; mine = (j == x) ? c : mine; }
        if (sum == G) break;
        __builtin_amdgcn_s_sleep(1);
        if ((++sp & 255u) == 0u) { if (xb_ld(&bar[XB_TMO])) break; if (sp > XB_SPIN_CAP) { atomicAdd(&bar[XB_TMO], 1u); break; } }
    }
    nloc = mine > 0u ? mine : 1u; nx = cnt > 0u ? cnt : 1u;
}

__device__ __forceinline__ void xcd_barrier(const XcdBarrier& b) {
    asm volatile("s_waitcnt vmcnt(0)" ::: "memory");
    __syncthreads();
    if (threadIdx.x == 0) {
        unsigned* bar = b.bar;
        __builtin_amdgcn_s_waitcnt(0);
        unsigned nloc = b.st[0], nx = b.st[1];
        if (nloc == 0u) { xcd_barrier_complete(bar, b.x, nloc, nx); b.st[0] = nloc; b.st[1] = nx; }
        const unsigned old = xb_add(&bar[XB_XSUB(b.x)], 1u);
        const unsigned gen = old / nloc;
        if (old + 1u == (gen + 1u) * nloc) {
            __builtin_amdgcn_fence(__ATOMIC_RELEASE, "agent");
            asm volatile("s_waitcnt vmcnt(0)" ::: "memory");
            const unsigned og = xb_add(&bar[XB_TOP], 1u);
            const unsigned tg = og / nx;
            if (og + 1u == (tg + 1u) * nx) xb_add(&bar[XB_TOPGEN], 1u);
            else XB_SPIN(xb_ld(&bar[XB_TOPGEN]) == tg, bar);
            __builtin_amdgcn_fence(__ATOMIC_ACQUIRE, "agent");
            xb_add(&bar[XB_XGEN(b.x)], 1u);
            asm volatile("s_waitcnt vmcnt(0)" ::: "memory");
        } else {
            XB_SPIN(xb_ld(&bar[XB_XGEN(b.x)]) == gen, bar);
            __builtin_amdgcn_fence(__ATOMIC_ACQUIRE, "agent");
            asm volatile("s_waitcnt vmcnt(0)" ::: "memory");
        }
    }
    __syncthreads();
}

namespace tk {
typedef short bf16x8 __attribute__((ext_vector_type(8)));
typedef float f32x4 __attribute__((ext_vector_type(4)));
constexpr int HIST_OFF = 0, HSTR = 1025;
constexpr int TCNT_OFF = 65664;
constexpr int MROW = 260;
constexpr int MSTG_OFF = TCNT_OFF + 16384;
constexpr int TBASE_OFF = MSTG_OFF + 8448;
constexpr int RES_OFF = TBASE_OFF + 8192;
constexpr int QST_OFF = 102400;
#define TK_BAR() do { asm volatile("s_waitcnt lgkmcnt(0)" ::: "memory"); __builtin_amdgcn_s_barrier(); asm volatile("" ::: "memory"); } while (0)

__device__ __forceinline__ unsigned wave_prefix_incl(unsigned x) {
    x += (unsigned)__builtin_amdgcn_update_dpp(0, (int)x, 0x111, 0xf, 0xf, true);
    x += (unsigned)__builtin_amdgcn_update_dpp(0, (int)x, 0x112, 0xf, 0xf, true);
    x += (unsigned)__builtin_amdgcn_update_dpp(0, (int)x, 0x114, 0xf, 0xf, true);
    x += (unsigned)__builtin_amdgcn_update_dpp(0, (int)x, 0x118, 0xf, 0xf, true);
    x += (unsigned)__builtin_amdgcn_update_dpp(0, (int)x, 0x142, 0xa, 0xf, false);
    x += (unsigned)__builtin_amdgcn_update_dpp(0, (int)x, 0x143, 0xc, 0xf, false);
    return x;
}
template <int NW>
__device__ __forceinline__ void scan_query(const LAS unsigned* hq, LAS unsigned* res, int qq, unsigned r, int lane) {
    const int wbase = (63 - lane) * NW;
    unsigned ws = 0;
#pragma unroll
    for (int x = 0; x < NW; ++x) ws += hq[wbase + x];
    const unsigned tot = (ws & 0xffffu) + (ws >> 16);
    const unsigned incl = wave_prefix_incl(tot);
    const unsigned above = incl - tot;
    const unsigned long long bal = __ballot(above < r && incl >= r);
    const int Ls = __builtin_amdgcn_readfirstlane((int)__builtin_ctzll(bal));
    const unsigned r2 = r - (unsigned)__builtin_amdgcn_readlane((int)above, Ls);
    const int word = (63 - Ls) * NW + (NW - 1 - (lane & (NW - 1)));
    const unsigned w = hq[word], hi = w >> 16, lo = w & 0xffffu, t2 = hi + lo;
    unsigned inc2 = t2;
    inc2 += (unsigned)__builtin_amdgcn_update_dpp(0, (int)inc2, 0x111, 0xf, 0xf, true);
    inc2 += (unsigned)__builtin_amdgcn_update_dpp(0, (int)inc2, 0x112, 0xf, 0xf, true);
    inc2 += (unsigned)__builtin_amdgcn_update_dpp(0, (int)inc2, 0x114, 0xf, 0xf, true);
    inc2 += (unsigned)__builtin_amdgcn_update_dpp(0, (int)inc2, 0x118, 0xf, 0xf, true);
    const unsigned ab2 = inc2 - t2;
    if (lane < NW && ab2 < r2 && inc2 >= r2) {
        const bool uh = ab2 + hi >= r2;
        res[qq] = (unsigned)word * 2u + (uh ? 1u : 0u); res[16 + qq] = r2 - (uh ? ab2 : ab2 + hi); res[32 + qq] = uh ? hi : lo;
    }
}

__device__ __forceinline__ v4u tk_load_q(const bf16_t* __restrict__ QI, int b, int tq0, int lane, int wave) {
    const size_t row = (size_t)b * K::S + tq0 + (lane & 15);
    return *(const v4u*)(QI + row * 256 + (wave >> 1) * 64 + (wave & 1) * 32 + (lane >> 4) * 8);
}
__device__ __forceinline__ void tk_store_q(LAS unsigned char* L, v4u v, int lane, int wave) { *(LAS v4u*)(L + QST_OFF + wave * 1024 + lane * 16) = v; }
#define TK_S(F_, i_, rest_) if (8 * (i_) <= jw) { F_.template operator()<i_>(); rest_ }
#define TK_SLOTS(F_) do { TK_S(F_, 0, TK_S(F_, 1, TK_S(F_, 2, TK_S(F_, 3, TK_S(F_, 4, TK_S(F_, 5, TK_S(F_, 6, TK_S(F_, 7, TK_S(F_, 8, TK_S(F_, 9, TK_S(F_, 10, TK_S(F_, 11, TK_S(F_, 12, TK_S(F_, 13, TK_S(F_, 14, TK_S(F_, 15, TK_S(F_, 16, TK_S(F_, 17, TK_S(F_, 18, TK_S(F_, 19, TK_S(F_, 20, TK_S(F_, 21, TK_S(F_, 22, TK_S(F_, 23, TK_S(F_, 24, TK_S(F_, 25, TK_S(F_, 26, TK_S(F_, 27, TK_S(F_, 28, TK_S(F_, 29, TK_S(F_, 30, TK_S(F_, 31, )))))))))))))))))))))))))))))))) } while (0)
template <int PV>
__device__ __forceinline__ void topk_group(LAS unsigned char* L, const bf16_t* __restrict__ QI, const bf16_t* __restrict__ KI, const float* __restrict__ WI, u64* __restrict__ MASK,
                                           int b, int tq0, int nb, int ntq0, int tid, int lane, int wave, int nrep = 1) {
    using namespace K;
    const int q = lane & 15, g = lane >> 4;
    const int row0 = b * S + tq0, jmax = tq0 >> 4, jw = jmax - wave;
    LAS unsigned* hist = (LAS unsigned*)(L + HIST_OFF); LAS unsigned* tcnt = (LAS unsigned*)(L + TCNT_OFF);
    LAS unsigned short* mstg = (LAS unsigned short*)(L + MSTG_OFF); LAS unsigned short* tbase = (LAS unsigned short*)(L + TBASE_OFF); LAS unsigned* res = (LAS unsigned*)(L + RES_OFF);
    for (int i = tid; i < (16384 + 16 * MROW * 2) / 4; i += NWAVES * 64) tcnt[i] = 0u;
    if (tq0 < TOPK) {
        if (ntq0 >= TOPK) tk_store_q(L, tk_load_q(QI, nb, ntq0, lane, wave), lane, wave);
        TK_BAR();
        for (int idx = tid; idx < 16 * (jmax + 1); idx += NWAVES * 64) { const int qq = idx & 15, j = idx >> 4; mstg[qq * MROW + j] = (unsigned short)((j < jmax) ? 0xffffu : ((2u << qq) - 1u)); }
    } else {
        v4u key[32];
        for (int i = tid; i < 16 * HSTR / 4; i += NWAVES * 64) ((LAS v4u*)hist)[i] = (v4u){0u, 0u, 0u, 0u};
        TK_BAR();
        bf16x8 qf[4][2];
#pragma unroll
        for (int h = 0; h < 4; ++h)
#pragma unroll
            for (int ks = 0; ks < 2; ++ks) qf[h][ks] = *(const LAS bf16x8*)(L + QST_OFF + (h * 2 + ks) * 1024 + lane * 16);
        const f32x4 wv = *(const f32x4*)(WI + (size_t)(row0 + q) * 4);
        bf16x8 kk[2][2];
#define TK_LOADK(i_) do { const int o_ = 8 * (i_), jc_ = wave + (o_ < jw ? o_ : jw); const bf16_t* kp_ = KI + (size_t)(b * S + jc_ * 16 + q) * 64 + g * 8; \
            kk[(i_) % 2][0] = *(const bf16x8*)kp_; kk[(i_) % 2][1] = *(const bf16x8*)(kp_ + 32); } while (0)
        TK_LOADK(0);
        unsigned zb = 0x80000000u + ((4095u - (((unsigned)wave << 4) + 4u * (unsigned)g)) << 10); asm volatile("" : "+v"(zb));
        const int lim = q - 4 * g;
        auto sslot = [&]<int i>() __attribute__((always_inline)) {
            if (i < 31) TK_LOADK(i + 1);
            asm volatile("" ::: "memory");
            f32x4 sc = {0.f, 0.f, 0.f, 0.f};
#pragma unroll
            for (int h = 0; h < 4; ++h) {
                f32x4 d = __builtin_amdgcn_mfma_f32_16x16x32_bf16(kk[i % 2][0], qf[h][0], (f32x4){0.f, 0.f, 0.f, 0.f}, 0, 0, 0);
                d = __builtin_amdgcn_mfma_f32_16x16x32_bf16(kk[i % 2][1], qf[h][1], d, 0, 0, 0);
#pragma unroll
                for (int r = 0; r < 4; ++r) { const int di = __float_as_int(d[r]); sc[r] = __builtin_fmaf(wv[h], __int_as_float(di > 0 ? di : 0), sc[r]); }
                if (h == 1) __builtin_amdgcn_sched_barrier(0);
            }
            const int tl = (8 * i == jw) ? lim : 3;
#pragma unroll
            for (int r = 0; r < 4; ++r) {
                const unsigned u = __float_as_uint(sc[r]);
                unsigned k = ((int)u < 0) ? ~u : u + 0x80400000u;
                k = (u == 0u) ? zb - ((128u * i + r) << 10) : k;
                if (PV == 21) k = u ^ ((unsigned)((int)u >> 31) | 0x80000000u);
                k = (r > tl) ? 0u : k;
                key[i][r] = k;
                if (PV != 3) { const unsigned bin = k >> 21; __hip_atomic_fetch_add(hist + q * HSTR + (bin >> 1), k ? (1u << (16 * (bin & 1u))) : 0u, __ATOMIC_RELAXED, __HIP_MEMORY_SCOPE_WORKGROUP); }
            }
            __builtin_amdgcn_sched_barrier(0);
        };
        TK_SLOTS(sslot);
#undef TK_LOADK
        if (PV == 1 || PV == 3) {
            unsigned xs = 0u;
#pragma unroll
            for (int i = 0; i < 32; ++i) { if (8 * i <= jw) {
#pragma unroll
                for (int r = 0; r < 4; ++r) xs ^= key[i][r]; } }
            TK_BAR();
            if (ntq0 >= TOPK) tk_store_q(L, tk_load_q(QI, nb, ntq0, lane, wave), lane, wave);
            res[64 + lane] = xs;
        } else {
        int ln = lane; asm volatile("" : "+v"(ln));
        LAS unsigned* const tc_q = tcnt + (ln & 15) * 256 + wave; LAS unsigned short* const tb_q = tbase + (ln & 15) * 256 + wave;
        LAS unsigned* const ms32_q = (LAS unsigned*)mstg + (((ln & 15) * MROW + wave) >> 1); const unsigned sh_q = 16u * (wave & 1) + 4u * (unsigned)(ln >> 4);
        unsigned prefix = 0u, rnk = (unsigned)TOPK, cnt_eq = 0u; v4u qnext = {0u, 0u, 0u, 0u};
        const LAS unsigned* const hq_c = hist + q * HSTR; LAS unsigned* const hq = (LAS unsigned*)hq_c;
        LAS unsigned* const lcnt = (LAS unsigned*)(L + TBASE_OFF);
        LAS unsigned* const lstk = (LAS unsigned*)(L + TBASE_OFF + 64), * const lsti = lstk + 256;
        constexpr unsigned LCAP = 16;
        if (tid < 16) lcnt[tid] = 0u;
        auto radix = [&]<int pass>() __attribute__((always_inline)) {
            constexpr int pshift = (pass == 1) ? 21 : 10;
            if (pass != 0) {
                TK_BAR();
                if (pass == 1 && ntq0 >= TOPK) qnext = tk_load_q(QI, nb, ntq0, lane, wave);
                for (int i = tid; i < 16 * HSTR / 4; i += NWAVES * 64) ((LAS v4u*)hist)[i] = (v4u){0u, 0u, 0u, 0u};
                TK_BAR();
                auto pslot = [&]<int i>() __attribute__((always_inline)) {
#pragma unroll
                    for (int r = 0; r < 4; ++r) {
                        const unsigned k = key[i][r];
                        const unsigned word = (pass == 1) ? ((k >> 11) & 1023u) : ((k >> 1) & 511u);
                        const unsigned inc = (k & ((pass == 1) ? 0x400u : 1u)) ? 0x10000u : 1u;
                        __hip_atomic_fetch_add(hq + word, ((k >> pshift) == prefix) ? inc : 0u, __ATOMIC_RELAXED, __HIP_MEMORY_SCOPE_WORKGROUP);
                    }
                };
                TK_SLOTS(pslot);
            }
            TK_BAR();
            { const unsigned r0 = (unsigned)__builtin_amdgcn_readlane((int)rnk, 2 * wave), r1 = (unsigned)__builtin_amdgcn_readlane((int)rnk, 2 * wave + 1);
              if (pass < 2) { scan_query<16>(hist + (2 * wave) * HSTR, res, 2 * wave, r0, lane); scan_query<16>(hist + (2 * wave + 1) * HSTR, res, 2 * wave + 1, r1, lane); }
              else { scan_query<8>(hist + (2 * wave) * HSTR, res, 2 * wave, r0, lane); scan_query<8>(hist + (2 * wave + 1) * HSTR, res, 2 * wave + 1, r1, lane); } }
            TK_BAR();
            prefix = (prefix << ((pass == 2) ? 10 : 11)) | res[q]; rnk = res[16 + q]; cnt_eq = res[32 + q];
        };
        radix.template operator()<0>();
        if (PV != 5) radix.template operator()<1>();
        const bool amb = rnk != cnt_eq;
        const bool fb = (PV == 20 || PV == 21) ? true : (PV == 5 || PV == 6) ? false : __any(amb && cnt_eq > LCAP);
        if (!fb) {
            const unsigned base = prefix << 10, Tsel = amb ? base + 1024u : base, clim = amb ? 1024u : 0u;
            LAS unsigned short* const ms16_q = mstg + (ln & 15) * MROW + wave; const unsigned sh4 = 4u * (unsigned)(ln >> 4);
            unsigned idx0 = ((unsigned)wave << 4) + 4u * (unsigned)(ln >> 4);
            asm volatile("" : "+v"(idx0));
            auto fslot = [&]<int i>() __attribute__((always_inline)) {
                unsigned nib = 0;
#pragma unroll
                for (int r = 3; r >= 0; --r) nib = nib + nib + ((key[i][r] >= Tsel) ? 1u : 0u);
                unsigned m16 = nib << sh4;
                { auto sw = __builtin_amdgcn_permlane16_swap(m16, m16, false, false); m16 = sw[0] | sw[1]; }
                { auto sw = __builtin_amdgcn_permlane32_swap(m16, m16, false, false); m16 = sw[0] | sw[1]; }
                if (ln < 16) ms16_q[8 * i] = (unsigned short)m16;
                const unsigned t0 = key[i][0] - base, t1 = key[i][1] - base, t2 = key[i][2] - base, t3 = key[i][3] - base;
                const unsigned ta = t0 < t1 ? t0 : t1, tb = t2 < t3 ? t2 : t3, tm = ta < tb ? ta : tb;
                if (__builtin_expect(tm < clim, 0)) {
#pragma unroll
                    for (int r = 0; r < 4; ++r) {
                        const unsigned k = key[i][r];
                        if (k - base < clim) { const unsigned pos = __hip_atomic_fetch_add(lcnt + q, 1u, __ATOMIC_RELAXED, __HIP_MEMORY_SCOPE_WORKGROUP);
                            lstk[q * LCAP + (pos & (LCAP - 1))] = k; lsti[q * LCAP + (pos & (LCAP - 1))] = ~(idx0 + 128u * i + r); }
                    }
                }
            };
            TK_SLOTS(fslot);
            TK_BAR();
#pragma unroll
            for (int s2 = 0; s2 < 2; ++s2) {
                const int qq = 2 * wave + s2;
                const unsigned n = (unsigned)__builtin_amdgcn_readfirstlane((int)lcnt[qq]), rq = (unsigned)__builtin_amdgcn_readlane((int)rnk, qq);
                const unsigned mk = lstk[qq * LCAP + (lane & (LCAP - 1))], mi = lsti[qq * LCAP + (lane & (LCAP - 1))];
                unsigned better = 0;
                for (unsigned e = 0; e < n; ++e) { const unsigned ek = lstk[qq * LCAP + e], ei = lsti[qq * LCAP + e]; better += (ek > mk || (ek == mk && ei > mi)) ? 1u : 0u; }
                if ((unsigned)lane < n && better < rq) {
                    const unsigned idx = ~mi, j = idx >> 4;
                    __hip_atomic_fetch_or((LAS unsigned*)mstg + ((qq * MROW + j) >> 1), 1u << (16u * (j & 1u) + (idx & 15u)), __ATOMIC_RELAXED, __HIP_MEMORY_SCOPE_WORKGROUP);
                }
            }
        } else {
        radix.template operator()<2>();
        const unsigned T = prefix, need = rnk;
        const bool slow = __any(need != cnt_eq);
        if (slow) {
#pragma unroll
            for (int i = 0; i < 32; ++i) {
                if (8 * i <= jw) {
                    unsigned c = 0;
#pragma unroll
                    for (int r = 0; r < 4; ++r) c += (key[i][r] == T) ? 1u : 0u;
                    if (c) __hip_atomic_fetch_add(tc_q + 8 * i, c << (8 * g), __ATOMIC_RELAXED, __HIP_MEMORY_SCOPE_WORKGROUP);
                }
            }
            TK_BAR();
#pragma unroll
            for (int s = 0; s < 2; ++s) {
                const int qq = 2 * wave + s; unsigned tt[4], tot = 0;
#pragma unroll
                for (int x = 0; x < 4; ++x) { const unsigned e = tcnt[qq * 256 + lane * 4 + x]; tt[x] = (e & 255u) + ((e >> 8) & 255u) + ((e >> 16) & 255u) + (e >> 24); tot += tt[x]; }
                const unsigned incl = wave_prefix_incl(tot);
                unsigned base = incl - tot;
#pragma unroll
                for (int x = 0; x < 4; ++x) { tbase[qq * 256 + lane * 4 + x] = (unsigned short)base; base += tt[x]; }
            }
            TK_BAR();
        }
#pragma unroll
        for (int i = 0; i < 32; ++i) {
            if (8 * i > jw) continue;
            unsigned nib = 0;
            if (!slow) {
#pragma unroll
                for (int r = 0; r < 4; ++r) nib |= (key[i][r] >= T) ? (1u << r) : 0u;
            } else {
                const unsigned e = tc_q[8 * i]; unsigned rank = tb_q[8 * i];
                if (g > 0) rank += e & 255u; if (g > 1) rank += (e >> 8) & 255u; if (g > 2) rank += (e >> 16) & 255u;
#pragma unroll
                for (int r = 0; r < 4; ++r) { const unsigned k = key[i][r];
                    if (k > T) nib |= 1u << r; else if (k == T && k != 0u) { if (rank < need) nib |= 1u << r; ++rank; } }
            }
            __hip_atomic_fetch_or(ms32_q + 4 * i, nib << sh_q, __ATOMIC_RELAXED, __HIP_MEMORY_SCOPE_WORKGROUP);
        }
        }
        if (ntq0 >= TOPK) tk_store_q(L, qnext, lane, wave);
        }
    }
    TK_BAR();
    if (PV == 0 || PV == 5 || PV == 6 || PV == 13 || PV == 14 || PV == 20 || PV == 21)
    for (int idx = tid; idx < 1024; idx += NWAVES * 64) {
        const int qq = idx & 15, t64 = idx >> 4;
        const u64 wd = *(const LAS u64*)(mstg + qq * MROW + t64 * 4);
        MASK[((size_t)b * 64 + t64) * S + tq0 + qq] = wd;
    }
    TK_BAR();
}

__device__ __forceinline__ void gating_block(LAS unsigned char* L, const bf16_t* __restrict__ QO, const float* __restrict__ KMEAN, unsigned* __restrict__ BMASK, int blk64, int tid) {
    using namespace K;
    const int row0 = 64 * blk64, b = row0 / S;
    LAS float* km = (LAS float*)L;
    const int r = tid >> 3, h = tid & 7, row = row0 + r, t = row % S, own = t / MBLK;
    uint4 qraw[8];
#pragma unroll
    for (int x = 0; x < 8; ++x) qraw[x] = *(const uint4*)(QO + (size_t)row * 1024 + 512 + h * 64 + 8 * x);
    for (int i = tid; i < 16 * 8 * 64; i += NWAVES * 64) { const int n = i >> 9, hh = (i >> 6) & 7, d = i & 63; km[(n * 8 + hh) * 68 + d] = KMEAN[((size_t)(b * 16 + n) * 8 + hh) * 64 + d]; }
    TK_BAR();
    float qv[64];
#pragma unroll
    for (int x = 0; x < 8; ++x) { const uint4 u = qraw[x];
        qv[8 * x + 0] = __uint_as_float(u.x << 16); qv[8 * x + 1] = __uint_as_float(u.x & 0xffff0000u); qv[8 * x + 2] = __uint_as_float(u.y << 16); qv[8 * x + 3] = __uint_as_float(u.y & 0xffff0000u);
        qv[8 * x + 4] = __uint_as_float(u.z << 16); qv[8 * x + 5] = __uint_as_float(u.z & 0xffff0000u); qv[8 * x + 6] = __uint_as_float(u.w << 16); qv[8 * x + 7] = __uint_as_float(u.w & 0xffff0000u); }
    float b0 = -INFINITY, b1 = -INFINITY, b2 = -INFINITY; int i0 = -1, i1 = -1, i2 = -1;
    for (int n = 0; n < own; ++n) {
        const LAS f32x4* kp = (const LAS f32x4*)(km + (n * 8 + h) * 68); float gs = 0.f;
#pragma unroll
        for (int d4 = 0; d4 < 16; ++d4) { const f32x4 kv = kp[d4]; gs = __builtin_fmaf(qv[4 * d4], kv[0], gs); gs = __builtin_fmaf(qv[4 * d4 + 1], kv[1], gs); gs = __builtin_fmaf(qv[4 * d4 + 2], kv[2], gs); gs = __builtin_fmaf(qv[4 * d4 + 3], kv[3], gs); }
        if (gs > b0) { b2 = b1; i2 = i1; b1 = b0; i1 = i0; b0 = gs; i0 = n; }
        else if (gs > b1) { b2 = b1; i2 = i1; b1 = gs; i1 = n; }
        else if (gs > b2) { b2 = gs; i2 = n; }
    }
    unsigned bm = 1u << own;
    if (i0 >= 0) bm |= 1u << i0; if (i1 >= 0) bm |= 1u << i1; if (i2 >= 0) bm |= 1u << i2;
    BMASK[(size_t)row * 8 + h] = bm;
    TK_BAR();
}
#undef TK_BAR
}
namespace attn_body {
using bf16=__hip_bfloat16;
using bf16x8=__attribute__((ext_vector_type(8)))short;
using s16x4=__attribute__((ext_vector_type(4)))short;
using f32x16=__attribute__((ext_vector_type(16)))float;
using u32x4=__attribute__((ext_vector_type(4)))unsigned;
constexpr int BATCH=4,NHEAD=16,SEQ=4096,D=64,DM=NHEAD*D;
constexpr int NW=8,QBLK=32,QB=QBLK*NW,KVBLK=64,NQB=SEQ/QB;
constexpr int ATTN_PITCH=DM, ATTN_UNIT_ROWS=QB;
__device__ __forceinline__ int crow(int r,int hi){return (r&3)+8*(r>>2)+4*hi;}
#define SBAR() __builtin_amdgcn_sched_barrier(0)
typedef __attribute__((address_space(3))) const float* lds_fptr;
__device__ __forceinline__ void addbias(f32x16&p0,f32x16&p1,int jb6,int qrel,int hi,lds_fptr bt){
  const lds_fptr b=bt+(qrel+128-64*jb6-4*hi+197);
  #pragma unroll
  for(int r=0;r<16;++r){const int c=(r&3)+8*(r>>2); p0[r]+=b[59-c]; p1[r]+=b[27-c];}
}

constexpr int BT_N=640;
constexpr int NSLOT=3, SLOTB=8192;
#define EXM(p,w) do{ if(MOBA) asm volatile("v_sub_f32 %0, %0, %2\n\tv_exp_f32 %0, %0\n\tv_add_co_u32 %1, vcc, %1, %1\n\tv_cndmask_b32 %0, 0, %0, vcc":"+v"(p),"+v"(w):"v"(mhat):"vcc"); \
  else asm volatile("v_exp_f32 %0, %0\n\tv_add_co_u32 %1, vcc, %1, %1\n\tv_cndmask_b32 %0, 0, %0, vcc":"+v"(p),"+v"(w)::"vcc"); }while(0)
#define EXS(p,mh) asm volatile("v_sub_f32 %0, %0, %1\n\tv_exp_f32 %0, %0\n\ts_nop 0":"+v"(p):"v"(mh))
#define EXM16(P,w) do{ EXM(P[15],w);EXM(P[14],w);EXM(P[13],w);EXM(P[12],w); w<<=4; EXM(P[11],w);EXM(P[10],w);EXM(P[9],w);EXM(P[8],w); w<<=4; EXM(P[7],w);EXM(P[6],w);EXM(P[5],w);EXM(P[4],w); w<<=4; EXM(P[3],w);EXM(P[2],w);EXM(P[1],w);EXM(P[0],w); }while(0)
__device__ __forceinline__ int cbit(int r){return (r&3)+8*(r>>2);}
constexpr int LDS_K=0, LDS_V=NSLOT*SLOTB, LDS_WS=2*NSLOT*SLOTB, LDS_OST=LDS_WS+NW*64*4, LDS_BT=LDS_OST+NW*4096, LDS_BYTES=LDS_BT+BT_N*4;
constexpr float C2=0.125f*1.4426950408889634f;
__device__ __forceinline__ void glds16(const void*gsrc,unsigned lds_dst){unsigned keep;
  asm volatile("s_mov_b32 %0, m0\n\ts_mov_b32 m0, %2\n\ts_nop 0\n\tglobal_load_lds_dwordx4 %1, off\n\ts_mov_b32 m0, %0":"=&s"(keep):"v"(gsrc),"s"(lds_dst):"memory");}
__device__ __forceinline__ float max3f(float a,float b,float c){float r;asm("v_max3_f32 %0, %1, %2, %3":"=v"(r):"v"(a),"v"(b),"v"(c));return r;}
__device__ __forceinline__ float max2f(float a,float b){float r;asm("v_max_f32_e32 %0, %1, %2":"=v"(r):"v"(a),"v"(b));return r;}
__device__ __forceinline__ float fadd_s(float a,float b){float r;asm("v_add_f32_e32 %0, %1, %2":"=v"(r):"v"(a),"v"(b));return r;}
__device__ __forceinline__ float fsub_s(float a,float b){float r;asm("v_sub_f32_e32 %0, %1, %2":"=v"(r):"v"(a),"v"(b));return r;}
typedef float f32x2_t __attribute__((ext_vector_type(2))); typedef __bf16 bf16x2_t __attribute__((ext_vector_type(2)));
__device__ __forceinline__ unsigned cvtpk_s(float lo,float hi){f32x2_t v={lo,hi};bf16x2_t b=__builtin_convertvector(v,bf16x2_t);return __builtin_bit_cast(unsigned,b);}
#define WAIT_BAR(N) asm volatile("s_waitcnt vmcnt(" #N ") lgkmcnt(0)\n\ts_barrier":::"memory")

__device__ __forceinline__ void qkt(f32x16&p0,f32x16&p1,const char*Kslot,const bf16x8*qr,const f32x16&c0,int r32,int hi){
  const char*kb=Kslot+hi*1024+r32*16;
  #pragma unroll
  for(int d0=0;d0<4;++d0){
    const bf16x8 b0=*reinterpret_cast<const bf16x8*>(kb+d0*2048);
    const bf16x8 b1=*reinterpret_cast<const bf16x8*>(kb+d0*2048+512);
    if(d0==0){p0=__builtin_amdgcn_mfma_f32_32x32x16_bf16(b0,qr[0],c0,0,0,0);p1=__builtin_amdgcn_mfma_f32_32x32x16_bf16(b1,qr[0],c0,0,0,0);}
    else{p0=__builtin_amdgcn_mfma_f32_32x32x16_bf16(b0,qr[d0],p0,0,0,0);p1=__builtin_amdgcn_mfma_f32_32x32x16_bf16(b1,qr[d0],p1,0,0,0);}}
}
typedef __attribute__((address_space(3))) const char* lds_cptr;
typedef short v4i16_t __attribute__((ext_vector_type(4)));
__device__ __forceinline__ void kload8(bf16x8*kf,lds_cptr kp){
  kf[0]=*(const __attribute__((address_space(3))) bf16x8*)(kp);      kf[1]=*(const __attribute__((address_space(3))) bf16x8*)(kp+512);
  kf[2]=*(const __attribute__((address_space(3))) bf16x8*)(kp+2048); kf[3]=*(const __attribute__((address_space(3))) bf16x8*)(kp+2560);
  kf[4]=*(const __attribute__((address_space(3))) bf16x8*)(kp+4096); kf[5]=*(const __attribute__((address_space(3))) bf16x8*)(kp+4608);
  kf[6]=*(const __attribute__((address_space(3))) bf16x8*)(kp+6144); kf[7]=*(const __attribute__((address_space(3))) bf16x8*)(kp+6656);
}
__device__ __forceinline__ void kload2(bf16x8*kf,lds_cptr kp,int j){ kf[2*j]=*(const __attribute__((address_space(3))) bf16x8*)(kp+j*2048); kf[2*j+1]=*(const __attribute__((address_space(3))) bf16x8*)(kp+j*2048+512); }
__device__ __forceinline__ s16x4 vtr(lds_cptr p){ return __builtin_bit_cast(s16x4,__builtin_amdgcn_ds_read_tr16_b64_v4i16((__attribute__((address_space(3))) v4i16_t*)p)); }
__device__ __forceinline__ float rowmax(const f32x16&p0,const f32x16&p1){
  float a=max3f(p0[0],p0[1],p1[0]),b=max3f(p0[2],p0[3],p1[1]);a=max3f(a,p1[2],p1[3]);
  #pragma unroll
  for(int r=4;r<16;r+=4){a=max3f(a,p0[r],p0[r+1]);b=max3f(b,p0[r+2],p0[r+3]);a=max3f(a,p1[r],p1[r+1]);b=max3f(b,p1[r+2],p1[r+3]);}
  const float m=max2f(a,b);
  auto rr=__builtin_amdgcn_permlane32_swap(__float_as_uint(m),__float_as_uint(m),false,false);
  return max2f(__uint_as_float(rr[0]),__uint_as_float(rr[1]));
}
__device__ __forceinline__ void pv(f32x16*o,int vb,bf16x8 pa0,bf16x8 pa1,bf16x8 pa2,bf16x8 pa3){
  #pragma unroll
  for(int d0=0;d0<2;++d0){s16x4 lo[4],hi[4];
    #pragma unroll
    for(int ks=0;ks<4;++ks){
      asm volatile("ds_read_b64_tr_b16 %0,%1 offset:%c2":"=&v"(lo[ks]):"v"(vb),"i"(d0*4096+ks*1024):"memory");
      asm volatile("ds_read_b64_tr_b16 %0,%1 offset:%c2":"=&v"(hi[ks]):"v"(vb),"i"(d0*4096+ks*1024+512):"memory");}
    asm volatile("s_waitcnt lgkmcnt(0)":::"memory");SBAR();
    #define PK(k) (bf16x8){lo[k][0],lo[k][1],lo[k][2],lo[k][3],hi[k][0],hi[k][1],hi[k][2],hi[k][3]}
    o[d0]=__builtin_amdgcn_mfma_f32_32x32x16_bf16(pa0,PK(0),o[d0],0,0,0);
    o[d0]=__builtin_amdgcn_mfma_f32_32x32x16_bf16(pa1,PK(1),o[d0],0,0,0);
    o[d0]=__builtin_amdgcn_mfma_f32_32x32x16_bf16(pa2,PK(2),o[d0],0,0,0);
    o[d0]=__builtin_amdgcn_mfma_f32_32x32x16_bf16(pa3,PK(3),o[d0],0,0,0);
    #undef PK
  }
}

#ifndef ATTN_STORE16
#define ATTN_STORE16(p,v) (*(u32x4*)(p)=(v))
#endif
template<int THRL,bool MOBA> __device__ __forceinline__ void attn_unit(int b,int h,int qb,const bf16*Q,const bf16*__restrict__ K,const bf16*__restrict__ V,bf16*O,const unsigned long long*__restrict__ MASKW,const unsigned*__restrict__ BMASK,const float*__restrict__ relb,const float*__restrict__ gq,const float*__restrict__ gk,char*shm){
  int tid_=threadIdx.x; asm volatile("":"+v"(tid_)); const int tid=tid_,lane=tid&63,r32=lane&31,hi=lane>>5; const int wid=__builtin_amdgcn_readfirstlane(tid>>6);
  const long rowbase=(long)b*SEQ; const int q0=qb*QB;
  const bf16*Qw=Q+(rowbase+q0+wid*QBLK)*DM+h*D;
  const bf16*Kh=K+rowbase*DM+h*D,*Vh=V+rowbase*DM+h*D;
  const unsigned lds0=(unsigned)(uintptr_t)shm;
  float*wsf=(float*)(shm+LDS_WS)+wid*64;
  const bf16*ksrc=Kh+(long)lane*DM+wid*8;
  const bf16*vsrc=Vh+(long)(16*(wid&3)+(lane>>2))*DM+(wid>>2)*32+(lane&3)*8;
  const unsigned kdst=lds0+LDS_K+wid*1024, vdst=lds0+LDS_V+wid*1024;
  #define DMA_K(t,slot) glds16(ksrc+(long)(t)*KVBLK*DM,(unsigned)__builtin_amdgcn_readfirstlane(kdst+(slot)))
  #define DMA_V(t,slot) glds16(vsrc+(long)(t)*KVBLK*DM,(unsigned)__builtin_amdgcn_readfirstlane(vdst+(slot)))
  const int vb0=(int)(lds0+LDS_V)+((lane>>4)&1)*32+(lane&3)*8+(4*hi+((lane&15)>>2))*64;
  const char*Kbase=shm+LDS_K; bf16x8 kf[8];
  const lds_cptr shm3=(lds_cptr)shm; const lds_cptr kp0=shm3+LDS_K+hi*1024+r32*16; const lds_cptr vp0=shm3+LDS_V+((lane>>4)&1)*32+(lane&3)*8+(4*hi+((lane&15)>>2))*64;
  const int NT=(q0+QB)/KVBLK;
  const int qrel=wid*QBLK+r32; constexpr bool moba=MOBA;
  const lds_fptr bt=(lds_fptr)(shm3+LDS_BT);
  unsigned bm=0u;
  const unsigned mvoff=(unsigned)(q0+qrel)*8u; unsigned long long mraw=0ull; unsigned mlo=0u,mhi=0u;
  #define MLOAD(tt) do{ if(!moba&&(tt)<NT){ const unsigned long long*mb_=MASKW+((size_t)(b*64+(tt)))*SEQ; \
      asm volatile("s_nop 4\n\tglobal_load_dwordx2 %0, %1, %2":"=v"(mraw):"v"(mvoff),"s"(mb_):"memory"); } }while(0)
  #define MSET(tt) do{ if(!moba){ asm volatile("":"+v"(mraw)); mlo=(unsigned)mraw<<(4-4*hi); mhi=(unsigned)(mraw>>32)<<(4-4*hi); } \
      else{ unsigned wl=((bm>>((tt)>>2))&1u)?0xffffffffu:0u, wh=wl; const int jb_=(tt)-(NT-4); \
        if(jb_>=0){ const int n=qrel-64*jb_, n2=n-32; wl&=(n<0)?0u:((n>=31)?0xffffffffu:((2u<<n)-1u)); wh&=(n2<0)?0u:((n2>=31)?0xffffffffu:((2u<<n2)-1u)); } \
        mlo=wl<<(4-4*hi); mhi=wh<<(4-4*hi); } }while(0)
  MLOAD(0);
  DMA_K(0,0);DMA_V(0,0);DMA_K(1,SLOTB);
  bf16x8 qr[4];
  #pragma unroll
  for(int d0=0;d0<4;++d0)qr[d0]=*reinterpret_cast<const bf16x8*>(&Qw[(long)r32*DM+d0*16+hi*8]);
  if(moba)bm=BMASK[(size_t)(rowbase+q0+qrel)*8+(h-8)];
  { __attribute__((address_space(3))) float*btw=(__attribute__((address_space(3))) float*)(shm3+LDS_BT); const float b31=relb[31*16+h];
    for(int i=tid;i<BT_N;i+=NW*64){ const int d=i-256; btw[i]=(d>=0&&d<=112)?(relb[t5_bucket(d)*16+h]-b31)*1.4426950408889634f:0.f; } }
  constexpr float mhat=16.0f; float l_reg=0.f;f32x16 o[2];o[0]=f32x16{};o[1]=f32x16{}; f32x16 negm=f32x16{}; (void)gq; (void)gk;
  if(!MOBA){ _Pragma("unroll") for(int r=0;r<16;++r)negm[r]=-mhat; asm volatile("":"+v"(negm)); }
  #define CMASK(P0,P1,t) do{int jb_=(t)-(NT-6); if(jb_>=0)addbias(P0,P1,jb_,qrel,hi,bt);}while(0)
  #define START(P0,P1) do{ EXM16(P0,mlo); }while(0)
  #define RESC() do{}while(0)
  f32x16 pA0,pA1,pB0,pB1;
  int sl_prev=0,sl_cur=0,sl_next=SLOTB;
  #define ROT() do{sl_prev=sl_cur;sl_cur=sl_next;sl_next=(sl_next==(NSLOT-1)*SLOTB)?0:sl_next+SLOTB;}while(0)
  DMA_K(2,2*SLOTB);
  WAIT_BAR(3);
  MSET(0); MLOAD(1);
  qkt(pA0,pA1,Kbase,qr,(MOBA?f32x16{}:negm),r32,hi);asm volatile("s_nop 15\n\ts_nop 7":"+v"(pA0),"+v"(pA1));CMASK(pA0,pA1,0);
  START(pA0,pA1);
  EXM16(pA1,mhi);
  WAIT_BAR(0);
  MSET(1);
  DMA_K(3,0);DMA_V(1,SLOTB);
  ROT();
  kload8(kf,kp0+sl_cur);
  WAIT_BAR(2);
  s16x4 vlo[8],vhi[8]; u32x4 pw0,pw1,pw2,pw3;
  #define PKW(P,B) cvtpk_s(P[B],P[B+1])
  #define PAF(k) __builtin_bit_cast(bf16x8,pw##k)
  #define VFR(i) (bf16x8){vlo[i][0],vlo[i][1],vlo[i][2],vlo[i][3],vhi[i][0],vhi[i][1],vhi[i][2],vhi[i][3]}
  #define PIN(x) asm volatile("":"+v"(x))
  #define MX3(a,b,c) __builtin_fmaxf(__builtin_fmaxf((a),(b)),(c))
  #define GAPA(MF,A0,A1,A2,A3,W0,W1,PW) do{ MF; sacc+=A0; sacc+=A1; sacc+=A2; sacc+=A3; PIN(sacc); W0; W1; PIN(PW); SBAR(); }while(0)
  #define EX(v) __builtin_amdgcn_exp2f(v)
  #define GAPB(MF,X,B,MW,CH) do{ MF; if(CH){ EXS(X[B+3],mh_); EXS(X[B+2],mh_); EXS(X[B+1],mh_); EXS(X[B],mh_); } else { EXM(X[B+3],MW); EXM(X[B+2],MW); EXM(X[B+1],MW); EXM(X[B],MW); if((B)>0)MW<<=4; } PIN(X); SBAR(); }while(0)
  #define VRD(i) do{ vlo[i]=vtr(vp_+(((i)>>2)*4096+((i)&3)*1024)); vhi[i]=vtr(vp_+(((i)>>2)*4096+((i)&3)*1024+512)); }while(0)
  #define KRD(G,j) do{ if(G){ kload2(kf,kp0+sl_next,j); SBAR(); } }while(0)
  #define STEP(C0,C1,P0,P1,t,GK,GV,GL,CH) do{ SBAR(); \
    const lds_cptr vp_=vp0+sl_prev; \
    VRD(0); SBAR(); float sacc=(P0[0]+P0[1]); \
    GAPA(C0=__builtin_amdgcn_mfma_f32_32x32x16_bf16(kf[0],qr[0],(MOBA?f32x16{}:negm),0,0,0), P0[2],P0[3],P0[4],P0[5],     pw0[0]=PKW(P0,0), pw0[1]=PKW(P0,2), pw0); \
    VRD(4); SBAR(); GAPA(C1=__builtin_amdgcn_mfma_f32_32x32x16_bf16(kf[1],qr[0],(MOBA?f32x16{}:negm),0,0,0), P0[6],P0[7],P0[8],P0[9],     pw0[2]=PKW(P0,4), pw0[3]=PKW(P0,6), pw0); \
    VRD(1); SBAR(); GAPA(C0=__builtin_amdgcn_mfma_f32_32x32x16_bf16(kf[2],qr[1],C0,0,0,0),   P0[10],P0[11],P0[12],P0[13], pw1[0]=PKW(P0,8), pw1[1]=PKW(P0,10), pw1); \
    VRD(5); SBAR(); GAPA(C1=__builtin_amdgcn_mfma_f32_32x32x16_bf16(kf[3],qr[1],C1,0,0,0),   P0[14],P0[15],P1[0],P1[1],   pw1[2]=PKW(P0,12),pw1[3]=PKW(P0,14), pw1); \
    VRD(2); SBAR(); GAPA(C0=__builtin_amdgcn_mfma_f32_32x32x16_bf16(kf[4],qr[2],C0,0,0,0),   P1[2],P1[3],P1[4],P1[5],     pw2[0]=PKW(P1,0), pw2[1]=PKW(P1,2), pw2); \
    VRD(6); SBAR(); GAPA(C1=__builtin_amdgcn_mfma_f32_32x32x16_bf16(kf[5],qr[2],C1,0,0,0),   P1[6],P1[7],P1[8],P1[9],     pw2[2]=PKW(P1,4), pw2[3]=PKW(P1,6), pw2); \
    VRD(3); SBAR(); GAPA(C0=__builtin_amdgcn_mfma_f32_32x32x16_bf16(kf[6],qr[3],C0,0,0,0),   P1[10],P1[11],P1[12],P1[13], pw3[0]=PKW(P1,8), pw3[1]=PKW(P1,10), pw3); \
    VRD(7); SBAR(); GAPA(C1=__builtin_amdgcn_mfma_f32_32x32x16_bf16(kf[7],qr[3],C1,0,0,0),   P1[14],P1[15],0.f,0.f,       pw3[2]=PKW(P1,12),pw3[3]=PKW(P1,14), pw3); \
    l_reg+=sacc; \
    if(GK){DMA_K((t)+3,sl_cur);} if(GV){DMA_V((t)+1,sl_next);} \
    CMASK(C0,C1,t); \
    const float mh_=(CH)?((mlo!=0u)?mhat:__builtin_inff()):0.f; (void)mh_; \
    SBAR(); \
    GAPB(o[0]=__builtin_amdgcn_mfma_f32_32x32x16_bf16(PAF(0),VFR(0),o[0],0,0,0), C0,12,mlo,CH); \
    GAPB(o[1]=__builtin_amdgcn_mfma_f32_32x32x16_bf16(PAF(0),VFR(4),o[1],0,0,0), C0,8,mlo,CH); \
    KRD(GL,0); GAPB(o[0]=__builtin_amdgcn_mfma_f32_32x32x16_bf16(PAF(1),VFR(1),o[0],0,0,0), C0,4,mlo,CH); \
    KRD(GL,1); GAPB(o[1]=__builtin_amdgcn_mfma_f32_32x32x16_bf16(PAF(1),VFR(5),o[1],0,0,0), C0,0,mlo,CH); \
    KRD(GL,2); GAPB(o[0]=__builtin_amdgcn_mfma_f32_32x32x16_bf16(PAF(2),VFR(2),o[0],0,0,0), C1,12,mhi,CH); \
    KRD(GL,3); GAPB(o[1]=__builtin_amdgcn_mfma_f32_32x32x16_bf16(PAF(2),VFR(6),o[1],0,0,0), C1,8,mhi,CH); \
    GAPB(o[0]=__builtin_amdgcn_mfma_f32_32x32x16_bf16(PAF(3),VFR(3),o[0],0,0,0), C1,4,mhi,CH); \
    GAPB(o[1]=__builtin_amdgcn_mfma_f32_32x32x16_bf16(PAF(3),VFR(7),o[1],0,0,0), C1,0,mhi,CH); \
    }while(0)
  int t=1;
  #undef CMASK
  #define CMASK(P0,P1,t) do{}while(0)
  for(;t+7<NT;t+=2){
    MLOAD(t+1); STEP(pB0,pB1,pA0,pA1,t,true,true,true,MOBA);     WAIT_BAR(2); RESC(); ROT(); MSET(t+1);
    MLOAD(t+2); STEP(pA0,pA1,pB0,pB1,t+1,true,true,true,MOBA);   WAIT_BAR(2); RESC(); ROT(); MSET(t+2);
  }
  #undef CMASK
  #define CMASK(P0,P1,t) do{int jb_=(t)-(NT-6); if(jb_>=0)addbias(P0,P1,jb_,qrel,hi,bt);}while(0)
  #define ENDW(tt) do{ if((tt)+3<NT){WAIT_BAR(2);} else if((tt)+2<NT){WAIT_BAR(1);} else {WAIT_BAR(0);} }while(0)
  for(;t+1<NT;t+=2){
    MLOAD(t+1); STEP(pB0,pB1,pA0,pA1,t,(t+3<NT),(t+1<NT),(t+1<NT),0);       ENDW(t);   RESC(); ROT(); MSET(t+1);
    MLOAD(t+2); STEP(pA0,pA1,pB0,pB1,t+1,(t+4<NT),(t+2<NT),(t+2<NT),0);     ENDW(t+1); RESC(); ROT(); MSET(t+2);
  }
  STEP(pB0,pB1,pA0,pA1,NT-1,false,false,false,0); RESC();
  { float sacc=pB0[0]+pB0[1]; _Pragma("unroll") for(int r=2;r<16;++r)sacc+=pB0[r]; _Pragma("unroll") for(int r=0;r<16;++r)sacc+=pB1[r]; l_reg+=sacc;
    pw0=(u32x4){PKW(pB0,0),PKW(pB0,2),PKW(pB0,4),PKW(pB0,6)};pw1=(u32x4){PKW(pB0,8),PKW(pB0,10),PKW(pB0,12),PKW(pB0,14)};pw2=(u32x4){PKW(pB1,0),PKW(pB1,2),PKW(pB1,4),PKW(pB1,6)};pw3=(u32x4){PKW(pB1,8),PKW(pB1,10),PKW(pB1,12),PKW(pB1,14)};
    SBAR(); pv(o,vb0+sl_cur,PAF(0),PAF(1),PAF(2),PAF(3)); }
  #undef PKW
  #undef PAF
  #undef VFR
  #undef PIN
  #undef MX3
  #undef GAPA
  #undef GAPB
  #undef EX
  #undef VRD
  #undef KRD
  #undef STEP
  #undef ENDW
  {auto rr=__builtin_amdgcn_permlane32_swap(__float_as_uint(l_reg),__float_as_uint(l_reg),false,false);l_reg=__uint_as_float(rr[0])+__uint_as_float(rr[1]);}
  if(hi==0)wsf[32+r32]=l_reg;asm volatile("s_waitcnt lgkmcnt(0)":::"memory");
  float rli[16];
  #pragma unroll
  for(int r=0;r<16;++r)rli[r]=__builtin_amdgcn_rcpf(wsf[32+crow(r,hi)]);
  bf16*Ow=O+(rowbase+q0+wid*QBLK)*DM+h*D;
  { bf16*stg=(bf16*)(shm+LDS_OST)+wid*2048;
    #pragma unroll
    for(int r=0;r<16;++r){const int orow=crow(r,hi);
      #pragma unroll
      for(int d0=0;d0<2;++d0)stg[orow*64+d0*32+r32]=__float2bfloat16(o[d0][r]*rli[r]);}
    asm volatile("s_waitcnt lgkmcnt(0)":::"memory");
    #pragma unroll
    for(int i=0;i<4;++i){const int row=i*8+(lane>>3),ch=lane&7; const u32x4 v=*(const u32x4*)(stg+row*64+ch*8); ATTN_STORE16(Ow+(long)row*DM+ch*8,v);} }
  asm volatile("s_waitcnt lgkmcnt(0)\n\ts_barrier":::"memory");
  #undef MLOAD
  #undef MSET
  #undef DMA_K
  #undef DMA_V
  #undef CMASK
  #undef START
  #undef RESC
  #undef ROT
}
constexpr int ATTN_LDS_BYTES=LDS_BYTES;
#undef SBAR
#undef WAIT_BAR
}

__device__ __forceinline__ float wave_sum_fast(float v) {
#define WS_DPP_(ctrl, rm, bc) v += __int_as_float(__builtin_amdgcn_update_dpp(0, __float_as_int(v), ctrl, rm, 0xf, bc))
    WS_DPP_(0x111, 0xf, true); WS_DPP_(0x112, 0xf, true); WS_DPP_(0x114, 0xf, true); WS_DPP_(0x118, 0xf, true); WS_DPP_(0x142, 0xa, false); WS_DPP_(0x143, 0xc, false);
#undef WS_DPP_
    return __int_as_float(__builtin_amdgcn_readlane(__float_as_int(v), 63));
}
__device__ __forceinline__ int rowmap(int map, int n) {
    if (map == 1) { const int up = n >= 2816; const int j = up ? n - 2816 : n; return 256 * (j >> 7) + (up ? 128 : 0) + (j & 127); }
    if (map == 2) {
        if (n < 3072) { const int part = n >> 9, cc = n & 511, tl = cc >> 8, wc = (cc & 255) >> 6, d = cc & 63; return 256 * (2 * part + tl) + 128 * (d >> 5) + 32 * wc + (d & 31); }
        if (n < 3328) return 256 * 12 + (n - 3072);
        if (n < 3396) return 256 * 13 + (n - 3328);
        if (n < 5444) return 256 * 14 + (n - 3396);
        return 256 * 13 + 68 + (n - 5444);
    }
    if (map == 3) return 1024 + n;
    return n;
}
__device__ __forceinline__ void conv_item(const float* __restrict__ W, int ldw, int N, int Nw, const float* __restrict__ gain, bf16_t* WT, int ldk, int map, int koff, LAS float* scr, int item, int lane) {
    const int nblk = (Nw + 31) >> 5, kb = item / nblk, nb = item % nblk, k0 = 64 * kb, n0 = 32 * nb;
    const int rr = lane >> 3, c4 = (lane & 7) * 4; const bool inb = (n0 + c4) < N;
    f32x4 v[8];
#pragma unroll
    for (int i = 0; i < 8; ++i) v[i] = inb ? *(const GAS f32x4*)(W + (size_t)(k0 + 8 * i + rr) * ldw + n0 + c4) : (f32x4){0.f, 0.f, 0.f, 0.f};
#pragma unroll
    for (int i = 0; i < 8; ++i) { const int kk = 8 * i + rr; const float gk = gain ? gain[k0 + kk] : 1.0f; LAS float* s = scr + kk * 33 + c4;
        s[0] = v[i][0] * gk; s[1] = v[i][1] * gk; s[2] = v[i][2] * gk; s[3] = v[i][3] * gk; }
    LDS_WAIT(); asm volatile("" ::: "memory");
    const int c = lane & 7;
#pragma unroll
    for (int j = 0; j < 4; ++j) { const int n = (lane >> 3) + 8 * j; const LAS float* s = scr + (8 * c) * 33 + n;
        if (n0 + n < Nw) {
            v4u o; o.x = pk2(s[0 * 33], s[1 * 33]); o.y = pk2(s[2 * 33], s[3 * 33]); o.z = pk2(s[4 * 33], s[5 * 33]); o.w = pk2(s[6 * 33], s[7 * 33]);
            *(GAS v4u*)((unsigned char*)WT + pg8::tiled_b_off(rowmap(map, n0 + n), koff + k0 + 8 * c, ldk >> 6)) = o; } }
    LDS_WAIT(); asm volatile("" ::: "memory");
}

struct Args { const float* in[18]; float* out; unsigned char* ws; int ph_lo, ph_hi, li, pad; };
enum { I_X = 0, I_N1, I_GU1, I_DN1, I_NM, I_WIN, I_BG, I_QNA, I_KNA, I_QNB, I_KNB, I_WBA, I_WBB, I_WO, I_N2, I_GU2, I_DN2, I_RB };

__device__ __forceinline__ void p0_prologue(const Args& args, LAS unsigned char* L, int gw, int NGW, int lane, int gtid, int ngt) {
    using namespace K;
    unsigned char* ws = args.ws;
    LAS float* scr = (LAS float*)(L + RING_OFF + (gw & 7) * 16384);
    constexpr int I0 = 16 * 176, I1 = 44 * 32, I2 = 16 * 176, I3 = 8 * 32, I4 = 8 * 32, I5 = 16 * 32;
    constexpr int NITEMS = 2 * I0 + 2 * I1 + I2 + I3 + I4 + I5;
    for (int it = gw; it < NITEMS; it += NGW) {
        int r = it;
        if (r < I0) { conv_item(args.in[I_GU1], 2 * DFF, 2 * DFF, 2 * DFF, args.in[I_N1], (bf16_t*)(ws + WS::GU1), D, 1, 0, scr, r, lane); continue; } r -= I0;
        if (r < I0) { conv_item(args.in[I_GU2], 2 * DFF, 2 * DFF, 2 * DFF, args.in[I_N2], (bf16_t*)(ws + WS::GU2), D, 1, 0, scr, r, lane); continue; } r -= I0;
        if (r < I1) { conv_item(args.in[I_DN1], D, D, D, nullptr, (bf16_t*)(ws + WS::DN1), DFF, 0, 0, scr, r, lane); continue; } r -= I1;
        if (r < I1) { conv_item(args.in[I_DN2], D, D, D, nullptr, (bf16_t*)(ws + WS::DN2), DFF, 0, 0, scr, r, lane); continue; } r -= I1;
        if (r < I2) { conv_item(args.in[I_WIN], DIN, DIN, 5632, args.in[I_NM], (bf16_t*)(ws + WS::WIN), D, 2, 0, scr, r, lane); continue; } r -= I2;
        if (r < I3) { conv_item(args.in[I_WBA], D, D, D, nullptr, (bf16_t*)(ws + WS::WB), D, 0, 0, scr, r, lane); continue; } r -= I3;
        if (r < I4) { conv_item(args.in[I_WBB], D, D, D, nullptr, (bf16_t*)(ws + WS::WB), D, 0, 512, scr, r, lane); continue; } r -= I4;
        conv_item(args.in[I_WO], D, D, D, nullptr, (bf16_t*)(ws + WS::WO), D, 0, 0, scr, r, lane);
    }
    const float* x = args.in[I_X];
    for (int m0 = 2 * gw; m0 < M; m0 += 2 * NGW) {
        f32x4 v[2][4]; float s[2] = {0.f, 0.f};
#pragma unroll
        for (int rr = 0; rr < 2; ++rr) { const GAS f32x4* xr = (const GAS f32x4*)(x + (size_t)(m0 + rr) * D) + lane;
#pragma unroll
            for (int j = 0; j < 4; ++j) v[rr][j] = xr[64 * j]; }
#pragma unroll
        for (int rr = 0; rr < 2; ++rr) {
#pragma unroll
            for (int j = 0; j < 4; ++j) s[rr] += (v[rr][j][0] * v[rr][j][0] + v[rr][j][1] * v[rr][j][1]) + (v[rr][j][2] * v[rr][j][2] + v[rr][j][3] * v[rr][j][3]);
            s[rr] = wave_sum_fast(s[rr]);
            GAS unsigned long long* o8 = (GAS unsigned long long*)(ws + WS::XB + (size_t)(m0 + rr) * D * 2) + lane;
#pragma unroll
            for (int j = 0; j < 4; ++j) o8[64 * j] = (unsigned long long)pk2(v[rr][j][0], v[rr][j][1]) | ((unsigned long long)pk2(v[rr][j][2], v[rr][j][3]) << 32);
            if (lane < 4) { f32x4 q = {lane == 0 ? s[rr] : 0.f, 0.f, 0.f, 0.f}; *((GAS f32x4*)(ws + WS::SSQ + (size_t)(m0 + rr) * 64) + lane) = q; }
        }
    }
}

__global__ void __launch_bounds__(NWAVES * 64, 2) mega(Args args) {
    extern __shared__ __attribute__((aligned(16))) unsigned char lds[];
    using namespace K;
    LAS unsigned char* L = (LAS unsigned char*)lds;
    volatile LAS unsigned* MISC = (volatile LAS unsigned*)(L + MISC_OFF);
    const int tid = threadIdx.x, lane = tid & 63, wave = __builtin_amdgcn_readfirstlane(tid >> 6);
    const int G = gridDim.x, bx = blockIdx.x; const int vcu = (G % 8 == 0) ? (bx % 8) * (G / 8) + bx / 8 : bx;
    unsigned char* ws = args.ws;
    for (int u = tid; u < (LDS_BYTES - LDSCTL_OFF) / 4; u += NWAVES * 64) ((LAS unsigned*)(L + LDSCTL_OFF))[u] = 0u;
    __syncthreads();
    XcdBarrier bar = xcd_barrier_post((unsigned*)(ws + WS::CTL) + CW_BAR + args.li * XCD_BAR_WORDS, MISC + 8);
    const int lo = args.ph_lo, hi = args.ph_hi;
#define IN(k) (lo <= (k) && (k) < hi)
#define SEAM(k) do { if (IN(k) && IN((k) + 1)) xcd_barrier(bar); } while (0)
    bf16_t* XB = (bf16_t*)(ws + WS::XB); bf16_t* ACT = (bf16_t*)(ws + WS::ACT); float* SSQ = (float*)(ws + WS::SSQ);

    if (IN(0)) { p0_prologue(args, L, vcu * NWAVES + wave, G * NWAVES, lane, bx * (NWAVES * 64) + tid, G * NWAVES * 64); SEAM(0); }
    if (IN(1)) {
        pg8::Gemm g{XB, (const bf16_t*)(ws + WS::GU1), M, 2 * DFF, D, D, 1 << 30, 0}; pg8::StaticOrder S; S.init(M, 2 * DFF, G, bx);
        pg8::EpiGu E{ACT, SSQ, (LAS float*)(L + RTAB_OFF)};
        pg8::gemm_phase<pg8::EpiGu, pg8::StaticOrder, true, true>(L + RING_OFF, g, S, E);
        SEAM(1);
    }
    if (IN(2)) {
        pg8::Gemm g{ACT, (const bf16_t*)(ws + WS::DN1), M, D, DFF, DFF, 1 << 30, 0}; pg8::StaticOrder S; S.init(M, D, G, bx);
        pg8::EpiRes<true, false, true> E{args.in[I_X], nullptr, nullptr, XB, SSQ, 0.5f};
        pg8::gemm_phase<pg8::EpiRes<true, false, true>, pg8::StaticOrder, false, true>(L + RING_OFF, g, S, E);
        SEAM(2);
    }
    if (IN(3)) {
        pg8::Gemm g{XB, (const bf16_t*)(ws + WS::WIN), M, 5632, D, D, 1 << 30, 0}; pg8::StaticOrder S; S.init(M, 5632, G, bx);
        pg8::EpiIn E{(bf16_t*)(ws + WS::QO), (bf16_t*)(ws + WS::KB), (bf16_t*)(ws + WS::VB), (bf16_t*)(ws + WS::GATES), (bf16_t*)(ws + WS::QI), (bf16_t*)(ws + WS::KI), (float*)(ws + WS::WI), (float*)(ws + WS::KMEAN), SSQ,
                     args.in[I_BG], args.in[I_QNA], args.in[I_KNA], args.in[I_QNB], args.in[I_KNB], (LAS float*)(L + RTAB_OFF)};
        pg8::gemm_phase<pg8::EpiIn, pg8::StaticOrder, true, true>(L + RING_OFF, g, S, E);
        SEAM(3);
    }
    if (IN(4)) {
        int tid4_ = threadIdx.x; asm volatile("" : "+v"(tid4_)); const int tid = tid4_, lane = tid & 63;
        {
#define TK_POS(it_, bb_, tq_) do { bb_ = (it_) >> 8; const int v_ = (it_) & 255, vv_ = (v_ + 128 * (bb_ >> 1)) & 255; tq_ = 16 * ((bb_ & 1) ? 255 - vv_ : vv_); } while (0)
            int bb = 0, tq = -1;
            if (vcu < 1024) { TK_POS(vcu, bb, tq); if (tq >= TOPK) tk::tk_store_q(L, tk::tk_load_q((const bf16_t*)(ws + WS::QI), bb, tq, lane, wave), lane, wave); }
            for (int blk = vcu; blk < M / 64; blk += G) tk::gating_block(L, (const bf16_t*)(ws + WS::QO), (const float*)(ws + WS::KMEAN), (unsigned*)(ws + WS::BMASK), blk, tid);
            for (int it = vcu; it < 1024; it += G) {
                int nb = 0, ntq = -1; if (it + G < 1024) TK_POS(it + G, nb, ntq);
                tk::topk_group<0>(L, (const bf16_t*)(ws + WS::QI), (const bf16_t*)(ws + WS::KI), (const float*)(ws + WS::WI), (u64*)args.out, bb, tq, nb, ntq, tid, lane, wave);
                bb = nb; tq = ntq;
            }
#undef TK_POS
        }
        SEAM(4);
    }
    if (IN(5)) {
        static_assert(attn_body::ATTN_LDS_BYTES <= RING_BYTES, "attention LDS vs frame");
        const attn_body::bf16* Qp = (const attn_body::bf16*)(ws + WS::QO); const attn_body::bf16* Kp = (const attn_body::bf16*)(ws + WS::KB); const attn_body::bf16* Vp = (const attn_body::bf16*)(ws + WS::VB);
        for (int p = vcu; p < 512; p += G) {
            const int s = p & 7, bh = (p < 256) ? (p >> 3) : (32 + (((p - 256) >> 3) ^ 8));
            if ((bh & 15) >= 8) { for (int k = 0; k < 2; ++k)
                attn_body::attn_unit<8, true>(bh >> 4, bh & 15, k ? s : 15 - s, Qp, Kp, Vp, (attn_body::bf16*)(ws + WS::QO), (const unsigned long long*)args.out, (const unsigned*)(ws + WS::BMASK), args.in[I_RB], args.in[I_QNB], args.in[I_KNB], (char*)lds); }
            else { for (int k = 0; k < 2; ++k)
                attn_body::attn_unit<8, false>(bh >> 4, bh & 15, k ? s : 15 - s, Qp, Kp, Vp, (attn_body::bf16*)(ws + WS::QO), (const unsigned long long*)args.out, (const unsigned*)(ws + WS::BMASK), args.in[I_RB], args.in[I_QNA], args.in[I_KNA], (char*)lds); }
        }
        SEAM(5);
    }
    if (IN(6)) {
        pg8::Gemm g{(const bf16_t*)(ws + WS::QO), (const bf16_t*)(ws + WS::WB), M, D, D, D, 1 << 30, 0}; pg8::StaticOrder S; S.init(M, D, G, bx);
        pg8::EpiBranch2 E{(const bf16_t*)(ws + WS::GATES), (bf16_t*)(ws + WS::GM)};
        pg8::gemm_phase<pg8::EpiBranch2, pg8::StaticOrder, false, true>(L + RING_OFF, g, S, E);
        SEAM(6);
    }
    if (IN(7)) {
        pg8::Gemm g{(const bf16_t*)(ws + WS::GM), (const bf16_t*)(ws + WS::WO), M, D, D, D, 1 << 30, 0}; pg8::StaticOrder S; S.init(M, D, G, bx);
        pg8::EpiRes<false, false, true> E{nullptr, XB, nullptr, XB, SSQ, 1.0f};
        pg8::gemm_phase<pg8::EpiRes<false, false, true>, pg8::StaticOrder, false, true>(L + RING_OFF, g, S, E);
        SEAM(7);
    }
    if (IN(8)) {
        pg8::Gemm g{XB, (const bf16_t*)(ws + WS::GU2), M, 2 * DFF, D, D, 1 << 30, 0}; pg8::StaticOrder S; S.init(M, 2 * DFF, G, bx);
        pg8::EpiGu E{ACT, SSQ, (LAS float*)(L + RTAB_OFF)};
        pg8::gemm_phase<pg8::EpiGu, pg8::StaticOrder, true, true>(L + RING_OFF, g, S, E);
        SEAM(8);
    }
    if (IN(9)) {
        pg8::Gemm g{ACT, (const bf16_t*)(ws + WS::DN2), M, D, DFF, DFF, 1 << 30, 0}; pg8::StaticOrder S; S.init(M, D, G, bx);
        pg8::EpiRes<false, true, false> E{nullptr, XB, args.out, nullptr, nullptr, 0.5f};
        pg8::gemm_phase<pg8::EpiRes<false, true, false>, pg8::StaticOrder, false, true>(L + RING_OFF, g, S, E);
    }
#undef IN
#undef SEAM
}

extern "C" void kernel_launch(void* const* d_in, const int* in_sizes, int n_in, void* d_out, int out_size, void* d_ws, size_t ws_size, hipStream_t stream) {
    using namespace K;
    static int grid = 0;
    if (grid == 0) {
        if (n_in != 18 || in_sizes[0] != M * D || out_size != M * D || ws_size < WS::END) { fprintf(stderr, "kernel_launch: unexpected shapes (n_in %d, in0 %d, out %d, ws %zu)\n", n_in, n_in > 0 ? in_sizes[0] : -1, out_size, ws_size); grid = -1; return; }
        int dev = 0, cus = 0, per_cu = 0;
        if (hipGetDevice(&dev) != hipSuccess || hipDeviceGetAttribute(&cus, hipDeviceAttributeMultiprocessorCount, dev) != hipSuccess) { grid = -1; return; }
        if (hipFuncSetAttribute((const void*)mega, hipFuncAttributeMaxDynamicSharedMemorySize, LDS_BYTES) != hipSuccess) { fprintf(stderr, "kernel_launch: hipFuncSetAttribute failed\n"); grid = -1; return; }
        if (hipOccupancyMaxActiveBlocksPerMultiprocessor(&per_cu, (const void*)mega, NWAVES * 64, LDS_BYTES) != hipSuccess || per_cu < 1) { fprintf(stderr, "kernel_launch: occupancy query says %d blocks/CU\n", per_cu); (void)hipGetLastError(); grid = -1; return; }
        grid = cus;
    }
    if (grid < 0) return;
    const float* const* in = (const float* const*)d_in;
    float* out = (float*)d_out; char* ws = (char*)d_ws;
    (void)hipMemsetAsync(ws + WS::CTL, 0, WS::CTL_ZERO_BYTES, stream);
    Args a{};
    for (int i = 0; i < 18; ++i) a.in[i] = in[i];
    a.out = out; a.ws = (unsigned char*)d_ws; a.pad = 0;
    a.ph_lo = 0; a.ph_hi = 10; a.li = 0;
    hipLaunchKernelGGL(mega, dim3(grid), dim3(NWAVES * 64), LDS_BYTES, stream, a);

}
```

```cpp
#include <hip/hip_runtime.h>
#include <hip/hip_bf16.h>
#include <cstdint>
#include <cstdio>
#include <cmath>

namespace K {
constexpr int B = 4, S = 4096, M = B * S, D = 1024, DFF = 2816, H = 8, HD = 64, NIH = 4, IDIM = 64, TOPK = 256, MBLK = 256, NBLK = 16;
constexpr int DIN = 5444;
constexpr float EPS = 1e-6f;
constexpr float LOG2E = 1.4426950408889634f;
constexpr float C2 = 0.125f * LOG2E;
}
typedef unsigned short bf16_t;
typedef unsigned long long u64;

__device__ __forceinline__ bf16_t f2bf(float f) { unsigned u = __float_as_uint(f); return (bf16_t)((u + 0x7fffu + ((u >> 16) & 1u)) >> 16); }
__device__ __forceinline__ int t5_bucket(int d) {
    if (d < 16) return d;
    int large = 16 + (int)(logf((float)d / 16.0f) / 2.0794415416798357f * 16.0f);
    return large < 31 ? large : 31;
}
namespace pg8 {
#define PG8_LAS __attribute__((address_space(3)))
typedef short bf16x8 __attribute__((ext_vector_type(8)));
typedef float f32x4 __attribute__((ext_vector_type(4)));
typedef unsigned u32x4 __attribute__((ext_vector_type(4)));
constexpr int BM = 256, BK = 64, HALF = 128, HTB = HALF * BK * 2  , STAGE_BYTES = 8 * HTB, NXCD = 8, WGM = 8;

__host__ __device__ __forceinline__ int lds_byte(int r, int c) { const int st = (r >> 4) * 2 + (c >> 5), rr = r & 15, cc = c & 31, ob = rr * 64 + cc * 2; return st * 1024 + (ob ^ (((ob >> 9) & 1) << 5)); }
__host__ __device__ __forceinline__ void stage_rc(int b, int& R, int& C) { const int st = b / 1024, sb = b % 1024, swz = sb ^ (((sb >> 9) & 1) << 5); R = (st >> 1) * 16 + swz / 64; C = (st & 1) * 32 + (swz % 64) / 2; }
__host__ __device__ __forceinline__ int perm32(int rho) { const int n = rho >> 4, i = rho & 15; return 8 * (i >> 2) + 4 * n + (i & 3); }

__host__ __device__ __forceinline__ size_t tiled_b_off(int nrow, int k, int nkt) {
    const int ht = nrow >> 7, rb = nrow & 127, c = rb & 31, rho = ((c >> 2) & 1) * 16 + ((c >> 3) << 2) + (c & 3), R = (rb & ~31) + rho;
    return ((size_t)ht * nkt + (k >> 6)) * (size_t)(HALF * BK * 2) + (size_t)lds_byte(R, k & 63);
}
struct Unit { int pm, pn; };
struct Gemm { const bf16_t* A; const bf16_t* Bt; int M, N, K, lda, asplit_pn, asplit_off; };

struct StaticOrder {
    int nM, nN, nwg, G, c;
    __host__ __device__ void init(int M, int N, int G_, int c_) { nM = M / BM; nN = N / BM; nwg = nM * nN; G = G_; c = c_; }
    __host__ __device__ bool next(int i, Unit& u) const {
        const long L = (long)i * G + c; if (L >= nwg) return false;
        int wgid = (int)L; { const int q = nwg / NXCD, r = nwg % NXCD, xcd = wgid % NXCD, off = wgid / NXCD; wgid = (xcd < r ? xcd * (q + 1) : r * (q + 1) + (xcd - r) * q) + off; }
        const int nig = WGM * nN, gid = wgid / nig, fm = gid * WGM, gsz = (nM - fm) < WGM ? (nM - fm) : WGM;
        u.pm = fm + ((wgid % nig) % gsz); u.pn = (wgid % nig) / gsz; return true;
    }
    __device__ __forceinline__ void a_ready(const Unit&) const {}
    __device__ __forceinline__ void done(const Unit&) const {}
};


typedef float f32x2_t __attribute__((ext_vector_type(2))); typedef __bf16 bf16x2_t __attribute__((ext_vector_type(2)));
__device__ __forceinline__ unsigned cvt_pk_bf16(float lo, float hi) { f32x2_t v = {lo, hi}; bf16x2_t b = __builtin_convertvector(v, bf16x2_t); return __builtin_bit_cast(unsigned, b); }
__device__ __forceinline__ float row_rstd(const float* __restrict__ ssq, int row) {
    const f32x4* p = (const f32x4*)(ssq + (size_t)row * 16);
    const f32x4 a = p[0], b = p[1], c = p[2], d = p[3];
    const float s = (((a[0] + a[1]) + (a[2] + a[3])) + ((b[0] + b[1]) + (b[2] + b[3]))) + (((c[0] + c[1]) + (c[2] + c[3])) + ((d[0] + d[1]) + (d[2] + d[3])));
    return 1.0f / sqrtf(s * (1.0f / 1024.0f) + 1e-6f);
}
__device__ __forceinline__ void rstd_stage(const float* __restrict__ ssq, PG8_LAS float* tab, int pm, int wr, int fr, int fq) {
    const int l = fq * 16 + fr;
    tab[l] = row_rstd(ssq, pm * BM + wr * 64 + l);
    tab[64 + l] = row_rstd(ssq, pm * BM + HALF + wr * 64 + l);
    asm volatile("s_waitcnt lgkmcnt(0)" ::: "memory");
}
__device__ __forceinline__ float xrow_sum4(float v) {
    { auto r = __builtin_amdgcn_permlane16_swap(__float_as_uint(v), __float_as_uint(v), false, false); v = __uint_as_float(r[0]) + __uint_as_float(r[1]); }
    { auto r = __builtin_amdgcn_permlane32_swap(__float_as_uint(v), __float_as_uint(v), false, false); v = __uint_as_float(r[0]) + __uint_as_float(r[1]); }
    return v;
}
__device__ __forceinline__ float silu_f(float g) { return g * __builtin_amdgcn_rcpf(1.0f + __builtin_amdgcn_exp2f(-1.4426950408889634f * g)); }
__device__ __forceinline__ float sigmoid_f(float g) { return __builtin_amdgcn_rcpf(1.0f + __builtin_amdgcn_exp2f(-1.4426950408889634f * g)); }

struct EpiGu {
    static constexpr bool PERM = true, AFTER_DRAIN = false, HAS_MID = false, HAS_PRE = true;
    bf16_t* act; const float* ssq; PG8_LAS float* rtab; mutable int lastpm = -1;
    __device__ __forceinline__ void pre(const Unit& u, int wr, int wc, int fr, int fq) const { if (u.pm != lastpm) { rstd_stage(ssq, rtab + (wr * 4 + wc) * 128, u.pm, wr, fr, fq); lastpm = u.pm; } }
    __device__ __forceinline__ void operator()(const f32x4 (&acc)[2][2][4][2], const Unit& u, int wr, int wc, int fr, int fq) const {
        asm volatile("" : "+v"(fr), "+v"(fq));
        const int row0 = u.pm * BM + wr * 64 + fr, col0 = u.pn * 128 + wc * 32 + 8 * fq;
        PG8_LAS float* tab = rtab + (wr * 4 + wc) * 128; pre(u, wr, wc, fr, fq);
#pragma unroll
        for (int ai = 0; ai < 2; ++ai)
#pragma unroll
            for (int m = 0; m < 4; ++m) {
                const int row = row0 + ai * HALF + m * 16; const float rs = tab[64 * ai + 16 * m + fr];
                float o[8];
#pragma unroll
                for (int n = 0; n < 2; ++n)
#pragma unroll
                    for (int i = 0; i < 4; ++i) o[n * 4 + i] = silu_f(acc[ai][0][m][n][i] * rs) * (acc[ai][1][m][n][i] * rs);
                u32x4 w; w.x = cvt_pk_bf16(o[0], o[1]); w.y = cvt_pk_bf16(o[2], o[3]); w.z = cvt_pk_bf16(o[4], o[5]); w.w = cvt_pk_bf16(o[6], o[7]);
                *(u32x4*)(act + (size_t)row * 2816 + col0) = w;
            }
    }
};
template <bool RIN32, bool OUT32, bool STATS> struct EpiRes {
    static constexpr bool PERM = true, AFTER_DRAIN = false, HAS_MID = false, HAS_PRE = false;
    const float* hin32; const bf16_t* hin16; float* hout; bf16_t* hb; float* ssq; float scale;
    __device__ __forceinline__ void operator()(const f32x4 (&acc)[2][2][4][2], const Unit& u, int wr, int wc, int fr, int fq) const {
        asm volatile("" : "+v"(fr), "+v"(fq));
        const int row0 = u.pm * BM + wr * 64 + fr, col0 = u.pn * BM + wc * 32 + 8 * fq;
        u32x4 rw16[2][4][2]; f32x4 rw32[RIN32 ? 2 : 1][RIN32 ? 4 : 1][RIN32 ? 2 : 1][2];
#pragma unroll
        for (int ai = 0; ai < 2; ++ai)
#pragma unroll
            for (int m = 0; m < 4; ++m)
#pragma unroll
                for (int bj = 0; bj < 2; ++bj) {
                    const size_t off = (size_t)(row0 + ai * HALF + m * 16) * 1024 + col0 + bj * HALF;
                    if (RIN32) { rw32[ai][m][bj][0] = *(const f32x4*)(hin32 + off); rw32[ai][m][bj][1] = *(const f32x4*)(hin32 + off + 4); }
                    else rw16[ai][m][bj] = *(const u32x4*)(hin16 + off);
                }
        asm volatile("" ::: "memory");
#pragma unroll
        for (int ai = 0; ai < 2; ++ai)
#pragma unroll
            for (int m = 0; m < 4; ++m) {
                const int row = row0 + ai * HALF + m * 16; float ss = 0.f;
#pragma unroll
                for (int bj = 0; bj < 2; ++bj) {
                    const size_t off = (size_t)row * 1024 + col0 + bj * HALF;
                    f32x4 r0, r1;
                    if (RIN32) { r0 = rw32[RIN32 ? ai : 0][RIN32 ? m : 0][RIN32 ? bj : 0][0]; r1 = rw32[RIN32 ? ai : 0][RIN32 ? m : 0][RIN32 ? bj : 0][1]; }
                    else { const u32x4 rw = rw16[ai][m][bj];
                        r0 = (f32x4){__uint_as_float(rw.x << 16), __uint_as_float(rw.x & 0xffff0000u), __uint_as_float(rw.y << 16), __uint_as_float(rw.y & 0xffff0000u)};
                        r1 = (f32x4){__uint_as_float(rw.z << 16), __uint_as_float(rw.z & 0xffff0000u), __uint_as_float(rw.w << 16), __uint_as_float(rw.w & 0xffff0000u)}; }
                    const f32x4 v0 = r0 + acc[ai][bj][m][0] * scale, v1 = r1 + acc[ai][bj][m][1] * scale;
                    if (OUT32) { *(f32x4*)(hout + off) = v0; *(f32x4*)(hout + off + 4) = v1; }
                    if (STATS) {
                        u32x4 w; w.x = cvt_pk_bf16(v0[0], v0[1]); w.y = cvt_pk_bf16(v0[2], v0[3]); w.z = cvt_pk_bf16(v1[0], v1[1]); w.w = cvt_pk_bf16(v1[2], v1[3]);
                        *(u32x4*)(hb + off) = w;
                        ss += (v0[0] * v0[0] + v0[1] * v0[1]) + (v0[2] * v0[2] + v0[3] * v0[3]) + (v1[0] * v1[0] + v1[1] * v1[1]) + (v1[2] * v1[2] + v1[3] * v1[3]);
                    }
                }
                if (STATS) { ss = xrow_sum4(ss); if (fq == 0) ssq[(size_t)row * 16 + u.pn * 4 + wc] = ss; }
            }
    }
};
struct EpiIn {
    static constexpr bool PERM = true, AFTER_DRAIN = false, HAS_MID = false, HAS_PRE = true;
    bf16_t *QO, *KB, *VB, *GATES, *QI, *KI; float* WI; float* KMEAN; const float* ssq; PG8_LAS const float* gtab; PG8_LAS float* rtab;
    mutable int lastpm = -1;
    __device__ __forceinline__ void pre(const Unit& u, int wr, int wc, int fr, int fq) const { if (u.pm != lastpm) { rstd_stage(ssq, rtab + (wr * 4 + wc) * 128, u.pm, wr, fr, fq); lastpm = u.pm; } }
    template <int KIND, bool MOBA> __device__ __forceinline__ void qkv(const f32x4 (&acc)[2][2][4][2], const Unit& u, int wr, int wc, int fr, int fq, PG8_LAS float* tab, bf16_t* base, PG8_LAS const float* gn) const {
        const int row0 = u.pm * BM + wr * 64 + fr, head = 4 * (u.pn & 1) + wc;
        bf16_t* dst = base + (MOBA ? 512 : 0) + head * 64 + 8 * fq;
        f32x4 gv[2][2];
#pragma unroll
        for (int bj = 0; bj < 2; ++bj)
#pragma unroll
            for (int n = 0; n < 2; ++n) gv[bj][n] = (KIND < 2) ? *(PG8_LAS const f32x4*)(gn + 32 * bj + 8 * fq + 4 * n) : (f32x4){1.f, 1.f, 1.f, 1.f};
        constexpr bool km = (KIND == 1) && MOBA;
        f32x4 ks[2][2];
#pragma unroll
        for (int bj = 0; bj < 2; ++bj)
#pragma unroll
            for (int n = 0; n < 2; ++n) ks[bj][n] = (f32x4){0.f, 0.f, 0.f, 0.f};
#pragma unroll
        for (int ai = 0; ai < 2; ++ai)
#pragma unroll
            for (int m = 0; m < 4; ++m) {
                const int row = row0 + ai * HALF + m * 16; const float rs = tab[64 * ai + 16 * m + fr];
                f32x4 v[2][2]; float ss = 0.f;
#pragma unroll
                for (int bj = 0; bj < 2; ++bj)
#pragma unroll
                    for (int n = 0; n < 2; ++n) { v[bj][n] = acc[ai][bj][m][n] * rs; ss += (v[bj][n][0] * v[bj][n][0] + v[bj][n][1] * v[bj][n][1]) + (v[bj][n][2] * v[bj][n][2] + v[bj][n][3] * v[bj][n][3]); }
                if (KIND < 2) {
                    ss = xrow_sum4(ss);
                    float r = 1.0f / sqrtf(ss * (1.0f / 64.0f) + 1e-6f); if (KIND == 0) r *= K::C2;
#pragma unroll
                    for (int bj = 0; bj < 2; ++bj)
#pragma unroll
                        for (int n = 0; n < 2; ++n) v[bj][n] = v[bj][n] * gv[bj][n] * r;
                }
#pragma unroll
                for (int bj = 0; bj < 2; ++bj) {
                    u32x4 w; w.x = cvt_pk_bf16(v[bj][0][0], v[bj][0][1]); w.y = cvt_pk_bf16(v[bj][0][2], v[bj][0][3]); w.z = cvt_pk_bf16(v[bj][1][0], v[bj][1][1]); w.w = cvt_pk_bf16(v[bj][1][2], v[bj][1][3]);
                    *(u32x4*)(dst + (size_t)row * 1024 + 32 * bj) = w;
                    if (km) { ks[bj][0] += v[bj][0]; ks[bj][1] += v[bj][1]; }
                }
                if (km) asm volatile("" : "+v"(ks[0][0]), "+v"(ks[0][1]), "+v"(ks[1][0]), "+v"(ks[1][1]));
                asm volatile("" ::: "memory");
            }
        if (km) {
            float* kd = KMEAN + ((size_t)u.pm * 8 + head) * 64 + 8 * fq;
#pragma unroll
            for (int bj = 0; bj < 2; ++bj)
#pragma unroll
                for (int n = 0; n < 2; ++n)
#pragma unroll
                    for (int i = 0; i < 4; ++i) { float s = ks[bj][n][i]; s += __shfl_xor(s, 1); s += __shfl_xor(s, 2); s += __shfl_xor(s, 4); s += __shfl_xor(s, 8);
                        if (fr == 0) atomicAdd(kd + 32 * bj + 4 * n + i, s); }
        }
    }
    __device__ __forceinline__ void operator()(const f32x4 (&acc)[2][2][4][2], const Unit& u, int wr, int wc, int fr, int fq) const {
        asm volatile("" : "+v"(fr), "+v"(fq));
        const int pn = u.pn, row0 = u.pm * BM + wr * 64 + fr;
        PG8_LAS float* tab = rtab + (wr * 4 + wc) * 128; pre(u, wr, wc, fr, fq);
        if (pn < 2) qkv<0, false>(acc, u, wr, wc, fr, fq, tab, QO, gtab);
        else if (pn < 4) qkv<1, false>(acc, u, wr, wc, fr, fq, tab, KB, gtab + 64);
        else if (pn < 6) qkv<2, false>(acc, u, wr, wc, fr, fq, tab, VB, gtab);
        else if (pn < 8) qkv<0, true>(acc, u, wr, wc, fr, fq, tab, QO, gtab + 128);
        else if (pn < 10) qkv<1, true>(acc, u, wr, wc, fr, fq, tab, KB, gtab + 192);
        else if (pn < 12) qkv<2, true>(acc, u, wr, wc, fr, fq, tab, VB, gtab);
        else if (pn == 12) {
#pragma unroll
            for (int ai = 0; ai < 2; ++ai)
#pragma unroll
                for (int m = 0; m < 4; ++m) { const int row = row0 + ai * HALF + m * 16; const float rs = tab[64 * ai + 16 * m + fr];
#pragma unroll
                    for (int bj = 0; bj < 2; ++bj) { const f32x4 a = acc[ai][bj][m][0] * rs, b = acc[ai][bj][m][1] * rs;
                        u32x4 w; w.x = cvt_pk_bf16(a[0], a[1]); w.y = cvt_pk_bf16(a[2], a[3]); w.z = cvt_pk_bf16(b[0], b[1]); w.w = cvt_pk_bf16(b[2], b[3]);
                        *(u32x4*)(QI + (size_t)row * 256 + 128 * bj + 32 * wc + 8 * fq) = w; } }
        } else if (pn == 13) {
#pragma unroll
            for (int ai = 0; ai < 2; ++ai)
#pragma unroll
                for (int m = 0; m < 4; ++m) { const int row = row0 + ai * HALF + m * 16; const float rs = tab[64 * ai + 16 * m + fr];
                    const f32x4 a = acc[ai][0][m][0] * rs, b = acc[ai][0][m][1] * rs;
                    if (wc < 2) { u32x4 w; w.x = cvt_pk_bf16(a[0], a[1]); w.y = cvt_pk_bf16(a[2], a[3]); w.z = cvt_pk_bf16(b[0], b[1]); w.w = cvt_pk_bf16(b[2], b[3]);
                        *(u32x4*)(KI + (size_t)row * 64 + 32 * wc + 8 * fq) = w; }
                    else if (wc == 2 && fq == 0) *(f32x4*)(WI + (size_t)row * 4) = a * 0.5f; }
        } else {
            const int cg0 = 256 * (pn - 14) + 32 * wc + 8 * fq;
            f32x4 bv[2][2];
#pragma unroll
            for (int bj = 0; bj < 2; ++bj)
#pragma unroll
                for (int n = 0; n < 2; ++n) bv[bj][n] = *(PG8_LAS const f32x4*)(gtab + 256 + cg0 + 128 * bj + 4 * n);
#pragma unroll
            for (int ai = 0; ai < 2; ++ai)
#pragma unroll
                for (int m = 0; m < 4; ++m) { const int row = row0 + ai * HALF + m * 16; const float rs = tab[64 * ai + 16 * m + fr];
#pragma unroll
                    for (int bj = 0; bj < 2; ++bj) { const f32x4 a = acc[ai][bj][m][0] * rs + bv[bj][0], b = acc[ai][bj][m][1] * rs + bv[bj][1];
                        u32x4 w; w.x = cvt_pk_bf16(sigmoid_f(a[0]), sigmoid_f(a[1])); w.y = cvt_pk_bf16(sigmoid_f(a[2]), sigmoid_f(a[3])); w.z = cvt_pk_bf16(sigmoid_f(b[0]), sigmoid_f(b[1])); w.w = cvt_pk_bf16(sigmoid_f(b[2]), sigmoid_f(b[3]));
                        *(u32x4*)(GATES + (size_t)row * 2048 + cg0 + 128 * bj) = w; } }
        }
    }
};
struct EpiBranch2 {
    static constexpr bool PERM = true, AFTER_DRAIN = false, HAS_MID = true, HAS_PRE = false;
    const bf16_t* gates; bf16_t* mx;
    __device__ __forceinline__ void mid(f32x4 (&acc)[2][2][4][2], const Unit& u, int wr, int wc, int fr, int fq) const {
        asm volatile("" : "+v"(fr), "+v"(fq));
        const int row0 = u.pm * BM + wr * 64 + fr, col0 = u.pn * BM + wc * 32 + 8 * fq;
#pragma unroll
        for (int ai = 0; ai < 2; ++ai)
#pragma unroll
            for (int m = 0; m < 4; ++m) {
                const int row = row0 + ai * HALF + m * 16;
#pragma unroll
                for (int bj = 0; bj < 2; ++bj) {
                    const size_t off = (size_t)row * 2048 + col0 + bj * HALF;
                    const u32x4 ga = *(const u32x4*)(gates + off), gb = *(const u32x4*)(gates + off + 1024);
                    float r[8];
#pragma unroll
                    for (int x = 0; x < 4; ++x) {
                        r[2 * x] = __uint_as_float(ga[x] << 16) * __builtin_amdgcn_rcpf(__builtin_fmaxf(__uint_as_float(gb[x] << 16), 1e-30f));
                        r[2 * x + 1] = __uint_as_float(ga[x] & 0xffff0000u) * __builtin_amdgcn_rcpf(__builtin_fmaxf(__uint_as_float(gb[x] & 0xffff0000u), 1e-30f)); }
                    acc[ai][bj][m][0] = acc[ai][bj][m][0] * (f32x4){r[0], r[1], r[2], r[3]};
                    acc[ai][bj][m][1] = acc[ai][bj][m][1] * (f32x4){r[4], r[5], r[6], r[7]};
                }
                asm volatile("" ::: "memory");
            }
    }
    __device__ __forceinline__ void operator()(const f32x4 (&acc)[2][2][4][2], const Unit& u, int wr, int wc, int fr, int fq) const {
        asm volatile("" : "+v"(fr), "+v"(fq));
        const int row0 = u.pm * BM + wr * 64 + fr, col0 = u.pn * BM + wc * 32 + 8 * fq;
#pragma unroll
        for (int ai = 0; ai < 2; ++ai)
#pragma unroll
            for (int m = 0; m < 4; ++m) {
                const int row = row0 + ai * HALF + m * 16;
#pragma unroll
                for (int bj = 0; bj < 2; ++bj) {
                    const u32x4 gw = *(const u32x4*)(gates + (size_t)row * 2048 + 1024 + col0 + bj * HALF);
                    const f32x4 a = acc[ai][bj][m][0], b = acc[ai][bj][m][1];
                    u32x4 w;
                    w.x = cvt_pk_bf16(a[0] * __builtin_fmaxf(__uint_as_float(gw.x << 16), 1e-30f), a[1] * __builtin_fmaxf(__uint_as_float(gw.x & 0xffff0000u), 1e-30f));
                    w.y = cvt_pk_bf16(a[2] * __builtin_fmaxf(__uint_as_float(gw.y << 16), 1e-30f), a[3] * __builtin_fmaxf(__uint_as_float(gw.y & 0xffff0000u), 1e-30f));
                    w.z = cvt_pk_bf16(b[0] * __builtin_fmaxf(__uint_as_float(gw.z << 16), 1e-30f), b[1] * __builtin_fmaxf(__uint_as_float(gw.z & 0xffff0000u), 1e-30f));
                    w.w = cvt_pk_bf16(b[2] * __builtin_fmaxf(__uint_as_float(gw.w << 16), 1e-30f), b[3] * __builtin_fmaxf(__uint_as_float(gw.w & 0xffff0000u), 1e-30f));
                    *(u32x4*)(mx + (size_t)row * 1024 + col0 + bj * HALF) = w;
                }
                asm volatile("" ::: "memory");
            }
    }
};
template <class Epi, class Sched, bool ALIGN_EPI = false, bool SP2 = false>
__device__ __forceinline__ void gemm_phase(PG8_LAS unsigned char* lds, const Gemm g, const Sched& S, const Epi& E) {
    int tid_ = threadIdx.x; asm volatile("" : "+v"(tid_));
    const int tid = tid_, wid = __builtin_amdgcn_readfirstlane(tid >> 6), lane = tid & 63, wr = wid >> 2, wc = wid & 3, fr = lane & 15, fq = lane >> 4;
    const int K = g.K, nt = K / BK;
    unsigned voffA[2], voffB[2];
#pragma unroll
    for (int i = 0; i < 2; ++i) { int R, C; stage_rc(tid * 16 + i * 8192, R, C); const int Rb = Epi::PERM ? ((R & ~31) + perm32(R & 31)) : R;
        voffA[i] = (unsigned)(R * g.lda + C) * 2u; voffB[i] = (unsigned)(tid * 16 + i * 8192); (void)Rb; }
    const size_t kstep = (size_t)(BK * 2), kstepB = (size_t)HTB;
    const size_t hstepA = (size_t)HALF * g.lda * 2, hstepB = (size_t)nt * kstepB;
    const size_t tstepA = 2 * hstepA, tstepB = 2 * hstepB;
#define PG8_ABASE(u_) ((const char*)g.A + (size_t)(u_).pm * tstepA + (((u_).pn >= g.asplit_pn) ? (size_t)g.asplit_off : (size_t)0))
    const unsigned ldsw = (unsigned)wid * 1024u;
    const int aoff = lds_byte(wr * 64 + fr, fq * 8), boff = lds_byte(wc * 32 + fr, fq * 8);
#define PG8_SA(b, h) (((b) * 2 + (h)) * HTB)
#define PG8_SB(b, h) ((4 + (b) * 2 + (h)) * HTB)
#define PG8_STAGE(bufoff, gbase, voff) do { _Pragma("unroll") for (int _i = 0; _i < 2; ++_i) \
        __builtin_amdgcn_global_load_lds((const unsigned*)((const char*)(gbase) + (voff)[_i]), (PG8_LAS unsigned*)(lds + (bufoff) + ldsw + _i * 8192), 16, 0, 0); } while (0)
#define PG8_LDA(dst, b, h) do { _Pragma("unroll") for (int m = 0; m < 4; ++m) _Pragma("unroll") for (int k = 0; k < 2; ++k) dst[m][k] = *(const PG8_LAS bf16x8*)(lds + PG8_SA(b, h) + aoff + m * 2048 + k * 1024); } while (0)
#define PG8_LDB(dst, b, h) do { _Pragma("unroll") for (int n = 0; n < 2; ++n) _Pragma("unroll") for (int k = 0; k < 2; ++k) dst[n][k] = *(const PG8_LAS bf16x8*)(lds + PG8_SB(b, h) + boff + n * 2048 + k * 1024); } while (0)
#define PG8_MMA(ai, bj, At, Bt) do { __builtin_amdgcn_s_setprio(1); _Pragma("unroll") for (int m = 0; m < 4; ++m) _Pragma("unroll") for (int n = 0; n < 2; ++n) _Pragma("unroll") for (int k = 0; k < 2; ++k) \
        acc[ai][bj][m][n] = __builtin_amdgcn_mfma_f32_16x16x32_bf16(Bt[n][k], At[m][k], acc[ai][bj][m][n], 0, 0, 0); __builtin_amdgcn_s_setprio(0); } while (0)
#define PG8_WAIT_V(n) asm volatile("s_waitcnt vmcnt(" #n ")" ::: "memory")
#define PG8_WAIT_L(n) asm volatile("s_waitcnt lgkmcnt(" #n ")" ::: "memory")
#define PG8_BAR __builtin_amdgcn_s_barrier()
#define PG8_SCHED __builtin_amdgcn_sched_barrier(0)
    Unit cur, nxt; int ui = 0;
    if (!S.next(0, cur)) return;
    f32x4 acc[2][2][4][2];
#pragma unroll
    for (int a = 0; a < 2; ++a)
#pragma unroll
        for (int b = 0; b < 2; ++b)
#pragma unroll
            for (int m = 0; m < 4; ++m)
#pragma unroll
                for (int n = 0; n < 2; ++n) acc[a][b][m][n] = (f32x4){0.f, 0.f, 0.f, 0.f};
    bf16x8 At[4][2], B0[2][2], B1[2][2];
    const char* cA = PG8_ABASE(cur); const char* cB = (const char*)g.Bt + (size_t)cur.pn * tstepB;
    S.a_ready(cur);
    if constexpr (SP2) {
        PG8_STAGE(PG8_SB(0, 0), cB, voffB); PG8_STAGE(PG8_SB(0, 1), cB + hstepB, voffB); PG8_STAGE(PG8_SA(0, 0), cA, voffA); PG8_STAGE(PG8_SA(0, 1), cA + hstepA, voffA);
        PG8_STAGE(PG8_SB(1, 0), cB + kstepB, voffB); PG8_STAGE(PG8_SA(1, 0), cA + kstep, voffA); PG8_STAGE(PG8_SB(1, 1), cB + hstepB + kstepB, voffB);
        if constexpr (Epi::HAS_PRE) { int fr_ = fr, fq_ = fq; E.pre(cur, wr, wc, fr_, fq_); }
        if (wr == 1) PG8_BAR;
        PG8_WAIT_V(8); PG8_BAR;
        PG8_WAIT_V(6); PG8_BAR;
    } else {
        PG8_STAGE(PG8_SB(0, 0), cB, voffB); PG8_STAGE(PG8_SA(0, 0), cA, voffA); PG8_STAGE(PG8_SB(0, 1), cB + hstepB, voffB); PG8_STAGE(PG8_SA(0, 1), cA + hstepA, voffA);
        if (wr == 1) PG8_BAR;
        PG8_WAIT_V(4); PG8_BAR;
        PG8_STAGE(PG8_SB(1, 0), cB + kstepB, voffB); PG8_STAGE(PG8_SA(1, 0), cA + kstep, voffA); PG8_STAGE(PG8_SB(1, 1), cB + hstepB + kstepB, voffB);
        PG8_WAIT_V(6); PG8_BAR;
    }
    for (;;) {
        const bool has_next = S.next(ui + 1, nxt);
        const char* nA = has_next ? PG8_ABASE(nxt) : cA; const char* nB = has_next ? (const char*)g.Bt + (size_t)nxt.pn * tstepB : cB;
        for (int t = 0; t < nt; t += 2) {
            const bool last = (t == nt - 2);
            const char* a1 = cA + (size_t)(t + 1) * kstep;
            const char* a2 = last ? nA : cA + (size_t)(t + 2) * kstep; const char* b2 = last ? nB : cB + (size_t)(t + 2) * kstepB;
            const char* a3 = a2 + kstep; const char* b3 = b2 + kstepB;
            if (last && has_next) S.a_ready(nxt);
            if constexpr (SP2) {
            PG8_LDB(B0, 0, 0); PG8_LDB(B1, 0, 1); PG8_SCHED; PG8_LDA(At, 0, 0); PG8_STAGE(PG8_SA(1, 1), a1 + hstepA, voffA);
            PG8_WAIT_V(8); PG8_WAIT_L(0); PG8_BAR; PG8_MMA(0, 0, At, B0); PG8_MMA(0, 1, At, B1); PG8_BAR; PG8_SCHED;
            PG8_LDA(At, 0, 1); PG8_STAGE(PG8_SB(0, 0), b2, voffB); PG8_STAGE(PG8_SB(0, 1), b2 + hstepB, voffB); PG8_STAGE(PG8_SA(0, 0), a2, voffA);
            PG8_WAIT_V(8); PG8_WAIT_L(0); PG8_BAR; PG8_MMA(1, 0, At, B0); PG8_MMA(1, 1, At, B1); PG8_BAR; PG8_SCHED;
            PG8_LDB(B0, 1, 0); PG8_LDB(B1, 1, 1); PG8_SCHED; PG8_LDA(At, 1, 0); PG8_STAGE(PG8_SA(0, 1), a2 + hstepA, voffA);
            PG8_WAIT_V(8); PG8_WAIT_L(0); PG8_BAR; PG8_MMA(0, 0, At, B0); PG8_MMA(0, 1, At, B1); PG8_BAR; PG8_SCHED;
            PG8_LDA(At, 1, 1); PG8_STAGE(PG8_SB(1, 0), b3, voffB); PG8_STAGE(PG8_SB(1, 1), b3 + hstepB, voffB); PG8_STAGE(PG8_SA(1, 0), a3, voffA);
            PG8_WAIT_V(8); PG8_WAIT_L(0); PG8_BAR; PG8_MMA(1, 0, At, B0); PG8_MMA(1, 1, At, B1); PG8_BAR; PG8_SCHED;
            } else {
            PG8_LDB(B0, 0, 0); PG8_SCHED; PG8_LDA(At, 0, 0); PG8_STAGE(PG8_SA(1, 1), a1 + hstepA, voffA);
            PG8_WAIT_L(8); PG8_BAR; PG8_WAIT_L(0); PG8_MMA(0, 0, At, B0); PG8_BAR; PG8_SCHED;
            PG8_LDB(B1, 0, 1); PG8_STAGE(PG8_SB(0, 0), b2, voffB);
            PG8_BAR; PG8_WAIT_L(0); PG8_MMA(0, 1, At, B1); PG8_BAR;
            PG8_LDA(At, 0, 1); PG8_STAGE(PG8_SA(0, 0), a2, voffA);
            PG8_BAR; PG8_WAIT_L(0); PG8_MMA(1, 0, At, B0); PG8_BAR; PG8_SCHED;
            PG8_STAGE(PG8_SB(0, 1), b2 + hstepB, voffB);
            PG8_WAIT_V(6); PG8_BAR; PG8_MMA(1, 1, At, B1); PG8_BAR;
            PG8_LDB(B0, 1, 0); PG8_SCHED; PG8_LDA(At, 1, 0); PG8_STAGE(PG8_SA(0, 1), a2 + hstepA, voffA);
            PG8_WAIT_L(8); PG8_BAR; PG8_WAIT_L(0); PG8_MMA(0, 0, At, B0); PG8_BAR; PG8_SCHED;
            PG8_LDB(B1, 1, 1); PG8_STAGE(PG8_SB(1, 0), b3, voffB);
            PG8_BAR; PG8_WAIT_L(0); PG8_MMA(0, 1, At, B1); PG8_BAR;
            PG8_LDA(At, 1, 1); PG8_STAGE(PG8_SA(1, 0), a3, voffA);
            PG8_BAR; PG8_WAIT_L(0); PG8_MMA(1, 0, At, B0); PG8_BAR; PG8_SCHED;
            PG8_STAGE(PG8_SB(1, 1), b3 + hstepB, voffB);
            PG8_WAIT_V(6); PG8_BAR; PG8_MMA(1, 1, At, B1); PG8_BAR;
            }
            if constexpr (Epi::HAS_MID) { if (t + 2 == nt / 2) E.mid(acc, cur, wr, wc, fr, fq); }
        }
        if constexpr (ALIGN_EPI) { if (wr == 0) PG8_BAR; }
        if constexpr (!Epi::AFTER_DRAIN) { E(acc, cur, wr, wc, fr, fq); S.done(cur); }
        if (!has_next) break;
#pragma unroll
        for (int a = 0; a < 2; ++a)
#pragma unroll
            for (int b = 0; b < 2; ++b)
#pragma unroll
                for (int m = 0; m < 4; ++m)
#pragma unroll
                    for (int n = 0; n < 2; ++n) acc[a][b][m][n] = (f32x4){0.f, 0.f, 0.f, 0.f};
        cur = nxt; cA = nA; cB = nB; ++ui;
        if constexpr (ALIGN_EPI) { if (wr == 1) PG8_BAR; }
    }
    PG8_WAIT_V(0);
    if constexpr (!ALIGN_EPI) { if (wr == 0) PG8_BAR; }
    PG8_BAR;
    if constexpr (Epi::AFTER_DRAIN) { E.fused(acc, cur, wr, wc, fr, fq, lds, wid, lane); S.done(cur); }
#undef PG8_ABASE
#undef PG8_SA
#undef PG8_SB
#undef PG8_STAGE
#undef PG8_LDA
#undef PG8_LDB
#undef PG8_MMA
#undef PG8_WAIT_V
#undef PG8_WAIT_L
#undef PG8_BAR
#undef PG8_SCHED
}
}

constexpr int NWAVES = 8;
namespace WS {
constexpr size_t MiB = 1u << 20;
constexpr size_t CTL = 0, CTL_ZERO_BYTES = 1 * MiB;
constexpr size_t KMEAN = 512 * 1024;
constexpr size_t SSQ = 1 * MiB;
constexpr size_t GU1 = 2 * MiB, DN1 = 13 * MiB, WIN = 19 * MiB, WB = 30 * MiB, WO = 32 * MiB, GU2 = 36 * MiB, DN2 = 47 * MiB;
constexpr size_t XB = 53 * MiB;
constexpr size_t QO = 85 * MiB, KB = 117 * MiB, VB = 149 * MiB;
constexpr size_t GATES = 181 * MiB;
constexpr size_t QI = 245 * MiB, KI = 253 * MiB, WI = 255 * MiB, BMASK = 255 * MiB + 256 * 1024;
constexpr size_t ACT = 85 * MiB;
constexpr size_t GM = 117 * MiB;
constexpr size_t END = 256 * MiB;
}
constexpr int CW_BAR = 4096;
constexpr int RING_OFF = 0, RING_BYTES = 131072;
constexpr int LDSCTL_OFF = RING_BYTES, MISC_OFF = LDSCTL_OFF + 320;
constexpr int RTAB_OFF = LDSCTL_OFF + 1024;
constexpr int GTAB_OFF = RTAB_OFF + 4096;
constexpr int LDS_BYTES = 147456;

#define GAS __attribute__((address_space(1)))
#define LAS __attribute__((address_space(3)))
typedef unsigned v4u __attribute__((ext_vector_type(4)));
typedef float f32x4 __attribute__((ext_vector_type(4)));
typedef GAS unsigned gu32;
#define LDS_WAIT() asm volatile("s_waitcnt lgkmcnt(0)" ::: "memory")
#define VM_WAIT() asm volatile("s_waitcnt vmcnt(0)" ::: "memory")
__device__ __forceinline__ unsigned pk2(float lo, float hi) { return (unsigned)f2bf(lo) | ((unsigned)f2bf(hi) << 16); }
#define XB_TMO      128
#define XB_XCNT(j)  (256  + 64 * (j))
#define XB_XSUB(j)  (1280 + 64 * (j))
#define XB_XGEN(j)  (2304 + 64 * (j))
#define XB_TOP      3328
#define XB_TOPGEN   3392
#define XCD_BAR_WORDS 3456
#define XB_SPIN_CAP (1u << 18)

__device__ __forceinline__ unsigned xb_ld(unsigned* p)              { return __hip_atomic_load(p, __ATOMIC_RELAXED, __HIP_MEMORY_SCOPE_AGENT); }
__device__ __forceinline__ unsigned xb_add(unsigned* p, unsigned v) { return __hip_atomic_fetch_add(p, v, __ATOMIC_RELAXED, __HIP_MEMORY_SCOPE_AGENT); }
__device__ __forceinline__ unsigned xb_xcc_id() { return (unsigned)__builtin_amdgcn_s_getreg((3 << 11) | 20) & 0xFu; }
#define XB_SPIN(cond, bar) do { unsigned _sp = 0; while (cond) { __builtin_amdgcn_s_sleep(1); \
    if ((++_sp & 255u) == 0u) { if (xb_ld(&(bar)[XB_TMO])) break; if (_sp > XB_SPIN_CAP) { atomicAdd(&(bar)[XB_TMO], 1u); break; } } } } while (0)

struct XcdBarrier {
    unsigned* bar; unsigned x;
    volatile LAS unsigned* st;
};

__device__ __forceinline__ XcdBarrier xcd_barrier_post(unsigned* bar, volatile LAS unsigned* st) {
    XcdBarrier b; b.bar = bar; b.x = xb_xcc_id(); b.st = st;
    if (threadIdx.x == 0) st[2] = xb_add(&bar[XB_XCNT(b.x)], 1u);
    return b;
}
__device__ __forceinline__ void xcd_barrier_complete(unsigned* bar, unsigned x, unsigned& nloc, unsigned& nx) {
    const unsigned G = gridDim.x * gridDim.y * gridDim.z;
    unsigned sum, cnt, mine, sp = 0u;
    for (;;) {
        sum = 0u; cnt = 0u; mine = 0u;
#pragma unroll
        for (unsigned j = 0; j < 16; ++j) { const unsigned c = xb_ld(&bar[XB_XCNT(j)]); sum += c; cnt += (c > 0u) ? 1u : 0u; mine = (j == x) ? c : mine; }
        if (sum == G) break;
        __builtin_amdgcn_s_sleep(1);
        if ((++sp & 255u) == 0u) { if (xb_ld(&bar[XB_TMO])) break; if (sp > XB_SPIN_CAP) { atomicAdd(&bar[XB_TMO], 1u); break; } }
    }
    nloc = mine > 0u ? mine : 1u; nx = cnt > 0u ? cnt : 1u;
}

__device__ __forceinline__ void xcd_barrier(const XcdBarrier& b) {
    asm volatile("s_waitcnt vmcnt(0)" ::: "memory");
    __syncthreads();
    if (threadIdx.x == 0) {
        unsigned* bar = b.bar;
        __builtin_amdgcn_s_waitcnt(0);
        unsigned nloc = b.st[0], nx = b.st[1];
        if (nloc == 0u) { xcd_barrier_complete(bar, b.x, nloc, nx); b.st[0] = nloc; b.st[1] = nx; }
        const unsigned old = xb_add(&bar[XB_XSUB(b.x)], 1u);
        const unsigned gen = old / nloc;
        if (old + 1u == (gen + 1u) * nloc) {
            __builtin_amdgcn_fence(__ATOMIC_RELEASE, "agent");
            asm volatile("s_waitcnt vmcnt(0)" ::: "memory");
            const unsigned og = xb_add(&bar[XB_TOP], 1u);
            const unsigned tg = og / nx;
            if (og + 1u == (tg + 1u) * nx) xb_add(&bar[XB_TOPGEN], 1u);
            else XB_SPIN(xb_ld(&bar[XB_TOPGEN]) == tg, bar);
            __builtin_amdgcn_fence(__ATOMIC_ACQUIRE, "agent");
            xb_add(&bar[XB_XGEN(b.x)], 1u);
            asm volatile("s_waitcnt vmcnt(0)" ::: "memory");
        } else {
            XB_SPIN(xb_ld(&bar[XB_XGEN(b.x)]) == gen, bar);
            __builtin_amdgcn_fence(__ATOMIC_ACQUIRE, "agent");
            asm volatile("s_waitcnt vmcnt(0)" ::: "memory");
        }
    }
    __syncthreads();
}
__device__ __forceinline__ void xcd_barrier_local(const XcdBarrier& b) {
    asm volatile("s_waitcnt vmcnt(0)" ::: "memory");
    __syncthreads();
    if (threadIdx.x == 0) {
        unsigned* bar = b.bar;
        __builtin_amdgcn_s_waitcnt(0);
        unsigned nloc = b.st[0], nx = b.st[1];
        if (nloc == 0u) { xcd_barrier_complete(bar, b.x, nloc, nx); b.st[0] = nloc; b.st[1] = nx; }
        const unsigned old = xb_add(&bar[XB_XSUB(b.x)], 1u);
        const unsigned gen = old / nloc;
        if (old + 1u == (gen + 1u) * nloc) {
            __builtin_amdgcn_fence(__ATOMIC_ACQUIRE, "agent");
            xb_add(&bar[XB_XGEN(b.x)], 1u);
            asm volatile("s_waitcnt vmcnt(0)" ::: "memory");
        } else {
            XB_SPIN(xb_ld(&bar[XB_XGEN(b.x)]) == gen, bar);
            __builtin_amdgcn_fence(__ATOMIC_ACQUIRE, "agent");
            asm volatile("s_waitcnt vmcnt(0)" ::: "memory");
        }
    }
    __syncthreads();
}

namespace tk {
typedef short bf16x8 __attribute__((ext_vector_type(8)));
typedef float f32x4 __attribute__((ext_vector_type(4)));
constexpr int HIST_OFF = 0, HSTR = 1025;
constexpr int TCNT_OFF = 65664;
constexpr int MROW = 260;
constexpr int MSTG_OFF = TCNT_OFF + 16384;
constexpr int TBASE_OFF = MSTG_OFF + 8448;
constexpr int RES_OFF = TBASE_OFF + 8192;
constexpr int HB_OFF = 110592, HBSTR = 257;
constexpr int QST_OFF = 102400;
#define TK_BAR() do { asm volatile("s_waitcnt lgkmcnt(0)" ::: "memory"); __builtin_amdgcn_s_barrier(); asm volatile("" ::: "memory"); } while (0)

__device__ __forceinline__ unsigned wave_prefix_incl(unsigned x) {
    x += (unsigned)__builtin_amdgcn_update_dpp(0, (int)x, 0x111, 0xf, 0xf, true);
    x += (unsigned)__builtin_amdgcn_update_dpp(0, (int)x, 0x112, 0xf, 0xf, true);
    x += (unsigned)__builtin_amdgcn_update_dpp(0, (int)x, 0x114, 0xf, 0xf, true);
    x += (unsigned)__builtin_amdgcn_update_dpp(0, (int)x, 0x118, 0xf, 0xf, true);
    x += (unsigned)__builtin_amdgcn_update_dpp(0, (int)x, 0x142, 0xa, 0xf, false);
    x += (unsigned)__builtin_amdgcn_update_dpp(0, (int)x, 0x143, 0xc, 0xf, false);
    return x;
}
template <int NW>
__device__ __forceinline__ void scan_query(const LAS unsigned* hq, LAS unsigned* res, int qq, unsigned r, int lane) {
    const int wbase = (63 - lane) * NW;
    unsigned ws = 0;
#pragma unroll
    for (int x = 0; x < NW; ++x) ws += hq[wbase + x];
    const unsigned tot = (ws & 0xffffu) + (ws >> 16);
    const unsigned incl = wave_prefix_incl(tot);
    const unsigned above = incl - tot;
    const unsigned long long bal = __ballot(above < r && incl >= r);
    const int Ls = __builtin_amdgcn_readfirstlane((int)__builtin_ctzll(bal));
    const unsigned r2 = r - (unsigned)__builtin_amdgcn_readlane((int)above, Ls);
    const int word = (63 - Ls) * NW + (NW - 1 - (lane & (NW - 1)));
    const unsigned w = hq[word], hi = w >> 16, lo = w & 0xffffu, t2 = hi + lo;
    unsigned inc2 = t2;
    inc2 += (unsigned)__builtin_amdgcn_update_dpp(0, (int)inc2, 0x111, 0xf, 0xf, true);
    inc2 += (unsigned)__builtin_amdgcn_update_dpp(0, (int)inc2, 0x112, 0xf, 0xf, true);
    inc2 += (unsigned)__builtin_amdgcn_update_dpp(0, (int)inc2, 0x114, 0xf, 0xf, true);
    inc2 += (unsigned)__builtin_amdgcn_update_dpp(0, (int)inc2, 0x118, 0xf, 0xf, true);
    const unsigned ab2 = inc2 - t2;
    if (lane < NW && ab2 < r2 && inc2 >= r2) {
        const bool uh = ab2 + hi >= r2;
        res[qq] = (unsigned)word * 2u + (uh ? 1u : 0u); res[16 + qq] = r2 - (uh ? ab2 : ab2 + hi); res[32 + qq] = uh ? hi : lo;
    }
}

__device__ __forceinline__ v4u tk_load_q(const bf16_t* __restrict__ QI, int b, int tq0, int lane, int wave) {
    const size_t row = (size_t)b * K::S + tq0 + (lane & 15);
    return *(const v4u*)(QI + row * 256 + (wave >> 1) * 64 + (wave & 1) * 32 + (lane >> 4) * 8);
}
__device__ __forceinline__ void tk_store_q(LAS unsigned char* L, v4u v, int lane, int wave) { *(LAS v4u*)(L + QST_OFF + wave * 1024 + lane * 16) = v; }
#define TK_S(F_, i_, rest_) if (8 * (i_) <= jw) { F_.template operator()<i_>(); rest_ }
#define TK_SLOTS(F_) do { TK_S(F_, 0, TK_S(F_, 1, TK_S(F_, 2, TK_S(F_, 3, TK_S(F_, 4, TK_S(F_, 5, TK_S(F_, 6, TK_S(F_, 7, TK_S(F_, 8, TK_S(F_, 9, TK_S(F_, 10, TK_S(F_, 11, TK_S(F_, 12, TK_S(F_, 13, TK_S(F_, 14, TK_S(F_, 15, TK_S(F_, 16, TK_S(F_, 17, TK_S(F_, 18, TK_S(F_, 19, TK_S(F_, 20, TK_S(F_, 21, TK_S(F_, 22, TK_S(F_, 23, TK_S(F_, 24, TK_S(F_, 25, TK_S(F_, 26, TK_S(F_, 27, TK_S(F_, 28, TK_S(F_, 29, TK_S(F_, 30, TK_S(F_, 31, )))))))))))))))))))))))))))))))) } while (0)
template <int PV>
__device__ __forceinline__ void topk_group(LAS unsigned char* L, const bf16_t* __restrict__ QI, const bf16_t* __restrict__ KI, const float* __restrict__ WI, u64* __restrict__ MASK,
                                           int b, int tq0, int nb, int ntq0, int tid, int lane, int wave, int nrep = 1) {
    using namespace K;
    const int q = lane & 15, g = lane >> 4;
    const int row0 = b * S + tq0, jmax = tq0 >> 4, jw = jmax - wave;
    LAS unsigned* hist = (LAS unsigned*)(L + HIST_OFF); LAS unsigned* tcnt = (LAS unsigned*)(L + TCNT_OFF);
    LAS unsigned short* mstg = (LAS unsigned short*)(L + MSTG_OFF); LAS unsigned short* tbase = (LAS unsigned short*)(L + TBASE_OFF); LAS unsigned* res = (LAS unsigned*)(L + RES_OFF);
    for (int i = tid; i < 16 * MROW * 2 / 16; i += NWAVES * 64) ((LAS v4u*)mstg)[i] = (v4u){0u, 0u, 0u, 0u};
    if (tq0 < TOPK) {
        if (ntq0 >= TOPK) tk_store_q(L, tk_load_q(QI, nb, ntq0, lane, wave), lane, wave);
        TK_BAR();
        for (int idx = tid; idx < 16 * (jmax + 1); idx += NWAVES * 64) { const int qq = idx & 15, j = idx >> 4; mstg[qq * MROW + j] = (unsigned short)((j < jmax) ? 0xffffu : ((2u << qq) - 1u)); }
    } else {
        v4u key[32];
        bf16x8 kk[2][2];
#define TK_LOADK(i_) do { const int o_ = 8 * (i_), jc_ = wave + (o_ < jw ? o_ : jw); const bf16_t* kp_ = KI + (size_t)(b * S + jc_ * 16 + q) * 64 + g * 8; \
            kk[(i_) % 2][0] = *(const bf16x8*)kp_; kk[(i_) % 2][1] = *(const bf16x8*)(kp_ + 32); } while (0)
        TK_LOADK(0);
        const f32x4 wv = *(const f32x4*)(WI + (size_t)(row0 + q) * 4);
        asm volatile("" ::: "memory");
        for (int i = tid; i < 16 * HSTR / 4; i += NWAVES * 64) ((LAS v4u*)hist)[i] = (v4u){0u, 0u, 0u, 0u};
        for (int i = tid; i < 16 * HBSTR / 4; i += NWAVES * 64) ((LAS v4u*)(L + HB_OFF))[i] = (v4u){0u, 0u, 0u, 0u};
        TK_BAR();
        bf16x8 qf[4][2];
#pragma unroll
        for (int h = 0; h < 4; ++h)
#pragma unroll
            for (int ks = 0; ks < 2; ++ks) qf[h][ks] = *(const LAS bf16x8*)(L + QST_OFF + (h * 2 + ks) * 1024 + lane * 16);
        unsigned zb = 0x80000000u + ((4095u - (((unsigned)wave << 4) + 4u * (unsigned)g)) << 10); asm volatile("" : "+v"(zb));
        const int lim = q - 4 * g;
        auto sslot = [&]<int i>() __attribute__((always_inline)) {
            if (i < 31) TK_LOADK(i + 1);
            asm volatile("" ::: "memory");
            f32x4 sc = {0.f, 0.f, 0.f, 0.f};
#pragma unroll
            for (int h = 0; h < 4; ++h) {
                f32x4 d = __builtin_amdgcn_mfma_f32_16x16x32_bf16(kk[i % 2][0], qf[h][0], (f32x4){0.f, 0.f, 0.f, 0.f}, 0, 0, 0);
                d = __builtin_amdgcn_mfma_f32_16x16x32_bf16(kk[i % 2][1], qf[h][1], d, 0, 0, 0);
#pragma unroll
                for (int r = 0; r < 4; ++r) { const int di = __float_as_int(d[r]); sc[r] = __builtin_fmaf(wv[h], __int_as_float(di > 0 ? di : 0), sc[r]); }
                if (h == 1) __builtin_amdgcn_sched_barrier(0);
            }
            const int tl = (8 * i == jw) ? lim : 3;
#pragma unroll
            for (int r = 0; r < 4; ++r) {
                const unsigned u = __float_as_uint(sc[r]);
                unsigned k = ((int)u < 0) ? ~u : u + 0x80400000u;
                k = (u == 0u) ? zb - ((128u * i + r) << 10) : k;
                if (PV == 21) k = u ^ ((unsigned)((int)u >> 31) | 0x80000000u);
                k = (r > tl) ? 0u : k;
                key[i][r] = k;
                if (PV != 3) { const unsigned bin = k >> 21; __hip_atomic_fetch_add(hist + q * HSTR + (bin >> 1), 1u << (16 * (bin & 1u)), __ATOMIC_RELAXED, __HIP_MEMORY_SCOPE_WORKGROUP); }
            }
            __builtin_amdgcn_sched_barrier(0);
        };
        TK_SLOTS(sslot);
#undef TK_LOADK
        if (PV == 1 || PV == 3) {
            unsigned xs = 0u;
#pragma unroll
            for (int i = 0; i < 32; ++i) { if (8 * i <= jw) {
#pragma unroll
                for (int r = 0; r < 4; ++r) xs ^= key[i][r]; } }
            TK_BAR();
            if (ntq0 >= TOPK) tk_store_q(L, tk_load_q(QI, nb, ntq0, lane, wave), lane, wave);
            res[64 + lane] = xs;
        } else {
        int ln = lane; asm volatile("" : "+v"(ln));
        LAS unsigned* const tc_q = tcnt + (ln & 15) * 256 + wave; LAS unsigned short* const tb_q = tbase + (ln & 15) * 256 + wave;
        LAS unsigned* const ms32_q = (LAS unsigned*)mstg + (((ln & 15) * MROW + wave) >> 1); const unsigned sh_q = 16u * (wave & 1) + 4u * (unsigned)(ln >> 4);
        unsigned prefix = 0u, rnk = (unsigned)TOPK, cnt_eq = 0u; v4u qnext = {0u, 0u, 0u, 0u};
        const LAS unsigned* const hq_c = hist + q * HSTR; LAS unsigned* const hq = (LAS unsigned*)hq_c;
        LAS unsigned* const lcnt = (LAS unsigned*)(L + TBASE_OFF);
        LAS unsigned* const lstk = (LAS unsigned*)(L + TBASE_OFF + 64), * const lsti = lstk + 256;
        constexpr unsigned LCAP = 16;
        if (tid < 16) lcnt[tid] = 0u;
        auto radix = [&]<int pass>() __attribute__((always_inline)) {
            constexpr int pshift = (pass == 1) ? 21 : 10;
            if (pass != 0) {
                TK_BAR();
                for (int i = tid; i < 16 * HSTR / 4; i += NWAVES * 64) ((LAS v4u*)hist)[i] = (v4u){0u, 0u, 0u, 0u};
                TK_BAR();
                auto pslot = [&]<int i>() __attribute__((always_inline)) {
#pragma unroll
                    for (int r = 0; r < 4; ++r) {
                        const unsigned k = key[i][r];
                        const unsigned word = (pass == 1) ? ((k >> 11) & 1023u) : ((k >> 1) & 511u);
                        const unsigned inc = (k & ((pass == 1) ? 0x400u : 1u)) ? 0x10000u : 1u;
                        __hip_atomic_fetch_add(hq + word, ((k >> pshift) == prefix) ? inc : 0u, __ATOMIC_RELAXED, __HIP_MEMORY_SCOPE_WORKGROUP);
                    }
                };
                TK_SLOTS(pslot);
            }
            TK_BAR();
            { const unsigned r0 = (unsigned)__builtin_amdgcn_readlane((int)rnk, 2 * wave), r1 = (unsigned)__builtin_amdgcn_readlane((int)rnk, 2 * wave + 1);
              if (pass < 2) { scan_query<16>(hist + (2 * wave) * HSTR, res, 2 * wave, r0, lane); scan_query<16>(hist + (2 * wave + 1) * HSTR, res, 2 * wave + 1, r1, lane); }
              else { scan_query<8>(hist + (2 * wave) * HSTR, res, 2 * wave, r0, lane); scan_query<8>(hist + (2 * wave + 1) * HSTR, res, 2 * wave + 1, r1, lane); } }
            TK_BAR();
            prefix = (prefix << ((pass == 2) ? 10 : 11)) | res[q]; rnk = res[16 + q]; cnt_eq = res[32 + q];
        };
        radix.template operator()<0>();
        const unsigned prefix0 = prefix, rnk0 = rnk;
        if (PV != 5) {
            if (ntq0 >= TOPK) qnext = tk_load_q(QI, nb, ntq0, lane, wave);
            LAS unsigned* const hb = (LAS unsigned*)(L + HB_OFF) + q * HBSTR;
            auto bslot = [&]<int i>() __attribute__((always_inline)) {
#pragma unroll
                for (int r = 0; r < 4; ++r) {
                    const unsigned k = key[i][r];
                    __hip_atomic_fetch_add(hb + ((k >> 13) & 255u), ((k >> 21) == prefix) ? ((k & 0x1000u) ? 0x10000u : 1u) : 0u, __ATOMIC_RELAXED, __HIP_MEMORY_SCOPE_WORKGROUP);
                }
            };
            TK_SLOTS(bslot);
            TK_BAR();
            { const unsigned r0 = (unsigned)__builtin_amdgcn_readlane((int)rnk, 2 * wave), r1 = (unsigned)__builtin_amdgcn_readlane((int)rnk, 2 * wave + 1);
              scan_query<4>((LAS unsigned*)(L + HB_OFF) + (2 * wave) * HBSTR, res, 2 * wave, r0, lane); scan_query<4>((LAS unsigned*)(L + HB_OFF) + (2 * wave + 1) * HBSTR, res, 2 * wave + 1, r1, lane); }
            TK_BAR();
            prefix = (prefix << 9) | res[q]; rnk = res[16 + q]; cnt_eq = res[32 + q];
        }
        const bool amb = rnk != cnt_eq;
        const bool fb = (PV == 20 || PV == 21) ? true : (PV == 5 || PV == 6) ? false : __any(amb && cnt_eq > LCAP);
        if (!fb) {
            const unsigned base = prefix << 12, Tsel = amb ? base + 4096u : base, clim = amb ? 4096u : 0u;
            LAS unsigned short* const ms16_q = mstg + (ln & 15) * MROW + wave; const unsigned sh4 = 4u * (unsigned)(ln >> 4);
            unsigned idx0 = ((unsigned)wave << 4) + 4u * (unsigned)(ln >> 4);
            asm volatile("" : "+v"(idx0));
            auto fslot = [&]<int i>() __attribute__((always_inline)) {
                unsigned nib = 0;
#pragma unroll
                for (int r = 3; r >= 0; --r) nib = nib + nib + ((key[i][r] >= Tsel) ? 1u : 0u);
                unsigned m16 = nib << sh4;
                { auto sw = __builtin_amdgcn_permlane16_swap(m16, m16, false, false); m16 = sw[0] | sw[1]; }
                { auto sw = __builtin_amdgcn_permlane32_swap(m16, m16, false, false); m16 = sw[0] | sw[1]; }
                if (ln < 16) ms16_q[8 * i] = (unsigned short)m16;
                const unsigned t0 = key[i][0] - base, t1 = key[i][1] - base, t2 = key[i][2] - base, t3 = key[i][3] - base;
                const unsigned ta = t0 < t1 ? t0 : t1, tb = t2 < t3 ? t2 : t3, tm = ta < tb ? ta : tb;
                if (__builtin_expect(tm < clim, 0)) {
#pragma unroll
                    for (int r = 0; r < 4; ++r) {
                        const unsigned k = key[i][r];
                        if (k - base < clim) { const unsigned pos = __hip_atomic_fetch_add(lcnt + q, 1u, __ATOMIC_RELAXED, __HIP_MEMORY_SCOPE_WORKGROUP);
                            lstk[q * LCAP + (pos & (LCAP - 1))] = k; lsti[q * LCAP + (pos & (LCAP - 1))] = ~(idx0 + 128u * i + r); }
                    }
                }
            };
            TK_SLOTS(fslot);
            TK_BAR();
#pragma unroll
            for (int s2 = 0; s2 < 2; ++s2) {
                const int qq = 2 * wave + s2;
                const unsigned n = (unsigned)__builtin_amdgcn_readfirstlane((int)lcnt[qq]), rq = (unsigned)__builtin_amdgcn_readlane((int)rnk, qq);
                const unsigned mk = lstk[qq * LCAP + (lane & (LCAP - 1))], mi = lsti[qq * LCAP + (lane & (LCAP - 1))];
                unsigned better = 0;
                for (unsigned e = 0; e < n; ++e) { const unsigned ek = lstk[qq * LCAP + e], ei = lsti[qq * LCAP + e]; better += (ek > mk || (ek == mk && ei > mi)) ? 1u : 0u; }
                if ((unsigned)lane < n && better < rq) {
                    const unsigned idx = ~mi, j = idx >> 4;
                    __hip_atomic_fetch_or((LAS unsigned*)mstg + ((qq * MROW + j) >> 1), 1u << (16u * (j & 1u) + (idx & 15u)), __ATOMIC_RELAXED, __HIP_MEMORY_SCOPE_WORKGROUP);
                }
            }
        } else {
        prefix = prefix0; rnk = rnk0;
        radix.template operator()<1>();
        radix.template operator()<2>();
        const unsigned T = prefix, need = rnk;
        const bool slow = __any(need != cnt_eq);
        if (slow) {
            for (int i = tid; i < 16384 / 16; i += NWAVES * 64) ((LAS v4u*)tcnt)[i] = (v4u){0u, 0u, 0u, 0u};
            TK_BAR();
#pragma unroll
            for (int i = 0; i < 32; ++i) {
                if (8 * i <= jw) {
                    unsigned c = 0;
#pragma unroll
                    for (int r = 0; r < 4; ++r) c += (key[i][r] == T) ? 1u : 0u;
                    if (c) __hip_atomic_fetch_add(tc_q + 8 * i, c << (8 * g), __ATOMIC_RELAXED, __HIP_MEMORY_SCOPE_WORKGROUP);
                }
            }
            TK_BAR();
#pragma unroll
            for (int s = 0; s < 2; ++s) {
                const int qq = 2 * wave + s; unsigned tt[4], tot = 0;
#pragma unroll
                for (int x = 0; x < 4; ++x) { const unsigned e = tcnt[qq * 256 + lane * 4 + x]; tt[x] = (e & 255u) + ((e >> 8) & 255u) + ((e >> 16) & 255u) + (e >> 24); tot += tt[x]; }
                const unsigned incl = wave_prefix_incl(tot);
                unsigned base = incl - tot;
#pragma unroll
                for (int x = 0; x < 4; ++x) { tbase[qq * 256 + lane * 4 + x] = (unsigned short)base; base += tt[x]; }
            }
            TK_BAR();
        }
#pragma unroll
        for (int i = 0; i < 32; ++i) {
            if (8 * i > jw) continue;
            unsigned nib = 0;
            if (!slow) {
#pragma unroll
                for (int r = 0; r < 4; ++r) nib |= (key[i][r] >= T) ? (1u << r) : 0u;
            } else {
                const unsigned e = tc_q[8 * i]; unsigned rank = tb_q[8 * i];
                if (g > 0) rank += e & 255u; if (g > 1) rank += (e >> 8) & 255u; if (g > 2) rank += (e >> 16) & 255u;
#pragma unroll
                for (int r = 0; r < 4; ++r) { const unsigned k = key[i][r];
                    if (k > T) nib |= 1u << r; else if (k == T && k != 0u) { if (rank < need) nib |= 1u << r; ++rank; } }
            }
            __hip_atomic_fetch_or(ms32_q + 4 * i, nib << sh_q, __ATOMIC_RELAXED, __HIP_MEMORY_SCOPE_WORKGROUP);
        }
        }
        if (ntq0 >= TOPK) tk_store_q(L, qnext, lane, wave);
        }
    }
    TK_BAR();
    if (PV == 0 || PV == 5 || PV == 6 || PV == 13 || PV == 14 || PV == 20 || PV == 21)
    for (int idx = tid; idx < 1024; idx += NWAVES * 64) {
        const int qq = idx & 15, t64 = idx >> 4;
        const u64 wd = *(const LAS u64*)(mstg + qq * MROW + t64 * 4);
        MASK[((size_t)b * 64 + t64) * S + tq0 + qq] = wd;
    }
    TK_BAR();
}

__device__ __forceinline__ void gating_block(LAS unsigned char* L, const bf16_t* __restrict__ QO, const float* __restrict__ KMEAN, unsigned* __restrict__ BMASK, int blk64, int tid) {
    using namespace K;
    const int row0 = 64 * blk64, b = row0 / S;
    LAS float* km = (LAS float*)L;
    const int r = tid >> 3, h = tid & 7, row = row0 + r, t = row % S, own = t / MBLK;
    uint4 qraw[8];
#pragma unroll
    for (int x = 0; x < 8; ++x) qraw[x] = *(const uint4*)(QO + (size_t)row * 1024 + 512 + h * 64 + 8 * x);
    for (int i = tid; i < 16 * 8 * 64; i += NWAVES * 64) { const int n = i >> 9, hh = (i >> 6) & 7, d = i & 63; km[(n * 8 + hh) * 68 + d] = KMEAN[((size_t)(b * 16 + n) * 8 + hh) * 64 + d]; }
    TK_BAR();
    float qv[64];
#pragma unroll
    for (int x = 0; x < 8; ++x) { const uint4 u = qraw[x];
        qv[8 * x + 0] = __uint_as_float(u.x << 16); qv[8 * x + 1] = __uint_as_float(u.x & 0xffff0000u); qv[8 * x + 2] = __uint_as_float(u.y << 16); qv[8 * x + 3] = __uint_as_float(u.y & 0xffff0000u);
        qv[8 * x + 4] = __uint_as_float(u.z << 16); qv[8 * x + 5] = __uint_as_float(u.z & 0xffff0000u); qv[8 * x + 6] = __uint_as_float(u.w << 16); qv[8 * x + 7] = __uint_as_float(u.w & 0xffff0000u); }
    float b0 = -INFINITY, b1 = -INFINITY, b2 = -INFINITY; int i0 = -1, i1 = -1, i2 = -1;
    for (int n = 0; n < own; ++n) {
        const LAS f32x4* kp = (const LAS f32x4*)(km + (n * 8 + h) * 68); float gs = 0.f;
#pragma unroll
        for (int d4 = 0; d4 < 16; ++d4) { const f32x4 kv = kp[d4]; gs = __builtin_fmaf(qv[4 * d4], kv[0], gs); gs = __builtin_fmaf(qv[4 * d4 + 1], kv[1], gs); gs = __builtin_fmaf(qv[4 * d4 + 2], kv[2], gs); gs = __builtin_fmaf(qv[4 * d4 + 3], kv[3], gs); }
        if (gs > b0) { b2 = b1; i2 = i1; b1 = b0; i1 = i0; b0 = gs; i0 = n; }
        else if (gs > b1) { b2 = b1; i2 = i1; b1 = gs; i1 = n; }
        else if (gs > b2) { b2 = gs; i2 = n; }
    }
    unsigned bm = 1u << own;
    if (i0 >= 0) bm |= 1u << i0; if (i1 >= 0) bm |= 1u << i1; if (i2 >= 0) bm |= 1u << i2;
    BMASK[(size_t)row * 8 + h] = bm;
    TK_BAR();
}
#undef TK_BAR
}
namespace attn_body {
using bf16=__hip_bfloat16;
using bf16x8=__attribute__((ext_vector_type(8)))short;
using s16x4=__attribute__((ext_vector_type(4)))short;
using f32x16=__attribute__((ext_vector_type(16)))float;
using u32x4=__attribute__((ext_vector_type(4)))unsigned;
constexpr int BATCH=4,NHEAD=16,SEQ=4096,D=64,DM=NHEAD*D;
constexpr int NW=8,QBLK=32,QB=QBLK*NW,KVBLK=64,NQB=SEQ/QB;
constexpr int ATTN_PITCH=DM, ATTN_UNIT_ROWS=QB;
__device__ __forceinline__ int crow(int r,int hi){return (r&3)+8*(r>>2)+4*hi;}
#define SBAR() __builtin_amdgcn_sched_barrier(0)
typedef __attribute__((address_space(3))) const float* lds_fptr;
__device__ __forceinline__ void addbias(f32x16&p0,f32x16&p1,int jb6,int qrel,int hi,lds_fptr bt){
  const lds_fptr b=bt+(qrel+128-64*jb6-4*hi+197);
  #pragma unroll
  for(int r=0;r<16;++r){const int c=(r&3)+8*(r>>2); p0[r]+=b[59-c]; p1[r]+=b[27-c];}
}

constexpr int BT_N=640;
constexpr int NSLOT=3, SLOTB=8192;
#define EXM(p,w) do{ if(MOBA) asm volatile("v_sub_f32 %0, %0, %2\n\tv_exp_f32 %0, %0\n\tv_add_co_u32 %1, vcc, %1, %1\n\tv_cndmask_b32 %0, 0, %0, vcc":"+v"(p),"+v"(w):"v"(mhat):"vcc"); \
  else asm volatile("v_exp_f32 %0, %0\n\tv_add_co_u32 %1, vcc, %1, %1\n\tv_cndmask_b32 %0, 0, %0, vcc":"+v"(p),"+v"(w)::"vcc"); }while(0)
#define EXS(p,mh) asm volatile("v_sub_f32 %0, %0, %1\n\tv_exp_f32 %0, %0\n\ts_nop 0":"+v"(p):"v"(mh))
#define EXM16(P,w) do{ EXM(P[15],w);EXM(P[14],w);EXM(P[13],w);EXM(P[12],w); w<<=4; EXM(P[11],w);EXM(P[10],w);EXM(P[9],w);EXM(P[8],w); w<<=4; EXM(P[7],w);EXM(P[6],w);EXM(P[5],w);EXM(P[4],w); w<<=4; EXM(P[3],w);EXM(P[2],w);EXM(P[1],w);EXM(P[0],w); }while(0)
__device__ __forceinline__ int cbit(int r){return (r&3)+8*(r>>2);}
constexpr int LDS_K=0, LDS_V=NSLOT*SLOTB, LDS_WS=2*NSLOT*SLOTB, LDS_OST=LDS_WS+NW*64*4, LDS_BT=LDS_OST+NW*4096, LDS_BYTES=LDS_BT+BT_N*4;
constexpr float C2=0.125f*1.4426950408889634f;
__device__ __forceinline__ void glds16(const void*gsrc,unsigned lds_dst){unsigned keep;
  asm volatile("s_mov_b32 %0, m0\n\ts_mov_b32 m0, %2\n\ts_nop 0\n\tglobal_load_lds_dwordx4 %1, off\n\ts_mov_b32 m0, %0":"=&s"(keep):"v"(gsrc),"s"(lds_dst):"memory");}
__device__ __forceinline__ float max3f(float a,float b,float c){float r;asm("v_max3_f32 %0, %1, %2, %3":"=v"(r):"v"(a),"v"(b),"v"(c));return r;}
__device__ __forceinline__ float max2f(float a,float b){float r;asm("v_max_f32_e32 %0, %1, %2":"=v"(r):"v"(a),"v"(b));return r;}
__device__ __forceinline__ float fadd_s(float a,float b){float r;asm("v_add_f32_e32 %0, %1, %2":"=v"(r):"v"(a),"v"(b));return r;}
__device__ __forceinline__ float fsub_s(float a,float b){float r;asm("v_sub_f32_e32 %0, %1, %2":"=v"(r):"v"(a),"v"(b));return r;}
typedef float f32x2_t __attribute__((ext_vector_type(2))); typedef __bf16 bf16x2_t __attribute__((ext_vector_type(2)));
__device__ __forceinline__ unsigned cvtpk_s(float lo,float hi){f32x2_t v={lo,hi};bf16x2_t b=__builtin_convertvector(v,bf16x2_t);return __builtin_bit_cast(unsigned,b);}
#define WAIT_BAR(N) asm volatile("s_waitcnt vmcnt(" #N ") lgkmcnt(0)\n\ts_barrier":::"memory")

__device__ __forceinline__ void qkt(f32x16&p0,f32x16&p1,const char*Kslot,const bf16x8*qr,const f32x16&c0,int r32,int hi){
  const char*kb=Kslot+hi*1024+r32*16;
  #pragma unroll
  for(int d0=0;d0<4;++d0){
    const bf16x8 b0=*reinterpret_cast<const bf16x8*>(kb+d0*2048);
    const bf16x8 b1=*reinterpret_cast<const bf16x8*>(kb+d0*2048+512);
    if(d0==0){p0=__builtin_amdgcn_mfma_f32_32x32x16_bf16(b0,qr[0],c0,0,0,0);p1=__builtin_amdgcn_mfma_f32_32x32x16_bf16(b1,qr[0],c0,0,0,0);}
    else{p0=__builtin_amdgcn_mfma_f32_32x32x16_bf16(b0,qr[d0],p0,0,0,0);p1=__builtin_amdgcn_mfma_f32_32x32x16_bf16(b1,qr[d0],p1,0,0,0);}}
}
typedef __attribute__((address_space(3))) const char* lds_cptr;
typedef short v4i16_t __attribute__((ext_vector_type(4)));
__device__ __forceinline__ void kload8(bf16x8*kf,lds_cptr kp){
  kf[0]=*(const __attribute__((address_space(3))) bf16x8*)(kp);      kf[1]=*(const __attribute__((address_space(3))) bf16x8*)(kp+512);
  kf[2]=*(const __attribute__((address_space(3))) bf16x8*)(kp+2048); kf[3]=*(const __attribute__((address_space(3))) bf16x8*)(kp+2560);
  kf[4]=*(const __attribute__((address_space(3))) bf16x8*)(kp+4096); kf[5]=*(const __attribute__((address_space(3))) bf16x8*)(kp+4608);
  kf[6]=*(const __attribute__((address_space(3))) bf16x8*)(kp+6144); kf[7]=*(const __attribute__((address_space(3))) bf16x8*)(kp+6656);
}
__device__ __forceinline__ void kload2(bf16x8*kf,lds_cptr kp,int j){ kf[2*j]=*(const __attribute__((address_space(3))) bf16x8*)(kp+j*2048); kf[2*j+1]=*(const __attribute__((address_space(3))) bf16x8*)(kp+j*2048+512); }
__device__ __forceinline__ s16x4 vtr(lds_cptr p){ return __builtin_bit_cast(s16x4,__builtin_amdgcn_ds_read_tr16_b64_v4i16((__attribute__((address_space(3))) v4i16_t*)p)); }
__device__ __forceinline__ float rowmax(const f32x16&p0,const f32x16&p1){
  float a=max3f(p0[0],p0[1],p1[0]),b=max3f(p0[2],p0[3],p1[1]);a=max3f(a,p1[2],p1[3]);
  #pragma unroll
  for(int r=4;r<16;r+=4){a=max3f(a,p0[r],p0[r+1]);b=max3f(b,p0[r+2],p0[r+3]);a=max3f(a,p1[r],p1[r+1]);b=max3f(b,p1[r+2],p1[r+3]);}
  const float m=max2f(a,b);
  auto rr=__builtin_amdgcn_permlane32_swap(__float_as_uint(m),__float_as_uint(m),false,false);
  return max2f(__uint_as_float(rr[0]),__uint_as_float(rr[1]));
}
__device__ __forceinline__ void pv(f32x16*o,int vb,bf16x8 pa0,bf16x8 pa1,bf16x8 pa2,bf16x8 pa3){
  #pragma unroll
  for(int d0=0;d0<2;++d0){s16x4 lo[4],hi[4];
    #pragma unroll
    for(int ks=0;ks<4;++ks){
      asm volatile("ds_read_b64_tr_b16 %0,%1 offset:%c2":"=&v"(lo[ks]):"v"(vb),"i"(d0*4096+ks*1024):"memory");
      asm volatile("ds_read_b64_tr_b16 %0,%1 offset:%c2":"=&v"(hi[ks]):"v"(vb),"i"(d0*4096+ks*1024+512):"memory");}
    asm volatile("s_waitcnt lgkmcnt(0)":::"memory");SBAR();
    #define PK(k) (bf16x8){lo[k][0],lo[k][1],lo[k][2],lo[k][3],hi[k][0],hi[k][1],hi[k][2],hi[k][3]}
    o[d0]=__builtin_amdgcn_mfma_f32_32x32x16_bf16(pa0,PK(0),o[d0],0,0,0);
    o[d0]=__builtin_amdgcn_mfma_f32_32x32x16_bf16(pa1,PK(1),o[d0],0,0,0);
    o[d0]=__builtin_amdgcn_mfma_f32_32x32x16_bf16(pa2,PK(2),o[d0],0,0,0);
    o[d0]=__builtin_amdgcn_mfma_f32_32x32x16_bf16(pa3,PK(3),o[d0],0,0,0);
    #undef PK
  }
}

#ifndef ATTN_STORE16
#define ATTN_STORE16(p,v) (*(u32x4*)(p)=(v))
#endif
template<int THRL,bool MOBA> __device__ __forceinline__ void attn_unit(int b,int h,int qb,const bf16*Q,const bf16*__restrict__ K,const bf16*__restrict__ V,bf16*O,const unsigned long long*__restrict__ MASKW,const unsigned*__restrict__ BMASK,const float*__restrict__ relb,const float*__restrict__ gq,const float*__restrict__ gk,char*shm){
  int tid_=threadIdx.x; asm volatile("":"+v"(tid_)); const int tid=tid_,lane=tid&63,r32=lane&31,hi=lane>>5; const int wid=__builtin_amdgcn_readfirstlane(tid>>6);
  const long rowbase=(long)b*SEQ; const int q0=qb*QB;
  const bf16*Qw=Q+(rowbase+q0+wid*QBLK)*DM+h*D;
  const bf16*Kh=K+rowbase*DM+h*D,*Vh=V+rowbase*DM+h*D;
  const unsigned lds0=(unsigned)(uintptr_t)shm;
  float*wsf=(float*)(shm+LDS_WS)+wid*64;
  const bf16*ksrc=Kh+(long)lane*DM+wid*8;
  const bf16*vsrc=Vh+(long)(16*(wid&3)+(lane>>2))*DM+(wid>>2)*32+(lane&3)*8;
  const unsigned kdst=lds0+LDS_K+wid*1024, vdst=lds0+LDS_V+wid*1024;
  #define DMA_K(t,slot) glds16(ksrc+(long)(t)*KVBLK*DM,(unsigned)__builtin_amdgcn_readfirstlane(kdst+(slot)))
  #define DMA_V(t,slot) glds16(vsrc+(long)(t)*KVBLK*DM,(unsigned)__builtin_amdgcn_readfirstlane(vdst+(slot)))
  const int vb0=(int)(lds0+LDS_V)+((lane>>4)&1)*32+(lane&3)*8+(4*hi+((lane&15)>>2))*64;
  const char*Kbase=shm+LDS_K; bf16x8 kf[8];
  const lds_cptr shm3=(lds_cptr)shm; const lds_cptr kp0=shm3+LDS_K+hi*1024+r32*16; const lds_cptr vp0=shm3+LDS_V+((lane>>4)&1)*32+(lane&3)*8+(4*hi+((lane&15)>>2))*64;
  const int NT=(q0+QB)/KVBLK;
  const int qrel=wid*QBLK+r32; constexpr bool moba=MOBA;
  const lds_fptr bt=(lds_fptr)(shm3+LDS_BT);
  unsigned bm=0u;
  const unsigned mvoff=(unsigned)(q0+qrel)*8u; unsigned long long mraw=0ull; unsigned mlo=0u,mhi=0u;
  #define MLOAD(tt) do{ if(!moba&&(tt)<NT){ const unsigned long long*mb_=MASKW+((size_t)(b*64+(tt)))*SEQ; \
      asm volatile("s_nop 4\n\tglobal_load_dwordx2 %0, %1, %2":"=v"(mraw):"v"(mvoff),"s"(mb_):"memory"); } }while(0)
  #define MSET(tt) do{ if(!moba){ asm volatile("":"+v"(mraw)); mlo=(unsigned)mraw<<(4-4*hi); mhi=(unsigned)(mraw>>32)<<(4-4*hi); } \
      else{ unsigned wl=((bm>>((tt)>>2))&1u)?0xffffffffu:0u, wh=wl; const int jb_=(tt)-(NT-4); \
        if(jb_>=0){ const int n=qrel-64*jb_, n2=n-32; wl&=(n<0)?0u:((n>=31)?0xffffffffu:((2u<<n)-1u)); wh&=(n2<0)?0u:((n2>=31)?0xffffffffu:((2u<<n2)-1u)); } \
        mlo=wl<<(4-4*hi); mhi=wh<<(4-4*hi); } }while(0)
  MLOAD(0);
  DMA_K(0,0);DMA_V(0,0);DMA_K(1,SLOTB);
  bf16x8 qr[4];
  #pragma unroll
  for(int d0=0;d0<4;++d0)qr[d0]=*reinterpret_cast<const bf16x8*>(&Qw[(long)r32*DM+d0*16+hi*8]);
  if(moba)bm=BMASK[(size_t)(rowbase+q0+qrel)*8+(h-8)];
  { __attribute__((address_space(3))) float*btw=(__attribute__((address_space(3))) float*)(shm3+LDS_BT); const float b31=relb[31*16+h];
    for(int i=tid;i<BT_N;i+=NW*64){ const int d=i-256; btw[i]=(d>=0&&d<=112)?(relb[t5_bucket(d)*16+h]-b31)*1.4426950408889634f:0.f; } }
  constexpr float mhat=16.0f; float l_reg=0.f;f32x16 o[2];o[0]=f32x16{};o[1]=f32x16{}; f32x16 negm=f32x16{}; (void)gq; (void)gk;
  if(!MOBA){ _Pragma("unroll") for(int r=0;r<16;++r)negm[r]=-mhat; asm volatile("":"+v"(negm)); }
  #define CMASK(P0,P1,t) do{int jb_=(t)-(NT-6); if(jb_>=0)addbias(P0,P1,jb_,qrel,hi,bt);}while(0)
  #define START(P0,P1) do{ EXM16(P0,mlo); }while(0)
  #define RESC() do{}while(0)
  f32x16 pA0,pA1,pB0,pB1;
  int sl_prev=0,sl_cur=0,sl_next=SLOTB;
  #define ROT() do{sl_prev=sl_cur;sl_cur=sl_next;sl_next=(sl_next==(NSLOT-1)*SLOTB)?0:sl_next+SLOTB;}while(0)
  DMA_K(2,2*SLOTB);
  WAIT_BAR(3);
  MSET(0); MLOAD(1);
  qkt(pA0,pA1,Kbase,qr,(MOBA?f32x16{}:negm),r32,hi);asm volatile("s_nop 15\n\ts_nop 7":"+v"(pA0),"+v"(pA1));CMASK(pA0,pA1,0);
  START(pA0,pA1);
  EXM16(pA1,mhi);
  WAIT_BAR(0);
  MSET(1);
  DMA_K(3,0);DMA_V(1,SLOTB);
  ROT();
  kload8(kf,kp0+sl_cur);
  WAIT_BAR(2);
  s16x4 vlo[8],vhi[8]; u32x4 pw0,pw1,pw2,pw3;
  #define PKW(P,B) cvtpk_s(P[B],P[B+1])
  #define PAF(k) __builtin_bit_cast(bf16x8,pw##k)
  #define VFR(i) (bf16x8){vlo[i][0],vlo[i][1],vlo[i][2],vlo[i][3],vhi[i][0],vhi[i][1],vhi[i][2],vhi[i][3]}
  #define PIN(x) asm volatile("":"+v"(x))
  #define MX3(a,b,c) __builtin_fmaxf(__builtin_fmaxf((a),(b)),(c))
  #define GAPA(MF,A0,A1,A2,A3,W0,W1,PW) do{ MF; sacc+=A0; sacc+=A1; sacc+=A2; sacc+=A3; PIN(sacc); W0; W1; PIN(PW); SBAR(); }while(0)
  #define EX(v) __builtin_amdgcn_exp2f(v)
  #define GAPB(MF,X,B,MW,CH) do{ MF; if(CH){ EXS(X[B+3],mh_); EXS(X[B+2],mh_); EXS(X[B+1],mh_); EXS(X[B],mh_); } else { EXM(X[B+3],MW); EXM(X[B+2],MW); EXM(X[B+1],MW); EXM(X[B],MW); if((B)>0)MW<<=4; } PIN(X); SBAR(); }while(0)
  #define VRD(i) do{ vlo[i]=vtr(vp_+(((i)>>2)*4096+((i)&3)*1024)); vhi[i]=vtr(vp_+(((i)>>2)*4096+((i)&3)*1024+512)); }while(0)
  #define KRD(G,j) do{ if(G){ kload2(kf,kp0+sl_next,j); SBAR(); } }while(0)
  #define STEP(C0,C1,P0,P1,t,GK,GV,GL,CH) do{ SBAR(); \
    const lds_cptr vp_=vp0+sl_prev; \
    VRD(0); SBAR(); float sacc=(P0[0]+P0[1]); \
    GAPA(C0=__builtin_amdgcn_mfma_f32_32x32x16_bf16(kf[0],qr[0],(MOBA?f32x16{}:negm),0,0,0), P0[2],P0[3],P0[4],P0[5],     pw0[0]=PKW(P0,0), pw0[1]=PKW(P0,2), pw0); \
    VRD(4); SBAR(); GAPA(C1=__builtin_amdgcn_mfma_f32_32x32x16_bf16(kf[1],qr[0],(MOBA?f32x16{}:negm),0,0,0), P0[6],P0[7],P0[8],P0[9],     pw0[2]=PKW(P0,4), pw0[3]=PKW(P0,6), pw0); \
    VRD(1); SBAR(); GAPA(C0=__builtin_amdgcn_mfma_f32_32x32x16_bf16(kf[2],qr[1],C0,0,0,0),   P0[10],P0[11],P0[12],P0[13], pw1[0]=PKW(P0,8), pw1[1]=PKW(P0,10), pw1); \
    VRD(5); SBAR(); GAPA(C1=__builtin_amdgcn_mfma_f32_32x32x16_bf16(kf[3],qr[1],C1,0,0,0),   P0[14],P0[15],P1[0],P1[1],   pw1[2]=PKW(P0,12),pw1[3]=PKW(P0,14), pw1); \
    VRD(2); SBAR(); GAPA(C0=__builtin_amdgcn_mfma_f32_32x32x16_bf16(kf[4],qr[2],C0,0,0,0),   P1[2],P1[3],P1[4],P1[5],     pw2[0]=PKW(P1,0), pw2[1]=PKW(P1,2), pw2); \
    VRD(6); SBAR(); GAPA(C1=__builtin_amdgcn_mfma_f32_32x32x16_bf16(kf[5],qr[2],C1,0,0,0),   P1[6],P1[7],P1[8],P1[9],     pw2[2]=PKW(P1,4), pw2[3]=PKW(P1,6), pw2); \
    VRD(3); SBAR(); GAPA(C0=__builtin_amdgcn_mfma_f32_32x32x16_bf16(kf[6],qr[3],C0,0,0,0),   P1[10],P1[11],P1[12],P1[13], pw3[0]=PKW(P1,8), pw3[1]=PKW(P1,10), pw3); \
    VRD(7); SBAR(); GAPA(C1=__builtin_amdgcn_mfma_f32_32x32x16_bf16(kf[7],qr[3],C1,0,0,0),   P1[14],P1[15],0.f,0.f,       pw3[2]=PKW(P1,12),pw3[3]=PKW(P1,14), pw3); \
    l_reg+=sacc; \
    if(GK){DMA_K((t)+3,sl_cur);} if(GV){DMA_V((t)+1,sl_next);} \
    CMASK(C0,C1,t); \
    const float mh_=(CH)?((mlo!=0u)?mhat:__builtin_inff()):0.f; (void)mh_; \
    SBAR(); \
    GAPB(o[0]=__builtin_amdgcn_mfma_f32_32x32x16_bf16(PAF(0),VFR(0),o[0],0,0,0), C0,12,mlo,CH); \
    GAPB(o[1]=__builtin_amdgcn_mfma_f32_32x32x16_bf16(PAF(0),VFR(4),o[1],0,0,0), C0,8,mlo,CH); \
    KRD(GL,0); GAPB(o[0]=__builtin_amdgcn_mfma_f32_32x32x16_bf16(PAF(1),VFR(1),o[0],0,0,0), C0,4,mlo,CH); \
    KRD(GL,1); GAPB(o[1]=__builtin_amdgcn_mfma_f32_32x32x16_bf16(PAF(1),VFR(5),o[1],0,0,0), C0,0,mlo,CH); \
    KRD(GL,2); GAPB(o[0]=__builtin_amdgcn_mfma_f32_32x32x16_bf16(PAF(2),VFR(2),o[0],0,0,0), C1,12,mhi,CH); \
    KRD(GL,3); GAPB(o[1]=__builtin_amdgcn_mfma_f32_32x32x16_bf16(PAF(2),VFR(6),o[1],0,0,0), C1,8,mhi,CH); \
    GAPB(o[0]=__builtin_amdgcn_mfma_f32_32x32x16_bf16(PAF(3),VFR(3),o[0],0,0,0), C1,4,mhi,CH); \
    GAPB(o[1]=__builtin_amdgcn_mfma_f32_32x32x16_bf16(PAF(3),VFR(7),o[1],0,0,0), C1,0,mhi,CH); \
    }while(0)
  int t=1;
  #undef CMASK
  #define CMASK(P0,P1,t) do{}while(0)
  for(;t+7<NT;t+=2){
    MLOAD(t+1); STEP(pB0,pB1,pA0,pA1,t,true,true,true,MOBA);     WAIT_BAR(2); RESC(); ROT(); MSET(t+1);
    MLOAD(t+2); STEP(pA0,pA1,pB0,pB1,t+1,true,true,true,MOBA);   WAIT_BAR(2); RESC(); ROT(); MSET(t+2);
  }
  #undef CMASK
  #define CMASK(P0,P1,t) do{int jb_=(t)-(NT-6); if(jb_>=0)addbias(P0,P1,jb_,qrel,hi,bt);}while(0)
  #define ENDW(tt) do{ if((tt)+3<NT){WAIT_BAR(2);} else if((tt)+2<NT){WAIT_BAR(1);} else {WAIT_BAR(0);} }while(0)
  for(;t+1<NT;t+=2){
    MLOAD(t+1); STEP(pB0,pB1,pA0,pA1,t,(t+3<NT),(t+1<NT),(t+1<NT),0);       ENDW(t);   RESC(); ROT(); MSET(t+1);
    MLOAD(t+2); STEP(pA0,pA1,pB0,pB1,t+1,(t+4<NT),(t+2<NT),(t+2<NT),0);     ENDW(t+1); RESC(); ROT(); MSET(t+2);
  }
  STEP(pB0,pB1,pA0,pA1,NT-1,false,false,false,0); RESC();
  { float sacc=pB0[0]+pB0[1]; _Pragma("unroll") for(int r=2;r<16;++r)sacc+=pB0[r]; _Pragma("unroll") for(int r=0;r<16;++r)sacc+=pB1[r]; l_reg+=sacc;
    pw0=(u32x4){PKW(pB0,0),PKW(pB0,2),PKW(pB0,4),PKW(pB0,6)};pw1=(u32x4){PKW(pB0,8),PKW(pB0,10),PKW(pB0,12),PKW(pB0,14)};pw2=(u32x4){PKW(pB1,0),PKW(pB1,2),PKW(pB1,4),PKW(pB1,6)};pw3=(u32x4){PKW(pB1,8),PKW(pB1,10),PKW(pB1,12),PKW(pB1,14)};
    SBAR(); pv(o,vb0+sl_cur,PAF(0),PAF(1),PAF(2),PAF(3)); }
  #undef PKW
  #undef PAF
  #undef VFR
  #undef PIN
  #undef MX3
  #undef GAPA
  #undef GAPB
  #undef EX
  #undef VRD
  #undef KRD
  #undef STEP
  #undef ENDW
  {auto rr=__builtin_amdgcn_permlane32_swap(__float_as_uint(l_reg),__float_as_uint(l_reg),false,false);l_reg=__uint_as_float(rr[0])+__uint_as_float(rr[1]);}
  if(hi==0)wsf[32+r32]=l_reg;asm volatile("s_waitcnt lgkmcnt(0)":::"memory");
  float rli[16];
  #pragma unroll
  for(int r=0;r<16;++r)rli[r]=__builtin_amdgcn_rcpf(wsf[32+crow(r,hi)]);
  bf16*Ow=O+(rowbase+q0+wid*QBLK)*DM+h*D;
  { bf16*stg=(bf16*)(shm+LDS_OST)+wid*2048;
    #pragma unroll
    for(int r=0;r<16;++r){const int orow=crow(r,hi);
      #pragma unroll
      for(int d0=0;d0<2;++d0)stg[orow*64+d0*32+r32]=__float2bfloat16(o[d0][r]*rli[r]);}
    asm volatile("s_waitcnt lgkmcnt(0)":::"memory");
    #pragma unroll
    for(int i=0;i<4;++i){const int row=i*8+(lane>>3),ch=lane&7; const u32x4 v=*(const u32x4*)(stg+row*64+ch*8); ATTN_STORE16(Ow+(long)row*DM+ch*8,v);} }
  asm volatile("s_waitcnt lgkmcnt(0)\n\ts_barrier":::"memory");
  #undef MLOAD
  #undef MSET
  #undef DMA_K
  #undef DMA_V
  #undef CMASK
  #undef START
  #undef RESC
  #undef ROT
}
constexpr int ATTN_LDS_BYTES=LDS_BYTES;
#undef SBAR
#undef WAIT_BAR
}

__device__ __forceinline__ float wave_sum_fast(float v) {
#define WS_DPP_(ctrl, rm, bc) v += __int_as_float(__builtin_amdgcn_update_dpp(0, __float_as_int(v), ctrl, rm, 0xf, bc))
    WS_DPP_(0x111, 0xf, true); WS_DPP_(0x112, 0xf, true); WS_DPP_(0x114, 0xf, true); WS_DPP_(0x118, 0xf, true); WS_DPP_(0x142, 0xa, false); WS_DPP_(0x143, 0xc, false);
#undef WS_DPP_
    return __int_as_float(__builtin_amdgcn_readlane(__float_as_int(v), 63));
}
__device__ __forceinline__ int rowmap(int map, int n) {
    if (map == 1) { const int up = n >= 2816; const int j = up ? n - 2816 : n; return 256 * (j >> 7) + (up ? 128 : 0) + (j & 127); }
    if (map == 2) {
        if (n < 3072) { const int part = n >> 9, cc = n & 511, tl = cc >> 8, wc = (cc & 255) >> 6, d = cc & 63; return 256 * (2 * part + tl) + 128 * (d >> 5) + 32 * wc + (d & 31); }
        if (n < 3328) return 256 * 12 + (n - 3072);
        if (n < 3396) return 256 * 13 + (n - 3328);
        if (n < 5444) return 256 * 14 + (n - 3396);
        return 256 * 13 + 68 + (n - 5444);
    }
    if (map == 3) return 1024 + n;
    return n;
}
__device__ __forceinline__ void conv_item(const float* __restrict__ W, int ldw, int N, int Nw, const float* __restrict__ gain, bf16_t* WT, int ldk, int map, int koff, LAS float* scr, int item, int lane) {
    const int nblk = (Nw + 31) >> 5, kb = item / nblk, nb = item % nblk, k0 = 64 * kb, n0 = 32 * nb;
    const int rr = lane >> 3, c4 = (lane & 7) * 4; const bool inb = (n0 + c4) < N;
    f32x4 v[8];
#pragma unroll
    for (int i = 0; i < 8; ++i) v[i] = inb ? __builtin_nontemporal_load((const GAS f32x4*)(W + (size_t)(k0 + 8 * i + rr) * ldw + n0 + c4)) : (f32x4){0.f, 0.f, 0.f, 0.f};
#pragma unroll
    for (int i = 0; i < 8; ++i) { const int kk = 8 * i + rr; const float gk = gain ? gain[k0 + kk] : 1.0f; LAS float* s = scr + kk * 33 + c4;
        s[0] = v[i][0] * gk; s[1] = v[i][1] * gk; s[2] = v[i][2] * gk; s[3] = v[i][3] * gk; }
    LDS_WAIT(); asm volatile("" ::: "memory");
    const int c = lane & 7;
#pragma unroll
    for (int j = 0; j < 4; ++j) { const int n = (lane >> 3) + 8 * j; const LAS float* s = scr + (8 * c) * 33 + n;
        if (n0 + n < Nw) {
            v4u o; o.x = pk2(s[0 * 33], s[1 * 33]); o.y = pk2(s[2 * 33], s[3 * 33]); o.z = pk2(s[4 * 33], s[5 * 33]); o.w = pk2(s[6 * 33], s[7 * 33]);
            *(GAS v4u*)((unsigned char*)WT + pg8::tiled_b_off(rowmap(map, n0 + n), koff + k0 + 8 * c, ldk >> 6)) = o; } }
    LDS_WAIT(); asm volatile("" ::: "memory");
}

struct Args { const float* in[18]; float* out; unsigned char* ws; int ph_lo, ph_hi, li, pad; };
enum { I_X = 0, I_N1, I_GU1, I_DN1, I_NM, I_WIN, I_BG, I_QNA, I_KNA, I_QNB, I_KNB, I_WBA, I_WBB, I_WO, I_N2, I_GU2, I_DN2, I_RB };

namespace CV { constexpr int I0 = 16 * 176, I1 = 44 * 32, I2 = 16 * 176, I3 = 8 * 32, I4 = 8 * 32, I5 = 16 * 32;
               constexpr int A0 = 0, A1 = I0 + I1 + I2, A2 = A1 + I0, A3 = A2 + I1 + I3 + I4 + I5; }
__device__ __forceinline__ void conv_range(const Args& args, LAS unsigned char* L, int it_lo, int it_hi, int gw, int NGW, int lane) {
    using namespace K; using namespace CV;
    unsigned char* ws = args.ws;
    LAS float* scr = (LAS float*)(L + RING_OFF + (gw & 7) * 16384);
    for (int it = it_lo + gw; it < it_hi; it += NGW) {
        int r = it;
        if (r < I0) { conv_item(args.in[I_GU1], 2 * DFF, 2 * DFF, 2 * DFF, args.in[I_N1], (bf16_t*)(ws + WS::GU1), D, 1, 0, scr, r, lane); continue; } r -= I0;
        if (r < I1) { conv_item(args.in[I_DN1], D, D, D, nullptr, (bf16_t*)(ws + WS::DN1), DFF, 0, 0, scr, r, lane); continue; } r -= I1;
        if (r < I2) { conv_item(args.in[I_WIN], DIN, DIN, 5632, args.in[I_NM], (bf16_t*)(ws + WS::WIN), D, 2, 0, scr, r, lane); continue; } r -= I2;
        if (r < I0) { conv_item(args.in[I_GU2], 2 * DFF, 2 * DFF, 2 * DFF, args.in[I_N2], (bf16_t*)(ws + WS::GU2), D, 1, 0, scr, r, lane); continue; } r -= I0;
        if (r < I1) { conv_item(args.in[I_DN2], D, D, D, nullptr, (bf16_t*)(ws + WS::DN2), DFF, 0, 0, scr, r, lane); continue; } r -= I1;
        if (r < I3) { conv_item(args.in[I_WBA], D, D, D, nullptr, (bf16_t*)(ws + WS::WB), D, 0, 0, scr, r, lane); continue; } r -= I3;
        if (r < I4) { conv_item(args.in[I_WBB], D, D, D, nullptr, (bf16_t*)(ws + WS::WB), D, 0, 512, scr, r, lane); continue; } r -= I4;
        conv_item(args.in[I_WO], D, D, D, nullptr, (bf16_t*)(ws + WS::WO), D, 0, 0, scr, r, lane);
    }
}
__device__ __forceinline__ void p0_prologue(const Args& args, LAS unsigned char* L, int gw, int NGW, int lane, int gtid, int ngt, int it_hi) {
    using namespace K;
    unsigned char* ws = args.ws;
    conv_range(args, L, CV::A0, it_hi, gw, NGW, lane);
    const float* x = args.in[I_X];
    for (int m0 = 2 * gw; m0 < M; m0 += 2 * NGW) {
        f32x4 v[2][4]; float s[2] = {0.f, 0.f};
#pragma unroll
        for (int rr = 0; rr < 2; ++rr) { const GAS f32x4* xr = (const GAS f32x4*)(x + (size_t)(m0 + rr) * D) + lane;
#pragma unroll
            for (int j = 0; j < 4; ++j) v[rr][j] = __builtin_nontemporal_load(xr + 64 * j); }
#pragma unroll
        for (int rr = 0; rr < 2; ++rr) {
#pragma unroll
            for (int j = 0; j < 4; ++j) s[rr] += (v[rr][j][0] * v[rr][j][0] + v[rr][j][1] * v[rr][j][1]) + (v[rr][j][2] * v[rr][j][2] + v[rr][j][3] * v[rr][j][3]);
            s[rr] = wave_sum_fast(s[rr]);
            GAS unsigned long long* o8 = (GAS unsigned long long*)(ws + WS::XB + (size_t)(m0 + rr) * D * 2) + lane;
#pragma unroll
            for (int j = 0; j < 4; ++j) o8[64 * j] = (unsigned long long)pk2(v[rr][j][0], v[rr][j][1]) | ((unsigned long long)pk2(v[rr][j][2], v[rr][j][3]) << 32);
            if (lane < 4) { f32x4 q = {lane == 0 ? s[rr] : 0.f, 0.f, 0.f, 0.f}; *((GAS f32x4*)(ws + WS::SSQ + (size_t)(m0 + rr) * 64) + lane) = q; }
        }
    }
}

__global__ void __launch_bounds__(NWAVES * 64, 2) mega(Args args) {
    extern __shared__ __attribute__((aligned(16))) unsigned char lds[];
    using namespace K;
    LAS unsigned char* L = (LAS unsigned char*)lds;
    volatile LAS unsigned* MISC = (volatile LAS unsigned*)(L + MISC_OFF);
    const int tid = threadIdx.x, lane = tid & 63, wave = __builtin_amdgcn_readfirstlane(tid >> 6);
    const int G = gridDim.x, bx = blockIdx.x; const int vcu = (G % 8 == 0) ? (bx % 8) * (G / 8) + bx / 8 : bx;
    unsigned char* ws = args.ws;
    for (int u = tid; u < (LDS_BYTES - LDSCTL_OFF) / 4; u += NWAVES * 64) ((LAS unsigned*)(L + LDSCTL_OFF))[u] = 0u;
    __syncthreads();
    XcdBarrier bar = xcd_barrier_post((unsigned*)(ws + WS::CTL) + CW_BAR + args.li * XCD_BAR_WORDS, MISC + 8);
    const int lo = args.ph_lo, hi = args.ph_hi;
#define IN(k) (lo <= (k) && (k) < hi)
#define SEAM(k) do { if (IN(k) && IN((k) + 1)) xcd_barrier(bar); } while (0)
    int cg = bx; bool xlocal = false;
#define SEAM_L(k) do { if (IN(k) && IN((k) + 1)) { if (xlocal) xcd_barrier_local(bar); else xcd_barrier(bar); } } while (0)
    bf16_t* XB = (bf16_t*)(ws + WS::XB); bf16_t* ACT = (bf16_t*)(ws + WS::ACT); float* SSQ = (float*)(ws + WS::SSQ);

    if (IN(0)) { p0_prologue(args, L, vcu * NWAVES + wave, G * NWAVES, lane, bx * (NWAVES * 64) + tid, G * NWAVES * 64, (IN(1) && IN(3) && G == 256) ? CV::I0 : CV::A3); SEAM(0); }
    if (IN(0) && IN(1)) {
        if (tid == 0) { unsigned* bw = (unsigned*)(ws + WS::CTL) + CW_BAR + args.li * XCD_BAR_WORDS; bool ok = (G == 256);
            for (int j = 0; j < 16; ++j) { const unsigned c = xb_ld(&bw[XB_XCNT(j)]); ok = ok && (c == (j < 8 ? 32u : 0u)); }
            MISC[11] = ok ? 1u : 0u; }
        __syncthreads();
        xlocal = MISC[11] != 0u; if (xlocal) cg = (int)MISC[10] * 8 + (int)bar.x;
    }
    if (IN(1)) {
        pg8::Gemm g{XB, (const bf16_t*)(ws + WS::GU1), M, 2 * DFF, D, D, 1 << 30, 0}; pg8::StaticOrder S; S.init(M, 2 * DFF, G, cg);
        pg8::EpiGu E{ACT, SSQ, (LAS float*)(L + RTAB_OFF)};
        pg8::gemm_phase<pg8::EpiGu, pg8::StaticOrder, true, true>(L + RING_OFF, g, S, E);
        if (IN(0) && IN(3) && G == 256) {
            if (cg >= 128) conv_range(args, L, CV::I0, CV::A1, (cg - 128) * NWAVES + wave, 128 * NWAVES, lane);
            SEAM(1);
        } else SEAM_L(1);
    }
    if (IN(2)) {
        pg8::Gemm g{ACT, (const bf16_t*)(ws + WS::DN1), M, D, DFF, DFF, 1 << 30, 0}; pg8::StaticOrder S; S.init(M, D, G, cg);
        pg8::EpiRes<false, false, true> E{nullptr, XB, nullptr, XB, SSQ, 0.5f};
        pg8::gemm_phase<pg8::EpiRes<false, false, true>, pg8::StaticOrder, true, true>(L + RING_OFF, g, S, E);
        SEAM_L(2);
    }
    if (IN(3)) {
        pg8::Gemm g{XB, (const bf16_t*)(ws + WS::WIN), M, 5632, D, D, 1 << 30, 0}; pg8::StaticOrder S; S.init(M, 5632, G, cg);
        {
            LAS float* gt = (LAS float*)(L + GTAB_OFF);
            for (int i = tid; i < 2304; i += NWAVES * 64) gt[i] = (i < 64) ? args.in[I_QNA][i] : (i < 128) ? args.in[I_KNA][i - 64] : (i < 192) ? args.in[I_QNB][i - 128] : (i < 256) ? args.in[I_KNB][i - 192] : args.in[I_BG][i - 256];
            asm volatile("s_waitcnt lgkmcnt(0)" ::: "memory");
        }
        pg8::EpiIn E{(bf16_t*)(ws + WS::QO), (bf16_t*)(ws + WS::KB), (bf16_t*)(ws + WS::VB), (bf16_t*)(ws + WS::GATES), (bf16_t*)(ws + WS::QI), (bf16_t*)(ws + WS::KI), (float*)(ws + WS::WI), (float*)(ws + WS::KMEAN), SSQ,
                     (LAS const float*)(L + GTAB_OFF), (LAS float*)(L + RTAB_OFF)};
        pg8::gemm_phase<pg8::EpiIn, pg8::StaticOrder, true, true>(L + RING_OFF, g, S, E);
        if (IN(0) && IN(1) && G == 256 && cg >= 128) conv_range(args, L, CV::A1, CV::A3, (cg - 128) * NWAVES + wave, 128 * NWAVES, lane);
        SEAM(3);
    }
    if (IN(4)) {
        int tid4_ = threadIdx.x; asm volatile("" : "+v"(tid4_)); const int tid = tid4_, lane = tid & 63;
        {
#define TK_POS(it_, bb_, tq_) do { bb_ = (it_) >> 8; const int v_ = (it_) & 255, vv_ = (v_ + 128 * (bb_ >> 1)) & 255; tq_ = 16 * ((bb_ & 1) ? 255 - vv_ : vv_); } while (0)
            int bb = 0, tq = -1;
            if (vcu < 1024) { TK_POS(vcu, bb, tq); if (tq >= TOPK) tk::tk_store_q(L, tk::tk_load_q((const bf16_t*)(ws + WS::QI), bb, tq, lane, wave), lane, wave); }
            for (int blk = vcu; blk < M / 64; blk += G) tk::gating_block(L, (const bf16_t*)(ws + WS::QO), (const float*)(ws + WS::KMEAN), (unsigned*)(ws + WS::BMASK), blk, tid);
            for (int it = vcu; it < 1024; it += G) {
                int nb = 0, ntq = -1; if (it + G < 1024) TK_POS(it + G, nb, ntq);
                tk::topk_group<0>(L, (const bf16_t*)(ws + WS::QI), (const bf16_t*)(ws + WS::KI), (const float*)(ws + WS::WI), (u64*)args.out, bb, tq, nb, ntq, tid, lane, wave);
                bb = nb; tq = ntq;
            }
#undef TK_POS
        }
        SEAM(4);
    }
    if (IN(5)) {
        static_assert(attn_body::ATTN_LDS_BYTES <= RING_BYTES, "attention LDS vs frame");
        const attn_body::bf16* Qp = (const attn_body::bf16*)(ws + WS::QO); const attn_body::bf16* Kp = (const attn_body::bf16*)(ws + WS::KB); const attn_body::bf16* Vp = (const attn_body::bf16*)(ws + WS::VB);
        for (int p = vcu; p < 512; p += G) {
            const int s = p & 7, bh = (p < 256) ? (p >> 3) : (32 + (((p - 256) >> 3) ^ 8));
            if ((bh & 15) >= 8) { for (int k = 0; k < 2; ++k)
                attn_body::attn_unit<8, true>(bh >> 4, bh & 15, k ? s : 15 - s, Qp, Kp, Vp, (attn_body::bf16*)(ws + WS::QO), (const unsigned long long*)args.out, (const unsigned*)(ws + WS::BMASK), args.in[I_RB], args.in[I_QNB], args.in[I_KNB], (char*)lds); }
            else { for (int k = 0; k < 2; ++k)
                attn_body::attn_unit<8, false>(bh >> 4, bh & 15, k ? s : 15 - s, Qp, Kp, Vp, (attn_body::bf16*)(ws + WS::QO), (const unsigned long long*)args.out, (const unsigned*)(ws + WS::BMASK), args.in[I_RB], args.in[I_QNA], args.in[I_KNA], (char*)lds); }
        }
        SEAM(5);
    }
    if (IN(6)) {
        pg8::Gemm g{(const bf16_t*)(ws + WS::QO), (const bf16_t*)(ws + WS::WB), M, D, D, D, 1 << 30, 0}; pg8::StaticOrder S; S.init(M, D, G, cg);
        pg8::EpiBranch2 E{(const bf16_t*)(ws + WS::GATES), (bf16_t*)(ws + WS::GM)};
        pg8::gemm_phase<pg8::EpiBranch2, pg8::StaticOrder, true, true>(L + RING_OFF, g, S, E);
        SEAM_L(6);
    }
    if (IN(7)) {
        pg8::Gemm g{(const bf16_t*)(ws + WS::GM), (const bf16_t*)(ws + WS::WO), M, D, D, D, 1 << 30, 0}; pg8::StaticOrder S; S.init(M, D, G, cg);
        pg8::EpiRes<false, false, true> E{nullptr, XB, nullptr, XB, SSQ, 1.0f};
        pg8::gemm_phase<pg8::EpiRes<false, false, true>, pg8::StaticOrder, true, true>(L + RING_OFF, g, S, E);
        SEAM_L(7);
    }
    if (IN(8)) {
        pg8::Gemm g{XB, (const bf16_t*)(ws + WS::GU2), M, 2 * DFF, D, D, 1 << 30, 0}; pg8::StaticOrder S; S.init(M, 2 * DFF, G, cg);
        pg8::EpiGu E{ACT, SSQ, (LAS float*)(L + RTAB_OFF)};
        pg8::gemm_phase<pg8::EpiGu, pg8::StaticOrder, true, true>(L + RING_OFF, g, S, E);
        SEAM_L(8);
    }
    if (IN(9)) {
        pg8::Gemm g{ACT, (const bf16_t*)(ws + WS::DN2), M, D, DFF, DFF, 1 << 30, 0}; pg8::StaticOrder S; S.init(M, D, G, cg);
        pg8::EpiRes<false, true, false> E{nullptr, XB, args.out, nullptr, nullptr, 0.5f};
        pg8::gemm_phase<pg8::EpiRes<false, true, false>, pg8::StaticOrder, true, true>(L + RING_OFF, g, S, E);
    }
#undef IN
#undef SEAM
#undef SEAM_L
}

extern "C" void kernel_launch(void* const* d_in, const int* in_sizes, int n_in, void* d_out, int out_size, void* d_ws, size_t ws_size, hipStream_t stream) {
    using namespace K;
    static int grid = 0;
    if (grid == 0) {
        if (n_in != 18 || in_sizes[0] != M * D || out_size != M * D || ws_size < WS::END) { fprintf(stderr, "kernel_launch: unexpected shapes (n_in %d, in0 %d, out %d, ws %zu)\n", n_in, n_in > 0 ? in_sizes[0] : -1, out_size, ws_size); grid = -1; return; }
        int dev = 0, cus = 0, per_cu = 0;
        if (hipGetDevice(&dev) != hipSuccess || hipDeviceGetAttribute(&cus, hipDeviceAttributeMultiprocessorCount, dev) != hipSuccess) { grid = -1; return; }
        if (hipFuncSetAttribute((const void*)mega, hipFuncAttributeMaxDynamicSharedMemorySize, LDS_BYTES) != hipSuccess) { fprintf(stderr, "kernel_launch: hipFuncSetAttribute failed\n"); grid = -1; return; }
        if (hipOccupancyMaxActiveBlocksPerMultiprocessor(&per_cu, (const void*)mega, NWAVES * 64, LDS_BYTES) != hipSuccess || per_cu < 1) { fprintf(stderr, "kernel_launch: occupancy query says %d blocks/CU\n", per_cu); (void)hipGetLastError(); grid = -1; return; }
        grid = cus;
    }
    if (grid < 0) return;
    const float* const* in = (const float* const*)d_in;
    float* out = (float*)d_out; char* ws = (char*)d_ws;
    (void)hipMemsetAsync(ws + WS::CTL, 0, WS::CTL_ZERO_BYTES, stream);
    Args a{};
    for (int i = 0; i < 18; ++i) a.in[i] = in[i];
    a.out = out; a.ws = (unsigned char*)d_ws; a.pad = 0;
    a.ph_lo = 0; a.ph_hi = 10; a.li = 0;
    hipLaunchKernelGGL(mega, dim3(grid), dim3(NWAVES * 64), LDS_BYTES, stream, a);

}
```
